# Optimizing an MI355X kernel written in HIP

```python
import jax, jax.numpy as jnp
from jax import lax
import numpy as np

D_MODEL = 2048
BATCH = 4
SEQ = 2048
DEPTH = 2

GRID_W = 64
CTX_LEN = 256
HEAD_DIM = 128
HEADS_A = 8
KV_HEADS_A = 2
GROUP_A = HEADS_A // KV_HEADS_A
HEADS_B = 8
KV_HEADS_B = 2
GROUP_B = HEADS_B // KV_HEADS_B
WIDTH_A = HEADS_A * HEAD_DIM
KVW_A = KV_HEADS_A * HEAD_DIM
WIDTH_B = HEADS_B * HEAD_DIM
KVW_B = KV_HEADS_B * HEAD_DIM
IN_WIDTHS = (WIDTH_A, KVW_A, KVW_A, WIDTH_B, KVW_B, KVW_B, D_MODEL, D_MODEL)
IN_COLS = WIDTH_A + 2 * KVW_A + WIDTH_B + 2 * KVW_B + 2 * D_MODEL
Q_BLOCK = 128
WINDOW = 128
ROPE_BASE = 10000.0
ATTN_SCALE = HEAD_DIM ** -0.5
N_GROUPS = 8
EXPERTS_PER_GROUP = 8
N_EXPERTS = N_GROUPS * EXPERTS_PER_GROUP
TOP_K = 2
D_EXPERT = D_MODEL // 4
MOE_BLOCK = 128
EPS = 1e-6
NEG_INF = -1e30

kernel_name = "hybrid_dit_gqa_window_sink_hmoe"


def _rmsnorm(x, w):
    xf = x.astype(jnp.float32)
    y = xf * lax.rsqrt(jnp.mean(xf * xf, axis=-1, keepdims=True) + EPS)
    return (y * w.astype(jnp.float32)).astype(x.dtype)


def _modulate(x, shift, scale):
    return x * (1.0 + scale) + shift


def _split_in(p):
    idx, acc = [], 0
    for w in IN_WIDTHS[:-1]:
        acc += w
        idx.append(acc)
    return jnp.split(p, idx, axis=-1)


def _rope2d(x, row, col):
    half = HEAD_DIM // 2
    n_freq = half // 2
    freqs = ROPE_BASE ** (-jnp.arange(n_freq, dtype=jnp.float32) / n_freq)
    expand = (slice(None),) + (None,) * (x.ndim - 3)

    def rot(xh, pos):
        ang = pos.astype(jnp.float32)[:, None] * freqs[None, :]
        cos, sin = jnp.cos(ang)[expand], jnp.sin(ang)[expand]
        x1, x2 = xh[..., :n_freq], xh[..., n_freq:]
        return jnp.concatenate([x1 * cos - x2 * sin, x1 * sin + x2 * cos], axis=-1)

    xf = x.astype(jnp.float32)
    out = jnp.concatenate([rot(xf[..., :half], row), rot(xf[..., half:], col)], axis=-1)
    return out.astype(x.dtype)


def _dense_attention(q, k, v):
    s = jnp.einsum('bqkgd,bskd->bkgqs', q, k).astype(jnp.float32) * ATTN_SCALE
    p = jax.nn.softmax(s, axis=-1).astype(v.dtype)
    return jnp.einsum('bkgqs,bskd->bqkgd', p, v)


def _block_dense_attention(q, k, v):
    B, S = q.shape[:2]
    nb = S // Q_BLOCK
    qb = q.reshape((B, nb, Q_BLOCK) + q.shape[2:]).swapaxes(0, 1)
    out = lax.map(lambda qi: _dense_attention(qi, k, v), qb)
    return out.swapaxes(0, 1).reshape(q.shape)


def _window_sink_attention(q, k, v, kc, vc, sink):
    B, S, KV, G, D = q.shape
    nb = S // Q_BLOCK
    qb = q.reshape(B, nb, Q_BLOCK, KV, G, D)
    pad = ((0, 0), (Q_BLOCK, Q_BLOCK), (0, 0), (0, 0))
    kp = jnp.pad(k, pad).reshape(B, nb + 2, Q_BLOCK, KV, D)
    vp = jnp.pad(v, pad).reshape(B, nb + 2, Q_BLOCK, KV, D)

    def band(t):
        return jnp.concatenate([t[:, :-2], t[:, 1:-1], t[:, 2:]], axis=2)

    kb, vb = band(kp), band(vp)
    blk = jnp.arange(nb, dtype=jnp.int32)[:, None] * Q_BLOCK
    qidx = blk + jnp.arange(Q_BLOCK, dtype=jnp.int32)[None, :]
    kidx = blk - Q_BLOCK + jnp.arange(3 * Q_BLOCK, dtype=jnp.int32)[None, :]
    valid = ((jnp.abs(qidx[:, :, None] - kidx[:, None, :]) <= WINDOW)
             & (kidx[:, None, :] >= 0) & (kidx[:, None, :] < S))
    s_loc = jnp.einsum('bnqkgd,bnskd->bnkgqs', qb, kb).astype(jnp.float32) * ATTN_SCALE
    s_loc = jnp.where(valid[None, :, None, None], s_loc, NEG_INF)
    s_ctx = jnp.einsum('bnqkgd,bckd->bnkgqc', qb, kc).astype(jnp.float32) * ATTN_SCALE
    s_sink = jnp.broadcast_to(sink.astype(jnp.float32).reshape(1, 1, KV, G, 1, 1),
                              s_loc.shape[:-1] + (1,))
    p = jax.nn.softmax(jnp.concatenate([s_loc, s_ctx, s_sink], axis=-1), axis=-1).astype(v.dtype)
    n_loc = 3 * Q_BLOCK
    n_ctx = kc.shape[1]
    out = (jnp.einsum('bnkgqs,bnskd->bnqkgd', p[..., :n_loc], vb)
           + jnp.einsum('bnkgqc,bckd->bnqkgd', p[..., n_loc:n_loc + n_ctx], vc))
    return out.reshape(B, S, KV, G, D)


def _ctx_sink_attention(q, k, v, sink):
    B, C, KV, G, D = q.shape
    s = jnp.einsum('bqkgd,bskd->bkgqs', q, k).astype(jnp.float32) * ATTN_SCALE
    s_sink = jnp.broadcast_to(sink.astype(jnp.float32).reshape(1, KV, G, 1, 1), s.shape[:-1] + (1,))
    p = jax.nn.softmax(jnp.concatenate([s, s_sink], axis=-1), axis=-1)[..., :-1].astype(v.dtype)
    return jnp.einsum('bkgqs,bskd->bqkgd', p, v)


def _merge(ya, yb, ga, gb, w_br_a, w_br_b, w_out):
    m = jax.nn.sigmoid(ga) * (ya @ w_br_a) + jax.nn.sigmoid(gb) * (yb @ w_br_b)
    return m @ w_out


def _moe(h, w_rg, b_rg, w_re, b_re, w1, w3, w2):
    N, D = h.shape
    gl = (h @ w_rg).astype(jnp.float32) + b_rg.astype(jnp.float32)
    g = jnp.argmax(gl, axis=-1).astype(jnp.int32)
    pg = jnp.take_along_axis(jax.nn.softmax(gl, axis=-1), g[:, None], axis=-1)
    el = ((h @ w_re).astype(jnp.float32) + b_re.astype(jnp.float32)).reshape(N, N_GROUPS, EXPERTS_PER_GROUP)
    el_g = jnp.take_along_axis(el, g[:, None, None], axis=1)[:, 0]
    tv, ti = lax.top_k(el_g, TOP_K)
    wts = jax.nn.softmax(tv, axis=-1) * pg
    eid = g[:, None] * EXPERTS_PER_GROUP + ti.astype(jnp.int32)

    A = N * TOP_K
    e_flat = eid.reshape(A)
    w_flat = wts.reshape(A)
    tok = jnp.repeat(jnp.arange(N, dtype=jnp.int32), TOP_K)
    order = jnp.argsort(e_flat)
    e_s, tok_s, w_s = e_flat[order], tok[order], w_flat[order]
    counts = jnp.bincount(e_flat, length=N_EXPERTS).astype(jnp.int32)
    start = jnp.cumsum(counts) - counts
    padded = (counts + MOE_BLOCK - 1) // MOE_BLOCK * MOE_BLOCK
    pad_end = jnp.cumsum(padded)
    pad_start = pad_end - padded
    dest = pad_start[e_s] + jnp.arange(A, dtype=jnp.int32) - start[e_s]
    n_blk = -(-A // MOE_BLOCK) + N_EXPERTS
    P = n_blk * MOE_BLOCK
    xbuf = jnp.zeros((P, D), h.dtype).at[dest].set(h[tok_s])
    blk_e = jnp.clip(jnp.searchsorted(pad_end, jnp.arange(n_blk, dtype=jnp.int32) * MOE_BLOCK, side='right'),
                     0, N_EXPERTS - 1)

    def expert_block(args):
        xb, e = args
        return (jax.nn.silu(xb @ w1[e]) * (xb @ w3[e])) @ w2[e]

    ybuf = lax.map(expert_block, (xbuf.reshape(n_blk, MOE_BLOCK, D), blk_e)).reshape(P, D)
    contrib = (ybuf[dest] * w_s[:, None]).astype(h.dtype)
    return jnp.zeros((N, D), h.dtype).at[tok_s].add(contrib)


def _layer(x, xc, c, c_ctx, w_mod, b_mod, norm_mix, norm_ffn, w_in, qn_a, kn_a, sink_b,
           w_br_a, w_br_b, w_out, w_rg, b_rg, w_re, b_re, w1, w3, w2, row, col, ctx_out):
    B, S, D = x.shape
    C = xc.shape[1]
    mod = jax.nn.silu(c) @ w_mod + b_mod
    sh1, sc1, g1, sh2, sc2, g2 = [m[:, None, :] for m in jnp.split(mod, 6, axis=-1)]
    modc = jax.nn.silu(c_ctx) @ w_mod + b_mod
    csh1, csc1, cg1, csh2, csc2, cg2 = jnp.split(modc, 6, axis=-1)

    h = _modulate(_rmsnorm(x, norm_mix), sh1, sc1)
    hc = _modulate(_rmsnorm(xc, norm_mix), csh1, csc1)
    p = jnp.concatenate([hc, h], axis=1) @ w_in
    qa, ka, va, qb, kb, vb, ga, gb = _split_in(p)
    T = C + S
    qa = _rmsnorm(qa.reshape(B, T, KV_HEADS_A, GROUP_A, HEAD_DIM), qn_a)
    ka = _rmsnorm(ka.reshape(B, T, KV_HEADS_A, HEAD_DIM), kn_a)
    va = va.reshape(B, T, KV_HEADS_A, HEAD_DIM)
    qb = qb.reshape(B, T, KV_HEADS_B, GROUP_B, HEAD_DIM)
    kb = kb.reshape(B, T, KV_HEADS_B, HEAD_DIM)
    vb = vb.reshape(B, T, KV_HEADS_B, HEAD_DIM)

    ka_all = jnp.concatenate([ka[:, :C], _rope2d(ka[:, C:], row, col)], axis=1)
    ya = _block_dense_attention(_rope2d(qa[:, C:], row, col), ka_all, va).reshape(B, S, WIDTH_A)
    yb = _window_sink_attention(_rope2d(qb[:, C:], row, col), _rope2d(kb[:, C:], row, col),
                                vb[:, C:], kb[:, :C], vb[:, :C], sink_b).reshape(B, S, WIDTH_B)
    x = x + g1 * _merge(ya, yb, ga[:, C:], gb[:, C:], w_br_a, w_br_b, w_out)

    if ctx_out:
        ya_c = _dense_attention(qa[:, :C], ka[:, :C], va[:, :C]).reshape(B, C, WIDTH_A)
        yb_c = _ctx_sink_attention(qb[:, :C], kb[:, :C], vb[:, :C], sink_b).reshape(B, C, WIDTH_B)
        xc = xc + cg1 * _merge(ya_c, yb_c, ga[:, :C], gb[:, :C], w_br_a, w_br_b, w_out)
        h2 = _modulate(_rmsnorm(x, norm_ffn), sh2, sc2)
        h2c = _modulate(_rmsnorm(xc, norm_ffn), csh2, csc2)
        tokens = jnp.concatenate([h2c.reshape(B * C, D), h2.reshape(B * S, D)], axis=0)
        y = _moe(tokens, w_rg, b_rg, w_re, b_re, w1, w3, w2)
        xc = xc + cg2 * y[:B * C].reshape(B, C, D)
        y_lat = y[B * C:].reshape(B, S, D)
    else:
        h2 = _modulate(_rmsnorm(x, norm_ffn), sh2, sc2)
        y_lat = _moe(h2.reshape(B * S, D), w_rg, b_rg, w_re, b_re, w1, w3, w2).reshape(B, S, D)
    x = x + g2 * y_lat
    return x, xc


def setup_inputs(seed: int = 0) -> dict:
    key = jax.random.key(seed)
    ks = jax.random.split(key, 24)
    f32 = jnp.float32

    def nrm(k, shape, scale):
        return jax.random.normal(k, shape, f32) * scale

    D, L = D_MODEL, DEPTH
    return {
        "x": nrm(ks[0], (BATCH, SEQ, D), 1.0),
        "c": nrm(ks[1], (BATCH, D), 1.0),
        "ctx": nrm(ks[2], (BATCH, CTX_LEN, D), 1.0),
        "c_ctx": nrm(ks[3], (D,), 1.0),
        "w_mod": nrm(ks[4], (L, D, 6 * D), 0.5 * D ** -0.5),
        "b_mod": nrm(ks[5], (L, 6 * D), 0.02),
        "norm_mix": 1.0 + nrm(ks[6], (L, D), 0.02),
        "norm_ffn": 1.0 + nrm(ks[7], (L, D), 0.02),
        "w_in": nrm(ks[8], (L, D, IN_COLS), D ** -0.5),
        "qn_a": 1.0 + nrm(ks[9], (L, HEAD_DIM), 0.02),
        "kn_a": 1.0 + nrm(ks[10], (L, HEAD_DIM), 0.02),
        "sink_b": nrm(ks[11], (L, HEADS_B), 0.5),
        "w_br_a": nrm(ks[12], (L, WIDTH_A, D), WIDTH_A ** -0.5),
        "w_br_b": nrm(ks[13], (L, WIDTH_B, D), WIDTH_B ** -0.5),
        "w_out": nrm(ks[14], (L, D, D), D ** -0.5),
        "w_rg": nrm(ks[15], (L, D, N_GROUPS), D ** -0.5),
        "b_rg": nrm(ks[16], (L, N_GROUPS), 0.01),
        "w_re": nrm(ks[17], (L, D, N_EXPERTS), D ** -0.5),
        "b_re": nrm(ks[18], (L, N_EXPERTS), 0.01),
        "w1": nrm(ks[19], (L, N_EXPERTS, D, D_EXPERT), D ** -0.5),
        "w3": nrm(ks[20], (L, N_EXPERTS, D, D_EXPERT), D ** -0.5),
        "w2": nrm(ks[21], (L, N_EXPERTS, D_EXPERT, D), D_EXPERT ** -0.5),
        "norm_final": 1.0 + nrm(ks[22], (D,), 0.02),
    }


def reference(x, c, ctx, c_ctx, w_mod, b_mod, norm_mix, norm_ffn, w_in, qn_a, kn_a, sink_b,
              w_br_a, w_br_b, w_out, w_rg, b_rg, w_re, b_re, w1, w3, w2, norm_final):
    S = x.shape[1]
    rows_n = S // GRID_W
    row = jnp.repeat(jnp.arange(rows_n, dtype=jnp.int32), GRID_W)
    col = jnp.tile(jnp.arange(GRID_W, dtype=jnp.int32), rows_n)
    xc = ctx
    for l in range(DEPTH):
        x, xc = _layer(x, xc, c, c_ctx, w_mod[l], b_mod[l], norm_mix[l], norm_ffn[l], w_in[l],
                       qn_a[l], kn_a[l], sink_b[l], w_br_a[l], w_br_b[l], w_out[l],
                       w_rg[l], b_rg[l], w_re[l], b_re[l], w1[l], w3[l], w2[l],
                       row, col, l < DEPTH - 1)
    return _rmsnorm(x, norm_final)
```

```cpp
#include <hip/hip_runtime.h>
#include <cstdio>
#include <cstdint>

constexpr int D = 2048, NB = 4, SEQ = 2048, CTX = 256, TT = CTX + SEQ, M = NB * TT, DEPTH = 2;
constexpr int HD = 128, NH = 8, NKV = 2, GRIDW = 64;
constexpr int QW = NH * HD, KW = NKV * HD;
constexpr int INC = 2 * QW + 4 * KW + 2 * D;
constexpr int OFF_QA = 0, OFF_KA = 1024, OFF_VA = 1280, OFF_QB = 1536, OFF_KB = 2560, OFF_VB = 2816, OFF_GA = 3072, OFF_GB = 5120;
constexpr int NE = 64, NG = 8, EPG = 8, DE = 512;
constexpr float EPS = 1e-6f;
constexpr float ATTN_SCALE = 0.08838834764831845f;
constexpr int MODW = 6 * D;
constexpr int NIN = 23;

__host__ __device__ __forceinline__ int perm_d2j(int d) { return 32 * (2 * (d >> 6) + ((d >> 4) & 1)) + 16 * ((d >> 5) & 1) + (d & 15); }
__host__ __device__ __forceinline__ int perm_j2d(int j) { const int wc = j >> 5, n = (j >> 4) & 1, t = j & 15; return 64 * (wc >> 1) + 32 * n + 16 * (wc & 1) + t; }
__host__ __device__ __forceinline__ bool inproj_roped(int c) { return (c < OFF_VA) || (c >= OFF_QB && c < OFF_VB); }
__host__ __device__ __forceinline__ int inproj_src_col(int c) { return inproj_roped(c) ? (c & ~127) + perm_j2d(c & 127) : c; }
__host__ __device__ __forceinline__ int inproj_dst_col(int n) { return inproj_roped(n) ? (n & ~127) + perm_d2j(n & 127) : n; }

constexpr size_t MiB = 1u << 20;
constexpr size_t WS_CTL = 0, CTL_ZERO_BYTES = 1 * MiB;
constexpr size_t WS_MOD = 1 * MiB;
constexpr size_t WS_ROPE = 1 * MiB + 512 * 1024;
constexpr size_t WS_TOK = 2 * MiB;
constexpr size_t WS_LIST = 3 * MiB;
constexpr size_t WS_WIN = 8 * MiB;
constexpr size_t WS_WBR = 64 * MiB;
constexpr size_t WS_WOUT = 80 * MiB;
constexpr size_t WS_XW = 96 * MiB;
constexpr size_t WS_HA = 168 * MiB;
constexpr size_t WS_QA = 204 * MiB, WS_KA = 222 * MiB, WS_VA = 227 * MiB, WS_QB = 232 * MiB, WS_KB = 250 * MiB, WS_VB = 255 * MiB;
constexpr size_t WS_GA = 260 * MiB, WS_GB = 296 * MiB;
constexpr size_t WS_YAB = 332 * MiB;
constexpr size_t WS_MB = 368 * MiB;
constexpr size_t WS_HB = 404 * MiB;
constexpr size_t WS_YM = 424 * MiB;
constexpr size_t WS_P = 496 * MiB;
constexpr size_t WS_T1 = 748 * MiB, WS_T2 = 820 * MiB, WS_T3 = 892 * MiB;
constexpr size_t WS_END = 964 * MiB;
constexpr int CW_TMO = 0, CW_CODE = 1;
constexpr int CW_BAR = 4096;
constexpr int CW_CNT = 131072;
constexpr int MAX_LAUNCH = 32;

constexpr int RING_OFF = 0, RING_BYTES = 131072;
constexpr int XS_OFF = 131072, XS_BYTES = 16384;
constexpr int LDSCTL_OFF = 147456, MISC_OFF = LDSCTL_OFF;
constexpr int LDS_BYTES = 148480;
constexpr int NWAVES = 8;
constexpr bool FAST_INPROJ = true, FAST_ATTN = true, FAST_BR = true, FAST_OUT = true, FAST_UP = true, FAST_DOWN = true;
constexpr bool FUSE_POST = false, FUSE_GATE = false, FUSE_RES = false;
namespace pg8 {
#define PG8_LAS __attribute__((address_space(3)))
typedef unsigned short bf16_t;
typedef short bf16x8 __attribute__((ext_vector_type(8)));
typedef float f32x4 __attribute__((ext_vector_type(4)));
typedef unsigned u32x4 __attribute__((ext_vector_type(4)));
constexpr int BM = 256, BK = 64, HALF = 128, HTB = HALF * BK * 2  , STAGE_BYTES = 8 * HTB, NXCD = 8, WGM = 8;

__host__ __device__ __forceinline__ int lds_byte(int r, int c) { const int st = (r >> 4) * 2 + (c >> 5), rr = r & 15, cc = c & 31, ob = rr * 64 + cc * 2; return st * 1024 + (ob ^ (((ob >> 9) & 1) << 5)); }
__host__ __device__ __forceinline__ void stage_rc(int b, int& R, int& C) { const int st = b / 1024, sb = b % 1024, swz = sb ^ (((sb >> 9) & 1) << 5); R = (st >> 1) * 16 + swz / 64; C = (st & 1) * 32 + (swz % 64) / 2; }
__host__ __device__ __forceinline__ int perm32(int rho) { const int n = rho >> 4, i = rho & 15; return 8 * (i >> 2) + 4 * n + (i & 3); }

struct Unit { int pm, pn; };
struct Gemm { const bf16_t* A; const bf16_t* Bt; int M, N, K, lda, ldb; };

struct StaticOrder {
    int nM, nN, nwg, G, c;
    __host__ __device__ void init(int M, int N, int G_, int c_) { nM = M / BM; nN = N / BM; nwg = nM * nN; G = G_; c = c_; }
    __host__ __device__ bool next(int i, Unit& u) const {
        const long L = (long)i * G + c; if (L >= nwg) return false;
        int wgid = (int)L; { const int q = nwg / NXCD, r = nwg % NXCD, xcd = wgid % NXCD, off = wgid / NXCD; wgid = (xcd < r ? xcd * (q + 1) : r * (q + 1) + (xcd - r) * q) + off; }
        const int nig = WGM * nN, gid = wgid / nig, fm = gid * WGM, gsz = (nM - fm) < WGM ? (nM - fm) : WGM;
        u.pm = fm + ((wgid % nig) % gsz); u.pn = (wgid % nig) / gsz; return true;
    }
    __device__ __forceinline__ void a_ready(const Unit&) const {}
    __device__ __forceinline__ void done(const Unit&) const {}
};

__device__ __forceinline__ unsigned cvt_pk_bf16(float lo, float hi) { unsigned r; asm volatile("v_cvt_pk_bf16_f32 %0, %1, %2" : "=v"(r) : "v"(lo), "v"(hi)); return r; }
typedef float f32x2 __attribute__((ext_vector_type(2)));
__device__ __forceinline__ f32x2 gelu_pk(f32x2 v) {
    const f32x2 av = __builtin_elementwise_abs(v), d = av * 0.2316418882f + 1.0f;
    f32x2 t; t.x = __builtin_amdgcn_rcpf(d.x); t.y = __builtin_amdgcn_rcpf(d.y);
    f32x2 q = t * 0.5307027145f + (-0.7265760135f); q = q * t + 0.7107068705f; q = q * t + (-0.142248368f); q = q * t + 0.127414796f; q = q * t;
    const f32x2 s = (v * v) * (-0.72134752044f);
    f32x2 e; e.x = __builtin_amdgcn_exp2f(s.x); e.y = __builtin_amdgcn_exp2f(s.y);
    const f32x2 m = v * (q * e), r = v - m;
    f32x2 o; o.x = v.x < 0.f ? m.x : r.x; o.y = v.y < 0.f ? m.y : r.y; return o;
}

template <int ACT  > struct EpiBf16 {
    static constexpr bool PERM = true, AFTER_DRAIN = false; static_assert(ACT == 0 || ACT == 1, "EpiBf16: ACT is 0 (none) or 1 (gelu_pk)");
    bf16_t* O; int ldc; const float* bias; int split_cols; size_t split_stride; float scale0;
    __device__ __forceinline__ void operator()(const f32x4 (&acc)[2][2][4][2], const Unit& u, int wr, int wc, int fr, int fq) const {
        const int row0 = u.pm * BM + wr * 64 + fr; int colt = u.pn * BM; bf16_t* base = O;
        float sc = 1.f; if (split_cols) { const int t = colt / split_cols; base += (size_t)t * split_stride; colt -= t * split_cols; if (t == 0) sc = scale0; }
        const int col0 = colt + wc * 32 + 8 * fq, bcol0 = u.pn * BM + wc * 32 + 8 * fq;
        f32x4 bv[2][2];
#pragma unroll
        for (int bj = 0; bj < 2; ++bj)
#pragma unroll
            for (int n = 0; n < 2; ++n) bv[bj][n] = bias ? *(const f32x4*)(bias + bcol0 + bj * HALF + 4 * n) : (f32x4){0.f, 0.f, 0.f, 0.f};
#pragma unroll
        for (int ai = 0; ai < 2; ++ai)
#pragma unroll
            for (int m = 0; m < 4; ++m) { bf16_t* rowp = base + (size_t)(row0 + ai * HALF + m * 16) * ldc + col0;
#pragma unroll
                for (int bj = 0; bj < 2; ++bj) { f32x4 v0 = acc[ai][bj][m][0] + bv[bj][0], v1 = acc[ai][bj][m][1] + bv[bj][1];
                    if (ACT == 1) { f32x2 a = gelu_pk((f32x2){v0[0], v0[1]}), b = gelu_pk((f32x2){v0[2], v0[3]}), c = gelu_pk((f32x2){v1[0], v1[1]}), d = gelu_pk((f32x2){v1[2], v1[3]});
                        v0 = (f32x4){a.x, a.y, b.x, b.y}; v1 = (f32x4){c.x, c.y, d.x, d.y}; }
                    v0 = v0 * sc; v1 = v1 * sc; u32x4 w; w.x = cvt_pk_bf16(v0[0], v0[1]); w.y = cvt_pk_bf16(v0[2], v0[3]); w.z = cvt_pk_bf16(v1[0], v1[1]); w.w = cvt_pk_bf16(v1[2], v1[3]);
                    *(u32x4*)(rowp + bj * HALF) = w; } }
    }
};

struct PanelStats {
    unsigned* xbuf;
    unsigned* cnt;
    unsigned* tmo;
    int ntn; float eps;
    unsigned code;
    __device__ __forceinline__ bool run(const f32x4 (&v)[2][2][4][2], const Unit& u, int wr, int wc, int fr, int fq, PG8_LAS unsigned char* lds, int wid, int lane) const {
        typedef float f32x2v __attribute__((ext_vector_type(2)));
        PG8_LAS f32x2v* P = (PG8_LAS f32x2v*)lds;
        PG8_LAS f32x2v* S = (PG8_LAS f32x2v*)(lds + 8192);
        PG8_LAS unsigned* flag = (PG8_LAS unsigned*)(lds + 8192 + 2048);
#pragma unroll
        for (int ai = 0; ai < 2; ++ai)
#pragma unroll
            for (int m = 0; m < 4; ++m) {
                float s = 0.f;
#pragma unroll
                for (int bj = 0; bj < 2; ++bj)
#pragma unroll
                    for (int n = 0; n < 2; ++n) { const f32x4 x = v[ai][bj][m][n]; s += (x[0] + x[1]) + (x[2] + x[3]); }
                s += __shfl_xor(s, 16); s += __shfl_xor(s, 32);
                const float mw = s * (1.0f / 64.0f); float q = 0.f;
#pragma unroll
                for (int bj = 0; bj < 2; ++bj)
#pragma unroll
                    for (int n = 0; n < 2; ++n) { const f32x4 d = v[ai][bj][m][n] - mw; q += (d[0] * d[0] + d[1] * d[1]) + (d[2] * d[2] + d[3] * d[3]); }
                q += __shfl_xor(q, 16); q += __shfl_xor(q, 32);
                if (fq == 0) P[(ai * HALF + wr * 64 + m * 16 + fr) * 4 + wc] = (f32x2v){mw, q};
            }
        asm volatile("s_waitcnt lgkmcnt(0)" ::: "memory"); __builtin_amdgcn_s_barrier(); asm volatile("" ::: "memory");
#if defined(BROKEN_EXCHANGE_NO_WAIT)
#warning BROKEN CONTROL BUILD: the row-statistics exchange does not wait; results are wrong by design
        if (blockIdx.x >= 64) { const long long t0_ = clock64(); while (clock64() - t0_ < 60000) __builtin_amdgcn_s_sleep(8); }
#endif
        const int row = wid * 32 + (lane & 31);
        if (lane < 32) {
            const f32x2v a = P[row * 4 + 0], b = P[row * 4 + 1], c = P[row * 4 + 2], d = P[row * 4 + 3];
            const float mt = (a.x + b.x + c.x + d.x) * 0.25f;
            const float da = a.x - mt, db = b.x - mt, dc = c.x - mt, dd = d.x - mt;
            const float m2 = (a.y + b.y) + (c.y + d.y) + 64.0f * ((da * da + db * db) + (dc * dc + dd * dd));
            unsigned long long* slot = (unsigned long long*)xbuf + ((size_t)(u.pm * BM + row) * 4 + u.pn);
            __hip_atomic_store(slot, ((unsigned long long)__float_as_uint(m2) << 32) | __float_as_uint(mt), __ATOMIC_RELAXED, __HIP_MEMORY_SCOPE_AGENT);
        }
        asm volatile("s_waitcnt vmcnt(0)" ::: "memory");
        if (lane == 0) __hip_atomic_fetch_add(cnt + 64 * u.pm, 1u, __ATOMIC_RELAXED, __HIP_MEMORY_SCOPE_AGENT);
        if (wid == 0) {
            bool dead = false; const unsigned long long t0 = __builtin_amdgcn_s_memrealtime(); const unsigned want = 8u * (unsigned)ntn;
            for (;;) {
#if defined(BROKEN_EXCHANGE_NO_WAIT)
                break;
#endif
                if ((unsigned)__builtin_amdgcn_readfirstlane(__hip_atomic_load(cnt + 64 * u.pm, __ATOMIC_RELAXED, __HIP_MEMORY_SCOPE_AGENT)) >= want) break;
                if (__builtin_amdgcn_s_memrealtime() - t0 > 2000000ull) {
                    if (lane == 0) { unsigned expect = 0u; __hip_atomic_compare_exchange_strong(tmo + 1, &expect, code | (unsigned)(u.pm & 0xff), __ATOMIC_RELAXED, __ATOMIC_RELAXED, __HIP_MEMORY_SCOPE_AGENT);
                                     __hip_atomic_store(tmo, 1u, __ATOMIC_RELAXED, __HIP_MEMORY_SCOPE_AGENT); }
                    dead = true; break; }
                __builtin_amdgcn_s_sleep(2);
            }
            __builtin_amdgcn_fence(__ATOMIC_ACQUIRE, "agent");
            if (lane == 0) flag[0] = dead ? 1u : 0u;
        }
        asm volatile("s_waitcnt vmcnt(0) lgkmcnt(0)" ::: "memory"); __builtin_amdgcn_s_barrier(); asm volatile("" ::: "memory");
        const bool bad = flag[0] != 0u;
        if (lane < 32) {
            const unsigned long long* slot = (const unsigned long long*)xbuf + (size_t)(u.pm * BM + row) * 4; float mt[4], m2[4]; float ms = 0.f;
#pragma unroll
            for (int t = 0; t < 4; ++t) { if (t < ntn) { const unsigned long long w = __hip_atomic_load(slot + t, __ATOMIC_RELAXED, __HIP_MEMORY_SCOPE_AGENT); mt[t] = __uint_as_float((unsigned)w); m2[t] = __uint_as_float((unsigned)(w >> 32)); } else { mt[t] = 0.f; m2[t] = 0.f; } ms += mt[t]; }
            const float mean = ms / (float)ntn; float q = 0.f;
#pragma unroll
            for (int t = 0; t < 4; ++t) if (t < ntn) { const float dm = mt[t] - mean; q += m2[t] + 256.0f * dm * dm; }
            S[row] = (f32x2v){mean, 1.0f / sqrtf(q / (256.0f * (float)ntn) + eps)};
        }
        asm volatile("s_waitcnt lgkmcnt(0)" ::: "memory"); __builtin_amdgcn_s_barrier(); asm volatile("" ::: "memory");
        return bad;
    }
};
struct EpiLnRes {
    static constexpr bool PERM = false, AFTER_DRAIN = true;
    const float* base; float* out; int ldc; const float* bias; PanelStats st; unsigned poison;
    __device__ __forceinline__ void fused(f32x4 (&acc)[2][2][4][2], const Unit& u, int wr, int wc, int fr, int fq, PG8_LAS unsigned char* lds, int wid, int lane) const {
        typedef float f32x2v __attribute__((ext_vector_type(2)));
        const PG8_LAS f32x2v* S = (const PG8_LAS f32x2v*)(lds + 8192);
        const int col0 = u.pn * BM + wc * 32 + 4 * fq;
#pragma unroll
        for (int bj = 0; bj < 2; ++bj)
#pragma unroll
            for (int n = 0; n < 2; ++n) { const f32x4 bv = bias ? *(const f32x4*)(bias + col0 + bj * HALF + n * 16) : (f32x4){0.f, 0.f, 0.f, 0.f};
#pragma unroll
                for (int ai = 0; ai < 2; ++ai)
#pragma unroll
                    for (int m = 0; m < 4; ++m) acc[ai][bj][m][n] += bv; }
        f32x4 pre[4][2][2];
#pragma unroll
        for (int m = 0; m < 4; ++m) { const size_t off = (size_t)(u.pm * BM + wr * 64 + m * 16 + fr) * ldc + col0;
#pragma unroll
            for (int bj = 0; bj < 2; ++bj)
#pragma unroll
                for (int n = 0; n < 2; ++n) pre[m][bj][n] = *(const f32x4*)(base + off + bj * HALF + n * 16); }
        const bool bad = st.run(acc, u, wr, wc, fr, fq, lds, wid, lane) || poison != 0u;
        const float qnan = __builtin_nanf("");
#pragma unroll
        for (int ai = 0; ai < 2; ++ai)
#pragma unroll
            for (int m = 0; m < 4; ++m) { const int r = ai * HALF + wr * 64 + m * 16 + fr; const f32x2v sr = S[r]; const size_t off = (size_t)(u.pm * BM + r) * ldc + col0;
#pragma unroll
                for (int bj = 0; bj < 2; ++bj)
#pragma unroll
                    for (int n = 0; n < 2; ++n) { const f32x4 bs = ai == 0 ? pre[m][bj][n] : *(const f32x4*)(base + off + bj * HALF + n * 16); f32x4 o = bs + (acc[ai][bj][m][n] - sr.x) * sr.y;
                        if (bad) o = (f32x4){qnan, qnan, qnan, qnan}; *(f32x4*)(out + off + bj * HALF + n * 16) = o; }
                if (m & 1) asm volatile("" ::: "memory"); }
    }
};
struct EpiLnResLn {
    static constexpr bool PERM = false, AFTER_DRAIN = true;
    const float* base; float* out; bf16_t* xn; int ldc; const float* bias; PanelStats st1, st2; unsigned poison;
    __device__ __forceinline__ void fused(f32x4 (&acc)[2][2][4][2], const Unit& u, int wr, int wc, int fr, int fq, PG8_LAS unsigned char* lds, int wid, int lane) const {
        typedef float f32x2v __attribute__((ext_vector_type(2))); typedef unsigned u32x2v __attribute__((ext_vector_type(2)));
        const PG8_LAS f32x2v* S = (const PG8_LAS f32x2v*)(lds + 8192);
        const int col0 = u.pn * BM + wc * 32 + 4 * fq;
#pragma unroll
        for (int bj = 0; bj < 2; ++bj)
#pragma unroll
            for (int n = 0; n < 2; ++n) { const f32x4 bv = bias ? *(const f32x4*)(bias + col0 + bj * HALF + n * 16) : (f32x4){0.f, 0.f, 0.f, 0.f};
#pragma unroll
                for (int ai = 0; ai < 2; ++ai)
#pragma unroll
                    for (int m = 0; m < 4; ++m) acc[ai][bj][m][n] += bv; }
        bool bad = st1.run(acc, u, wr, wc, fr, fq, lds, wid, lane) || poison != 0u;
        const float qnan = __builtin_nanf("");
#pragma unroll
        for (int ai = 0; ai < 2; ++ai)
#pragma unroll
            for (int m = 0; m < 4; ++m) { const int r = ai * HALF + wr * 64 + m * 16 + fr; const f32x2v sr = S[r]; const size_t off = (size_t)(u.pm * BM + r) * ldc + col0;
#pragma unroll
                for (int bj = 0; bj < 2; ++bj)
#pragma unroll
                    for (int n = 0; n < 2; ++n) { const f32x4 bs = *(const f32x4*)(base + off + bj * HALF + n * 16); acc[ai][bj][m][n] = bs + (acc[ai][bj][m][n] - sr.x) * sr.y; }
                asm volatile("" : "+v"(acc[ai][0][m][0]), "+v"(acc[ai][0][m][1]), "+v"(acc[ai][1][m][0]), "+v"(acc[ai][1][m][1]));
                if (m & 1) asm volatile("" ::: "memory"); }
        const bool bad1 = bad;
        bad = st2.run(acc, u, wr, wc, fr, fq, lds, wid, lane) || bad;
#pragma unroll
        for (int ai = 0; ai < 2; ++ai)
#pragma unroll
            for (int m = 0; m < 4; ++m) { const int r = ai * HALF + wr * 64 + m * 16 + fr; const f32x2v sr = S[r]; const size_t off = (size_t)(u.pm * BM + r) * ldc + col0;
#pragma unroll
                for (int bj = 0; bj < 2; ++bj)
#pragma unroll
                    for (int n = 0; n < 2; ++n) { const f32x4 x1 = acc[ai][bj][m][n]; *(f32x4*)(out + off + bj * HALF + n * 16) = bad1 ? (f32x4){qnan, qnan, qnan, qnan} : x1;
                        const f32x4 o = (x1 - sr.x) * sr.y; u32x2v w; w.x = cvt_pk_bf16(o[0], o[1]); w.y = cvt_pk_bf16(o[2], o[3]);
                        if (bad) { w.x = 0x7fc07fc0u; w.y = 0x7fc07fc0u; } *(u32x2v*)(xn + off + bj * HALF + n * 16) = w; }
                asm volatile("" ::: "memory"); }
    }
};

template <class Epi, class Sched, bool ALIGN_EPI = false, bool SP2 = false>
__device__ __forceinline__ void gemm_phase(PG8_LAS unsigned char* lds, const Gemm g, const Sched& S, const Epi& E) {
    const int tid = threadIdx.x, wid = __builtin_amdgcn_readfirstlane(tid >> 6), lane = tid & 63, wr = wid >> 2, wc = wid & 3, fr = lane & 15, fq = lane >> 4;
    const int K = g.K, nt = K / BK;
    unsigned voffA[2], voffB[2];
#pragma unroll
    for (int i = 0; i < 2; ++i) { int R, C; stage_rc(tid * 16 + i * 8192, R, C); const int Rb = Epi::PERM ? ((R & ~31) + perm32(R & 31)) : R;
        voffA[i] = (unsigned)(R * g.lda + C) * 2u; voffB[i] = (unsigned)(Rb * g.ldb + C) * 2u; }
    const size_t kstep = (size_t)(BK * 2);
    const size_t hstepA = (size_t)HALF * g.lda * 2, hstepB = (size_t)HALF * g.ldb * 2;
    const size_t tstepA = 2 * hstepA, tstepB = 2 * hstepB;
    const unsigned ldsw = (unsigned)wid * 1024u;
    const int aoff = lds_byte(wr * 64 + fr, fq * 8), boff = lds_byte(wc * 32 + fr, fq * 8);
#define PG8_SA(b, h) (((b) * 2 + (h)) * HTB)
#define PG8_SB(b, h) ((4 + (b) * 2 + (h)) * HTB)
#define PG8_STAGE(bufoff, gbase, voff) do { _Pragma("unroll") for (int _i = 0; _i < 2; ++_i) \
        __builtin_amdgcn_global_load_lds((const unsigned*)((const char*)(gbase) + (voff)[_i]), (PG8_LAS unsigned*)(lds + (bufoff) + ldsw + _i * 8192), 16, 0, 0); } while (0)
#define PG8_LDA(dst, b, h) do { _Pragma("unroll") for (int m = 0; m < 4; ++m) _Pragma("unroll") for (int k = 0; k < 2; ++k) dst[m][k] = *(const PG8_LAS bf16x8*)(lds + PG8_SA(b, h) + aoff + m * 2048 + k * 1024); } while (0)
#define PG8_LDB(dst, b, h) do { _Pragma("unroll") for (int n = 0; n < 2; ++n) _Pragma("unroll") for (int k = 0; k < 2; ++k) dst[n][k] = *(const PG8_LAS bf16x8*)(lds + PG8_SB(b, h) + boff + n * 2048 + k * 1024); } while (0)
#define PG8_MMA(ai, bj, At, Bt) do { __builtin_amdgcn_s_setprio(1); _Pragma("unroll") for (int m = 0; m < 4; ++m) _Pragma("unroll") for (int n = 0; n < 2; ++n) _Pragma("unroll") for (int k = 0; k < 2; ++k) \
        acc[ai][bj][m][n] = __builtin_amdgcn_mfma_f32_16x16x32_bf16(Bt[n][k], At[m][k], acc[ai][bj][m][n], 0, 0, 0); __builtin_amdgcn_s_setprio(0); } while (0)
#define PG8_WAIT_V(n) asm volatile("s_waitcnt vmcnt(" #n ")" ::: "memory")
#define PG8_WAIT_L(n) asm volatile("s_waitcnt lgkmcnt(" #n ")" ::: "memory")
#define PG8_BAR __builtin_amdgcn_s_barrier()
#define PG8_SCHED __builtin_amdgcn_sched_barrier(0)
    Unit cur, nxt; int ui = 0;
    if (!S.next(0, cur)) return;
    f32x4 acc[2][2][4][2];
#pragma unroll
    for (int a = 0; a < 2; ++a)
#pragma unroll
        for (int b = 0; b < 2; ++b)
#pragma unroll
            for (int m = 0; m < 4; ++m)
#pragma unroll
                for (int n = 0; n < 2; ++n) acc[a][b][m][n] = (f32x4){0.f, 0.f, 0.f, 0.f};
    bf16x8 At[4][2], B0[2][2], B1[2][2];
    const char* cA = (const char*)g.A + (size_t)cur.pm * tstepA; const char* cB = (const char*)g.Bt + (size_t)cur.pn * tstepB;
    S.a_ready(cur);
    if constexpr (SP2) {
        PG8_STAGE(PG8_SB(0, 0), cB, voffB); PG8_STAGE(PG8_SB(0, 1), cB + hstepB, voffB); PG8_STAGE(PG8_SA(0, 0), cA, voffA); PG8_STAGE(PG8_SA(0, 1), cA + hstepA, voffA);
        if (wr == 1) PG8_BAR;
        PG8_WAIT_V(2); PG8_BAR;
        PG8_STAGE(PG8_SB(1, 0), cB + kstep, voffB); PG8_STAGE(PG8_SA(1, 0), cA + kstep, voffA); PG8_STAGE(PG8_SB(1, 1), cB + hstepB + kstep, voffB);
        PG8_WAIT_V(6); PG8_BAR;
    } else {
        PG8_STAGE(PG8_SB(0, 0), cB, voffB); PG8_STAGE(PG8_SA(0, 0), cA, voffA); PG8_STAGE(PG8_SB(0, 1), cB + hstepB, voffB); PG8_STAGE(PG8_SA(0, 1), cA + hstepA, voffA);
        if (wr == 1) PG8_BAR;
        PG8_WAIT_V(4); PG8_BAR;
        PG8_STAGE(PG8_SB(1, 0), cB + kstep, voffB); PG8_STAGE(PG8_SA(1, 0), cA + kstep, voffA); PG8_STAGE(PG8_SB(1, 1), cB + hstepB + kstep, voffB);
        PG8_WAIT_V(6); PG8_BAR;
    }
    for (;;) {
        const bool has_next = S.next(ui + 1, nxt);
        const char* nA = has_next ? (const char*)g.A + (size_t)nxt.pm * tstepA : cA; const char* nB = has_next ? (const char*)g.Bt + (size_t)nxt.pn * tstepB : cB;
        for (int t = 0; t < nt; t += 2) {
            const bool last = (t == nt - 2);
            const char* a1 = cA + (size_t)(t + 1) * kstep;
            const char* a2 = last ? nA : cA + (size_t)(t + 2) * kstep; const char* b2 = last ? nB : cB + (size_t)(t + 2) * kstep;
            const char* a3 = a2 + kstep; const char* b3 = b2 + kstep;
            if (last && has_next) S.a_ready(nxt);
            if constexpr (SP2) {
            PG8_LDB(B0, 0, 0); PG8_LDB(B1, 0, 1); PG8_SCHED; PG8_LDA(At, 0, 0); PG8_STAGE(PG8_SA(1, 1), a1 + hstepA, voffA);
            PG8_WAIT_V(8); PG8_WAIT_L(0); PG8_BAR; PG8_MMA(0, 0, At, B0); PG8_MMA(0, 1, At, B1); PG8_BAR; PG8_SCHED;
            PG8_LDA(At, 0, 1); PG8_STAGE(PG8_SB(0, 0), b2, voffB); PG8_STAGE(PG8_SB(0, 1), b2 + hstepB, voffB); PG8_STAGE(PG8_SA(0, 0), a2, voffA);
            PG8_WAIT_V(8); PG8_WAIT_L(0); PG8_BAR; PG8_MMA(1, 0, At, B0); PG8_MMA(1, 1, At, B1); PG8_BAR; PG8_SCHED;
            PG8_LDB(B0, 1, 0); PG8_LDB(B1, 1, 1); PG8_SCHED; PG8_LDA(At, 1, 0); PG8_STAGE(PG8_SA(0, 1), a2 + hstepA, voffA);
            PG8_WAIT_V(8); PG8_WAIT_L(0); PG8_BAR; PG8_MMA(0, 0, At, B0); PG8_MMA(0, 1, At, B1); PG8_BAR; PG8_SCHED;
            PG8_LDA(At, 1, 1); PG8_STAGE(PG8_SB(1, 0), b3, voffB); PG8_STAGE(PG8_SB(1, 1), b3 + hstepB, voffB); PG8_STAGE(PG8_SA(1, 0), a3, voffA);
            PG8_WAIT_V(8); PG8_WAIT_L(0); PG8_BAR; PG8_MMA(1, 0, At, B0); PG8_MMA(1, 1, At, B1); PG8_BAR; PG8_SCHED;
            } else {
            PG8_LDB(B0, 0, 0); PG8_SCHED; PG8_LDA(At, 0, 0); PG8_STAGE(PG8_SA(1, 1), a1 + hstepA, voffA);
            PG8_WAIT_L(8); PG8_BAR; PG8_WAIT_L(0); PG8_MMA(0, 0, At, B0); PG8_BAR; PG8_SCHED;
            PG8_LDB(B1, 0, 1); PG8_STAGE(PG8_SB(0, 0), b2, voffB);
            PG8_BAR; PG8_WAIT_L(0); PG8_MMA(0, 1, At, B1); PG8_BAR;
            PG8_LDA(At, 0, 1); PG8_STAGE(PG8_SA(0, 0), a2, voffA);
            PG8_BAR; PG8_WAIT_L(0); PG8_MMA(1, 0, At, B0); PG8_BAR; PG8_SCHED;
            PG8_STAGE(PG8_SB(0, 1), b2 + hstepB, voffB);
            PG8_WAIT_V(6); PG8_BAR; PG8_MMA(1, 1, At, B1); PG8_BAR;
            PG8_LDB(B0, 1, 0); PG8_SCHED; PG8_LDA(At, 1, 0); PG8_STAGE(PG8_SA(0, 1), a2 + hstepA, voffA);
            PG8_WAIT_L(8); PG8_BAR; PG8_WAIT_L(0); PG8_MMA(0, 0, At, B0); PG8_BAR; PG8_SCHED;
            PG8_LDB(B1, 1, 1); PG8_STAGE(PG8_SB(1, 0), b3, voffB);
            PG8_BAR; PG8_WAIT_L(0); PG8_MMA(0, 1, At, B1); PG8_BAR;
            PG8_LDA(At, 1, 1); PG8_STAGE(PG8_SA(1, 0), a3, voffA);
            PG8_BAR; PG8_WAIT_L(0); PG8_MMA(1, 0, At, B0); PG8_BAR; PG8_SCHED;
            PG8_STAGE(PG8_SB(1, 1), b3 + hstepB, voffB);
            PG8_WAIT_V(6); PG8_BAR; PG8_MMA(1, 1, At, B1); PG8_BAR;
            }
        }
        if constexpr (ALIGN_EPI) { if (wr == 0) PG8_BAR; }
        if constexpr (!Epi::AFTER_DRAIN) { E(acc, cur, wr, wc, fr, fq); S.done(cur); }
        if (!has_next) break;
#pragma unroll
        for (int a = 0; a < 2; ++a)
#pragma unroll
            for (int b = 0; b < 2; ++b)
#pragma unroll
                for (int m = 0; m < 4; ++m)
#pragma unroll
                    for (int n = 0; n < 2; ++n) acc[a][b][m][n] = (f32x4){0.f, 0.f, 0.f, 0.f};
        cur = nxt; cA = nA; cB = nB; ++ui;
        if constexpr (ALIGN_EPI) { if (wr == 1) PG8_BAR; }
    }
    PG8_WAIT_V(0);
    if constexpr (!ALIGN_EPI) { if (wr == 0) PG8_BAR; }
    PG8_BAR;
    if constexpr (Epi::AFTER_DRAIN) { E.fused(acc, cur, wr, wc, fr, fq, lds, wid, lane); S.done(cur); }
#undef PG8_SA
#undef PG8_SB
#undef PG8_STAGE
#undef PG8_LDA
#undef PG8_LDB
#undef PG8_MMA
#undef PG8_WAIT_V
#undef PG8_WAIT_L
#undef PG8_BAR
#undef PG8_SCHED
}
}
#define GAS __attribute__((address_space(1)))
#define LAS __attribute__((address_space(3)))
typedef unsigned short bf16;
typedef unsigned v4u __attribute__((ext_vector_type(4)));
typedef float f32x4 __attribute__((ext_vector_type(4)));
typedef short bf16x8 __attribute__((ext_vector_type(8)));
typedef GAS unsigned gu32;
typedef GAS unsigned long long gu64;
#define RLX_AGENT __ATOMIC_RELAXED, __HIP_MEMORY_SCOPE_AGENT
#define LDS_WAIT() asm volatile("s_waitcnt lgkmcnt(0)" ::: "memory")
#define VM_WAIT() asm volatile("s_waitcnt vmcnt(0)" ::: "memory")
__device__ __forceinline__ unsigned long long rt() { return __builtin_amdgcn_s_memrealtime(); }
__device__ __forceinline__ unsigned f2bf(float f) { unsigned u = __builtin_bit_cast(unsigned, f); return (u + 0x7fffu + ((u >> 16) & 1u)) >> 16; }
__device__ __forceinline__ unsigned pk2(float lo, float hi) { return f2bf(lo) | (f2bf(hi) << 16); }

#define XB_TMO      128
#define XB_XCNT(j)  (256  + 64 * (j))
#define XB_XSUB(j)  (1280 + 64 * (j))
#define XB_XGEN(j)  (2304 + 64 * (j))
#define XB_TOP      3328
#define XB_TOPGEN   3392
#define XCD_BAR_WORDS 3456
#define XB_SPIN_CAP (1u << 18)

__device__ __forceinline__ unsigned xb_ld(unsigned* p)              { return __hip_atomic_load(p, __ATOMIC_RELAXED, __HIP_MEMORY_SCOPE_AGENT); }
__device__ __forceinline__ unsigned xb_add(unsigned* p, unsigned v) { return __hip_atomic_fetch_add(p, v, __ATOMIC_RELAXED, __HIP_MEMORY_SCOPE_AGENT); }
__device__ __forceinline__ unsigned xb_xcc_id() { return (unsigned)__builtin_amdgcn_s_getreg((3 << 11) | 20) & 0xFu; }
#define XB_SPIN(cond, bar) do { unsigned _sp = 0; while (cond) { __builtin_amdgcn_s_sleep(1); \
    if ((++_sp & 255u) == 0u) { if (xb_ld(&(bar)[XB_TMO])) break; if (_sp > XB_SPIN_CAP) { atomicAdd(&(bar)[XB_TMO], 1u); break; } } } } while (0)

struct XcdBarrier {
    unsigned* bar; unsigned x;
    volatile LAS unsigned* st;
};

__device__ __forceinline__ XcdBarrier xcd_barrier_post(unsigned* bar, volatile LAS unsigned* st) {
    XcdBarrier b; b.bar = bar; b.x = xb_xcc_id(); b.st = st;
    if (threadIdx.x == 0) (void)xb_add(&bar[XB_XCNT(b.x)], 1u);
    return b;
}
__device__ __forceinline__ void xcd_barrier_complete(unsigned* bar, unsigned x, unsigned& nloc, unsigned& nx) {
    const unsigned G = gridDim.x * gridDim.y * gridDim.z;
    unsigned sum, cnt, mine, sp = 0u;
    for (;;) {
        sum = 0u; cnt = 0u; mine = 0u;
#pragma unroll
        for (unsigned j = 0; j < 16; ++j) { const unsigned c = xb_ld(&bar[XB_XCNT(j)]); sum += c; cnt += (c > 0u) ? 1u : 0u; mine = (j == x) ? c : mine; }
        if (sum == G) break;
        __builtin_amdgcn_s_sleep(1);
        if ((++sp & 255u) == 0u) { if (xb_ld(&bar[XB_TMO])) break; if (sp > XB_SPIN_CAP) { atomicAdd(&bar[XB_TMO], 1u); break; } }
    }
    nloc = mine > 0u ? mine : 1u; nx = cnt > 0u ? cnt : 1u;
}

__device__ __forceinline__ void xcd_barrier(const XcdBarrier& b) {
    asm volatile("s_waitcnt vmcnt(0)" ::: "memory");
    __syncthreads();
    if (threadIdx.x == 0) {
        unsigned* bar = b.bar;
        __builtin_amdgcn_s_waitcnt(0);
        unsigned nloc = b.st[0], nx = b.st[1];
        if (nloc == 0u) { xcd_barrier_complete(bar, b.x, nloc, nx); b.st[0] = nloc; b.st[1] = nx; }
        const unsigned old = xb_add(&bar[XB_XSUB(b.x)], 1u);
        const unsigned gen = old / nloc;
        if (old + 1u == (gen + 1u) * nloc) {
            __builtin_amdgcn_fence(__ATOMIC_RELEASE, "agent");
            asm volatile("s_waitcnt vmcnt(0)" ::: "memory");
            const unsigned og = xb_add(&bar[XB_TOP], 1u);
            const unsigned tg = og / nx;
            if (og + 1u == (tg + 1u) * nx) xb_add(&bar[XB_TOPGEN], 1u);
            else XB_SPIN(xb_ld(&bar[XB_TOPGEN]) == tg, bar);
            __builtin_amdgcn_fence(__ATOMIC_ACQUIRE, "agent");
            xb_add(&bar[XB_XGEN(b.x)], 1u);
            asm volatile("s_waitcnt vmcnt(0)" ::: "memory");
        } else {
            XB_SPIN(xb_ld(&bar[XB_XGEN(b.x)]) == gen, bar);
            __builtin_amdgcn_fence(__ATOMIC_ACQUIRE, "agent");
            asm volatile("s_waitcnt vmcnt(0)" ::: "memory");
        }
    }
    __syncthreads();
}
typedef float f32x4v __attribute__((ext_vector_type(4)));
struct Frame {
    LAS unsigned char* lds;
    volatile LAS unsigned* MISC;
    gu32* ctl;
    int tid, lane, wave, G, vcu;
    float* out; unsigned char* ws;
};
typedef const float* cfptr;
#define INP(i) (((const LAS cfptr*)(F.lds + LDSCTL_OFF + 256))[i])
#define IN_X 0
#define IN_C 1
#define IN_CTX 2
#define IN_CCTX 3
#define IN_WMOD 4
#define IN_BMOD 5
#define IN_NMIX 6
#define IN_NFFN 7
#define IN_WIN 8
#define IN_QNA 9
#define IN_KNA 10
#define IN_SINK 11
#define IN_WBRA 12
#define IN_WBRB 13
#define IN_WOUT 14
#define IN_WRG 15
#define IN_BRG 16
#define IN_WRE 17
#define IN_BRE 18
#define IN_W1 19
#define IN_W3 20
#define IN_W2 21
#define IN_NFIN 22

__device__ __forceinline__ float wave_sum(float v) {
#pragma unroll
    for (int o = 1; o < 64; o <<= 1) v += __shfl_xor(v, o);
    return v;
}
__device__ __forceinline__ float wave_max(float v) {
#pragma unroll
    for (int o = 1; o < 64; o <<= 1) v = fmaxf(v, __shfl_xor(v, o));
    return v;
}
__device__ __forceinline__ float bf2f(bf16 h) { return __builtin_bit_cast(float, (unsigned)h << 16); }
__device__ __forceinline__ int mod_row(int m) { return (m % TT) < CTX ? 4 : m / TT; }

__device__ __forceinline__ void compute_base(const unsigned* cnt, LAS unsigned* base, int tid) {
    if (tid < 64) {
        const unsigned c = __hip_atomic_load(cnt + tid, RLX_AGENT); unsigned v = c;
#pragma unroll
        for (int o = 1; o < 64; o <<= 1) { const unsigned t = __shfl_up(v, o); if (tid >= o) v += t; }
        base[tid] = v - c; if (tid == 63) base[64] = v;
    }
    __syncthreads();
}

template <int MODE>
__device__ __forceinline__ void tr_item(const float* W, int ldw, bf16* WT, int ldt, int koff, LAS float* scr, int kb, int nb, int lane) {
    const int k0 = 64 * kb, n0 = 32 * nb;
#pragma unroll 8
    for (int i = 0; i < 32; ++i) { const int kk = 2 * i + (lane >> 5); scr[kk * 33 + (lane & 31)] = W[(size_t)(k0 + kk) * ldw + n0 + (lane & 31)]; }
    LDS_WAIT(); asm volatile("" ::: "memory");
    const int c = lane & 7;
#pragma unroll
    for (int j = 0; j < 4; ++j) { const int n = (lane >> 3) + 8 * j; const LAS float* s = scr + (8 * c) * 33 + n;
        v4u o; o.x = pk2(s[0 * 33], s[1 * 33]); o.y = pk2(s[2 * 33], s[3 * 33]); o.z = pk2(s[4 * 33], s[5 * 33]); o.w = pk2(s[6 * 33], s[7 * 33]);
        const int drow = (MODE == 1) ? inproj_dst_col(n0 + n) : (n0 + n);
        *(GAS v4u*)(WT + (size_t)drow * ldt + koff + k0 + 8 * c) = o; }
    LDS_WAIT(); asm volatile("" ::: "memory");
}

__device__ __forceinline__ void p0_prologue(Frame& F) {
    LAS float* sl = (LAS float*)(F.lds);
    LAS float* red = (LAS float*)(F.lds + 40960);
    for (int i = F.tid; i < 5 * D; i += NWAVES * 64) { const int r = i / D, k = i % D; const float v = r < 4 ? INP(IN_C)[r * D + k] : INP(IN_CCTX)[k]; sl[i] = v / (1.f + __expf(-v)); }
    __syncthreads();
    float* MOD = (float*)(F.ws + WS_MOD);
    for (int u = F.vcu; u < 2 * (MODW / 64); u += F.G) {
        const int l = u / (MODW / 64), cb = u % (MODW / 64), col0 = cb * 64, cq = F.tid & 15, ks = F.tid >> 4;
        const float* W = INP(IN_WMOD) + (size_t)l * D * MODW + col0 + 4 * cq;
        f32x4v acc[5];
#pragma unroll
        for (int r = 0; r < 5; ++r) acc[r] = (f32x4v){0.f, 0.f, 0.f, 0.f};
#pragma unroll 8
        for (int kk = 0; kk < 64; ++kk) { const int k = ks * 64 + kk; const f32x4v w = *(const f32x4v*)(W + (size_t)k * MODW);
#pragma unroll
            for (int r = 0; r < 5; ++r) acc[r] += sl[r * D + k] * w; }
#pragma unroll
        for (int r = 0; r < 5; ++r) *(LAS f32x4v*)(red + (ks * 5 + r) * 64 + cq * 4) = acc[r];
        __syncthreads();
        if (F.tid < 320) { const int r = F.tid / 64, cc = F.tid % 64; float s = 0.f;
#pragma unroll 8
            for (int k2 = 0; k2 < 32; ++k2) s += red[(k2 * 5 + r) * 64 + cc];
            MOD[(size_t)(l * 5 + r) * MODW + col0 + cc] = s + INP(IN_BMOD)[l * MODW + col0 + cc]; }
        __syncthreads();
    }
    if (F.vcu == 0) { float* RT = (float*)(F.ws + WS_ROPE);
        for (int i = F.tid; i < 64 * 32; i += NWAVES * 64) { const int pos = i >> 5, f = i & 31; const float freq = powf(10000.f, -(float)f / 32.f); const float ang = (float)pos * freq; RT[i] = cosf(ang); RT[2048 + i] = sinf(ang); } }
    LAS float* scr = (LAS float*)(F.lds + F.wave * 16384);
    const int gw = F.vcu * NWAVES + F.wave, NGW = F.G * NWAVES;
    constexpr int I_IN = 32 * 224, I_BR = 16 * 64, I_OUT = 32 * 64, I_L = I_IN + 2 * I_BR + I_OUT;
    for (int it = gw; it < 2 * I_L; it += NGW) {
        const int l = it / I_L; int r = it % I_L;
        if (r < I_IN) { tr_item<1>(INP(IN_WIN) + (size_t)l * D * INC, INC, (bf16*)(F.ws + WS_WIN) + (size_t)l * INC * D, D, 0, scr, r / 224, r % 224, F.lane); continue; } r -= I_IN;
        if (r < I_BR) { tr_item<0>(INP(IN_WBRA) + (size_t)l * QW * D, D, (bf16*)(F.ws + WS_WBR) + (size_t)l * D * D, D, 0, scr, r / 64, r % 64, F.lane); continue; } r -= I_BR;
        if (r < I_BR) { tr_item<0>(INP(IN_WBRB) + (size_t)l * QW * D, D, (bf16*)(F.ws + WS_WBR) + (size_t)l * D * D, D, QW, scr, r / 64, r % 64, F.lane); continue; } r -= I_BR;
        tr_item<0>(INP(IN_WOUT) + (size_t)l * D * D, D, (bf16*)(F.ws + WS_WOUT) + (size_t)l * D * D, D, 0, scr, r / 64, r % 64, F.lane);
    }
}

__device__ __forceinline__ void moe_combine_add(Frame& F, int lp, int m, const LAS unsigned* base, f32x4v (&v)[8]) {
    const unsigned* TE = (const unsigned*)(F.ws + WS_TOK) + (size_t)lp * M * 2;
    const unsigned* TP = (const unsigned*)(F.ws + WS_TOK) + (size_t)(2 + lp) * M * 2;
    const float* TW = (const float*)(F.ws + WS_TOK) + (size_t)(4 + lp) * M * 2;
    const unsigned e0 = TE[m * 2], e1 = TE[m * 2 + 1];
    const unsigned s0 = base[e0] + TP[m * 2], s1 = base[e1] + TP[m * 2 + 1];
    const float w0 = TW[m * 2], w1 = TW[m * 2 + 1];
    const bf16* Y0 = (const bf16*)(F.ws + WS_YM) + (size_t)s0 * D; const bf16* Y1 = (const bf16*)(F.ws + WS_YM) + (size_t)s1 * D;
    const float* g2 = (const float*)(F.ws + WS_MOD) + (size_t)(lp * 5 + mod_row(m)) * MODW + 5 * D;
#pragma unroll
    for (int j = 0; j < 8; ++j) { const int col = 4 * (F.lane + 64 * j);
        const uint2 a = *(const uint2*)(Y0 + col), b = *(const uint2*)(Y1 + col); const f32x4v g = *(const f32x4v*)(g2 + col);
        f32x4v ya = {__builtin_bit_cast(float, a.x << 16), __builtin_bit_cast(float, a.x & 0xffff0000u), __builtin_bit_cast(float, a.y << 16), __builtin_bit_cast(float, a.y & 0xffff0000u)};
        f32x4v yb = {__builtin_bit_cast(float, b.x << 16), __builtin_bit_cast(float, b.x & 0xffff0000u), __builtin_bit_cast(float, b.y << 16), __builtin_bit_cast(float, b.y & 0xffff0000u)};
        v[j] += g * (w0 * ya + w1 * yb); }
}
__device__ __forceinline__ void store_bf16_row(bf16* dst, int lane, const f32x4v (&h)[8]) {
#pragma unroll
    for (int j = 0; j < 8; ++j) { uint2 o; o.x = pk2(h[j].x, h[j].y); o.y = pk2(h[j].z, h[j].w); *(uint2*)(dst + 4 * (lane + 64 * j)) = o; }
}
__device__ __forceinline__ float row_sumsq(const f32x4v (&v)[8]) {
    float s = 0.f;
#pragma unroll
    for (int j = 0; j < 8; ++j) s += (v[j].x * v[j].x + v[j].y * v[j].y) + (v[j].z * v[j].z + v[j].w * v[j].w);
    return wave_sum(s);
}

__device__ __forceinline__ void ph_norm1(Frame& F, int l) {
    LAS unsigned* base = (LAS unsigned*)(F.lds);
    if (l > 0) compute_base((const unsigned*)F.ctl + CW_CNT + (l - 1) * 64, base, F.tid);
    const int gw = F.vcu * NWAVES + F.wave, NGW = F.G * NWAVES;
    float* XW = (float*)(F.ws + WS_XW); bf16* HA = (bf16*)(F.ws + WS_HA);
    const float* nw = INP(IN_NMIX) + l * D;
    for (int m = gw; m < M; m += NGW) {
        const int b = m / TT, t = m % TT;
        f32x4v v[8];
        if (l == 0) { const float* src = t < CTX ? INP(IN_CTX) + ((size_t)b * CTX + t) * D : INP(IN_X) + ((size_t)b * SEQ + (t - CTX)) * D;
#pragma unroll
            for (int j = 0; j < 8; ++j) v[j] = *(const f32x4v*)(src + 4 * (F.lane + 64 * j));
        } else {
#pragma unroll
            for (int j = 0; j < 8; ++j) v[j] = *(const f32x4v*)(XW + (size_t)m * D + 4 * (F.lane + 64 * j));
            if (t >= CTX || l - 1 < DEPTH - 1) moe_combine_add(F, l - 1, m, base, v);
        }
#pragma unroll
        for (int j = 0; j < 8; ++j) *(f32x4v*)(XW + (size_t)m * D + 4 * (F.lane + 64 * j)) = v[j];
        const float rstd = 1.0f / sqrtf(row_sumsq(v) * (1.0f / D) + EPS);
        const float* mod = (const float*)(F.ws + WS_MOD) + (size_t)(l * 5 + mod_row(m)) * MODW;
        f32x4v h[8];
#pragma unroll
        for (int j = 0; j < 8; ++j) { const int col = 4 * (F.lane + 64 * j); const f32x4v w = *(const f32x4v*)(nw + col), sh = *(const f32x4v*)(mod + col), sc = *(const f32x4v*)(mod + D + col);
            h[j] = (v[j] * rstd * w) * (1.0f + sc) + sh; }
        store_bf16_row(HA + (size_t)m * D, F.lane, h);
    }
}

__device__ __forceinline__ void post_head(const float* P, bf16* dst, const float* nw, bool rope, int rowpos, int colpos, const float* RT, int lane) {
    const int wc = lane >> 4, tt = lane & 15, j0 = 32 * wc + tt, j1 = j0 + 16, d1 = 64 * (wc >> 1) + 16 * (wc & 1) + tt, d2 = d1 + 32;
    float x1 = P[j0], x2 = P[j1];
    if (nw) { const float ss = wave_sum(x1 * x1 + x2 * x2); const float r = 1.0f / sqrtf(ss * (1.0f / HD) + EPS); x1 = x1 * r * nw[d1]; x2 = x2 * r * nw[d2]; }
    if (rope) { const int pos = (wc >> 1) ? colpos : rowpos, fi = 16 * (wc & 1) + tt; const float cs = RT[pos * 32 + fi], sn = RT[2048 + pos * 32 + fi];
        const float o1 = x1 * cs - x2 * sn, o2 = x1 * sn + x2 * cs; x1 = o1; x2 = o2; }
    dst[j0] = (bf16)f2bf(x1); dst[j1] = (bf16)f2bf(x2);
}
__device__ __forceinline__ void ph_post(Frame& F, int l) {
    const int gw = F.vcu * NWAVES + F.wave, NGW = F.G * NWAVES;
    const float* RT = (const float*)(F.ws + WS_ROPE);
    const float* qn = INP(IN_QNA) + l * HD; const float* kn = INP(IN_KNA) + l * HD;
    for (int m = gw; m < M; m += NGW) {
        const int t = m % TT; const bool rope = t >= CTX; const int s = t - CTX, rowpos = rope ? s / GRIDW : 0, colpos = rope ? s % GRIDW : 0;
        const float* P = (const float*)(F.ws + WS_P) + (size_t)m * INC;
        for (int h = 0; h < NH; ++h) post_head(P + OFF_QA + h * HD, (bf16*)(F.ws + WS_QA) + (size_t)m * QW + h * HD, qn, rope, rowpos, colpos, RT, F.lane);
        for (int h = 0; h < NKV; ++h) post_head(P + OFF_KA + h * HD, (bf16*)(F.ws + WS_KA) + (size_t)m * KW + h * HD, kn, rope, rowpos, colpos, RT, F.lane);
        for (int h = 0; h < NH; ++h) post_head(P + OFF_QB + h * HD, (bf16*)(F.ws + WS_QB) + (size_t)m * QW + h * HD, nullptr, rope, rowpos, colpos, RT, F.lane);
        for (int h = 0; h < NKV; ++h) post_head(P + OFF_KB + h * HD, (bf16*)(F.ws + WS_KB) + (size_t)m * KW + h * HD, nullptr, rope, rowpos, colpos, RT, F.lane);
        { const f32x4v a = *(const f32x4v*)(P + OFF_VA + 4 * F.lane), b = *(const f32x4v*)(P + OFF_VB + 4 * F.lane); uint2 o; o.x = pk2(a.x, a.y); o.y = pk2(a.z, a.w); *(uint2*)((bf16*)(F.ws + WS_VA) + (size_t)m * KW + 4 * F.lane) = o;
          o.x = pk2(b.x, b.y); o.y = pk2(b.z, b.w); *(uint2*)((bf16*)(F.ws + WS_VB) + (size_t)m * KW + 4 * F.lane) = o; }
#pragma unroll
        for (int j = 0; j < 8; ++j) { const int col = 4 * (F.lane + 64 * j);
            const f32x4v a = *(const f32x4v*)(P + OFF_GA + col), b = *(const f32x4v*)(P + OFF_GB + col);
            uint2 o; o.x = pk2(1.f / (1.f + __expf(-a.x)), 1.f / (1.f + __expf(-a.y))); o.y = pk2(1.f / (1.f + __expf(-a.z)), 1.f / (1.f + __expf(-a.w))); *(uint2*)((bf16*)(F.ws + WS_GA) + (size_t)m * D + col) = o;
            o.x = pk2(1.f / (1.f + __expf(-b.x)), 1.f / (1.f + __expf(-b.y))); o.y = pk2(1.f / (1.f + __expf(-b.z)), 1.f / (1.f + __expf(-b.w))); *(uint2*)((bf16*)(F.ws + WS_GB) + (size_t)m * D + col) = o; }
    }
}

__device__ __forceinline__ void ph_gate(Frame& F, int l) {
    const int gw = F.vcu * NWAVES + F.wave, NGW = F.G * NWAVES;
    for (int m = gw; m < M; m += NGW) {
        if (l == DEPTH - 1 && (m % TT) < CTX) continue;
        const bf16* GA = (const bf16*)(F.ws + WS_GA) + (size_t)m * D; const bf16* GB = (const bf16*)(F.ws + WS_GB) + (size_t)m * D;
        const float* T1 = (const float*)(F.ws + WS_T1) + (size_t)m * D; const float* T2 = (const float*)(F.ws + WS_T2) + (size_t)m * D;
        f32x4v h[8];
#pragma unroll
        for (int j = 0; j < 8; ++j) { const int col = 4 * (F.lane + 64 * j); const uint2 a = *(const uint2*)(GA + col), b = *(const uint2*)(GB + col);
            const f32x4v ga = {__builtin_bit_cast(float, a.x << 16), __builtin_bit_cast(float, a.x & 0xffff0000u), __builtin_bit_cast(float, a.y << 16), __builtin_bit_cast(float, a.y & 0xffff0000u)};
            const f32x4v gb = {__builtin_bit_cast(float, b.x << 16), __builtin_bit_cast(float, b.x & 0xffff0000u), __builtin_bit_cast(float, b.y << 16), __builtin_bit_cast(float, b.y & 0xffff0000u)};
            h[j] = ga * *(const f32x4v*)(T1 + col) + gb * *(const f32x4v*)(T2 + col); }
        store_bf16_row((bf16*)(F.ws + WS_MB) + (size_t)m * D, F.lane, h);
    }
}

template <bool ADD_T3>
__device__ __forceinline__ void ph_norm2_router(Frame& F, int l) {
    LAS float* hs = (LAS float*)(F.lds);
    LAS float* pe = (LAS float*)(F.lds + 65536);
    LAS float* pg = (LAS float*)(F.lds + 65536 + 16384);
    LAS float* elb = (LAS float*)(F.lds + 65536 + 16384 + 2048);
    LAS float* glb = elb + 8 * 64;
    float* XW = (float*)(F.ws + WS_XW); bf16* H2 = (bf16*)(F.ws + WS_HA);
    const float* nw = INP(IN_NFFN) + l * D;
    const float* wre = INP(IN_WRE) + (size_t)l * D * NE; const float* wrg = INP(IN_WRG) + (size_t)l * D * NG;
    const int nrows = (l == DEPTH - 1) ? NB * SEQ : M, niter = nrows / 8;
    unsigned* cnt = (unsigned*)F.ctl + CW_CNT + l * 64;
    unsigned* LIST = (unsigned*)(F.ws + WS_LIST) + (size_t)l * NE * M;
    unsigned* TE = (unsigned*)(F.ws + WS_TOK) + (size_t)l * M * 2; unsigned* TP = (unsigned*)(F.ws + WS_TOK) + (size_t)(2 + l) * M * 2; float* TW = (float*)(F.ws + WS_TOK) + (size_t)(4 + l) * M * 2;
    const int w = F.wave, lane = F.lane;
    for (int it = F.vcu; it < niter; it += F.G) {
        const int q = it * 8 + w; const int m = (l == DEPTH - 1) ? (q / SEQ) * TT + CTX + (q % SEQ) : q;
        {
            f32x4v v[8];
#pragma unroll
            for (int j = 0; j < 8; ++j) v[j] = *(const f32x4v*)(XW + (size_t)m * D + 4 * (lane + 64 * j));
            const float* mod = (const float*)(F.ws + WS_MOD) + (size_t)(l * 5 + mod_row(m)) * MODW;
            if (ADD_T3) { const float* T3 = (const float*)(F.ws + WS_T3) + (size_t)m * D;
#pragma unroll
                for (int j = 0; j < 8; ++j) { const int col = 4 * (lane + 64 * j); v[j] += *(const f32x4v*)(mod + 2 * D + col) * *(const f32x4v*)(T3 + col); *(f32x4v*)(XW + (size_t)m * D + col) = v[j]; } }
            const float rstd = 1.0f / sqrtf(row_sumsq(v) * (1.0f / D) + EPS);
            f32x4v h[8];
#pragma unroll
            for (int j = 0; j < 8; ++j) { const int col = 4 * (lane + 64 * j); const f32x4v ww = *(const f32x4v*)(nw + col), sh = *(const f32x4v*)(mod + 3 * D + col), sc = *(const f32x4v*)(mod + 4 * D + col);
                h[j] = (v[j] * rstd * ww) * (1.0f + sc) + sh; *(LAS f32x4v*)(hs + w * D + col) = h[j]; }
            store_bf16_row(H2 + (size_t)m * D, lane, h);
        }
        __syncthreads();
        {
            float acc[8];
#pragma unroll
            for (int r = 0; r < 8; ++r) acc[r] = 0.f;
            const float* wp = wre + (size_t)(256 * w) * NE + lane;
#pragma unroll 2
            for (int kk = 0; kk < 256; kk += 4) {
                const float w0 = wp[(kk + 0) * NE], w1 = wp[(kk + 1) * NE], w2 = wp[(kk + 2) * NE], w3 = wp[(kk + 3) * NE];
#pragma unroll
                for (int r = 0; r < 8; ++r) { const f32x4v hh = *(const LAS f32x4v*)(hs + r * D + 256 * w + kk); acc[r] += hh.x * w0 + hh.y * w1 + hh.z * w2 + hh.w * w3; }
            }
#pragma unroll
            for (int r = 0; r < 8; ++r) pe[(w * 8 + r) * 64 + lane] = acc[r];
            const int g = lane & 7, ksub = lane >> 3;
#pragma unroll
            for (int r = 0; r < 8; ++r) acc[r] = 0.f;
#pragma unroll 4
            for (int i = 0; i < 32; ++i) { const int k = 256 * w + 8 * i + ksub; const float wv = wrg[(size_t)k * NG + g];
#pragma unroll
                for (int r = 0; r < 8; ++r) acc[r] += hs[r * D + k] * wv; }
#pragma unroll
            for (int r = 0; r < 8; ++r) { float a = acc[r]; a += __shfl_xor(a, 8); a += __shfl_xor(a, 16); a += __shfl_xor(a, 32); if (lane < 8) pg[(w * 8 + r) * 8 + lane] = a; }
        }
        __syncthreads();
        {
            float el = INP(IN_BRE)[l * NE + lane];
#pragma unroll
            for (int k2 = 0; k2 < 8; ++k2) el += pe[(k2 * 8 + w) * 64 + lane];
            elb[w * 64 + lane] = el;
            if (lane < 8) { float gl = INP(IN_BRG)[l * NG + lane];
#pragma unroll
                for (int k2 = 0; k2 < 8; ++k2) gl += pg[(k2 * 8 + w) * 8 + lane];
                glb[w * 8 + lane] = gl; }
            LDS_WAIT(); asm volatile("" ::: "memory");
            float gmax = glb[w * 8]; int gi = 0;
#pragma unroll
            for (int i = 1; i < 8; ++i) { const float x = glb[w * 8 + i]; if (x > gmax) { gmax = x; gi = i; } }
            float gs = 0.f;
#pragma unroll
            for (int i = 0; i < 8; ++i) gs += __expf(glb[w * 8 + i] - gmax);
            const float pgv = 1.0f / gs;
            float v1 = elb[w * 64 + gi * 8]; int i1 = 0;
#pragma unroll
            for (int i = 1; i < 8; ++i) { const float x = elb[w * 64 + gi * 8 + i]; if (x > v1) { v1 = x; i1 = i; } }
            float v2 = -3.0e38f; int i2 = 0;
#pragma unroll
            for (int i = 0; i < 8; ++i) { const float x = elb[w * 64 + gi * 8 + i]; if (i != i1 && x > v2) { v2 = x; i2 = i; } }
            const float e2 = __expf(v2 - v1), s1 = 1.0f / (1.0f + e2), s2 = e2 * s1;
            if (lane == 0) {
                const unsigned ea = gi * 8 + i1, eb = gi * 8 + i2;
                const unsigned pa = __hip_atomic_fetch_add(cnt + ea, 1u, RLX_AGENT), pb = __hip_atomic_fetch_add(cnt + eb, 1u, RLX_AGENT);
                LIST[(size_t)ea * M + pa] = (unsigned)m; LIST[(size_t)eb * M + pb] = (unsigned)m;
                TE[m * 2] = ea; TE[m * 2 + 1] = eb; TP[m * 2] = pa; TP[m * 2 + 1] = pb; TW[m * 2] = s1 * pgv; TW[m * 2 + 1] = s2 * pgv;
            }
        }
    }
}

__device__ __forceinline__ void ph_final(Frame& F) {
    LAS unsigned* base = (LAS unsigned*)(F.lds);
    compute_base((const unsigned*)F.ctl + CW_CNT + (DEPTH - 1) * 64, base, F.tid);
    const int gw = F.vcu * NWAVES + F.wave, NGW = F.G * NWAVES;
    const float* XW = (const float*)(F.ws + WS_XW); const float* nw = INP(IN_NFIN);
    for (int q = gw; q < NB * SEQ; q += NGW) {
        const int m = (q / SEQ) * TT + CTX + (q % SEQ);
        f32x4v v[8];
#pragma unroll
        for (int j = 0; j < 8; ++j) v[j] = *(const f32x4v*)(XW + (size_t)m * D + 4 * (F.lane + 64 * j));
        moe_combine_add(F, DEPTH - 1, m, base, v);
        const float rstd = 1.0f / sqrtf(row_sumsq(v) * (1.0f / D) + EPS);
#pragma unroll
        for (int j = 0; j < 8; ++j) { const int col = 4 * (F.lane + 64 * j); *(f32x4v*)(F.out + (size_t)q * D + col) = v[j] * rstd * *(const f32x4v*)(nw + col); }
    }
}
template <int COLMAP>
__global__ void __launch_bounds__(256) naive_gemm(const bf16* A, int lda, const float* W, int ldw, float* Cc, int ldc, int K) {
    const int n = blockIdx.x * 64 + threadIdx.x, m0 = blockIdx.y * 32 + threadIdx.y * 8;
    const int sc = COLMAP ? inproj_src_col(n) : n;
    float acc[8];
#pragma unroll
    for (int i = 0; i < 8; ++i) acc[i] = 0.f;
    for (int k = 0; k < K; ++k) { const float w = W[(size_t)k * ldw + sc];
#pragma unroll
        for (int i = 0; i < 8; ++i) acc[i] += bf2f(A[(size_t)(m0 + i) * lda + k]) * w; }
#pragma unroll
    for (int i = 0; i < 8; ++i) Cc[(size_t)(m0 + i) * ldc + n] = acc[i];
}

__global__ void __launch_bounds__(256) naive_attn(const bf16* Q, const bf16* K, const bf16* V, bf16* Y, const float* sink, int mode, int with_ctx_q) {
    __shared__ float sc[4][TT]; __shared__ float qs[4][HD];
    const int wave = threadIdx.x >> 6, lane = threadIdx.x & 63;
    const int nq = with_ctx_q ? TT : SEQ; const long item = (long)blockIdx.x * 4 + wave; if (item >= (long)NB * NH * nq) return;
    const int tq = (int)(item % nq) + (with_ctx_q ? 0 : CTX), h = (int)((item / nq) % NH), b = (int)(item / ((long)nq * NH)), kvh = h / (NH / NKV);
    const size_t m = (size_t)b * TT + tq;
    qs[wave][lane] = bf2f(Q[m * QW + h * HD + lane]); qs[wave][lane + 64] = bf2f(Q[m * QW + h * HD + lane + 64]);
    __builtin_amdgcn_wave_barrier(); asm volatile("s_waitcnt lgkmcnt(0)" ::: "memory");
    const bool isctx = tq < CTX; const int nk = isctx ? CTX : TT;
    float mx = -3.0e38f;
    for (int kk = lane; kk < nk; kk += 64) {
        bool valid = true;
        if (mode == 1 && !isctx && kk >= CTX) { const int dq = (tq - CTX) - (kk - CTX); valid = dq <= 128 && dq >= -128; }
        float s = -3.0e38f;
        if (valid) { const bf16* kr = K + ((size_t)b * TT + kk) * KW + kvh * HD; float dsum = 0.f;
            for (int d = 0; d < HD; ++d) dsum += bf2f(kr[d]) * qs[wave][d];
            s = dsum * ATTN_SCALE; }
        sc[wave][kk] = s; mx = fmaxf(mx, s);
    }
    mx = wave_max(mx);
    float sk = 0.f; if (mode == 1) { sk = sink[h]; mx = fmaxf(mx, sk); }
    float sum = 0.f;
    for (int kk = lane; kk < nk; kk += 64) { const float s = sc[wave][kk]; const float p = s > -1.0e38f ? __expf(s - mx) : 0.f; sc[wave][kk] = p; sum += p; }
    sum = wave_sum(sum); if (mode == 1) sum += __expf(sk - mx);
    asm volatile("s_waitcnt lgkmcnt(0)" ::: "memory"); __builtin_amdgcn_wave_barrier();
    float o0 = 0.f, o1 = 0.f;
    for (int kk = 0; kk < nk; ++kk) { const float p = sc[wave][kk]; const bf16* vr = V + ((size_t)b * TT + kk) * KW + kvh * HD; o0 += p * bf2f(vr[lane]); o1 += p * bf2f(vr[lane + 64]); }
    const float inv = 1.0f / sum;
    Y[m * D + h * HD + lane] = (bf16)f2bf(o0 * inv); Y[m * D + h * HD + lane + 64] = (bf16)f2bf(o1 * inv);
}

__global__ void __launch_bounds__(256) naive_moe_up(const bf16* H2, const float* w1, const float* w3, const unsigned* cnt, const unsigned* LIST, bf16* HB) {
    __shared__ unsigned base[65];
    const int tid = threadIdx.y * 64 + threadIdx.x;
    if (tid == 0) { unsigned a = 0; for (int e = 0; e < NE; ++e) { base[e] = a; a += cnt[e]; } base[64] = a; }
    __syncthreads();
    const unsigned slot = blockIdx.y * 4 + threadIdx.y; if (slot >= base[64]) return;
    int e = 0; while (base[e + 1] <= slot) ++e;
    const unsigned tok = LIST[(size_t)e * M + (slot - base[e])];
    const int j = blockIdx.x * 64 + threadIdx.x;
    const float* W1 = w1 + (size_t)e * D * DE + j; const float* W3 = w3 + (size_t)e * D * DE + j; const bf16* x = H2 + (size_t)tok * D;
    float a = 0.f, b = 0.f;
    for (int k = 0; k < D; ++k) { const float xv = bf2f(x[k]); a += xv * W1[(size_t)k * DE]; b += xv * W3[(size_t)k * DE]; }
    HB[(size_t)slot * DE + j] = (bf16)f2bf(a / (1.f + __expf(-a)) * b);
}
__global__ void __launch_bounds__(256) naive_moe_down(const bf16* HB, const float* w2, const unsigned* cnt, bf16* YM) {
    __shared__ unsigned base[65];
    const int tid = threadIdx.y * 64 + threadIdx.x;
    if (tid == 0) { unsigned a = 0; for (int e = 0; e < NE; ++e) { base[e] = a; a += cnt[e]; } base[64] = a; }
    __syncthreads();
    const unsigned slot = blockIdx.y * 4 + threadIdx.y; if (slot >= base[64]) return;
    int e = 0; while (base[e + 1] <= slot) ++e;
    const int col = blockIdx.x * 64 + threadIdx.x;
    const float* W2 = w2 + (size_t)e * DE * D + col; const bf16* hrow = HB + (size_t)slot * DE;
    float a = 0.f;
    for (int k = 0; k < DE; ++k) a += bf2f(hrow[k]) * W2[(size_t)k * D];
    YM[(size_t)slot * D + col] = (bf16)f2bf(a);
}
namespace att {
constexpr int NW = 8, QBLK = 32, KVBLK = 64;
constexpr float THR = 8.f;
constexpr int LDQ = QW, LDK = KW, LDO = D;
constexpr size_t SHM_V = KVBLK * HD * 2, SHM_K = KVBLK * HD * 2, SHM_ATTN = 2 * SHM_V + 2 * SHM_K + NW * 64 * 4;
using bf16x8 = __attribute__((ext_vector_type(8))) short;
using s16x4  = __attribute__((ext_vector_type(4))) short;
using f32x16 = __attribute__((ext_vector_type(16))) float;
using u32x4  = __attribute__((ext_vector_type(4))) unsigned;
#define KSWZ(row, colB) ((row) * 256 + ((colB) ^ (((row) & 7) << 4)))
#define SBAR() __builtin_amdgcn_sched_barrier(0)
__device__ __forceinline__ int crow(int r, int hi) { return (r & 3) + 8 * (r >> 2) + 4 * hi; }
__device__ __forceinline__ unsigned cvtpk(float lo, float hi) { unsigned r; asm volatile("v_cvt_pk_bf16_f32 %0, %1, %2" : "=v"(r) : "v"(lo), "v"(hi)); return r; }
__device__ __forceinline__ void partialSM(f32x16& p0, f32x16& p1, float& m_reg, float& mn, float& alpha) {
  constexpr float C = ATTN_SCALE * 1.4426950408889634f;
  float pmax = p0[0]; for (int r = 1; r < 16; ++r) pmax = fmaxf(pmax, p0[r]); for (int r = 0; r < 16; ++r) pmax = fmaxf(pmax, p1[r]);
  { auto rr = __builtin_amdgcn_permlane32_swap(__float_as_uint(pmax), __float_as_uint(pmax), false, false);
    pmax = fmaxf(__uint_as_float(rr[0]), __uint_as_float(rr[1])); }
  if (__builtin_expect(__all(pmax - m_reg <= THR / ATTN_SCALE), 1)) { mn = m_reg; alpha = 1.f; }
  else { mn = fmaxf(m_reg, pmax); alpha = __builtin_amdgcn_exp2f((m_reg - mn) * C); m_reg = mn; }
  float mnC = -mn * C;
  for (int r = 0; r < 16; ++r) p0[r] = fmaf(p0[r], C, mnC); for (int r = 0; r < 16; ++r) p1[r] = fmaf(p1[r], C, mnC);
  for (int r = 0; r < 16; ++r) p0[r] = __builtin_amdgcn_exp2f(p0[r]);
}
__device__ __forceinline__ void finishSM(f32x16& p0, f32x16& p1, float alpha, float& l_reg, bf16x8& pa0, bf16x8& pa1, bf16x8& pa2, bf16x8& pa3) {
  for (int r = 0; r < 16; ++r) p1[r] = __builtin_amdgcn_exp2f(p1[r]);
  float ps = 0; for (int r = 0; r < 16; ++r) ps += p0[r]; for (int r = 0; r < 16; ++r) ps += p1[r];
  { auto rr = __builtin_amdgcn_permlane32_swap(__float_as_uint(ps), __float_as_uint(ps), false, false);
    ps = __uint_as_float(rr[0]) + __uint_as_float(rr[1]); }
  l_reg = l_reg * alpha + ps;
#define PK4(P, BASE, OUT) do { unsigned a0 = cvtpk(P[BASE + 0], P[BASE + 1]), a1 = cvtpk(P[BASE + 2], P[BASE + 3]);   \
    unsigned b0 = cvtpk(P[BASE + 4], P[BASE + 5]), b1 = cvtpk(P[BASE + 6], P[BASE + 7]);                              \
    auto r0 = __builtin_amdgcn_permlane32_swap(a0, b0, false, false); auto r1 = __builtin_amdgcn_permlane32_swap(a1, b1, false, false); \
    u32x4 w = {r0[0], r1[0], r0[1], r1[1]}; OUT = *reinterpret_cast<bf16x8*>(&w); } while (0)
  PK4(p0, 0, pa0); PK4(p0, 8, pa1); PK4(p1, 0, pa2); PK4(p1, 8, pa3);
#undef PK4
}
__device__ __forceinline__ void qkt(f32x16& p0, f32x16& p1, const bf16* Ks, const bf16x8* qr, int r32, int hi) {
  p0 = f32x16{}; p1 = f32x16{};
  for (int d0 = 0; d0 < 8; ++d0) { int cb = (d0 * 16 + hi * 8) * 2;
    bf16x8 b0 = *reinterpret_cast<const bf16x8*>((const char*)Ks + KSWZ(r32, cb));
    bf16x8 b1 = *reinterpret_cast<const bf16x8*>((const char*)Ks + KSWZ(32 + r32, cb));
    p0 = __builtin_amdgcn_mfma_f32_32x32x16_bf16(b0, qr[d0], p0, 0, 0, 0);
    p1 = __builtin_amdgcn_mfma_f32_32x32x16_bf16(b1, qr[d0], p1, 0, 0, 0); }
}
__device__ __forceinline__ void wmask(f32x16& p0, f32x16& p1, int kb, int qpos, int hi) {
  const float NEG = -1.0e30f; const int d0 = kb + 4 * hi - qpos;
#pragma unroll
  for (int r = 0; r < 16; ++r) { const int dd = d0 + (r & 3) + 8 * (r >> 2); if (dd > 128 || dd < -128) p0[r] = NEG; if (dd + 32 > 128 || dd + 32 < -128) p1[r] = NEG; }
}
__device__ __forceinline__ int v_st(int k, int c) { const int kk = (k & ~0xC) | ((k & 4) << 1) | ((k & 8) >> 1); return ((kk >> 3) * 4 + (c >> 5)) * 512 + ((kk & 7) * 32 + (c & 31)) * 2; }
__device__ __forceinline__ int v_rd_base(int lane) { return ((lane & 3) << 3) | (((lane >> 2) & 3) << 6) | (((lane >> 4) & 1) << 5) | (((lane >> 5) & 1) << 8); }
constexpr int v_rd_off(int d0, int ks, int half) { return d0 * 512 + ks * 4096 + half * 2048; }
template <int OFF> __device__ __forceinline__ s16x4 tr_read(int vb) {
  s16x4 r; asm volatile("ds_read_b64_tr_b16 %0, %1 offset:%2" : "=&v"(r) : "v"(vb), "i"(OFF) : "memory"); return r;
}
template <int D0> __device__ __forceinline__ void pv_one(f32x16& od, int vb, bf16x8 pa0, bf16x8 pa1, bf16x8 pa2, bf16x8 pa3) {
  const s16x4 l0 = tr_read<v_rd_off(D0, 0, 0)>(vb), h0 = tr_read<v_rd_off(D0, 0, 1)>(vb), l1 = tr_read<v_rd_off(D0, 1, 0)>(vb), h1 = tr_read<v_rd_off(D0, 1, 1)>(vb);
  const s16x4 l2 = tr_read<v_rd_off(D0, 2, 0)>(vb), h2 = tr_read<v_rd_off(D0, 2, 1)>(vb), l3 = tr_read<v_rd_off(D0, 3, 0)>(vb), h3 = tr_read<v_rd_off(D0, 3, 1)>(vb);
  asm volatile("s_waitcnt lgkmcnt(0)" ::: "memory"); SBAR();
#define PK(L, H) (bf16x8){L[0], L[1], L[2], L[3], H[0], H[1], H[2], H[3]}
  od = __builtin_amdgcn_mfma_f32_32x32x16_bf16(pa0, PK(l0, h0), od, 0, 0, 0);
  od = __builtin_amdgcn_mfma_f32_32x32x16_bf16(pa1, PK(l1, h1), od, 0, 0, 0);
  od = __builtin_amdgcn_mfma_f32_32x32x16_bf16(pa2, PK(l2, h2), od, 0, 0, 0);
  od = __builtin_amdgcn_mfma_f32_32x32x16_bf16(pa3, PK(l3, h3), od, 0, 0, 0);
#undef PK
}
__device__ __forceinline__ void pv_d0(f32x16* o, int vb, bf16x8 pa0, bf16x8 pa1, bf16x8 pa2, bf16x8 pa3) {
  pv_one<0>(o[0], vb, pa0, pa1, pa2, pa3); pv_one<1>(o[1], vb, pa0, pa1, pa2, pa3); pv_one<2>(o[2], vb, pa0, pa1, pa2, pa3); pv_one<3>(o[3], vb, pa0, pa1, pa2, pa3);
}
__device__ __forceinline__ void attn_unit(const bool MASKED, const bf16* __restrict__ Qb, const bf16* __restrict__ Kh, const bf16* __restrict__ Vh, bf16* __restrict__ Ob,
                                          int NT, int klo, int q0, float m0, float l0, char* lds) {
  const int tid = threadIdx.x, wid = tid >> 6, lane = tid & 63, r32 = lane & 31, hi = lane >> 5;
  bf16* V_lds = (bf16*)lds; bf16* K_lds = (bf16*)(lds + 2 * SHM_V);
  float* ws = (float*)(lds + 2 * SHM_V + 2 * SHM_K) + wid * 64; float* li_l = ws; float* al_l = ws + 32;
  float m_reg = m0, l_reg = l0; f32x16 o[4] = {}; bf16x8 qr[8];
  const bf16* Qw = Qb + (long)(wid * QBLK + r32) * LDQ + hi * 8;
#pragma unroll
  for (int d0 = 0; d0 < 8; ++d0) qr[d0] = *reinterpret_cast<const bf16x8*>(Qw + d0 * 16);
  const int sr = tid >> 4, sc = (tid & 15) * 8, vst0 = v_st(sr, sc), vst1 = v_st(32 + sr, sc);
  const int vb0 = (int)(uintptr_t)V_lds + v_rd_base(lane);
  const int qpos = q0 + wid * QBLK + r32;
  struct { bf16x8 vs0, vs1, ks0, ks1; } sr_[2];
#define KROW(j) ((!MASKED || (j) < 4) ? 64 * (j) : CTX + klo + 64 * ((j) - 4))
#define SLOAD(i, j) do { const int k0_ = KROW(j); sr_[i].vs0 = *reinterpret_cast<const bf16x8*>(&Vh[(long)(k0_ + sr) * LDK + sc]); sr_[i].vs1 = *reinterpret_cast<const bf16x8*>(&Vh[(long)(k0_ + 32 + sr) * LDK + sc]); \
    sr_[i].ks0 = *reinterpret_cast<const bf16x8*>(&Kh[(long)(k0_ + sr) * LDK + sc]); sr_[i].ks1 = *reinterpret_cast<const bf16x8*>(&Kh[(long)(k0_ + 32 + sr) * LDK + sc]); } while (0)
#define SWRITE(b, i) do { *(bf16x8*)((char*)V_lds + (b) * SHM_V + vst0) = sr_[i].vs0;          \
    *(bf16x8*)((char*)V_lds + (b) * SHM_V + vst1) = sr_[i].vs1; int kc = sc * 2;               \
    *(bf16x8*)((char*)K_lds + (b) * SHM_K + KSWZ(sr, kc)) = sr_[i].ks0;                       \
    *(bf16x8*)((char*)K_lds + (b) * SHM_K + KSWZ(32 + sr, kc)) = sr_[i].ks1; } while (0)
#define SWAIT() asm volatile("s_waitcnt vmcnt(4)" ::: "memory")
#define RESC(a) do { if (__any((a) < 1.f)) { if (hi == 0) al_l[r32] = (a); asm volatile("s_waitcnt lgkmcnt(0)" ::: "memory"); \
    for (int d = 0; d < 4; ++d) for (int r = 0; r < 16; ++r) o[d][r] *= al_l[crow(r, hi)]; } } while (0)
#define WMASK(P0, P1, j) do { if (MASKED && (j) >= 4) wmask(P0, P1, klo + 64 * ((j) - 4), qpos, hi); } while (0)
  f32x16 pA0, pA1, pB0, pB1; float mnA, mnB, alA, alB; bf16x8 pa0, pa1, pa2, pa3;
  constexpr int SE = 0, SO = 1;
  __syncthreads();
  SLOAD(SE, 0); asm volatile("s_waitcnt vmcnt(0)" ::: "memory"); SWRITE(0, SE); __syncthreads();
  qkt(pA0, pA1, K_lds, qr, r32, hi); WMASK(pA0, pA1, 0); partialSM(pA0, pA1, m_reg, mnA, alA);
  SLOAD(SO, 1); if (2 < NT) SLOAD(SE, 2);
  SWAIT(); SWRITE(1, SO); __syncthreads();
  for (int j = 1; j + 1 < NT; j += 2) {
    SBAR(); qkt(pB0, pB1, (bf16*)((char*)K_lds + SHM_K), qr, r32, hi); WMASK(pB0, pB1, j);
    finishSM(pA0, pA1, alA, l_reg, pa0, pa1, pa2, pa3); SBAR();
    SLOAD(SO, j + 2); SBAR();
    pv_d0(o, vb0, pa0, pa1, pa2, pa3); partialSM(pB0, pB1, m_reg, mnB, alB);
    __syncthreads(); SWAIT(); SWRITE(0, SE);
    RESC(alB); __syncthreads();
    SBAR(); qkt(pA0, pA1, K_lds, qr, r32, hi); WMASK(pA0, pA1, j + 1);
    finishSM(pB0, pB1, alB, l_reg, pa0, pa1, pa2, pa3); SBAR();
    if (j + 3 < NT) SLOAD(SE, j + 3); SBAR();
    pv_d0(o, vb0 + (int)SHM_V, pa0, pa1, pa2, pa3); partialSM(pA0, pA1, m_reg, mnA, alA);
    __syncthreads(); SWAIT(); SWRITE(1, SO);
    RESC(alA); __syncthreads();
  }
  SBAR(); qkt(pB0, pB1, (bf16*)((char*)K_lds + SHM_K), qr, r32, hi); WMASK(pB0, pB1, NT - 1);
  finishSM(pA0, pA1, alA, l_reg, pa0, pa1, pa2, pa3); SBAR();
  pv_d0(o, vb0, pa0, pa1, pa2, pa3); partialSM(pB0, pB1, m_reg, mnB, alB);
  __syncthreads(); RESC(alB);
  finishSM(pB0, pB1, alB, l_reg, pa0, pa1, pa2, pa3); SBAR();
  pv_d0(o, vb0 + (int)SHM_V, pa0, pa1, pa2, pa3);
  if (hi == 0) li_l[r32] = l_reg; asm volatile("s_waitcnt lgkmcnt(0)" ::: "memory");
  float rli[16];
#pragma unroll
  for (int r = 0; r < 16; ++r) rli[r] = __builtin_amdgcn_rcpf(li_l[crow(r, hi)]);
  bf16* Ow = Ob + (long)(wid * QBLK) * LDO;
#pragma unroll
  for (int r = 0; r < 16; ++r) { int orow = crow(r, hi);
    for (int d0 = 0; d0 < 4; ++d0) Ow[(long)orow * LDO + d0 * 32 + r32] = (bf16)f2bf(o[d0][r] * rli[r]); }
#undef KROW
#undef SLOAD
#undef SWRITE
#undef SWAIT
#undef RESC
#undef WMASK
}
#undef KSWZ
#undef SBAR
}

__device__ __forceinline__ void fast_attn(Frame& F, int l) {
    char* lds = (char*)F.lds;
    const int nsub = (l < DEPTH - 1) ? 3 : 2;
    for (int u = (int)blockIdx.x; u < 256; u += F.G) {
        const int x = u & 7, y = u >> 3, b = x >> 1, kvh = x & 1, g = y >> 3, qb = y & 7, h = kvh * 4 + g;
        for (int s = 0; s < nsub; ++s) {
            if (s == 2 && qb > 1) break;
            const bool mixB = (s == 1) || (s == 2 && qb == 1), ctxq = (s == 2);
            const size_t brow = (size_t)b * TT, qrow = ctxq ? brow : brow + CTX + 256 * qb;
            const bf16* Qp = (const bf16*)(F.ws + (mixB ? WS_QB : WS_QA)) + qrow * QW + h * HD;
            const bf16* Kp = (const bf16*)(F.ws + (mixB ? WS_KB : WS_KA)) + brow * KW + kvh * HD;
            const bf16* Vp = (const bf16*)(F.ws + (mixB ? WS_VB : WS_VA)) + brow * KW + kvh * HD;
            bf16* Op = (bf16*)(F.ws + WS_YAB) + qrow * D + (mixB ? QW : 0) + h * HD;
            const int q0 = 256 * qb, klo = q0 - 128 < 0 ? 0 : q0 - 128, khi = q0 + 384 > SEQ ? SEQ : q0 + 384;
            const int NT = ctxq ? CTX / 64 : (s == 0 ? TT / 64 : 4 + (khi - klo) / 64);
            const float m0 = mixB ? INP(IN_SINK)[l * NH + h] * (1.0f / ATTN_SCALE) : -1.0e30f, l0 = mixB ? 1.f : 0.f;
            att::attn_unit(s == 1, Qp, Kp, Vp, Op, NT, klo, q0, m0, l0, lds);
        }
    }
}
namespace moe {
typedef unsigned u32x2 __attribute__((ext_vector_type(2)));
using pg8::lds_byte; using pg8::stage_rc; using pg8::bf16x8; using pg8::f32x4;
constexpr int HTB = 16384;
#define MOE_SA(b, h) ((((b) * 3) + (h)) * moe::HTB)
#define MOE_SB(b) ((6 + (b)) * moe::HTB)
__device__ __forceinline__ unsigned cvt_pk(float lo, float hi) { unsigned r; asm volatile("v_cvt_pk_bf16_f32 %0, %1, %2" : "=v"(r) : "v"(lo), "v"(hi)); return r; }

template <int MODE>
__device__ __forceinline__ void moe_phase(Frame& F, int l) {
    LAS unsigned char* lds = F.lds + RING_OFF;
    LAS unsigned* base = (LAS unsigned*)(F.lds + XS_OFF);
    const unsigned* cnt = (const unsigned*)F.ctl + CW_CNT + l * 64;
    compute_base(cnt, base, F.tid);
    constexpr int NCS = MODE == 0 ? 8 : 16, K = MODE == 0 ? D : DE, NT = K / 64, LDW = MODE == 0 ? DE : D;
    const int tid = F.tid, wid = F.wave, lane = F.lane, wr = wid >> 2, wc = wid & 3, fr = lane & 15, fq = lane >> 4;
    const int kq = (lane & 7) + 8 * (wid & 1), cq = ((lane >> 3) & 7) + 8 * (wid >> 1);
    const int aoff = lds_byte(wr * 64 + fr, fq * 8), boff = lds_byte(wc * 32 + fr, fq * 8);
    int sR[2], sC[2];
#pragma unroll
    for (int i = 0; i < 2; ++i) stage_rc(tid * 16 + i * 8192, sR[i], sC[i]);
    int bw[4];
#pragma unroll
    for (int j = 0; j < 4; ++j) { int slot; if (MODE == 0) { const int c = 4 * (cq & 15) + j; slot = 32 * (c >> 4) + 16 * (cq >> 4) + (c & 15); } else slot = 4 * cq + j; bw[j] = lds_byte(slot, 4 * kq); }
    const unsigned* LISTl = (const unsigned*)(F.ws + WS_LIST) + (size_t)l * NE * M;
    for (int u = F.vcu; u < NE * NCS; u += F.G) {
        const int e = u / NCS, cs = u % NCS; const int n_e = (int)(base[e + 1] - base[e]), base_e = (int)base[e];
        const float* Wsrc;
        if (MODE == 0) Wsrc = ((cq >> 4) ? INP(IN_W3) : INP(IN_W1)) + ((size_t)(l * NE + e) * D) * DE + 64 * cs + 4 * (cq & 15) + (size_t)(4 * kq) * DE;
        else           Wsrc = INP(IN_W2) + ((size_t)(l * NE + e) * DE) * D + 128 * cs + 4 * cq + (size_t)(4 * kq) * D;
        const char* Abase = (MODE == 0) ? (const char*)(F.ws + WS_HA) : (const char*)(F.ws + WS_HB);
        for (int r0 = 0; r0 < n_e; r0 += 384) {
            const int nrows = (n_e - r0) < 384 ? (n_e - r0) : 384;
            unsigned aof[3][2];
#pragma unroll
            for (int h = 0; h < 3; ++h)
#pragma unroll
                for (int i = 0; i < 2; ++i) { int r = h * 128 + sR[i]; if (r >= nrows) r = 0;
                    if (MODE == 0) aof[h][i] = LISTl[(size_t)e * M + r0 + r] * (unsigned)(D * 2) + (unsigned)sC[i] * 2u;
                    else           aof[h][i] = (unsigned)(base_e + r0 + r) * (unsigned)(DE * 2) + (unsigned)sC[i] * 2u; }
            f32x4 acc[3][4][2];
#pragma unroll
            for (int a = 0; a < 3; ++a)
#pragma unroll
                for (int m = 0; m < 4; ++m)
#pragma unroll
                    for (int n = 0; n < 2; ++n) acc[a][m][n] = (f32x4){0.f, 0.f, 0.f, 0.f};
            f32x4 wB0[4], wB1[4];
#define MOE_DMA_A(t, b) do { _Pragma("unroll") for (int h_ = 0; h_ < 3; ++h_) _Pragma("unroll") for (int i_ = 0; i_ < 2; ++i_) \
        __builtin_amdgcn_global_load_lds((const unsigned*)(Abase + aof[h_][i_] + (size_t)(t) * 128), (LAS unsigned*)(lds + MOE_SA(b, h_) + wid * 1024 + i_ * 8192), 16, 0, 0); } while (0)
#define MOE_LOADB(t, W) do { _Pragma("unroll") for (int i_ = 0; i_ < 4; ++i_) W[i_] = *(const f32x4*)(Wsrc + ((size_t)(t) * 64 + i_) * LDW); } while (0)
#define MOE_WRITEB(W, b) do { _Pragma("unroll") for (int j_ = 0; j_ < 4; ++j_) { u32x2 o_; o_.x = cvt_pk(W[0][j_], W[1][j_]); o_.y = cvt_pk(W[2][j_], W[3][j_]); *(LAS u32x2*)(lds + MOE_SB(b) + bw[j_]) = o_; } } while (0)
#define MOE_TOP(more) do { if (more) asm volatile("s_waitcnt vmcnt(4)" ::: "memory"); else asm volatile("s_waitcnt vmcnt(0)" ::: "memory"); \
        asm volatile("s_waitcnt lgkmcnt(0)" ::: "memory"); __builtin_amdgcn_s_barrier(); asm volatile("" ::: "memory"); } while (0)
#define MOE_MMA(b) do { bf16x8 Bf[2][2]; _Pragma("unroll") for (int n_ = 0; n_ < 2; ++n_) _Pragma("unroll") for (int k_ = 0; k_ < 2; ++k_) Bf[n_][k_] = *(const LAS bf16x8*)(lds + MOE_SB(b) + boff + n_ * 2048 + k_ * 1024); \
        _Pragma("unroll") for (int a_ = 0; a_ < 3; ++a_) { if (a_ * 128 + wr * 64 < nrows) { bf16x8 At[4][2]; \
            _Pragma("unroll") for (int m_ = 0; m_ < 4; ++m_) _Pragma("unroll") for (int k_ = 0; k_ < 2; ++k_) At[m_][k_] = *(const LAS bf16x8*)(lds + MOE_SA(b, a_) + aoff + m_ * 2048 + k_ * 1024); \
            _Pragma("unroll") for (int m_ = 0; m_ < 4; ++m_) { if (a_ * 128 + wr * 64 + m_ * 16 < nrows) { _Pragma("unroll") for (int n_ = 0; n_ < 2; ++n_) _Pragma("unroll") for (int k_ = 0; k_ < 2; ++k_) \
                acc[a_][m_][n_] = __builtin_amdgcn_mfma_f32_16x16x32_bf16(Bf[n_][k_], At[m_][k_], acc[a_][m_][n_], 0, 0, 0); } } } } } while (0)
            asm volatile("s_waitcnt lgkmcnt(0)" ::: "memory"); __builtin_amdgcn_s_barrier(); asm volatile("" ::: "memory");
            MOE_DMA_A(0, 0); MOE_LOADB(0, wB0); MOE_LOADB(1, wB1); MOE_WRITEB(wB0, 0);
            for (int t = 0; t < NT; t += 2) {
                MOE_TOP(true);
                MOE_DMA_A(t + 1, 1);
                if (t + 2 < NT) MOE_LOADB(t + 2, wB0);
                MOE_MMA(0);
                MOE_WRITEB(wB1, 1);
                MOE_TOP(t + 2 < NT);
                if (t + 2 < NT) MOE_DMA_A(t + 2, 0);
                if (t + 3 < NT) MOE_LOADB(t + 3, wB1);
                MOE_MMA(1);
                if (t + 2 < NT) MOE_WRITEB(wB0, 0);
            }
#pragma unroll
            for (int a = 0; a < 3; ++a)
#pragma unroll
                for (int m = 0; m < 4; ++m) { const int row = a * 128 + wr * 64 + m * 16 + fr;
                    if (row < nrows) {
                        if (MODE == 0) { const f32x4 x = acc[a][m][0], y = acc[a][m][1]; uint2 o;
                            o.x = cvt_pk(x[0] / (1.f + __expf(-x[0])) * y[0], x[1] / (1.f + __expf(-x[1])) * y[1]); o.y = cvt_pk(x[2] / (1.f + __expf(-x[2])) * y[2], x[3] / (1.f + __expf(-x[3])) * y[3]);
                            *(uint2*)((bf16*)(F.ws + WS_HB) + (size_t)(base_e + r0 + row) * DE + 64 * cs + 16 * wc + 4 * fq) = o;
                        } else {
#pragma unroll
                            for (int n = 0; n < 2; ++n) { const f32x4 x = acc[a][m][n]; uint2 o; o.x = cvt_pk(x[0], x[1]); o.y = cvt_pk(x[2], x[3]);
                                *(uint2*)((bf16*)(F.ws + WS_YM) + (size_t)(base_e + r0 + row) * D + 128 * cs + 32 * wc + 16 * n + 4 * fq) = o; }
                        }
                    } }
        }
    }
    asm volatile("s_waitcnt vmcnt(0) lgkmcnt(0)" ::: "memory"); __syncthreads();
#undef MOE_DMA_A
#undef MOE_LOADB
#undef MOE_WRITEB
#undef MOE_TOP
#undef MOE_MMA
}
}
__device__ __forceinline__ void fast_moe_up(Frame& F, int l) { moe::moe_phase<0>(F, l); }
__device__ __forceinline__ void fast_moe_down(Frame& F, int l) { moe::moe_phase<1>(F, l); }
struct RowOrder {
    pg8::StaticOrder so; bool latent_only;
    __device__ void init(bool lat, int N, int G, int c) { latent_only = lat; so.init(lat ? NB * SEQ : M, N, G, c); }
    __device__ bool next(int i, pg8::Unit& u) const { if (!so.next(i, u)) return false; if (latent_only) u.pm = (u.pm >> 3) * 9 + 1 + (u.pm & 7); return true; }
    __device__ __forceinline__ void a_ready(const pg8::Unit&) const {}
    __device__ __forceinline__ void done(const pg8::Unit&) const {}
};
struct EpiF32 {
    static constexpr bool PERM = false, AFTER_DRAIN = false;
    float* O; int ldc;
    __device__ __forceinline__ void operator()(const pg8::f32x4 (&acc)[2][2][4][2], const pg8::Unit& u, int wr, int wc, int fr, int fq) const {
        const int row0 = u.pm * 256 + wr * 64 + fr, col0 = u.pn * 256 + wc * 32 + 4 * fq;
#pragma unroll
        for (int ai = 0; ai < 2; ++ai)
#pragma unroll
            for (int m = 0; m < 4; ++m) { float* rowp = O + (size_t)(row0 + ai * 128 + m * 16) * ldc + col0;
#pragma unroll
                for (int bj = 0; bj < 2; ++bj)
#pragma unroll
                    for (int n = 0; n < 2; ++n) *(pg8::f32x4*)(rowp + bj * 128 + n * 16) = acc[ai][bj][m][n]; }
    }
};
__device__ __forceinline__ void fast_inproj(Frame& F, int l) {
    pg8::Gemm g{(const bf16*)(F.ws + WS_HA), (const bf16*)(F.ws + WS_WIN) + (size_t)l * INC * D, M, INC, D, D, D};
    RowOrder S; S.init(false, INC, F.G, (int)blockIdx.x);
    EpiF32 E{(float*)(F.ws + WS_P), INC};
    pg8::gemm_phase<EpiF32, RowOrder, true, true>(F.lds + RING_OFF, g, S, E);
}
__device__ __forceinline__ void fast_br(Frame& F, int l) {
    const bool lat = (l == DEPTH - 1);
    { pg8::Gemm g{(const bf16*)(F.ws + WS_YAB), (const bf16*)(F.ws + WS_WBR) + (size_t)l * D * D, M, D, QW, D, D};
      RowOrder S; S.init(lat, D, F.G, (int)blockIdx.x); EpiF32 E{(float*)(F.ws + WS_T1), D};
      pg8::gemm_phase<EpiF32, RowOrder, true, true>(F.lds + RING_OFF, g, S, E); }
    { pg8::Gemm g{(const bf16*)(F.ws + WS_YAB) + QW, (const bf16*)(F.ws + WS_WBR) + (size_t)l * D * D + QW, M, D, QW, D, D};
      RowOrder S; S.init(lat, D, F.G, (int)blockIdx.x); EpiF32 E{(float*)(F.ws + WS_T2), D};
      pg8::gemm_phase<EpiF32, RowOrder, true, true>(F.lds + RING_OFF, g, S, E); }
}
__device__ __forceinline__ void fast_out(Frame& F, int l) {
    const bool lat = (l == DEPTH - 1);
    pg8::Gemm g{(const bf16*)(F.ws + WS_MB), (const bf16*)(F.ws + WS_WOUT) + (size_t)l * D * D, M, D, D, D, D};
    RowOrder S; S.init(lat, D, F.G, (int)blockIdx.x); EpiF32 E{(float*)(F.ws + WS_T3), D};
    pg8::gemm_phase<EpiF32, RowOrder, true, true>(F.lds + RING_OFF, g, S, E);
}
constexpr int PH_P0 = 0, PH_PER_LAYER = 10, PH_FINAL = 1 + PH_PER_LAYER * DEPTH, NPH = PH_FINAL + 1;
enum { L_NORM1 = 0, L_INPROJ = 1, L_POST = 2, L_ATTN = 3, L_BR = 4, L_GATE = 5, L_OUT = 6, L_NORM2R = 7, L_UP = 8, L_DOWN = 9 };
struct Args { const float* in[NIN]; float* out; unsigned char* ws; int ph_lo, ph_hi, li, pad; };

__global__ void __launch_bounds__(NWAVES * 64, 2) mk_fwd(Args args) {
    extern __shared__ __attribute__((aligned(16))) unsigned char lds[];
    Frame F;
    F.lds = (LAS unsigned char*)lds;
    F.MISC = (volatile LAS unsigned*)(F.lds + MISC_OFF);
    F.tid = threadIdx.x; F.lane = F.tid & 63; F.wave = __builtin_amdgcn_readfirstlane(F.tid >> 6);
    F.G = gridDim.x; { const int bx = blockIdx.x; F.vcu = (F.G % 8 == 0) ? (bx % 8) * (F.G / 8) + bx / 8 : bx; }
    F.ws = args.ws; F.out = args.out; F.ctl = (gu32*)(args.ws + WS_CTL);
    for (int u = F.tid; u < (LDS_BYTES - LDSCTL_OFF) / 4; u += NWAVES * 64) ((LAS unsigned*)(F.lds + LDSCTL_OFF))[u] = 0u;
    __syncthreads();
    if (F.tid < NIN) ((LAS cfptr*)(F.lds + LDSCTL_OFF + 256))[F.tid] = args.in[F.tid];
    __syncthreads();
    XcdBarrier bar = xcd_barrier_post((unsigned*)(F.ctl + CW_BAR) + args.li * XCD_BAR_WORDS, F.MISC + 8);
    const int lo = args.ph_lo, hi = args.ph_hi;
#define IN(k) (lo <= (k) && (k) < hi)
#define SEAM(k) do { if (IN(k) && IN((k) + 1)) xcd_barrier(bar); } while (0)

    if (IN(PH_P0)) p0_prologue(F);
    SEAM(PH_P0);
#define LAYER_PROGRAM(l) do { constexpr int pb = 1 + PH_PER_LAYER * (l); \
        if (IN(pb + L_NORM1)) ph_norm1(F, (l)); \
        SEAM(pb + L_NORM1); \
        if (IN(pb + L_INPROJ)) { if constexpr (FAST_INPROJ) fast_inproj(F, (l)); } \
        SEAM(pb + L_INPROJ); \
        if (IN(pb + L_POST)) { if constexpr (!FUSE_POST) ph_post(F, (l)); } \
        SEAM(pb + L_POST); \
        if (IN(pb + L_ATTN)) { if constexpr (FAST_ATTN) fast_attn(F, (l)); } \
        SEAM(pb + L_ATTN); \
        if (IN(pb + L_BR)) { if constexpr (FAST_BR) fast_br(F, (l)); } \
        SEAM(pb + L_BR); \
        if (IN(pb + L_GATE)) { if constexpr (!FUSE_GATE) ph_gate(F, (l)); } \
        SEAM(pb + L_GATE); \
        if (IN(pb + L_OUT)) { if constexpr (FAST_OUT) fast_out(F, (l)); } \
        SEAM(pb + L_OUT); \
        if (IN(pb + L_NORM2R)) ph_norm2_router<!FUSE_RES>(F, (l)); \
        SEAM(pb + L_NORM2R); \
        if (IN(pb + L_UP)) { if constexpr (FAST_UP) fast_moe_up(F, (l)); } \
        SEAM(pb + L_UP); \
        if (IN(pb + L_DOWN)) { if constexpr (FAST_DOWN) fast_moe_down(F, (l)); } \
        SEAM(pb + L_DOWN); } while (0)
    LAYER_PROGRAM(0);
    LAYER_PROGRAM(1);
#undef LAYER_PROGRAM
    if (IN(PH_FINAL)) ph_final(F);
#undef IN
#undef SEAM
}

static bool phase_is_naive(int ph) {
    if (ph == PH_P0 || ph == PH_FINAL) return false;
    const int k = (ph - 1) % PH_PER_LAYER;
    switch (k) { case L_INPROJ: return !FAST_INPROJ; case L_ATTN: return !FAST_ATTN; case L_BR: return !FAST_BR; case L_OUT: return !FAST_OUT; case L_UP: return !FAST_UP; case L_DOWN: return !FAST_DOWN; default: return false; }
}
extern "C" void kernel_launch(void* const* d_in, const int* in_sizes, int n_in, void* d_out, int out_size, void* d_ws, size_t ws_size, hipStream_t stream) {
    static int grid = 0;
    if (grid == 0) {
        if (n_in != NIN || in_sizes[0] != NB * SEQ * D || out_size != NB * SEQ * D || ws_size < WS_END) { fprintf(stderr, "kernel_launch: shape/workspace mismatch (n_in %d, ws %zu)\n", n_in, ws_size); grid = -1; return; }
        int dev = 0, cus = 0, per_cu = 0;
        if (hipGetDevice(&dev) != hipSuccess || hipDeviceGetAttribute(&cus, hipDeviceAttributeMultiprocessorCount, dev) != hipSuccess) { grid = -1; return; }
        if (hipFuncSetAttribute((const void*)mk_fwd, hipFuncAttributeMaxDynamicSharedMemorySize, LDS_BYTES) != hipSuccess) { fprintf(stderr, "kernel_launch: hipFuncSetAttribute failed\n"); grid = -1; return; }
        if (hipOccupancyMaxActiveBlocksPerMultiprocessor(&per_cu, (const void*)mk_fwd, NWAVES * 64, LDS_BYTES) != hipSuccess || per_cu < 1) fprintf(stderr, "kernel_launch: occupancy query reports %d\n", per_cu);
        (void)hipGetLastError();
        grid = cus;
    }
    if (grid < 0) return;
    unsigned char* ws = (unsigned char*)d_ws;
    (void)hipMemsetAsync(ws + WS_CTL, 0, CTL_ZERO_BYTES, stream);
    Args a{};
    for (int i = 0; i < NIN; ++i) a.in[i] = (const float*)d_in[i];
    a.out = (float*)d_out; a.ws = ws;
    const float* const* in = (const float* const*)d_in;
    int li = 0, lo = -1;
    for (int ph = 0; ph < NPH; ++ph) {
        const bool nv = phase_is_naive(ph);
        if (!nv && lo < 0) lo = ph;
        if (nv || ph == NPH - 1) {
            if (lo >= 0) { a.ph_lo = lo; a.ph_hi = nv ? ph : ph + 1; a.li = li++; hipLaunchKernelGGL(mk_fwd, dim3(grid), dim3(NWAVES * 64), LDS_BYTES, stream, a); lo = -1; }
            if (nv) {
                const int l = (ph - 1) / PH_PER_LAYER, k = (ph - 1) % PH_PER_LAYER;
                const unsigned* cnt = (const unsigned*)ws + CW_CNT + l * 64;
                if (k == L_INPROJ) hipLaunchKernelGGL(naive_gemm<1>, dim3(INC / 64, M / 32), dim3(64, 4), 0, stream, (const bf16*)(ws + WS_HA), D, in[IN_WIN] + (size_t)l * D * INC, INC, (float*)(ws + WS_P), INC, D);
                else if (k == L_ATTN) { const int wq = (l < DEPTH - 1) ? 1 : 0; const long items = (long)NB * NH * (wq ? TT : SEQ);
                    hipLaunchKernelGGL(naive_attn, dim3((unsigned)((items + 3) / 4)), dim3(256), 0, stream, (const bf16*)(ws + WS_QA), (const bf16*)(ws + WS_KA), (const bf16*)(ws + WS_VA), (bf16*)(ws + WS_YAB), (const float*)nullptr, 0, wq);
                    hipLaunchKernelGGL(naive_attn, dim3((unsigned)((items + 3) / 4)), dim3(256), 0, stream, (const bf16*)(ws + WS_QB), (const bf16*)(ws + WS_KB), (const bf16*)(ws + WS_VB), (bf16*)(ws + WS_YAB) + QW, in[IN_SINK] + l * NH, 1, wq); }
                else if (k == L_BR) { hipLaunchKernelGGL(naive_gemm<0>, dim3(D / 64, M / 32), dim3(64, 4), 0, stream, (const bf16*)(ws + WS_YAB), D, in[IN_WBRA] + (size_t)l * QW * D, D, (float*)(ws + WS_T1), D, QW);
                    hipLaunchKernelGGL(naive_gemm<0>, dim3(D / 64, M / 32), dim3(64, 4), 0, stream, (const bf16*)(ws + WS_YAB) + QW, D, in[IN_WBRB] + (size_t)l * QW * D, D, (float*)(ws + WS_T2), D, QW); }
                else if (k == L_OUT) hipLaunchKernelGGL(naive_gemm<0>, dim3(D / 64, M / 32), dim3(64, 4), 0, stream, (const bf16*)(ws + WS_MB), D, in[IN_WOUT] + (size_t)l * D * D, D, (float*)(ws + WS_T3), D, D);
                else if (k == L_UP) hipLaunchKernelGGL(naive_moe_up, dim3(DE / 64, 2 * M / 4), dim3(64, 4), 0, stream, (const bf16*)(ws + WS_HA), in[IN_W1] + (size_t)l * NE * D * DE, in[IN_W3] + (size_t)l * NE * D * DE, cnt, (const unsigned*)(ws + WS_LIST) + (size_t)l * NE * M, (bf16*)(ws + WS_HB));
                else if (k == L_DOWN) hipLaunchKernelGGL(naive_moe_down, dim3(D / 64, 2 * M / 4), dim3(64, 4), 0, stream, (const bf16*)(ws + WS_HB), in[IN_W2] + (size_t)l * NE * DE * D, cnt, (bf16*)(ws + WS_YM));
            }
        }
    }
    const hipError_t le = hipPeekAtLastError();
    if (le != hipSuccess) fprintf(stderr, "kernel_launch: launch failed: %s\n", hipGetErrorName(le));
}
```

```cpp
#include <hip/hip_runtime.h>
#include <cstdio>
#include <cstdint>

constexpr int D = 2048, NB = 4, SEQ = 2048, CTX = 256, TT = CTX + SEQ, M = NB * TT, DEPTH = 2;
constexpr int HD = 128, NH = 8, NKV = 2, GRIDW = 64;
constexpr int QW = NH * HD, KW = NKV * HD;
constexpr int INC = 2 * QW + 4 * KW + 2 * D;
constexpr int OFF_QA = 0, OFF_KA = 1024, OFF_VA = 1280, OFF_QB = 1536, OFF_KB = 2560, OFF_VB = 2816, OFF_GA = 3072, OFF_GB = 5120;
constexpr int NE = 64, NG = 8, EPG = 8, DE = 512;
constexpr float EPS = 1e-6f;
constexpr float ATTN_SCALE = 0.08838834764831845f;
constexpr int MODW = 6 * D;
constexpr int NIN = 23;

__host__ __device__ __forceinline__ int perm_d2j(int d) { return 32 * (2 * (d >> 6) + ((d >> 4) & 1)) + 16 * ((d >> 5) & 1) + (d & 15); }
__host__ __device__ __forceinline__ int perm_j2d(int j) { const int wc = j >> 5, n = (j >> 4) & 1, t = j & 15; return 64 * (wc >> 1) + 32 * n + 16 * (wc & 1) + t; }
__host__ __device__ __forceinline__ bool inproj_roped(int c) { return (c < OFF_VA) || (c >= OFF_QB && c < OFF_VB); }
__host__ __device__ __forceinline__ int inproj_src_col(int c) { return inproj_roped(c) ? (c & ~127) + perm_j2d(c & 127) : c; }
__host__ __device__ __forceinline__ int inproj_dst_col(int n) { return inproj_roped(n) ? (n & ~127) + perm_d2j(n & 127) : n; }

constexpr size_t MiB = 1u << 20;
constexpr size_t WS_CTL = 0, CTL_ZERO_BYTES = 1 * MiB;
constexpr size_t WS_MOD = 1 * MiB;
constexpr size_t WS_ROPE = 1 * MiB + 512 * 1024;
constexpr size_t WS_TOK = 2 * MiB;
constexpr size_t WS_LIST = 3 * MiB;
constexpr size_t WS_WIN = 8 * MiB;
constexpr size_t WS_WBR = 64 * MiB;
constexpr size_t WS_WOUT = 80 * MiB;
constexpr size_t WS_XW = 96 * MiB;
constexpr size_t WS_HA = 168 * MiB;
constexpr size_t WS_QA = 204 * MiB, WS_KA = 222 * MiB, WS_VA = 227 * MiB, WS_QB = 232 * MiB, WS_KB = 250 * MiB, WS_VB = 255 * MiB;
constexpr size_t WS_GA = 260 * MiB, WS_GB = 296 * MiB;
constexpr size_t WS_YAB = 332 * MiB;
constexpr size_t WS_MB = 368 * MiB;
constexpr size_t WS_HB = 404 * MiB;
constexpr size_t WS_YM = 424 * MiB;
constexpr size_t WS_P = 496 * MiB;
constexpr size_t WS_MODP = 964 * MiB;
constexpr size_t WS_WR = 740 * MiB;
constexpr size_t WS_T1 = 748 * MiB, WS_T2 = 820 * MiB, WS_T3 = 892 * MiB;
constexpr size_t WS_END = 996 * MiB;
constexpr int CW_TMO = 0, CW_CODE = 1;
constexpr int CW_BAR = 4096;
constexpr int CW_CNT = 131072;
constexpr int MAX_LAUNCH = 32;

constexpr int RING_OFF = 0, RING_BYTES = 131072;
constexpr int XS_OFF = 131072, XS_BYTES = 16384;
constexpr int LDSCTL_OFF = 162816, MISC_OFF = LDSCTL_OFF;
constexpr int LDS_BYTES = 163840;
constexpr int NWAVES = 8;
constexpr bool FAST_INPROJ = true, FAST_ATTN = true, FAST_BR = true, FAST_OUT = true, FAST_UP = true, FAST_DOWN = true;
constexpr bool FUSE_POST = true, FUSE_GATE = true, FUSE_RES = true, GATE_MIDK = true;
#ifndef REPMASK
#define REPMASK 0
#endif
#ifndef CNTPROBE
#define CNTPROBE 0
#define CNTPROBE_L 0
#endif
#ifndef MOEVAR
#define MOEVAR 0
#endif
#ifndef TPROBE
#define TPROBE -1
#define TPROBE_HI -1
#endif
#ifndef TPROBE_BLK
#define TPROBE_BLK 0
#endif
namespace pg8 {
#define PG8_LAS __attribute__((address_space(3)))
typedef unsigned short bf16_t;
typedef short bf16x8 __attribute__((ext_vector_type(8)));
typedef float f32x4 __attribute__((ext_vector_type(4)));
typedef unsigned u32x4 __attribute__((ext_vector_type(4)));
constexpr int BM = 256, BK = 64, HALF = 128, HTB = HALF * BK * 2  , STAGE_BYTES = 8 * HTB, NXCD = 8, WGM = 8;

__host__ __device__ __forceinline__ int lds_byte(int r, int c) { const int st = (r >> 4) * 2 + (c >> 5), rr = r & 15, cc = c & 31, ob = rr * 64 + cc * 2; return st * 1024 + (ob ^ (((ob >> 9) & 1) << 5)); }
__host__ __device__ __forceinline__ void stage_rc(int b, int& R, int& C) { const int st = b / 1024, sb = b % 1024, swz = sb ^ (((sb >> 9) & 1) << 5); R = (st >> 1) * 16 + swz / 64; C = (st & 1) * 32 + (swz % 64) / 2; }
__host__ __device__ __forceinline__ int perm32(int rho) { const int n = rho >> 4, i = rho & 15; return 8 * (i >> 2) + 4 * n + (i & 3); }

struct Unit { int pm, pn; };
struct Gemm { const bf16_t* A; const bf16_t* Bt; int M, N, K, lda, ldb; };

struct StaticOrder {
    int nM, nN, nwg, G, c;
    __host__ __device__ void init(int M, int N, int G_, int c_) { nM = M / BM; nN = N / BM; nwg = nM * nN; G = G_; c = c_; }
    __host__ __device__ bool next(int i, Unit& u) const {
        const long L = (long)i * G + c; if (L >= nwg) return false;
        int wgid = (int)L; { const int q = nwg / NXCD, r = nwg % NXCD, xcd = wgid % NXCD, off = wgid / NXCD; wgid = (xcd < r ? xcd * (q + 1) : r * (q + 1) + (xcd - r) * q) + off; }
        const int nig = WGM * nN, gid = wgid / nig, fm = gid * WGM, gsz = (nM - fm) < WGM ? (nM - fm) : WGM;
        u.pm = fm + ((wgid % nig) % gsz); u.pn = (wgid % nig) / gsz; return true;
    }
    __device__ __forceinline__ void a_ready(const Unit&) const {}
    __device__ __forceinline__ void done(const Unit&) const {}
};

__device__ __forceinline__ unsigned cvt_pk_bf16(float lo, float hi) { unsigned r; asm volatile("v_cvt_pk_bf16_f32 %0, %1, %2" : "=v"(r) : "v"(lo), "v"(hi)); return r; }
typedef float f32x2 __attribute__((ext_vector_type(2)));
__device__ __forceinline__ f32x2 gelu_pk(f32x2 v) {
    const f32x2 av = __builtin_elementwise_abs(v), d = av * 0.2316418882f + 1.0f;
    f32x2 t; t.x = __builtin_amdgcn_rcpf(d.x); t.y = __builtin_amdgcn_rcpf(d.y);
    f32x2 q = t * 0.5307027145f + (-0.7265760135f); q = q * t + 0.7107068705f; q = q * t + (-0.142248368f); q = q * t + 0.127414796f; q = q * t;
    const f32x2 s = (v * v) * (-0.72134752044f);
    f32x2 e; e.x = __builtin_amdgcn_exp2f(s.x); e.y = __builtin_amdgcn_exp2f(s.y);
    const f32x2 m = v * (q * e), r = v - m;
    f32x2 o; o.x = v.x < 0.f ? m.x : r.x; o.y = v.y < 0.f ? m.y : r.y; return o;
}

template <int ACT  > struct EpiBf16 {
    static constexpr int MIDK = 0; static constexpr bool PERM = true, AFTER_DRAIN = false; static_assert(ACT == 0 || ACT == 1, "EpiBf16: ACT is 0 (none) or 1 (gelu_pk)");
    bf16_t* O; int ldc; const float* bias; int split_cols; size_t split_stride; float scale0;
    __device__ __forceinline__ void operator()(const f32x4 (&acc)[2][2][4][2], const Unit& u, int wr, int wc, int fr, int fq) const {
        const int row0 = u.pm * BM + wr * 64 + fr; int colt = u.pn * BM; bf16_t* base = O;
        float sc = 1.f; if (split_cols) { const int t = colt / split_cols; base += (size_t)t * split_stride; colt -= t * split_cols; if (t == 0) sc = scale0; }
        const int col0 = colt + wc * 32 + 8 * fq, bcol0 = u.pn * BM + wc * 32 + 8 * fq;
        f32x4 bv[2][2];
#pragma unroll
        for (int bj = 0; bj < 2; ++bj)
#pragma unroll
            for (int n = 0; n < 2; ++n) bv[bj][n] = bias ? *(const f32x4*)(bias + bcol0 + bj * HALF + 4 * n) : (f32x4){0.f, 0.f, 0.f, 0.f};
#pragma unroll
        for (int ai = 0; ai < 2; ++ai)
#pragma unroll
            for (int m = 0; m < 4; ++m) { bf16_t* rowp = base + (size_t)(row0 + ai * HALF + m * 16) * ldc + col0;
#pragma unroll
                for (int bj = 0; bj < 2; ++bj) { f32x4 v0 = acc[ai][bj][m][0] + bv[bj][0], v1 = acc[ai][bj][m][1] + bv[bj][1];
                    if (ACT == 1) { f32x2 a = gelu_pk((f32x2){v0[0], v0[1]}), b = gelu_pk((f32x2){v0[2], v0[3]}), c = gelu_pk((f32x2){v1[0], v1[1]}), d = gelu_pk((f32x2){v1[2], v1[3]});
                        v0 = (f32x4){a.x, a.y, b.x, b.y}; v1 = (f32x4){c.x, c.y, d.x, d.y}; }
                    v0 = v0 * sc; v1 = v1 * sc; u32x4 w; w.x = cvt_pk_bf16(v0[0], v0[1]); w.y = cvt_pk_bf16(v0[2], v0[3]); w.z = cvt_pk_bf16(v1[0], v1[1]); w.w = cvt_pk_bf16(v1[2], v1[3]);
                    *(u32x4*)(rowp + bj * HALF) = w; } }
    }
};

struct PanelStats {
    unsigned* xbuf;
    unsigned* cnt;
    unsigned* tmo;
    int ntn; float eps;
    unsigned code;
    __device__ __forceinline__ bool run(const f32x4 (&v)[2][2][4][2], const Unit& u, int wr, int wc, int fr, int fq, PG8_LAS unsigned char* lds, int wid, int lane) const {
        typedef float f32x2v __attribute__((ext_vector_type(2)));
        PG8_LAS f32x2v* P = (PG8_LAS f32x2v*)lds;
        PG8_LAS f32x2v* S = (PG8_LAS f32x2v*)(lds + 8192);
        PG8_LAS unsigned* flag = (PG8_LAS unsigned*)(lds + 8192 + 2048);
#pragma unroll
        for (int ai = 0; ai < 2; ++ai)
#pragma unroll
            for (int m = 0; m < 4; ++m) {
                float s = 0.f;
#pragma unroll
                for (int bj = 0; bj < 2; ++bj)
#pragma unroll
                    for (int n = 0; n < 2; ++n) { const f32x4 x = v[ai][bj][m][n]; s += (x[0] + x[1]) + (x[2] + x[3]); }
                s += __shfl_xor(s, 16); s += __shfl_xor(s, 32);
                const float mw = s * (1.0f / 64.0f); float q = 0.f;
#pragma unroll
                for (int bj = 0; bj < 2; ++bj)
#pragma unroll
                    for (int n = 0; n < 2; ++n) { const f32x4 d = v[ai][bj][m][n] - mw; q += (d[0] * d[0] + d[1] * d[1]) + (d[2] * d[2] + d[3] * d[3]); }
                q += __shfl_xor(q, 16); q += __shfl_xor(q, 32);
                if (fq == 0) P[(ai * HALF + wr * 64 + m * 16 + fr) * 4 + wc] = (f32x2v){mw, q};
            }
        asm volatile("s_waitcnt lgkmcnt(0)" ::: "memory"); __builtin_amdgcn_s_barrier(); asm volatile("" ::: "memory");
#if defined(BROKEN_EXCHANGE_NO_WAIT)
#warning BROKEN CONTROL BUILD: the row-statistics exchange does not wait; results are wrong by design
        if (blockIdx.x >= 64) { const long long t0_ = clock64(); while (clock64() - t0_ < 60000) __builtin_amdgcn_s_sleep(8); }
#endif
        const int row = wid * 32 + (lane & 31);
        if (lane < 32) {
            const f32x2v a = P[row * 4 + 0], b = P[row * 4 + 1], c = P[row * 4 + 2], d = P[row * 4 + 3];
            const float mt = (a.x + b.x + c.x + d.x) * 0.25f;
            const float da = a.x - mt, db = b.x - mt, dc = c.x - mt, dd = d.x - mt;
            const float m2 = (a.y + b.y) + (c.y + d.y) + 64.0f * ((da * da + db * db) + (dc * dc + dd * dd));
            unsigned long long* slot = (unsigned long long*)xbuf + ((size_t)(u.pm * BM + row) * 4 + u.pn);
            __hip_atomic_store(slot, ((unsigned long long)__float_as_uint(m2) << 32) | __float_as_uint(mt), __ATOMIC_RELAXED, __HIP_MEMORY_SCOPE_AGENT);
        }
        asm volatile("s_waitcnt vmcnt(0)" ::: "memory");
        if (lane == 0) __hip_atomic_fetch_add(cnt + 64 * u.pm, 1u, __ATOMIC_RELAXED, __HIP_MEMORY_SCOPE_AGENT);
        if (wid == 0) {
            bool dead = false; const unsigned long long t0 = __builtin_amdgcn_s_memrealtime(); const unsigned want = 8u * (unsigned)ntn;
            for (;;) {
#if defined(BROKEN_EXCHANGE_NO_WAIT)
                break;
#endif
                if ((unsigned)__builtin_amdgcn_readfirstlane(__hip_atomic_load(cnt + 64 * u.pm, __ATOMIC_RELAXED, __HIP_MEMORY_SCOPE_AGENT)) >= want) break;
                if (__builtin_amdgcn_s_memrealtime() - t0 > 2000000ull) {
                    if (lane == 0) { unsigned expect = 0u; __hip_atomic_compare_exchange_strong(tmo + 1, &expect, code | (unsigned)(u.pm & 0xff), __ATOMIC_RELAXED, __ATOMIC_RELAXED, __HIP_MEMORY_SCOPE_AGENT);
                                     __hip_atomic_store(tmo, 1u, __ATOMIC_RELAXED, __HIP_MEMORY_SCOPE_AGENT); }
                    dead = true; break; }
                __builtin_amdgcn_s_sleep(2);
            }
            __builtin_amdgcn_fence(__ATOMIC_ACQUIRE, "agent");
            if (lane == 0) flag[0] = dead ? 1u : 0u;
        }
        asm volatile("s_waitcnt vmcnt(0) lgkmcnt(0)" ::: "memory"); __builtin_amdgcn_s_barrier(); asm volatile("" ::: "memory");
        const bool bad = flag[0] != 0u;
        if (lane < 32) {
            const unsigned long long* slot = (const unsigned long long*)xbuf + (size_t)(u.pm * BM + row) * 4; float mt[4], m2[4]; float ms = 0.f;
#pragma unroll
            for (int t = 0; t < 4; ++t) { if (t < ntn) { const unsigned long long w = __hip_atomic_load(slot + t, __ATOMIC_RELAXED, __HIP_MEMORY_SCOPE_AGENT); mt[t] = __uint_as_float((unsigned)w); m2[t] = __uint_as_float((unsigned)(w >> 32)); } else { mt[t] = 0.f; m2[t] = 0.f; } ms += mt[t]; }
            const float mean = ms / (float)ntn; float q = 0.f;
#pragma unroll
            for (int t = 0; t < 4; ++t) if (t < ntn) { const float dm = mt[t] - mean; q += m2[t] + 256.0f * dm * dm; }
            S[row] = (f32x2v){mean, 1.0f / sqrtf(q / (256.0f * (float)ntn) + eps)};
        }
        asm volatile("s_waitcnt lgkmcnt(0)" ::: "memory"); __builtin_amdgcn_s_barrier(); asm volatile("" ::: "memory");
        return bad;
    }
};
struct EpiLnRes {
    static constexpr int MIDK = 0; static constexpr bool PERM = false, AFTER_DRAIN = true;
    const float* base; float* out; int ldc; const float* bias; PanelStats st; unsigned poison;
    __device__ __forceinline__ void fused(f32x4 (&acc)[2][2][4][2], const Unit& u, int wr, int wc, int fr, int fq, PG8_LAS unsigned char* lds, int wid, int lane) const {
        typedef float f32x2v __attribute__((ext_vector_type(2)));
        const PG8_LAS f32x2v* S = (const PG8_LAS f32x2v*)(lds + 8192);
        const int col0 = u.pn * BM + wc * 32 + 4 * fq;
#pragma unroll
        for (int bj = 0; bj < 2; ++bj)
#pragma unroll
            for (int n = 0; n < 2; ++n) { const f32x4 bv = bias ? *(const f32x4*)(bias + col0 + bj * HALF + n * 16) : (f32x4){0.f, 0.f, 0.f, 0.f};
#pragma unroll
                for (int ai = 0; ai < 2; ++ai)
#pragma unroll
                    for (int m = 0; m < 4; ++m) acc[ai][bj][m][n] += bv; }
        f32x4 pre[4][2][2];
#pragma unroll
        for (int m = 0; m < 4; ++m) { const size_t off = (size_t)(u.pm * BM + wr * 64 + m * 16 + fr) * ldc + col0;
#pragma unroll
            for (int bj = 0; bj < 2; ++bj)
#pragma unroll
                for (int n = 0; n < 2; ++n) pre[m][bj][n] = *(const f32x4*)(base + off + bj * HALF + n * 16); }
        const bool bad = st.run(acc, u, wr, wc, fr, fq, lds, wid, lane) || poison != 0u;
        const float qnan = __builtin_nanf("");
#pragma unroll
        for (int ai = 0; ai < 2; ++ai)
#pragma unroll
            for (int m = 0; m < 4; ++m) { const int r = ai * HALF + wr * 64 + m * 16 + fr; const f32x2v sr = S[r]; const size_t off = (size_t)(u.pm * BM + r) * ldc + col0;
#pragma unroll
                for (int bj = 0; bj < 2; ++bj)
#pragma unroll
                    for (int n = 0; n < 2; ++n) { const f32x4 bs = ai == 0 ? pre[m][bj][n] : *(const f32x4*)(base + off + bj * HALF + n * 16); f32x4 o = bs + (acc[ai][bj][m][n] - sr.x) * sr.y;
                        if (bad) o = (f32x4){qnan, qnan, qnan, qnan}; *(f32x4*)(out + off + bj * HALF + n * 16) = o; }
                if (m & 1) asm volatile("" ::: "memory"); }
    }
};
struct EpiLnResLn {
    static constexpr int MIDK = 0; static constexpr bool PERM = false, AFTER_DRAIN = true;
    const float* base; float* out; bf16_t* xn; int ldc; const float* bias; PanelStats st1, st2; unsigned poison;
    __device__ __forceinline__ void fused(f32x4 (&acc)[2][2][4][2], const Unit& u, int wr, int wc, int fr, int fq, PG8_LAS unsigned char* lds, int wid, int lane) const {
        typedef float f32x2v __attribute__((ext_vector_type(2))); typedef unsigned u32x2v __attribute__((ext_vector_type(2)));
        const PG8_LAS f32x2v* S = (const PG8_LAS f32x2v*)(lds + 8192);
        const int col0 = u.pn * BM + wc * 32 + 4 * fq;
#pragma unroll
        for (int bj = 0; bj < 2; ++bj)
#pragma unroll
            for (int n = 0; n < 2; ++n) { const f32x4 bv = bias ? *(const f32x4*)(bias + col0 + bj * HALF + n * 16) : (f32x4){0.f, 0.f, 0.f, 0.f};
#pragma unroll
                for (int ai = 0; ai < 2; ++ai)
#pragma unroll
                    for (int m = 0; m < 4; ++m) acc[ai][bj][m][n] += bv; }
        bool bad = st1.run(acc, u, wr, wc, fr, fq, lds, wid, lane) || poison != 0u;
        const float qnan = __builtin_nanf("");
#pragma unroll
        for (int ai = 0; ai < 2; ++ai)
#pragma unroll
            for (int m = 0; m < 4; ++m) { const int r = ai * HALF + wr * 64 + m * 16 + fr; const f32x2v sr = S[r]; const size_t off = (size_t)(u.pm * BM + r) * ldc + col0;
#pragma unroll
                for (int bj = 0; bj < 2; ++bj)
#pragma unroll
                    for (int n = 0; n < 2; ++n) { const f32x4 bs = *(const f32x4*)(base + off + bj * HALF + n * 16); acc[ai][bj][m][n] = bs + (acc[ai][bj][m][n] - sr.x) * sr.y; }
                asm volatile("" : "+v"(acc[ai][0][m][0]), "+v"(acc[ai][0][m][1]), "+v"(acc[ai][1][m][0]), "+v"(acc[ai][1][m][1]));
                if (m & 1) asm volatile("" ::: "memory"); }
        const bool bad1 = bad;
        bad = st2.run(acc, u, wr, wc, fr, fq, lds, wid, lane) || bad;
#pragma unroll
        for (int ai = 0; ai < 2; ++ai)
#pragma unroll
            for (int m = 0; m < 4; ++m) { const int r = ai * HALF + wr * 64 + m * 16 + fr; const f32x2v sr = S[r]; const size_t off = (size_t)(u.pm * BM + r) * ldc + col0;
#pragma unroll
                for (int bj = 0; bj < 2; ++bj)
#pragma unroll
                    for (int n = 0; n < 2; ++n) { const f32x4 x1 = acc[ai][bj][m][n]; *(f32x4*)(out + off + bj * HALF + n * 16) = bad1 ? (f32x4){qnan, qnan, qnan, qnan} : x1;
                        const f32x4 o = (x1 - sr.x) * sr.y; u32x2v w; w.x = cvt_pk_bf16(o[0], o[1]); w.y = cvt_pk_bf16(o[2], o[3]);
                        if (bad) { w.x = 0x7fc07fc0u; w.y = 0x7fc07fc0u; } *(u32x2v*)(xn + off + bj * HALF + n * 16) = w; }
                asm volatile("" ::: "memory"); }
    }
};

template <class Epi, class Sched, bool ALIGN_EPI = false, bool SP2 = false>
__device__ __forceinline__ void gemm_phase(PG8_LAS unsigned char* lds, const Gemm g, const Sched& S, const Epi& E) {
    const int tid = threadIdx.x, wid = __builtin_amdgcn_readfirstlane(tid >> 6), lane = tid & 63, wr = wid >> 2, wc = wid & 3, fr = lane & 15, fq = lane >> 4;
    const int K = g.K, nt = K / BK;
    unsigned voffA[2], voffB[2];
#pragma unroll
    for (int i = 0; i < 2; ++i) { int R, C; stage_rc(tid * 16 + i * 8192, R, C); const int Rb = Epi::PERM ? ((R & ~31) + perm32(R & 31)) : R;
        voffA[i] = (unsigned)(R * g.lda + C) * 2u; voffB[i] = (unsigned)(Rb * g.ldb + C) * 2u; }
    const size_t kstep = (size_t)(BK * 2);
    const size_t hstepA = (size_t)HALF * g.lda * 2, hstepB = (size_t)HALF * g.ldb * 2;
    const size_t tstepA = 2 * hstepA, tstepB = 2 * hstepB;
    const unsigned ldsw = (unsigned)wid * 1024u;
    const int aoff = lds_byte(wr * 64 + fr, fq * 8), boff = lds_byte(wc * 32 + fr, fq * 8);
#define PG8_SA(b, h) (((b) * 2 + (h)) * HTB)
#define PG8_SB(b, h) ((4 + (b) * 2 + (h)) * HTB)
#define PG8_STAGE(bufoff, gbase, voff) do { _Pragma("unroll") for (int _i = 0; _i < 2; ++_i) \
        __builtin_amdgcn_global_load_lds((const unsigned*)((const char*)(gbase) + (voff)[_i]), (PG8_LAS unsigned*)(lds + (bufoff) + ldsw + _i * 8192), 16, 0, 0); } while (0)
#define PG8_LDA(dst, b, h) do { _Pragma("unroll") for (int m = 0; m < 4; ++m) _Pragma("unroll") for (int k = 0; k < 2; ++k) dst[m][k] = *(const PG8_LAS bf16x8*)(lds + PG8_SA(b, h) + aoff + m * 2048 + k * 1024); } while (0)
#define PG8_LDB(dst, b, h) do { _Pragma("unroll") for (int n = 0; n < 2; ++n) _Pragma("unroll") for (int k = 0; k < 2; ++k) dst[n][k] = *(const PG8_LAS bf16x8*)(lds + PG8_SB(b, h) + boff + n * 2048 + k * 1024); } while (0)
#define PG8_MMA(ai, bj, At, Bt) do { __builtin_amdgcn_s_setprio(1); _Pragma("unroll") for (int m = 0; m < 4; ++m) _Pragma("unroll") for (int n = 0; n < 2; ++n) _Pragma("unroll") for (int k = 0; k < 2; ++k) \
        acc[ai][bj][m][n] = __builtin_amdgcn_mfma_f32_16x16x32_bf16(Bt[n][k], At[m][k], acc[ai][bj][m][n], 0, 0, 0); __builtin_amdgcn_s_setprio(0); } while (0)
#define PG8_WAIT_V(n) asm volatile("s_waitcnt vmcnt(" #n ")" ::: "memory")
#define PG8_WAIT_L(n) asm volatile("s_waitcnt lgkmcnt(" #n ")" ::: "memory")
#define PG8_BAR __builtin_amdgcn_s_barrier()
#define PG8_SCHED __builtin_amdgcn_sched_barrier(0)
    Unit cur, nxt; int ui = 0;
    if (!S.next(0, cur)) return;
    f32x4 acc[2][2][4][2];
#pragma unroll
    for (int a = 0; a < 2; ++a)
#pragma unroll
        for (int b = 0; b < 2; ++b)
#pragma unroll
            for (int m = 0; m < 4; ++m)
#pragma unroll
                for (int n = 0; n < 2; ++n) acc[a][b][m][n] = (f32x4){0.f, 0.f, 0.f, 0.f};
    bf16x8 At[4][2], B0[2][2], B1[2][2];
    const char* cA = (const char*)g.A + (size_t)cur.pm * tstepA; const char* cB = (const char*)g.Bt + (size_t)cur.pn * tstepB;
    S.a_ready(cur);
    if constexpr (SP2) {
        PG8_STAGE(PG8_SB(0, 0), cB, voffB); PG8_STAGE(PG8_SB(0, 1), cB + hstepB, voffB); PG8_STAGE(PG8_SA(0, 0), cA, voffA); PG8_STAGE(PG8_SA(0, 1), cA + hstepA, voffA);
        if (wr == 1) PG8_BAR;
        PG8_WAIT_V(2); PG8_BAR;
        PG8_STAGE(PG8_SB(1, 0), cB + kstep, voffB); PG8_STAGE(PG8_SA(1, 0), cA + kstep, voffA); PG8_STAGE(PG8_SB(1, 1), cB + hstepB + kstep, voffB);
        PG8_WAIT_V(6); PG8_BAR;
    } else {
        PG8_STAGE(PG8_SB(0, 0), cB, voffB); PG8_STAGE(PG8_SA(0, 0), cA, voffA); PG8_STAGE(PG8_SB(0, 1), cB + hstepB, voffB); PG8_STAGE(PG8_SA(0, 1), cA + hstepA, voffA);
        if (wr == 1) PG8_BAR;
        PG8_WAIT_V(4); PG8_BAR;
        PG8_STAGE(PG8_SB(1, 0), cB + kstep, voffB); PG8_STAGE(PG8_SA(1, 0), cA + kstep, voffA); PG8_STAGE(PG8_SB(1, 1), cB + hstepB + kstep, voffB);
        PG8_WAIT_V(6); PG8_BAR;
    }
    for (;;) {
        const bool has_next = S.next(ui + 1, nxt);
        const char* nA = has_next ? (const char*)g.A + (size_t)nxt.pm * tstepA : cA; const char* nB = has_next ? (const char*)g.Bt + (size_t)nxt.pn * tstepB : cB;
        for (int t = 0; t < nt; t += 2) {
            if constexpr (Epi::MIDK > 0) { if (t == Epi::MIDK) E.mid(acc, cur, wr, wc, fr, fq); }
            const bool last = (t == nt - 2);
            const char* a1 = cA + (size_t)(t + 1) * kstep;
            const char* a2 = last ? nA : cA + (size_t)(t + 2) * kstep; const char* b2 = last ? nB : cB + (size_t)(t + 2) * kstep;
            const char* a3 = a2 + kstep; const char* b3 = b2 + kstep;
            if (last && has_next) S.a_ready(nxt);
            if constexpr (SP2) {
            PG8_LDB(B0, 0, 0); PG8_LDB(B1, 0, 1); PG8_SCHED; PG8_LDA(At, 0, 0); PG8_STAGE(PG8_SA(1, 1), a1 + hstepA, voffA);
            PG8_WAIT_V(8); PG8_WAIT_L(0); PG8_BAR; PG8_MMA(0, 0, At, B0); PG8_MMA(0, 1, At, B1); PG8_BAR; PG8_SCHED;
            PG8_LDA(At, 0, 1); PG8_STAGE(PG8_SB(0, 0), b2, voffB); PG8_STAGE(PG8_SB(0, 1), b2 + hstepB, voffB); PG8_STAGE(PG8_SA(0, 0), a2, voffA);
            PG8_WAIT_V(8); PG8_WAIT_L(0); PG8_BAR; PG8_MMA(1, 0, At, B0); PG8_MMA(1, 1, At, B1); PG8_BAR; PG8_SCHED;
            PG8_LDB(B0, 1, 0); PG8_LDB(B1, 1, 1); PG8_SCHED; PG8_LDA(At, 1, 0); PG8_STAGE(PG8_SA(0, 1), a2 + hstepA, voffA);
            PG8_WAIT_V(8); PG8_WAIT_L(0); PG8_BAR; PG8_MMA(0, 0, At, B0); PG8_MMA(0, 1, At, B1); PG8_BAR; PG8_SCHED;
            PG8_LDA(At, 1, 1); PG8_STAGE(PG8_SB(1, 0), b3, voffB); PG8_STAGE(PG8_SB(1, 1), b3 + hstepB, voffB); PG8_STAGE(PG8_SA(1, 0), a3, voffA);
            PG8_WAIT_V(8); PG8_WAIT_L(0); PG8_BAR; PG8_MMA(1, 0, At, B0); PG8_MMA(1, 1, At, B1); PG8_BAR; PG8_SCHED;
            } else {
            PG8_LDB(B0, 0, 0); PG8_SCHED; PG8_LDA(At, 0, 0); PG8_STAGE(PG8_SA(1, 1), a1 + hstepA, voffA);
            PG8_WAIT_L(8); PG8_BAR; PG8_WAIT_L(0); PG8_MMA(0, 0, At, B0); PG8_BAR; PG8_SCHED;
            PG8_LDB(B1, 0, 1); PG8_STAGE(PG8_SB(0, 0), b2, voffB);
            PG8_BAR; PG8_WAIT_L(0); PG8_MMA(0, 1, At, B1); PG8_BAR;
            PG8_LDA(At, 0, 1); PG8_STAGE(PG8_SA(0, 0), a2, voffA);
            PG8_BAR; PG8_WAIT_L(0); PG8_MMA(1, 0, At, B0); PG8_BAR; PG8_SCHED;
            PG8_STAGE(PG8_SB(0, 1), b2 + hstepB, voffB);
            PG8_WAIT_V(6); PG8_BAR; PG8_MMA(1, 1, At, B1); PG8_BAR;
            PG8_LDB(B0, 1, 0); PG8_SCHED; PG8_LDA(At, 1, 0); PG8_STAGE(PG8_SA(0, 1), a2 + hstepA, voffA);
            PG8_WAIT_L(8); PG8_BAR; PG8_WAIT_L(0); PG8_MMA(0, 0, At, B0); PG8_BAR; PG8_SCHED;
            PG8_LDB(B1, 1, 1); PG8_STAGE(PG8_SB(1, 0), b3, voffB);
            PG8_BAR; PG8_WAIT_L(0); PG8_MMA(0, 1, At, B1); PG8_BAR;
            PG8_LDA(At, 1, 1); PG8_STAGE(PG8_SA(1, 0), a3, voffA);
            PG8_BAR; PG8_WAIT_L(0); PG8_MMA(1, 0, At, B0); PG8_BAR; PG8_SCHED;
            PG8_STAGE(PG8_SB(1, 1), b3 + hstepB, voffB);
            PG8_WAIT_V(6); PG8_BAR; PG8_MMA(1, 1, At, B1); PG8_BAR;
            }
        }
        if constexpr (ALIGN_EPI) { if (wr == 0) PG8_BAR; }
        if constexpr (!Epi::AFTER_DRAIN) { E(acc, cur, wr, wc, fr, fq); S.done(cur); }
        if (!has_next) break;
#pragma unroll
        for (int a = 0; a < 2; ++a)
#pragma unroll
            for (int b = 0; b < 2; ++b)
#pragma unroll
                for (int m = 0; m < 4; ++m)
#pragma unroll
                    for (int n = 0; n < 2; ++n) acc[a][b][m][n] = (f32x4){0.f, 0.f, 0.f, 0.f};
        cur = nxt; cA = nA; cB = nB; ++ui;
        if constexpr (ALIGN_EPI) { if (wr == 1) PG8_BAR; }
    }
    PG8_WAIT_V(0);
    if constexpr (!ALIGN_EPI) { if (wr == 0) PG8_BAR; }
    PG8_BAR;
    if constexpr (Epi::AFTER_DRAIN) { E.fused(acc, cur, wr, wc, fr, fq, lds, wid, lane); S.done(cur); }
#undef PG8_SA
#undef PG8_SB
#undef PG8_STAGE
#undef PG8_LDA
#undef PG8_LDB
#undef PG8_MMA
#undef PG8_WAIT_V
#undef PG8_WAIT_L
#undef PG8_BAR
#undef PG8_SCHED
}
}
#define GAS __attribute__((address_space(1)))
#define LAS __attribute__((address_space(3)))
typedef unsigned short bf16;
typedef unsigned v4u __attribute__((ext_vector_type(4)));
typedef float f32x4 __attribute__((ext_vector_type(4)));
typedef short bf16x8 __attribute__((ext_vector_type(8)));
typedef GAS unsigned gu32;
typedef GAS unsigned long long gu64;
#define RLX_AGENT __ATOMIC_RELAXED, __HIP_MEMORY_SCOPE_AGENT
#define LDS_WAIT() asm volatile("s_waitcnt lgkmcnt(0)" ::: "memory")
#define VM_WAIT() asm volatile("s_waitcnt vmcnt(0)" ::: "memory")
__device__ __forceinline__ unsigned long long rt() { return __builtin_amdgcn_s_memrealtime(); }
__device__ __forceinline__ unsigned f2bf(float f) { unsigned u = __builtin_bit_cast(unsigned, f); return (u + 0x7fffu + ((u >> 16) & 1u)) >> 16; }
__device__ __forceinline__ unsigned pk2(float lo, float hi) { return f2bf(lo) | (f2bf(hi) << 16); }

#define XB_TMO      128
#define XB_XCNT(j)  (256  + 64 * (j))
#define XB_XSUB(j)  (1280 + 64 * (j))
#define XB_XGEN(j)  (2304 + 64 * (j))
#define XB_TOP      3328
#define XB_TOPGEN   3392
#define XCD_BAR_WORDS 3456
#define XB_SPIN_CAP (1u << 18)

__device__ __forceinline__ unsigned xb_ld(unsigned* p)              { return __hip_atomic_load(p, __ATOMIC_RELAXED, __HIP_MEMORY_SCOPE_AGENT); }
__device__ __forceinline__ unsigned xb_add(unsigned* p, unsigned v) { return __hip_atomic_fetch_add(p, v, __ATOMIC_RELAXED, __HIP_MEMORY_SCOPE_AGENT); }
__device__ __forceinline__ unsigned xb_xcc_id() { return (unsigned)__builtin_amdgcn_s_getreg((3 << 11) | 20) & 0xFu; }
#define XB_SPIN(cond, bar) do { unsigned _sp = 0; while (cond) { __builtin_amdgcn_s_sleep(1); \
    if ((++_sp & 255u) == 0u) { if (xb_ld(&(bar)[XB_TMO])) break; if (_sp > XB_SPIN_CAP) { atomicAdd(&(bar)[XB_TMO], 1u); break; } } } } while (0)

struct XcdBarrier {
    unsigned* bar; unsigned x;
    volatile LAS unsigned* st;
};

__device__ __forceinline__ XcdBarrier xcd_barrier_post(unsigned* bar, volatile LAS unsigned* st) {
    XcdBarrier b; b.bar = bar; b.x = xb_xcc_id(); b.st = st;
    if (threadIdx.x == 0) (void)xb_add(&bar[XB_XCNT(b.x)], 1u);
    return b;
}
__device__ __forceinline__ void xcd_barrier_complete(unsigned* bar, unsigned x, unsigned& nloc, unsigned& nx) {
    const unsigned G = gridDim.x * gridDim.y * gridDim.z;
    unsigned sum, cnt, mine, sp = 0u;
    for (;;) {
        sum = 0u; cnt = 0u; mine = 0u;
#pragma unroll
        for (unsigned j = 0; j < 16; ++j) { const unsigned c = xb_ld(&bar[XB_XCNT(j)]); sum += c; cnt += (c > 0u) ? 1u : 0u; mine = (j == x) ? c : mine; }
        if (sum == G) break;
        __builtin_amdgcn_s_sleep(1);
        if ((++sp & 255u) == 0u) { if (xb_ld(&bar[XB_TMO])) break; if (sp > XB_SPIN_CAP) { atomicAdd(&bar[XB_TMO], 1u); break; } }
    }
    nloc = mine > 0u ? mine : 1u; nx = cnt > 0u ? cnt : 1u;
}

__device__ __forceinline__ void xcd_barrier(const XcdBarrier& b) {
    asm volatile("s_waitcnt vmcnt(0)" ::: "memory");
    __syncthreads();
    if (threadIdx.x == 0) {
        unsigned* bar = b.bar;
        __builtin_amdgcn_s_waitcnt(0);
        unsigned nloc = b.st[0], nx = b.st[1];
        if (nloc == 0u) { xcd_barrier_complete(bar, b.x, nloc, nx); b.st[0] = nloc; b.st[1] = nx; }
        const unsigned old = xb_add(&bar[XB_XSUB(b.x)], 1u);
        const unsigned gen = old / nloc;
        if (old + 1u == (gen + 1u) * nloc) {
            __builtin_amdgcn_fence(__ATOMIC_RELEASE, "agent");
            asm volatile("s_waitcnt vmcnt(0)" ::: "memory");
            const unsigned og = xb_add(&bar[XB_TOP], 1u);
            const unsigned tg = og / nx;
            if (og + 1u == (tg + 1u) * nx) xb_add(&bar[XB_TOPGEN], 1u);
            else XB_SPIN(xb_ld(&bar[XB_TOPGEN]) == tg, bar);
            __builtin_amdgcn_fence(__ATOMIC_ACQUIRE, "agent");
            xb_add(&bar[XB_XGEN(b.x)], 1u);
            asm volatile("s_waitcnt vmcnt(0)" ::: "memory");
        } else {
            XB_SPIN(xb_ld(&bar[XB_XGEN(b.x)]) == gen, bar);
            __builtin_amdgcn_fence(__ATOMIC_ACQUIRE, "agent");
            asm volatile("s_waitcnt vmcnt(0)" ::: "memory");
        }
    }
    __syncthreads();
}
typedef float f32x4v __attribute__((ext_vector_type(4)));
struct Frame {
    LAS unsigned char* lds;
    volatile LAS unsigned* MISC;
    gu32* ctl;
    int tid, lane, wave, G, vcu;
    float* out; unsigned char* ws;
};
typedef const float* cfptr;
#define INP(i) (((const LAS cfptr*)(F.lds + LDSCTL_OFF + 256))[i])
#define IN_X 0
#define IN_C 1
#define IN_CTX 2
#define IN_CCTX 3
#define IN_WMOD 4
#define IN_BMOD 5
#define IN_NMIX 6
#define IN_NFFN 7
#define IN_WIN 8
#define IN_QNA 9
#define IN_KNA 10
#define IN_SINK 11
#define IN_WBRA 12
#define IN_WBRB 13
#define IN_WOUT 14
#define IN_WRG 15
#define IN_BRG 16
#define IN_WRE 17
#define IN_BRE 18
#define IN_W1 19
#define IN_W3 20
#define IN_W2 21
#define IN_NFIN 22

__device__ __forceinline__ float wave_sum(float v) {
#pragma unroll
    for (int o = 1; o < 64; o <<= 1) v += __shfl_xor(v, o);
    return v;
}
__device__ __forceinline__ float wave_max(float v) {
#pragma unroll
    for (int o = 1; o < 64; o <<= 1) v = fmaxf(v, __shfl_xor(v, o));
    return v;
}
__device__ __forceinline__ float bf2f(bf16 h) { return __builtin_bit_cast(float, (unsigned)h << 16); }
__device__ __forceinline__ int mod_row(int m) { return (m % TT) < CTX ? 4 : m / TT; }

__device__ __forceinline__ void compute_base(const unsigned* cnt, LAS unsigned* base, int tid) {
    if (tid < 64) {
        const unsigned c = __hip_atomic_load(cnt + tid, RLX_AGENT); unsigned v = c;
#pragma unroll
        for (int o = 1; o < 64; o <<= 1) { const unsigned t = __shfl_up(v, o); if (tid >= o) v += t; }
        base[tid] = v - c; if (tid == 63) base[64] = v;
    }
    __syncthreads();
}

template <int MODE>
__device__ __forceinline__ void tr_item(const float* W, int ldw, bf16* WT, int ldt, int koff, LAS float* scr, int kb, int nb, int lane) {
    const int k0 = 64 * kb, n0 = 32 * nb;
    const int lr = lane >> 3, lc = (lane & 7) * 4;
    f32x4v v[8];
#pragma unroll
    for (int i = 0; i < 8; ++i) v[i] = __builtin_nontemporal_load((const f32x4v*)(W + (size_t)(k0 + 8 * i + lr) * ldw + n0 + lc));
#pragma unroll
    for (int i = 0; i < 8; ++i) { LAS float* d = scr + (8 * i + lr) * 33 + lc; d[0] = v[i].x; d[1] = v[i].y; d[2] = v[i].z; d[3] = v[i].w; }
    LDS_WAIT(); asm volatile("" ::: "memory");
    const int c = lane & 7;
#pragma unroll
    for (int j = 0; j < 4; ++j) { const int n = (lane >> 3) + 8 * j; const LAS float* s = scr + (8 * c) * 33 + n;
        v4u o; o.x = pk2(s[0 * 33], s[1 * 33]); o.y = pk2(s[2 * 33], s[3 * 33]); o.z = pk2(s[4 * 33], s[5 * 33]); o.w = pk2(s[6 * 33], s[7 * 33]);
        const int drow = (MODE == 1) ? inproj_dst_col(n0 + n) : (n0 + n);
        *(GAS v4u*)(WT + (size_t)drow * ldt + koff + k0 + 8 * c) = o; }
    LDS_WAIT(); asm volatile("" ::: "memory");
}

__device__ __forceinline__ void p0_prologue(Frame& F) {
#if TPROBE >= 200
    if (F.tid == 0) atomicMax((unsigned*)F.ctl + 200000, (unsigned)__builtin_amdgcn_s_memrealtime());
#endif
    LAS float* sl = (LAS float*)(F.lds);
    LAS float* red = (LAS float*)(F.lds + 40960);
    for (int i = F.tid; i < 5 * D; i += NWAVES * 64) { const int r = i / D, k = i % D; const float v = r < 4 ? INP(IN_C)[r * D + k] : INP(IN_CCTX)[k]; sl[i] = v / (1.f + __expf(-v)); }
    __syncthreads();
#if TPROBE >= 200
    if (F.tid == 0) atomicMax((unsigned*)F.ctl + 200000 + 256, (unsigned)__builtin_amdgcn_s_memrealtime());
#endif
    float* MODP = (float*)(F.ws + WS_MODP);
    for (int u = F.vcu; u < 2 * 6 * 64; u += F.G) {
        const int l = u / (6 * 64), cb = (u / 64) % 6, kslc = u % 64, col = cb * 2048 + 4 * F.tid;
        const float* W = INP(IN_WMOD) + (size_t)l * D * MODW + (size_t)(kslc * 32) * MODW + col;
        f32x4v acc[5];
#pragma unroll
        for (int r = 0; r < 5; ++r) acc[r] = (f32x4v){0.f, 0.f, 0.f, 0.f};
#pragma unroll 16
        for (int kk = 0; kk < 32; ++kk) { const int k = kslc * 32 + kk; const f32x4v w = __builtin_nontemporal_load((const f32x4v*)(W + (size_t)kk * MODW));
#pragma unroll
            for (int r = 0; r < 5; ++r) acc[r] += sl[r * D + k] * w; }
#pragma unroll
        for (int r = 0; r < 5; ++r) *(f32x4v*)(MODP + ((size_t)(l * 64 + kslc) * 5 + r) * MODW + col) = acc[r];
    }
    __syncthreads();
#if TPROBE >= 200
    __syncthreads(); if (F.tid == 0) atomicMax((unsigned*)F.ctl + 200000 + 64, (unsigned)__builtin_amdgcn_s_memrealtime());
#endif
    if (F.vcu == 0) { float* RT = (float*)(F.ws + WS_ROPE);
        for (int i = F.tid; i < 64 * 32; i += NWAVES * 64) { const int pos = i >> 5, f = i & 31; const float freq = powf(10000.f, -(float)f / 32.f); const float ang = (float)pos * freq; RT[i] = cosf(ang); RT[2048 + i] = sinf(ang); } }
    { bf16* WRT = (bf16*)(F.ws + WS_WR);
      for (int it = F.vcu * NWAVES * 64 + F.tid; it < 2 * 80 * 256; it += F.G * NWAVES * 64) {
          const int l = it / (80 * 256), c = (it / 256) % 80, k0 = (it % 256) * 8;
          float wv[8];
#pragma unroll
          for (int i = 0; i < 8; ++i) wv[i] = c < 64 ? INP(IN_WRE)[((size_t)l * D + k0 + i) * NE + c] : (c < 72 ? INP(IN_WRG)[((size_t)l * D + k0 + i) * NG + (c - 64)] : 0.f);
          unsigned hi[4], lo[4];
#pragma unroll
          for (int i = 0; i < 4; ++i) { const unsigned h0 = f2bf(wv[2 * i]), h1 = f2bf(wv[2 * i + 1]); hi[i] = h0 | (h1 << 16);
              lo[i] = f2bf(wv[2 * i] - __builtin_bit_cast(float, h0 << 16)) | (f2bf(wv[2 * i + 1] - __builtin_bit_cast(float, h1 << 16)) << 16); }
          const int ko = k0 >> 3, sI = ko >> 2, fqI = ko & 3, cfI = c >> 4, frI = c & 15;
          *(v4u*)(WRT + ((((size_t)(l * 2 + 0) * 64 + sI) * 5 + cfI) * 64 + fqI * 16 + frI) * 8) = (v4u){hi[0], hi[1], hi[2], hi[3]};
          *(v4u*)(WRT + ((((size_t)(l * 2 + 1) * 64 + sI) * 5 + cfI) * 64 + fqI * 16 + frI) * 8) = (v4u){lo[0], lo[1], lo[2], lo[3]};
      } }
#if TPROBE >= 200
    __syncthreads(); if (F.tid == 0) atomicMax((unsigned*)F.ctl + 200000 + 128, (unsigned)__builtin_amdgcn_s_memrealtime());
#endif
    LAS float* scr = (LAS float*)(F.lds + F.wave * 16384);
    const int gw = F.vcu * NWAVES + F.wave, NGW = F.G * NWAVES;
    constexpr int I_IN = 32 * 224, I_BR = 16 * 64, I_OUT = 32 * 64, I_L = I_IN + 2 * I_BR + I_OUT;
    for (int it = gw; it < 2 * I_L; it += NGW) {
        const int l = it / I_L; int r = it % I_L;
        if (r < I_IN) { tr_item<1>(INP(IN_WIN) + (size_t)l * D * INC, INC, (bf16*)(F.ws + WS_WIN) + (size_t)l * INC * D, D, 0, scr, r / 224, r % 224, F.lane); continue; } r -= I_IN;
        if (r < I_BR) { tr_item<0>(INP(IN_WBRA) + (size_t)l * QW * D, D, (bf16*)(F.ws + WS_WBR) + (size_t)l * D * D, D, 0, scr, r / 64, r % 64, F.lane); continue; } r -= I_BR;
        if (r < I_BR) { tr_item<0>(INP(IN_WBRB) + (size_t)l * QW * D, D, (bf16*)(F.ws + WS_WBR) + (size_t)l * D * D, D, QW, scr, r / 64, r % 64, F.lane); continue; } r -= I_BR;
        tr_item<0>(INP(IN_WOUT) + (size_t)l * D * D, D, (bf16*)(F.ws + WS_WOUT) + (size_t)l * D * D, D, 0, scr, r / 64, r % 64, F.lane);
    }
#if TPROBE >= 200
    __syncthreads(); if (F.tid == 0) atomicMax((unsigned*)F.ctl + 200000 + 192, (unsigned)__builtin_amdgcn_s_memrealtime());
#endif
}

__device__ __forceinline__ void p0b_reduce(Frame& F) {
    const float* MODP = (const float*)(F.ws + WS_MODP); float* MOD = (float*)(F.ws + WS_MOD);
    for (int o = F.vcu * NWAVES * 64 + F.tid; o < 2 * 5 * (MODW / 4); o += F.G * NWAVES * 64) {
        const int l = o / (5 * (MODW / 4)), r = (o / (MODW / 4)) % 5, n = (o % (MODW / 4)) * 4;
        f32x4v a = *(const f32x4v*)(INP(IN_BMOD) + l * MODW + n);
#pragma unroll 16
        for (int k2 = 0; k2 < 64; ++k2) a += *(const f32x4v*)(MODP + ((size_t)(l * 64 + k2) * 5 + r) * MODW + n);
        *(f32x4v*)(MOD + (size_t)(l * 5 + r) * MODW + n) = a;
    }
}

__device__ __forceinline__ void moe_combine_add(Frame& F, int lp, int m, const LAS unsigned* base, f32x4v (&v)[8]) {
    const unsigned* TE = (const unsigned*)(F.ws + WS_TOK) + (size_t)lp * M * 2;
    const unsigned* TP = (const unsigned*)(F.ws + WS_TOK) + (size_t)(2 + lp) * M * 2;
    const float* TW = (const float*)(F.ws + WS_TOK) + (size_t)(4 + lp) * M * 2;
    const unsigned e0 = TE[m * 2], e1 = TE[m * 2 + 1];
    const unsigned s0 = base[e0] + TP[m * 2], s1 = base[e1] + TP[m * 2 + 1];
    const float w0 = TW[m * 2], w1 = TW[m * 2 + 1];
    const bf16* Y0 = (const bf16*)(F.ws + WS_YM) + (size_t)s0 * D; const bf16* Y1 = (const bf16*)(F.ws + WS_YM) + (size_t)s1 * D;
    const float* g2 = (const float*)(F.ws + WS_MOD) + (size_t)(lp * 5 + mod_row(m)) * MODW + 5 * D;
#pragma unroll
    for (int j = 0; j < 8; ++j) { const int col = 4 * (F.lane + 64 * j);
        const uint2 a = *(const uint2*)(Y0 + col), b = *(const uint2*)(Y1 + col); const f32x4v g = *(const f32x4v*)(g2 + col);
        f32x4v ya = {__builtin_bit_cast(float, a.x << 16), __builtin_bit_cast(float, a.x & 0xffff0000u), __builtin_bit_cast(float, a.y << 16), __builtin_bit_cast(float, a.y & 0xffff0000u)};
        f32x4v yb = {__builtin_bit_cast(float, b.x << 16), __builtin_bit_cast(float, b.x & 0xffff0000u), __builtin_bit_cast(float, b.y << 16), __builtin_bit_cast(float, b.y & 0xffff0000u)};
        v[j] += g * (w0 * ya + w1 * yb); }
}
__device__ __forceinline__ void store_bf16_row(bf16* dst, int lane, const f32x4v (&h)[8]) {
#pragma unroll
    for (int j = 0; j < 8; ++j) { uint2 o; o.x = pk2(h[j].x, h[j].y); o.y = pk2(h[j].z, h[j].w); *(uint2*)(dst + 4 * (lane + 64 * j)) = o; }
}
__device__ __forceinline__ float row_sumsq(const f32x4v (&v)[8]) {
    float s = 0.f;
#pragma unroll
    for (int j = 0; j < 8; ++j) s += (v[j].x * v[j].x + v[j].y * v[j].y) + (v[j].z * v[j].z + v[j].w * v[j].w);
    return wave_sum(s);
}

template <bool DRY>
__device__ __forceinline__ void ph_norm1(Frame& F, int l) {
    LAS unsigned* base = (LAS unsigned*)(F.lds);
    if (l > 0) compute_base((const unsigned*)F.ctl + CW_CNT + (l - 1) * 64, base, F.tid);
    const int gw = F.vcu * NWAVES + F.wave, NGW = F.G * NWAVES;
    float* XW = (float*)(F.ws + WS_XW); bf16* HA = (bf16*)(F.ws + (DRY ? WS_T2 : WS_HA)); float* XWo = (float*)(F.ws + (DRY ? WS_T1 : WS_XW));
    const float* nw = INP(IN_NMIX) + l * D;
#define N1_LOAD(m_, v_) do { const int b_ = (m_) / TT, t_ = (m_) % TT; \
        const float* src_ = (l == 0) ? (t_ < CTX ? INP(IN_CTX) + ((size_t)b_ * CTX + t_) * D : INP(IN_X) + ((size_t)b_ * SEQ + (t_ - CTX)) * D) : XW + (size_t)(m_) * D; \
        _Pragma("unroll") for (int j = 0; j < 8; ++j) v_[j] = *(const f32x4v*)(src_ + 4 * (F.lane + 64 * j)); } while (0)
#define N1_FINISH(m_, v_) do { \
        if (l > 0) moe_combine_add(F, l - 1, (m_), base, v_); \
        _Pragma("unroll") for (int j = 0; j < 8; ++j) *(f32x4v*)(XWo + (size_t)(m_) * D + 4 * (F.lane + 64 * j)) = v_[j]; \
        const float rstd = 1.0f / sqrtf(row_sumsq(v_) * (1.0f / D) + EPS); \
        const float* mod = (const float*)(F.ws + WS_MOD) + (size_t)(l * 5 + mod_row(m_)) * MODW; \
        f32x4v h[8]; \
        _Pragma("unroll") for (int j = 0; j < 8; ++j) { const int col = 4 * (F.lane + 64 * j); const f32x4v w = *(const f32x4v*)(nw + col), sh = *(const f32x4v*)(mod + col), sc = *(const f32x4v*)(mod + D + col); \
            h[j] = (v_[j] * rstd * w) * (1.0f + sc) + sh; } \
        store_bf16_row(HA + (size_t)(m_) * D, F.lane, h); } while (0)
    f32x4v va[8], vb[8];
    int m = gw; if (m < M) N1_LOAD(m, va);
    while (m < M) {
        const int m1 = m + NGW; if (m1 < M) N1_LOAD(m1, vb);
        N1_FINISH(m, va);
        if (m1 >= M) break;
        const int m2 = m1 + NGW; if (m2 < M) N1_LOAD(m2, va);
        N1_FINISH(m1, vb);
        m = m2;
    }
#undef N1_LOAD
#undef N1_FINISH
}

__device__ __forceinline__ void post_head(const float* P, bf16* dst, const float* nw, bool rope, int rowpos, int colpos, const float* RT, int lane) {
    const int wc = lane >> 4, tt = lane & 15, j0 = 32 * wc + tt, j1 = j0 + 16, d1 = 64 * (wc >> 1) + 16 * (wc & 1) + tt, d2 = d1 + 32;
    float x1 = P[j0], x2 = P[j1];
    if (nw) { const float ss = wave_sum(x1 * x1 + x2 * x2); const float r = 1.0f / sqrtf(ss * (1.0f / HD) + EPS); x1 = x1 * r * nw[d1]; x2 = x2 * r * nw[d2]; }
    if (rope) { const int pos = (wc >> 1) ? colpos : rowpos, fi = 16 * (wc & 1) + tt; const float cs = RT[pos * 32 + fi], sn = RT[2048 + pos * 32 + fi];
        const float o1 = x1 * cs - x2 * sn, o2 = x1 * sn + x2 * cs; x1 = o1; x2 = o2; }
    dst[j0] = (bf16)f2bf(x1); dst[j1] = (bf16)f2bf(x2);
}
__device__ __forceinline__ void ph_post(Frame& F, int l) {
    const int gw = F.vcu * NWAVES + F.wave, NGW = F.G * NWAVES;
    const float* RT = (const float*)(F.ws + WS_ROPE);
    const float* qn = INP(IN_QNA) + l * HD; const float* kn = INP(IN_KNA) + l * HD;
    for (int m = gw; m < M; m += NGW) {
        const int t = m % TT; const bool rope = t >= CTX; const int s = t - CTX, rowpos = rope ? s / GRIDW : 0, colpos = rope ? s % GRIDW : 0;
        const float* P = (const float*)(F.ws + WS_P) + (size_t)m * INC;
        for (int h = 0; h < NH; ++h) post_head(P + OFF_QA + h * HD, (bf16*)(F.ws + WS_QA) + (size_t)m * QW + h * HD, qn, rope, rowpos, colpos, RT, F.lane);
        for (int h = 0; h < NKV; ++h) post_head(P + OFF_KA + h * HD, (bf16*)(F.ws + WS_KA) + (size_t)m * KW + h * HD, kn, rope, rowpos, colpos, RT, F.lane);
        for (int h = 0; h < NH; ++h) post_head(P + OFF_QB + h * HD, (bf16*)(F.ws + WS_QB) + (size_t)m * QW + h * HD, nullptr, rope, rowpos, colpos, RT, F.lane);
        for (int h = 0; h < NKV; ++h) post_head(P + OFF_KB + h * HD, (bf16*)(F.ws + WS_KB) + (size_t)m * KW + h * HD, nullptr, rope, rowpos, colpos, RT, F.lane);
        { const f32x4v a = *(const f32x4v*)(P + OFF_VA + 4 * F.lane), b = *(const f32x4v*)(P + OFF_VB + 4 * F.lane); uint2 o; o.x = pk2(a.x, a.y); o.y = pk2(a.z, a.w); *(uint2*)((bf16*)(F.ws + WS_VA) + (size_t)m * KW + 4 * F.lane) = o;
          o.x = pk2(b.x, b.y); o.y = pk2(b.z, b.w); *(uint2*)((bf16*)(F.ws + WS_VB) + (size_t)m * KW + 4 * F.lane) = o; }
#pragma unroll
        for (int j = 0; j < 8; ++j) { const int col = 4 * (F.lane + 64 * j);
            const f32x4v a = *(const f32x4v*)(P + OFF_GA + col), b = *(const f32x4v*)(P + OFF_GB + col);
            uint2 o; o.x = pk2(1.f / (1.f + __expf(-a.x)), 1.f / (1.f + __expf(-a.y))); o.y = pk2(1.f / (1.f + __expf(-a.z)), 1.f / (1.f + __expf(-a.w))); *(uint2*)((bf16*)(F.ws + WS_GA) + (size_t)m * D + col) = o;
            o.x = pk2(1.f / (1.f + __expf(-b.x)), 1.f / (1.f + __expf(-b.y))); o.y = pk2(1.f / (1.f + __expf(-b.z)), 1.f / (1.f + __expf(-b.w))); *(uint2*)((bf16*)(F.ws + WS_GB) + (size_t)m * D + col) = o; }
    }
}

__device__ __forceinline__ void ph_gate(Frame& F, int l) {
    const int gw = F.vcu * NWAVES + F.wave, NGW = F.G * NWAVES;
    for (int m = gw; m < M; m += NGW) {
        if (l == DEPTH - 1 && (m % TT) < CTX) continue;
        const bf16* GA = (const bf16*)(F.ws + WS_GA) + (size_t)m * D; const bf16* GB = (const bf16*)(F.ws + WS_GB) + (size_t)m * D;
        const float* T1 = (const float*)(F.ws + WS_T1) + (size_t)m * D; const float* T2 = (const float*)(F.ws + WS_T2) + (size_t)m * D;
        f32x4v h[8];
#pragma unroll
        for (int j = 0; j < 8; ++j) { const int col = 4 * (F.lane + 64 * j); const uint2 a = *(const uint2*)(GA + col), b = *(const uint2*)(GB + col);
            const f32x4v ga = {__builtin_bit_cast(float, a.x << 16), __builtin_bit_cast(float, a.x & 0xffff0000u), __builtin_bit_cast(float, a.y << 16), __builtin_bit_cast(float, a.y & 0xffff0000u)};
            const f32x4v gb = {__builtin_bit_cast(float, b.x << 16), __builtin_bit_cast(float, b.x & 0xffff0000u), __builtin_bit_cast(float, b.y << 16), __builtin_bit_cast(float, b.y & 0xffff0000u)};
            h[j] = ga * *(const f32x4v*)(T1 + col) + gb * *(const f32x4v*)(T2 + col); }
        store_bf16_row((bf16*)(F.ws + WS_MB) + (size_t)m * D, F.lane, h);
    }
}

template <bool ADD_T3, bool DRY>
__device__ __forceinline__ void ph_norm2_router(Frame& F, int l) {
    typedef short bf16x8r __attribute__((ext_vector_type(8)));
    constexpr int HP = 4112;
    LAS unsigned char* hhi = F.lds; LAS unsigned char* hlo = F.lds + 16 * HP;
    float* XW = (float*)(F.ws + WS_XW); bf16* H2 = (bf16*)(F.ws + (DRY ? WS_T2 : WS_HA));
    const float* nw = INP(IN_NFFN) + l * D;
    const bf16* WRH = (const bf16*)(F.ws + WS_WR) + (size_t)(l * 2) * 80 * D; const bf16* WRL = WRH + (size_t)80 * D;
    const int nrows = (l == DEPTH - 1) ? NB * SEQ : M, niter = nrows / 16;
    unsigned* TE = (unsigned*)(F.ws + WS_TOK) + (size_t)l * M * 2; float* TW = (float*)(F.ws + WS_TOK) + (size_t)(4 + l) * M * 2;
    const int w = F.wave, lane = F.lane, fr = lane & 15, fq = lane >> 4;
#if TPROBE >= 100
    unsigned long long tacc1 = 0, tacc3 = 0, tacc5 = 0, tprev = __builtin_amdgcn_s_memrealtime();
#define SUBT(acc_) do { if (blockIdx.x == 0 && F.tid == 0 && l == 0) { const unsigned long long tn_ = __builtin_amdgcn_s_memrealtime(); acc_ += tn_ - tprev; tprev = tn_; } } while (0)
#else
#define SUBT(acc_) do { } while (0)
#endif
    f32x4v vrow[2][8];
#define N2_LOADROWS(it_) do { _Pragma("unroll") for (int rr_ = 0; rr_ < 2; ++rr_) { const int q_ = (it_) * 16 + 2 * w + rr_; const int m_ = (l == DEPTH - 1) ? (q_ / SEQ) * TT + CTX + (q_ % SEQ) : q_; \
        _Pragma("unroll") for (int j = 0; j < 8; ++j) vrow[rr_][j] = *(const f32x4v*)(XW + (size_t)m_ * D + 4 * (lane + 64 * j)); } } while (0)
    if (F.vcu < niter) N2_LOADROWS(F.vcu);
    for (int it = F.vcu; it < niter; it += F.G) {
        __syncthreads();
        if (it != F.vcu) N2_LOADROWS(it);
#pragma unroll
        for (int rr = 0; rr < 2; ++rr) {
            const int lr = 2 * w + rr, q = it * 16 + lr; const int m = (l == DEPTH - 1) ? (q / SEQ) * TT + CTX + (q % SEQ) : q;
            f32x4v v[8];
#pragma unroll
            for (int j = 0; j < 8; ++j) v[j] = vrow[rr][j];
            const float* mod = (const float*)(F.ws + WS_MOD) + (size_t)(l * 5 + mod_row(m)) * MODW;
            if (ADD_T3) { const float* T3 = (const float*)(F.ws + WS_T3) + (size_t)m * D;
#pragma unroll
                for (int j = 0; j < 8; ++j) { const int col = 4 * (lane + 64 * j); v[j] += *(const f32x4v*)(mod + 2 * D + col) * *(const f32x4v*)(T3 + col); *(f32x4v*)(XW + (size_t)m * D + col) = v[j]; } }
            const float rstd = 1.0f / sqrtf(row_sumsq(v) * (1.0f / D) + EPS);
            f32x4v h[8];
#pragma unroll
            for (int j = 0; j < 8; ++j) { const int col = 4 * (lane + 64 * j); const f32x4v ww = *(const f32x4v*)(nw + col), sh = *(const f32x4v*)(mod + 3 * D + col), sc = *(const f32x4v*)(mod + 4 * D + col);
                h[j] = (v[j] * rstd * ww) * (1.0f + sc) + sh;
                const unsigned a0 = f2bf(h[j].x), a1 = f2bf(h[j].y), a2 = f2bf(h[j].z), a3 = f2bf(h[j].w);
                typedef unsigned u32x2r __attribute__((ext_vector_type(2))); u32x2r hi2, lo2; hi2.x = a0 | (a1 << 16); hi2.y = a2 | (a3 << 16);
                lo2.x = f2bf(h[j].x - __builtin_bit_cast(float, a0 << 16)) | (f2bf(h[j].y - __builtin_bit_cast(float, a1 << 16)) << 16);
                lo2.y = f2bf(h[j].z - __builtin_bit_cast(float, a2 << 16)) | (f2bf(h[j].w - __builtin_bit_cast(float, a3 << 16)) << 16);
                *(LAS u32x2r*)(hhi + lr * HP + col * 2) = hi2; *(LAS u32x2r*)(hlo + lr * HP + col * 2) = lo2; }
            store_bf16_row(H2 + (size_t)m * D, lane, h);
        }
        __syncthreads(); SUBT(tacc1);
        {
            pg8::f32x4 acc[5];
#pragma unroll
            for (int cf = 0; cf < 5; ++cf) acc[cf] = (pg8::f32x4){0.f, 0.f, 0.f, 0.f};
            const __amdgpu_buffer_rsrc_t wrs = __builtin_amdgcn_make_buffer_rsrc((void*)WRH, 0, 2 * 80 * D * 2, 0x00020000);
            const unsigned wvo = (unsigned)lane * 16u;
            const LAS unsigned char* ah = hhi + fr * HP + (256 * w + 8 * fq) * 2; const LAS unsigned char* al = hlo + fr * HP + (256 * w + 8 * fq) * 2;
            bf16x8r Wh0[5], Wl0[5], Wh1[5], Wl1[5];
#define RT_LOADW(Wh, Wl, s_) do { _Pragma("unroll") for (int cf = 0; cf < 5; ++cf) { Wh[cf] = __builtin_bit_cast(bf16x8r, __builtin_amdgcn_raw_buffer_load_b128(wrs, wvo, ((8 * w + (s_)) * 5 + cf) * 1024, 0)); Wl[cf] = __builtin_bit_cast(bf16x8r, __builtin_amdgcn_raw_buffer_load_b128(wrs, wvo, ((64 + 8 * w + (s_)) * 5 + cf) * 1024, 0)); } } while (0)
#define RT_MMA(Wh, Wl, s_) do { const bf16x8r Hh = *(const LAS bf16x8r*)(ah + 64 * (s_)), Hl = *(const LAS bf16x8r*)(al + 64 * (s_)); \
            _Pragma("unroll") for (int cf = 0; cf < 5; ++cf) { acc[cf] = __builtin_amdgcn_mfma_f32_16x16x32_bf16(Wh[cf], Hh, acc[cf], 0, 0, 0); \
                acc[cf] = __builtin_amdgcn_mfma_f32_16x16x32_bf16(Wh[cf], Hl, acc[cf], 0, 0, 0); acc[cf] = __builtin_amdgcn_mfma_f32_16x16x32_bf16(Wl[cf], Hh, acc[cf], 0, 0, 0); } } while (0)
            RT_LOADW(Wh0, Wl0, 0);
#pragma unroll
            for (int s2 = 0; s2 < 8; s2 += 2) {
                RT_LOADW(Wh1, Wl1, s2 + 1); RT_MMA(Wh0, Wl0, s2);
                if (s2 + 2 < 8) RT_LOADW(Wh0, Wl0, s2 + 2);
                RT_MMA(Wh1, Wl1, s2 + 1);
            }
#undef RT_LOADW
#undef RT_MMA
            asm volatile("s_waitcnt lgkmcnt(0)" ::: "memory");
#pragma unroll
            for (int cf = 0; cf < 5; ++cf) *(LAS pg8::f32x4*)(hhi + fr * HP + 512 * w + (16 * cf + 4 * fq) * 4) = acc[cf];
        }
        __syncthreads(); SUBT(tacc3);
#pragma unroll 1
        for (int rr = 0; rr < 2; ++rr) {
            const int lr = 2 * w + rr, q = it * 16 + lr; const int m = (l == DEPTH - 1) ? (q / SEQ) * TT + CTX + (q % SEQ) : q;
            LAS float* elb = (LAS float*)(hlo + (2 * w + rr) * HP + 512 * w);
            float el = lane < 64 ? INP(IN_BRE)[l * NE + lane] : 0.f;
#pragma unroll
            for (int k2 = 0; k2 < 8; ++k2) el += *(const LAS float*)(hhi + lr * HP + 512 * k2 + lane * 4);
            elb[lane] = el;
            if (lane < 8) { float gl = INP(IN_BRG)[l * NG + lane];
#pragma unroll
                for (int k2 = 0; k2 < 8; ++k2) gl += *(const LAS float*)(hhi + lr * HP + 512 * k2 + (64 + lane) * 4);
                elb[64 + lane] = gl; }
            LDS_WAIT(); asm volatile("" ::: "memory");
            float gmax = elb[64]; int gi = 0;
#pragma unroll
            for (int i = 1; i < 8; ++i) { const float x = elb[64 + i]; if (x > gmax) { gmax = x; gi = i; } }
            float gs = 0.f;
#pragma unroll
            for (int i = 0; i < 8; ++i) gs += __expf(elb[64 + i] - gmax);
            const float pgv = 1.0f / gs;
            float v1 = elb[gi * 8]; int i1 = 0;
#pragma unroll
            for (int i = 1; i < 8; ++i) { const float x = elb[gi * 8 + i]; if (x > v1) { v1 = x; i1 = i; } }
            float v2 = -3.0e38f; int i2 = 0;
#pragma unroll
            for (int i = 0; i < 8; ++i) { const float x = elb[gi * 8 + i]; if (i != i1 && x > v2) { v2 = x; i2 = i; } }
            const float e2 = __expf(v2 - v1), s1 = 1.0f / (1.0f + e2), s2 = e2 * s1;
            if (lane == 0 && !DRY) {
                const unsigned ea = gi * 8 + i1, eb = gi * 8 + i2;
                TE[m * 2] = ea; TE[m * 2 + 1] = eb; TW[m * 2] = s1 * pgv; TW[m * 2 + 1] = s2 * pgv;
            }
        }
        SUBT(tacc5);
    }
#if TPROBE >= 100
    if (blockIdx.x == 0 && F.tid == 0 && l == 0) { volatile LAS unsigned long long* ts = (volatile LAS unsigned long long*)(F.lds + LDSCTL_OFF + 800); ts[26] = TPROBE == 100 ? tacc1 : TPROBE == 101 ? tacc3 : tacc5; }
#endif
#undef SUBT
}

__device__ __forceinline__ void ph_compact(Frame& F, int l) {
    LAS unsigned* wtot = (LAS unsigned*)(F.lds);
    const unsigned* TE = (const unsigned*)(F.ws + WS_TOK) + (size_t)l * M * 2; unsigned* TP = (unsigned*)(F.ws + WS_TOK) + (size_t)(2 + l) * M * 2;
    unsigned* LIST = (unsigned*)(F.ws + WS_LIST) + (size_t)l * NE * M; unsigned* cnt = (unsigned*)F.ctl + CW_CNT + l * 64;
    constexpr int TPT = M / (NWAVES * 64);
    for (int e = F.vcu; e < NE; e += F.G) {
        const int m0 = F.tid * TPT; unsigned c = 0;
        for (int i = 0; i < TPT; ++i) { const int m = m0 + i; const bool valid = (l < DEPTH - 1) || ((m % TT) >= CTX);
            const uint2 te = *(const uint2*)(TE + 2 * m); c += (valid && te.x == (unsigned)e) ? 1u : 0u; c += (valid && te.y == (unsigned)e) ? 1u : 0u; }
        unsigned v = c;
#pragma unroll
        for (int o = 1; o < 64; o <<= 1) { const unsigned t = __shfl_up(v, o); if (F.lane >= o) v += t; }
        if (F.lane == 63) wtot[F.wave] = v;
        __syncthreads();
        unsigned off = 0, tot = 0;
#pragma unroll
        for (int k2 = 0; k2 < NWAVES; ++k2) { const unsigned x = wtot[k2]; off += (k2 < F.wave) ? x : 0u; tot += x; }
        unsigned pos = off + v - c;
        for (int i = 0; i < TPT; ++i) { const int m = m0 + i; const bool valid = (l < DEPTH - 1) || ((m % TT) >= CTX);
            const uint2 te = *(const uint2*)(TE + 2 * m);
            if (valid && te.x == (unsigned)e) { LIST[(size_t)e * M + pos] = (unsigned)m; TP[2 * m] = pos; ++pos; }
            if (valid && te.y == (unsigned)e) { LIST[(size_t)e * M + pos] = (unsigned)m; TP[2 * m + 1] = pos; ++pos; } }
        if (F.tid == 0) cnt[e] = tot;
        __syncthreads();
    }
}

__device__ __forceinline__ void ph_final(Frame& F) {
    LAS unsigned* base = (LAS unsigned*)(F.lds);
    compute_base((const unsigned*)F.ctl + CW_CNT + (DEPTH - 1) * 64, base, F.tid);
    const int gw = F.vcu * NWAVES + F.wave, NGW = F.G * NWAVES;
    const float* XW = (const float*)(F.ws + WS_XW); const float* nw = INP(IN_NFIN);
    for (int q = gw; q < NB * SEQ; q += NGW) {
        const int m = (q / SEQ) * TT + CTX + (q % SEQ);
        f32x4v v[8];
#pragma unroll
        for (int j = 0; j < 8; ++j) v[j] = *(const f32x4v*)(XW + (size_t)m * D + 4 * (F.lane + 64 * j));
        moe_combine_add(F, DEPTH - 1, m, base, v);
        const float rstd = 1.0f / sqrtf(row_sumsq(v) * (1.0f / D) + EPS);
#pragma unroll
        for (int j = 0; j < 8; ++j) { const int col = 4 * (F.lane + 64 * j); *(f32x4v*)(F.out + (size_t)q * D + col) = v[j] * rstd * *(const f32x4v*)(nw + col); }
    }
}
template <int COLMAP>
__global__ void __launch_bounds__(256) naive_gemm(const bf16* A, int lda, const float* W, int ldw, float* Cc, int ldc, int K) {
    const int n = blockIdx.x * 64 + threadIdx.x, m0 = blockIdx.y * 32 + threadIdx.y * 8;
    const int sc = COLMAP ? inproj_src_col(n) : n;
    float acc[8];
#pragma unroll
    for (int i = 0; i < 8; ++i) acc[i] = 0.f;
    for (int k = 0; k < K; ++k) { const float w = W[(size_t)k * ldw + sc];
#pragma unroll
        for (int i = 0; i < 8; ++i) acc[i] += bf2f(A[(size_t)(m0 + i) * lda + k]) * w; }
#pragma unroll
    for (int i = 0; i < 8; ++i) Cc[(size_t)(m0 + i) * ldc + n] = acc[i];
}

__global__ void __launch_bounds__(256) naive_attn(const bf16* Q, const bf16* K, const bf16* V, bf16* Y, const float* sink, int mode, int with_ctx_q) {
    __shared__ float sc[4][TT]; __shared__ float qs[4][HD];
    const int wave = threadIdx.x >> 6, lane = threadIdx.x & 63;
    const int nq = with_ctx_q ? TT : SEQ; const long item = (long)blockIdx.x * 4 + wave; if (item >= (long)NB * NH * nq) return;
    const int tq = (int)(item % nq) + (with_ctx_q ? 0 : CTX), h = (int)((item / nq) % NH), b = (int)(item / ((long)nq * NH)), kvh = h / (NH / NKV);
    const size_t m = (size_t)b * TT + tq;
    qs[wave][lane] = bf2f(Q[m * QW + h * HD + lane]); qs[wave][lane + 64] = bf2f(Q[m * QW + h * HD + lane + 64]);
    __builtin_amdgcn_wave_barrier(); asm volatile("s_waitcnt lgkmcnt(0)" ::: "memory");
    const bool isctx = tq < CTX; const int nk = isctx ? CTX : TT;
    float mx = -3.0e38f;
    for (int kk = lane; kk < nk; kk += 64) {
        bool valid = true;
        if (mode == 1 && !isctx && kk >= CTX) { const int dq = (tq - CTX) - (kk - CTX); valid = dq <= 128 && dq >= -128; }
        float s = -3.0e38f;
        if (valid) { const bf16* kr = K + ((size_t)b * TT + kk) * KW + kvh * HD; float dsum = 0.f;
            for (int d = 0; d < HD; ++d) dsum += bf2f(kr[d]) * qs[wave][d];
            s = dsum * ATTN_SCALE; }
        sc[wave][kk] = s; mx = fmaxf(mx, s);
    }
    mx = wave_max(mx);
    float sk = 0.f; if (mode == 1) { sk = sink[h]; mx = fmaxf(mx, sk); }
    float sum = 0.f;
    for (int kk = lane; kk < nk; kk += 64) { const float s = sc[wave][kk]; const float p = s > -1.0e38f ? __expf(s - mx) : 0.f; sc[wave][kk] = p; sum += p; }
    sum = wave_sum(sum); if (mode == 1) sum += __expf(sk - mx);
    asm volatile("s_waitcnt lgkmcnt(0)" ::: "memory"); __builtin_amdgcn_wave_barrier();
    float o0 = 0.f, o1 = 0.f;
    for (int kk = 0; kk < nk; ++kk) { const float p = sc[wave][kk]; const bf16* vr = V + ((size_t)b * TT + kk) * KW + kvh * HD; o0 += p * bf2f(vr[lane]); o1 += p * bf2f(vr[lane + 64]); }
    const float inv = 1.0f / sum;
    Y[m * D + h * HD + lane] = (bf16)f2bf(o0 * inv); Y[m * D + h * HD + lane + 64] = (bf16)f2bf(o1 * inv);
}

__global__ void __launch_bounds__(256) naive_moe_up(const bf16* H2, const float* w1, const float* w3, const unsigned* cnt, const unsigned* LIST, bf16* HB) {
    __shared__ unsigned base[65];
    const int tid = threadIdx.y * 64 + threadIdx.x;
    if (tid == 0) { unsigned a = 0; for (int e = 0; e < NE; ++e) { base[e] = a; a += cnt[e]; } base[64] = a; }
    __syncthreads();
    const unsigned slot = blockIdx.y * 4 + threadIdx.y; if (slot >= base[64]) return;
    int e = 0; while (base[e + 1] <= slot) ++e;
    const unsigned tok = LIST[(size_t)e * M + (slot - base[e])];
    const int j = blockIdx.x * 64 + threadIdx.x;
    const float* W1 = w1 + (size_t)e * D * DE + j; const float* W3 = w3 + (size_t)e * D * DE + j; const bf16* x = H2 + (size_t)tok * D;
    float a = 0.f, b = 0.f;
    for (int k = 0; k < D; ++k) { const float xv = bf2f(x[k]); a += xv * W1[(size_t)k * DE]; b += xv * W3[(size_t)k * DE]; }
    HB[(size_t)slot * DE + j] = (bf16)f2bf(a / (1.f + __expf(-a)) * b);
}
__global__ void __launch_bounds__(256) naive_moe_down(const bf16* HB, const float* w2, const unsigned* cnt, bf16* YM) {
    __shared__ unsigned base[65];
    const int tid = threadIdx.y * 64 + threadIdx.x;
    if (tid == 0) { unsigned a = 0; for (int e = 0; e < NE; ++e) { base[e] = a; a += cnt[e]; } base[64] = a; }
    __syncthreads();
    const unsigned slot = blockIdx.y * 4 + threadIdx.y; if (slot >= base[64]) return;
    int e = 0; while (base[e + 1] <= slot) ++e;
    const int col = blockIdx.x * 64 + threadIdx.x;
    const float* W2 = w2 + (size_t)e * DE * D + col; const bf16* hrow = HB + (size_t)slot * DE;
    float a = 0.f;
    for (int k = 0; k < DE; ++k) a += bf2f(hrow[k]) * W2[(size_t)k * D];
    YM[(size_t)slot * D + col] = (bf16)f2bf(a);
}
namespace att {
constexpr int NW = 8, QBLK = 32, KVBLK = 64;
constexpr float THR = 8.f;
constexpr int LDQ = QW, LDK = KW, LDO = D;
constexpr size_t SHM_V = KVBLK * HD * 2, SHM_K = KVBLK * HD * 2, SHM_ATTN = 2 * SHM_V + 2 * SHM_K + NW * 64 * 4;
using bf16x8 = __attribute__((ext_vector_type(8))) short;
using s16x4  = __attribute__((ext_vector_type(4))) short;
using f32x16 = __attribute__((ext_vector_type(16))) float;
using u32x4  = __attribute__((ext_vector_type(4))) unsigned;
#define KSWZ(row, colB) ((row) * 256 + ((colB) ^ (((row) & 7) << 4)))
#define SBAR() __builtin_amdgcn_sched_barrier(0)
__device__ __forceinline__ int crow(int r, int hi) { return (r & 3) + 8 * (r >> 2) + 4 * hi; }
__device__ __forceinline__ unsigned cvtpk(float lo, float hi) { unsigned r; asm volatile("v_cvt_pk_bf16_f32 %0, %1, %2" : "=v"(r) : "v"(lo), "v"(hi)); return r; }
__device__ __forceinline__ void partialSM(f32x16& p0, f32x16& p1, float& m_reg, float& mn, float& alpha) {
  constexpr float C = ATTN_SCALE * 1.4426950408889634f;
  float pmax = p0[0]; for (int r = 1; r < 16; ++r) pmax = fmaxf(pmax, p0[r]); for (int r = 0; r < 16; ++r) pmax = fmaxf(pmax, p1[r]);
  { auto rr = __builtin_amdgcn_permlane32_swap(__float_as_uint(pmax), __float_as_uint(pmax), false, false);
    pmax = fmaxf(__uint_as_float(rr[0]), __uint_as_float(rr[1])); }
  if (__builtin_expect(__all(pmax - m_reg <= THR / ATTN_SCALE), 1)) { mn = m_reg; alpha = 1.f; }
  else { mn = fmaxf(m_reg, pmax); alpha = __builtin_amdgcn_exp2f((m_reg - mn) * C); m_reg = mn; }
  float mnC = -mn * C;
  for (int r = 0; r < 16; ++r) p0[r] = fmaf(p0[r], C, mnC); for (int r = 0; r < 16; ++r) p1[r] = fmaf(p1[r], C, mnC);
  for (int r = 0; r < 16; ++r) p0[r] = __builtin_amdgcn_exp2f(p0[r]);
}
__device__ __forceinline__ void finishSM(f32x16& p0, f32x16& p1, float alpha, float& l_reg, bf16x8& pa0, bf16x8& pa1, bf16x8& pa2, bf16x8& pa3) {
  for (int r = 0; r < 16; ++r) p1[r] = __builtin_amdgcn_exp2f(p1[r]);
  float ps = 0; for (int r = 0; r < 16; ++r) ps += p0[r]; for (int r = 0; r < 16; ++r) ps += p1[r];
  { auto rr = __builtin_amdgcn_permlane32_swap(__float_as_uint(ps), __float_as_uint(ps), false, false);
    ps = __uint_as_float(rr[0]) + __uint_as_float(rr[1]); }
  l_reg = l_reg * alpha + ps;
#define PK4(P, BASE, OUT) do { unsigned a0 = cvtpk(P[BASE + 0], P[BASE + 1]), a1 = cvtpk(P[BASE + 2], P[BASE + 3]);   \
    unsigned b0 = cvtpk(P[BASE + 4], P[BASE + 5]), b1 = cvtpk(P[BASE + 6], P[BASE + 7]);                              \
    auto r0 = __builtin_amdgcn_permlane32_swap(a0, b0, false, false); auto r1 = __builtin_amdgcn_permlane32_swap(a1, b1, false, false); \
    u32x4 w = {r0[0], r1[0], r0[1], r1[1]}; OUT = *reinterpret_cast<bf16x8*>(&w); } while (0)
  PK4(p0, 0, pa0); PK4(p0, 8, pa1); PK4(p1, 0, pa2); PK4(p1, 8, pa3);
#undef PK4
}
__device__ __forceinline__ void qkt(f32x16& p0, f32x16& p1, const bf16* Ks, const bf16x8* qr, int r32, int hi) {
  p0 = f32x16{}; p1 = f32x16{};
  for (int d0 = 0; d0 < 8; ++d0) { int cb = (d0 * 16 + hi * 8) * 2;
    bf16x8 b0 = *reinterpret_cast<const bf16x8*>((const char*)Ks + KSWZ(r32, cb));
    bf16x8 b1 = *reinterpret_cast<const bf16x8*>((const char*)Ks + KSWZ(32 + r32, cb));
    p0 = __builtin_amdgcn_mfma_f32_32x32x16_bf16(b0, qr[d0], p0, 0, 0, 0);
    p1 = __builtin_amdgcn_mfma_f32_32x32x16_bf16(b1, qr[d0], p1, 0, 0, 0); }
}
__device__ __forceinline__ void wmask(f32x16& p0, f32x16& p1, int kb, int qpos, int hi) {
  const float NEG = -1.0e30f; const int d0 = kb + 4 * hi - qpos;
#pragma unroll
  for (int r = 0; r < 16; ++r) { const int dd = d0 + (r & 3) + 8 * (r >> 2); if (dd > 128 || dd < -128) p0[r] = NEG; if (dd + 32 > 128 || dd + 32 < -128) p1[r] = NEG; }
}
__device__ __forceinline__ int v_st(int k, int c) { const int kk = (k & ~0xC) | ((k & 4) << 1) | ((k & 8) >> 1); return ((kk >> 3) * 4 + (c >> 5)) * 512 + ((kk & 7) * 32 + (c & 31)) * 2; }
__device__ __forceinline__ int v_rd_base(int lane) { return ((lane & 3) << 3) | (((lane >> 2) & 3) << 6) | (((lane >> 4) & 1) << 5) | (((lane >> 5) & 1) << 8); }
constexpr int v_rd_off(int d0, int ks, int half) { return d0 * 512 + ks * 4096 + half * 2048; }
template <int OFF> __device__ __forceinline__ s16x4 tr_read(int vb) {
  s16x4 r; asm volatile("ds_read_b64_tr_b16 %0, %1 offset:%2" : "=&v"(r) : "v"(vb), "i"(OFF) : "memory"); return r;
}
template <int D0> __device__ __forceinline__ void pv_one(f32x16& od, int vb, bf16x8 pa0, bf16x8 pa1, bf16x8 pa2, bf16x8 pa3) {
  const s16x4 l0 = tr_read<v_rd_off(D0, 0, 0)>(vb), h0 = tr_read<v_rd_off(D0, 0, 1)>(vb), l1 = tr_read<v_rd_off(D0, 1, 0)>(vb), h1 = tr_read<v_rd_off(D0, 1, 1)>(vb);
  const s16x4 l2 = tr_read<v_rd_off(D0, 2, 0)>(vb), h2 = tr_read<v_rd_off(D0, 2, 1)>(vb), l3 = tr_read<v_rd_off(D0, 3, 0)>(vb), h3 = tr_read<v_rd_off(D0, 3, 1)>(vb);
  asm volatile("s_waitcnt lgkmcnt(0)" ::: "memory"); SBAR();
#define PK(L, H) (bf16x8){L[0], L[1], L[2], L[3], H[0], H[1], H[2], H[3]}
  od = __builtin_amdgcn_mfma_f32_32x32x16_bf16(pa0, PK(l0, h0), od, 0, 0, 0);
  od = __builtin_amdgcn_mfma_f32_32x32x16_bf16(pa1, PK(l1, h1), od, 0, 0, 0);
  od = __builtin_amdgcn_mfma_f32_32x32x16_bf16(pa2, PK(l2, h2), od, 0, 0, 0);
  od = __builtin_amdgcn_mfma_f32_32x32x16_bf16(pa3, PK(l3, h3), od, 0, 0, 0);
#undef PK
}
__device__ __forceinline__ void pv_d0(f32x16* o, int vb, bf16x8 pa0, bf16x8 pa1, bf16x8 pa2, bf16x8 pa3) {
  pv_one<0>(o[0], vb, pa0, pa1, pa2, pa3); pv_one<1>(o[1], vb, pa0, pa1, pa2, pa3); pv_one<2>(o[2], vb, pa0, pa1, pa2, pa3); pv_one<3>(o[3], vb, pa0, pa1, pa2, pa3);
}
__device__ __forceinline__ void attn_unit(const bool MASKED, const bf16* __restrict__ Qb, const bf16* __restrict__ Kh, const bf16* __restrict__ Vh, bf16* __restrict__ Ob,
                                          int NT, int klo, int q0, float m0, float l0, char* lds) {
  const int tid = threadIdx.x, wid = tid >> 6, lane = tid & 63, r32 = lane & 31, hi = lane >> 5;
  bf16* V_lds = (bf16*)lds; bf16* K_lds = (bf16*)(lds + 2 * SHM_V);
  float* ws = (float*)(lds + 2 * SHM_V + 2 * SHM_K) + wid * 64; float* li_l = ws; float* al_l = ws + 32;
  float m_reg = m0, l_reg = l0; f32x16 o[4] = {}; bf16x8 qr[8];
  const bf16* Qw = Qb + (long)(wid * QBLK + r32) * LDQ + hi * 8;
#pragma unroll
  for (int d0 = 0; d0 < 8; ++d0) qr[d0] = *reinterpret_cast<const bf16x8*>(Qw + d0 * 16);
  const int sr = tid >> 4, sc = (tid & 15) * 8, vst0 = v_st(sr, sc), vst1 = v_st(32 + sr, sc);
  const int vb0 = (int)(uintptr_t)V_lds + v_rd_base(lane);
  const int qpos = q0 + wid * QBLK + r32;
  struct { bf16x8 vs0, vs1, ks0, ks1; } sr_[2];
#define KROW(j) ((!MASKED || (j) < 4) ? 64 * (j) : CTX + klo + 64 * ((j) - 4))
#define SLOAD(i, j) do { const int k0_ = KROW(j); sr_[i].vs0 = *reinterpret_cast<const bf16x8*>(&Vh[(long)(k0_ + sr) * LDK + sc]); sr_[i].vs1 = *reinterpret_cast<const bf16x8*>(&Vh[(long)(k0_ + 32 + sr) * LDK + sc]); \
    sr_[i].ks0 = *reinterpret_cast<const bf16x8*>(&Kh[(long)(k0_ + sr) * LDK + sc]); sr_[i].ks1 = *reinterpret_cast<const bf16x8*>(&Kh[(long)(k0_ + 32 + sr) * LDK + sc]); } while (0)
#define SWRITE(b, i) do { *(bf16x8*)((char*)V_lds + (b) * SHM_V + vst0) = sr_[i].vs0;          \
    *(bf16x8*)((char*)V_lds + (b) * SHM_V + vst1) = sr_[i].vs1; int kc = sc * 2;               \
    *(bf16x8*)((char*)K_lds + (b) * SHM_K + KSWZ(sr, kc)) = sr_[i].ks0;                       \
    *(bf16x8*)((char*)K_lds + (b) * SHM_K + KSWZ(32 + sr, kc)) = sr_[i].ks1; } while (0)
#define SWAIT() asm volatile("s_waitcnt vmcnt(4)" ::: "memory")
#define RESC(a) do { if (__any((a) < 1.f)) { if (hi == 0) al_l[r32] = (a); asm volatile("s_waitcnt lgkmcnt(0)" ::: "memory"); \
    for (int d = 0; d < 4; ++d) for (int r = 0; r < 16; ++r) o[d][r] *= al_l[crow(r, hi)]; } } while (0)
#define WMASK(P0, P1, j) do { if (MASKED && (j) >= 4) wmask(P0, P1, klo + 64 * ((j) - 4), qpos, hi); } while (0)
  f32x16 pA0, pA1, pB0, pB1; float mnA, mnB, alA, alB; bf16x8 pa0, pa1, pa2, pa3;
  constexpr int SE = 0, SO = 1;
  __syncthreads();
  SLOAD(SE, 0); asm volatile("s_waitcnt vmcnt(0)" ::: "memory"); SWRITE(0, SE); __syncthreads();
  qkt(pA0, pA1, K_lds, qr, r32, hi); WMASK(pA0, pA1, 0); partialSM(pA0, pA1, m_reg, mnA, alA);
  SLOAD(SO, 1); if (2 < NT) SLOAD(SE, 2);
  SWAIT(); SWRITE(1, SO); __syncthreads();
  for (int j = 1; j + 1 < NT; j += 2) {
    SBAR(); qkt(pB0, pB1, (bf16*)((char*)K_lds + SHM_K), qr, r32, hi); WMASK(pB0, pB1, j);
    finishSM(pA0, pA1, alA, l_reg, pa0, pa1, pa2, pa3); SBAR();
    SLOAD(SO, j + 2); SBAR();
    pv_d0(o, vb0, pa0, pa1, pa2, pa3); partialSM(pB0, pB1, m_reg, mnB, alB);
    __syncthreads(); SWAIT(); SWRITE(0, SE);
    RESC(alB); __syncthreads();
    SBAR(); qkt(pA0, pA1, K_lds, qr, r32, hi); WMASK(pA0, pA1, j + 1);
    finishSM(pB0, pB1, alB, l_reg, pa0, pa1, pa2, pa3); SBAR();
    if (j + 3 < NT) SLOAD(SE, j + 3); SBAR();
    pv_d0(o, vb0 + (int)SHM_V, pa0, pa1, pa2, pa3); partialSM(pA0, pA1, m_reg, mnA, alA);
    __syncthreads(); SWAIT(); SWRITE(1, SO);
    RESC(alA); __syncthreads();
  }
  SBAR(); qkt(pB0, pB1, (bf16*)((char*)K_lds + SHM_K), qr, r32, hi); WMASK(pB0, pB1, NT - 1);
  finishSM(pA0, pA1, alA, l_reg, pa0, pa1, pa2, pa3); SBAR();
  pv_d0(o, vb0, pa0, pa1, pa2, pa3); partialSM(pB0, pB1, m_reg, mnB, alB);
  __syncthreads(); RESC(alB);
  finishSM(pB0, pB1, alB, l_reg, pa0, pa1, pa2, pa3); SBAR();
  pv_d0(o, vb0 + (int)SHM_V, pa0, pa1, pa2, pa3);
  if (hi == 0) li_l[r32] = l_reg; asm volatile("s_waitcnt lgkmcnt(0)" ::: "memory");
  float rli[16];
#pragma unroll
  for (int r = 0; r < 16; ++r) rli[r] = __builtin_amdgcn_rcpf(li_l[crow(r, hi)]);
  bf16* Ow = Ob + (long)(wid * QBLK) * LDO;
#pragma unroll
  for (int r = 0; r < 16; ++r) { int orow = crow(r, hi);
    for (int d0 = 0; d0 < 4; ++d0) Ow[(long)orow * LDO + d0 * 32 + r32] = (bf16)f2bf(o[d0][r] * rli[r]); }
#undef KROW
#undef SLOAD
#undef SWRITE
#undef SWAIT
#undef RESC
#undef WMASK
}
#undef KSWZ
#undef SBAR
}

__device__ __forceinline__ void fast_attn(Frame& F, int l) {
    char* lds = (char*)F.lds;
    const int nsub = (l < DEPTH - 1) ? 3 : 2;
    for (int u = (int)blockIdx.x; u < 256; u += F.G) {
        const int x = u & 7, y = u >> 3, b = x >> 1, kvh = x & 1, g = y >> 3, qb = y & 7, h = kvh * 4 + g;
        for (int s = 0; s < nsub; ++s) {
            if (s == 2 && qb != 0 && qb != 7) break;
            const bool mixB = (s == 1) || (s == 2 && qb == 7), ctxq = (s == 2);
            const size_t brow = (size_t)b * TT, qrow = ctxq ? brow : brow + CTX + 256 * qb;
            const bf16* Qp = (const bf16*)(F.ws + (mixB ? WS_QB : WS_QA)) + qrow * QW + h * HD;
            const bf16* Kp = (const bf16*)(F.ws + (mixB ? WS_KB : WS_KA)) + brow * KW + kvh * HD;
            const bf16* Vp = (const bf16*)(F.ws + (mixB ? WS_VB : WS_VA)) + brow * KW + kvh * HD;
            bf16* Op = (bf16*)(F.ws + WS_YAB) + qrow * D + (mixB ? QW : 0) + h * HD;
            const int q0 = 256 * qb, klo = q0 - 128 < 0 ? 0 : q0 - 128, khi = q0 + 384 > SEQ ? SEQ : q0 + 384;
            const int NT = ctxq ? CTX / 64 : (s == 0 ? TT / 64 : 4 + (khi - klo) / 64);
            const float m0 = mixB ? INP(IN_SINK)[l * NH + h] * (1.0f / ATTN_SCALE) : -1.0e30f, l0 = mixB ? 1.f : 0.f;
            att::attn_unit(s == 1, Qp, Kp, Vp, Op, NT, klo, q0, m0, l0, lds);
        }
    }
}
namespace moe {
typedef unsigned u32x4 __attribute__((ext_vector_type(4)));
using pg8::bf16x8; using pg8::f32x4;
#ifndef MOE_CAPT
#define MOE_CAPT 576
#endif
constexpr int CAPT = MOE_CAPT;
constexpr int B_STAGE = 16384, CAP = 576, NMF = CAP / 32, GS = 3, NGRP = NMF / GS;
static_assert(2 * (CAP / 16) * 1024 + 4 * B_STAGE <= LDSCTL_OFF && NGRP == 6, "MoE LDS map / group nest");
__device__ __forceinline__ void wait_vm1(int n) {
    switch (n) { case 0: asm volatile("s_waitcnt vmcnt(0)" ::: "memory"); break; case 1: asm volatile("s_waitcnt vmcnt(1)" ::: "memory"); break; case 2: asm volatile("s_waitcnt vmcnt(2)" ::: "memory"); break;
                 case 3: asm volatile("s_waitcnt vmcnt(3)" ::: "memory"); break; case 4: asm volatile("s_waitcnt vmcnt(4)" ::: "memory"); break; case 5: asm volatile("s_waitcnt vmcnt(5)" ::: "memory"); break;
                 case 6: asm volatile("s_waitcnt vmcnt(6)" ::: "memory"); break; default: asm volatile("s_waitcnt vmcnt(7)" ::: "memory"); break; }
}
__device__ __forceinline__ void wait_vm8(int n) {
    switch (n) { case 0: asm volatile("s_waitcnt vmcnt(0)" ::: "memory"); break; case 1: asm volatile("s_waitcnt vmcnt(8)" ::: "memory"); break; case 2: asm volatile("s_waitcnt vmcnt(16)" ::: "memory"); break;
                 case 3: asm volatile("s_waitcnt vmcnt(24)" ::: "memory"); break; case 4: asm volatile("s_waitcnt vmcnt(32)" ::: "memory"); break; case 5: asm volatile("s_waitcnt vmcnt(40)" ::: "memory"); break; default: asm volatile("s_waitcnt vmcnt(48)" ::: "memory"); break; }
}
__device__ __forceinline__ unsigned cvt_pk(float lo, float hi) { unsigned r; asm volatile("v_cvt_pk_bf16_f32 %0, %1, %2" : "=v"(r) : "v"(lo), "v"(hi)); return r; }
__device__ __forceinline__ int swz(int ob) { return ob ^ (((ob >> 9) & 1) << 5); }

template <int MODE>
__device__ __forceinline__ void moe_phase(Frame& F, int l) {
    LAS unsigned char* lds = F.lds;
    LAS unsigned* base = (LAS unsigned*)(F.lds + LDSCTL_OFF + 512);
    const unsigned* cnt = (const unsigned*)F.ctl + CW_CNT + l * 64;
    compute_base(cnt, base, F.tid);
    LAS unsigned char* order = (LAS unsigned char*)(F.lds + LDSCTL_OFF + 512 + 272);
    if (F.tid < NE) { const unsigned c = base[F.tid + 1] - base[F.tid]; int rank = 0;
        for (int e2 = 0; e2 < NE; ++e2) { const unsigned c2 = base[e2 + 1] - base[e2]; rank += (c2 > c || (c2 == c && e2 < F.tid)) ? 1 : 0; }
        order[rank] = (unsigned char)F.tid; }
    __syncthreads();
    constexpr int NCS = MODE == 0 ? 8 : 16, K = MODE == 0 ? D : DE, NT = K / 32, LDW = MODE == 0 ? DE : D, BKS = MODE == 0 ? 256 : 512;
    const int wid = F.wave, lane = F.lane, wr = wid >> 2, wc = wid & 3, fr = lane & 15, fq = lane >> 4;
    const int afo = swz(fr * 64 + fq * 16);
    const int sb = swz(lane * 16), drow = sb >> 6, dk = (sb & 63) >> 1;
    int bro[2];
#pragma unroll
    for (int j = 0; j < 2; ++j) bro[j] = (MODE == 0) ? j * 8192 + ((8 * fq) * 64 + 16 * wc + fr) * 4 : ((8 * fq) * 128 + 32 * wc + 16 * j + fr) * 4;
    const int bw = wid - 6;
    const unsigned bvo = (MODE == 0) ? (unsigned)((lane >> 4) * LDW + (lane & 15) * 4) * 4u : (unsigned)((lane >> 5) * LDW + (lane & 31) * 4) * 4u;
    const unsigned* LISTl = (const unsigned*)(F.ws + WS_LIST) + (size_t)l * NE * M;
    const __amdgpu_buffer_rsrc_t ars = __builtin_amdgcn_make_buffer_rsrc((void*)(F.ws + (MODE == 0 ? WS_HA : WS_HB)), 0, 0x7ffffff0, 0x00020000);
    constexpr int UREP = (REPMASK & (MODE == 0 ? (1 << 8) : (1 << 9))) ? 2 : 1;
    for (int u2 = F.vcu; u2 < UREP * NE * NCS; u2 += F.G) {
        const int u = u2 % (NE * NCS); const int cs = u % NCS; const bool rep = (UREP > 1) && (u2 >= NE * NCS);
        const int uq = u / NCS; int rnk;
        if (F.G * NCS >= NE * NCS / 2 && NE * NCS / F.G == 2) { const int slot = uq % (NE / 2), i = uq / (NE / 2); rnk = i == 0 ? slot : NE - 1 - slot; }
        else if (NE * NCS / F.G == 4 && NE % 4 == 0) { const int slot = uq % (NE / 4), i = uq / (NE / 4); rnk = i == 0 ? slot : i == 1 ? NE / 2 - 1 - slot : i == 2 ? NE / 2 + slot : NE - 1 - slot; }
        else rnk = uq;
        const int e = (int)order[rnk];
        const int n_e = (int)(base[e + 1] - base[e]), base_e = (int)base[e];
        const float* wbase;
        if (MODE == 0) wbase = ((bw == 1) ? INP(IN_W3) : INP(IN_W1)) + ((size_t)(l * NE + e) * D) * DE + 64 * cs;
        else           wbase = INP(IN_W2) + ((size_t)(l * NE + e) * DE) * D + 128 * cs + (size_t)(bw == 1 ? 16 : 0) * D;
        unsigned wlo_v = (unsigned)(unsigned long long)wbase, whi_v = (unsigned)((unsigned long long)wbase >> 32);
        asm volatile("" : "+v"(wlo_v), "+v"(whi_v));
        for (int r0 = 0; r0 < n_e; r0 += CAPT) {
            const int nrows = (n_e - r0) < CAPT ? (n_e - r0) : CAPT, nsub = (nrows + 15) >> 4;
            const int asz = nsub * 1024; const int na = 2;
            const int boff = na * asz; int nstg = (LDSCTL_OFF - boff) / B_STAGE; nstg = nstg > 8 ? 8 : nstg;
            int naw = 0;
#pragma unroll
            for (int j = 0; j < 7; ++j) naw += (wid + 6 * j < nsub) ? 1 : 0;
            unsigned aof[7];
#pragma unroll
            for (int j = 0; j < 7; ++j) { const int sx = wid + 6 * j; int r = 16 * sx + drow; if (r >= nrows) r = 0;
                if (MODE == 0) aof[j] = LISTl[(size_t)e * M + r0 + r] * (unsigned)(D * 2) + (unsigned)dk * 2u;
                else           aof[j] = (unsigned)(base_e + r0 + r) * (unsigned)(DE * 2) + (unsigned)dk * 2u; }
            f32x4 acc[NMF][2];
#pragma unroll
            for (int m = 0; m < NMF; ++m)
#pragma unroll
                for (int n = 0; n < 2; ++n) acc[m][n] = (f32x4){0.f, 0.f, 0.f, 0.f};
#define MOE_DMA_A(t, b) do { _Pragma("unroll") for (int j_ = 0; j_ < 7; ++j_) { const int s_ = wid + 6 * j_; if (s_ < nsub) \
        __builtin_amdgcn_raw_ptr_buffer_load_lds(ars, (LAS void*)(lds + (b) * asz + s_ * 1024), 16, aof[j_], (t) * 64, 0, 0); } } while (0)
#define MOE_DMA_B(t) do { unsigned lo_, hi_; asm volatile("v_readfirstlane_b32 %0, %2\n\tv_readfirstlane_b32 %1, %3" : "=s"(lo_), "=s"(hi_) : "v"(wlo_v), "v"(whi_v)); \
        const __amdgpu_buffer_rsrc_t wrs_ = __builtin_amdgcn_make_buffer_rsrc((void*)(((unsigned long long)hi_ << 32) | lo_), 0, 0x7ffffff0, 0x00020000); \
        LAS unsigned char* bst_ = lds + boff + ((t) % nstg) * B_STAGE + bw * 8192; \
        _Pragma("unroll") for (int i_ = 0; i_ < 8; ++i_) __builtin_amdgcn_raw_ptr_buffer_load_lds(wrs_, (LAS void*)(bst_ + i_ * 1024), 16, bvo, ((t) * 32 + (MODE == 0 ? 4 : 2) * i_) * (LDW * 4), 0, 2); } while (0)
#define MOE_DMA_BS(t, slot) do { unsigned lo_, hi_; asm volatile("v_readfirstlane_b32 %0, %2\n\tv_readfirstlane_b32 %1, %3" : "=s"(lo_), "=s"(hi_) : "v"(wlo_v), "v"(whi_v)); \
        const __amdgpu_buffer_rsrc_t wrs_ = __builtin_amdgcn_make_buffer_rsrc((void*)(((unsigned long long)hi_ << 32) | lo_), 0, 0x7ffffff0, 0x00020000); \
        LAS unsigned char* bst_ = lds + boff + (slot) * B_STAGE + bw * 8192; \
        _Pragma("unroll") for (int i_ = 0; i_ < 8; ++i_) __builtin_amdgcn_raw_ptr_buffer_load_lds(wrs_, (LAS void*)(bst_ + i_ * 1024), 16, bvo, ((t) * 32 + (MODE == 0 ? 4 : 2) * i_) * (LDW * 4), 0, 2); } while (0)
#define MOE_LDA(dst, g_) do { _Pragma("unroll") for (int q_ = 0; q_ < GS; ++q_) dst[q_] = *(const LAS bf16x8*)(Ab + (2 * (GS * (g_) + q_) + wr) * 1024 + afo); } while (0)
#define MOE_MMA(src, g_) do { _Pragma("unroll") for (int q_ = 0; q_ < GS; ++q_) _Pragma("unroll") for (int j_ = 0; j_ < 2; ++j_) \
        acc[GS * (g_) + q_][j_] = __builtin_amdgcn_mfma_f32_16x16x32_bf16(Bf[j_], src[q_], acc[GS * (g_) + q_][j_], 0, 0, 0); } while (0)
            asm volatile("s_waitcnt vmcnt(0) lgkmcnt(0)" ::: "memory"); __builtin_amdgcn_s_barrier(); asm volatile("" ::: "memory");
            if (wid < 6) { MOE_DMA_A(0, 0); if (na == 3 && NT > 1) MOE_DMA_A(1, 1); }
            else { for (int p = 0; p < nstg - 1 && p < NT; ++p) MOE_DMA_B(p); }
            const int ngrp = (nsub - wr + 2 * GS - 1) / (2 * GS);
            int abuf = 0, bslot = 0;
            for (int t = 0; t < NT; ++t) {
                if (wid < 6) { if (na == 3 && t + 1 < NT) wait_vm1(naw); else asm volatile("s_waitcnt vmcnt(0)" ::: "memory"); }
                else { const int rem = NT - 1 - t; wait_vm8(rem < nstg - 2 ? rem : nstg - 2); }
                asm volatile("s_waitcnt lgkmcnt(0)" ::: "memory"); __builtin_amdgcn_s_barrier(); asm volatile("" ::: "memory");
                if (wid < 6) { if (t + na - 1 < NT) { int nb = abuf + na - 1; nb = nb >= na ? nb - na : nb; MOE_DMA_A(t + na - 1, nb); } }
                else { if (t + nstg - 1 < NT) { int ns = bslot + nstg - 1; ns = ns >= nstg ? ns - nstg : ns; MOE_DMA_BS(t + nstg - 1, ns); } }
                const LAS unsigned char* Ab = lds + abuf * asz; const LAS unsigned char* Bb = lds + boff + bslot * B_STAGE;
                abuf = (abuf + 1 == na) ? 0 : abuf + 1; bslot = (bslot + 1 == nstg) ? 0 : bslot + 1;
                bf16x8 At0[GS], At1[GS], Bf[2]; float w0[8], w1[8];
#pragma unroll
                for (int i = 0; i < 8; ++i) w0[i] = *(const LAS float*)(Bb + bro[0] + i * BKS);
#pragma unroll
                for (int i = 0; i < 8; ++i) w1[i] = *(const LAS float*)(Bb + bro[1] + i * BKS);
                MOE_LDA(At0, 0);
                __builtin_amdgcn_sched_barrier(0);
                { u32x4 p; p.x = cvt_pk(w0[0], w0[1]); p.y = cvt_pk(w0[2], w0[3]); p.z = cvt_pk(w0[4], w0[5]); p.w = cvt_pk(w0[6], w0[7]); Bf[0] = __builtin_bit_cast(bf16x8, p);
                  p.x = cvt_pk(w1[0], w1[1]); p.y = cvt_pk(w1[2], w1[3]); p.z = cvt_pk(w1[4], w1[5]); p.w = cvt_pk(w1[6], w1[7]); Bf[1] = __builtin_bit_cast(bf16x8, p); }
                __builtin_amdgcn_sched_barrier(0);
                if (ngrp > 1) MOE_LDA(At1, 1);
                MOE_MMA(At0, 0);
                if (ngrp > 1) { if (ngrp > 2) MOE_LDA(At0, 2); MOE_MMA(At1, 1);
                    if (ngrp > 2) { if (ngrp > 3) MOE_LDA(At1, 3); MOE_MMA(At0, 2);
                        if (ngrp > 3) { if (ngrp > 4) MOE_LDA(At0, 4); MOE_MMA(At1, 3);
                            if (ngrp > 4) { if (ngrp > 5) MOE_LDA(At1, 5); MOE_MMA(At0, 4);
                                if (ngrp > 5) MOE_MMA(At1, 5); } } } }
            }
#pragma unroll
            for (int m = 0; m < NMF; ++m) { const int row = 16 * (2 * m + wr) + fr;
                if (row < nrows && !rep) {
                    if (MODE == 0) { const f32x4 x = acc[m][0], y = acc[m][1]; uint2 o;
                        o.x = cvt_pk(x[0] / (1.f + __expf(-x[0])) * y[0], x[1] / (1.f + __expf(-x[1])) * y[1]); o.y = cvt_pk(x[2] / (1.f + __expf(-x[2])) * y[2], x[3] / (1.f + __expf(-x[3])) * y[3]);
                        *(uint2*)((bf16*)(F.ws + WS_HB) + (size_t)(base_e + r0 + row) * DE + 64 * cs + 16 * wc + 4 * fq) = o;
                    } else {
#pragma unroll
                        for (int n = 0; n < 2; ++n) { const f32x4 x = acc[m][n]; uint2 o; o.x = cvt_pk(x[0], x[1]); o.y = cvt_pk(x[2], x[3]);
                            typedef unsigned u32x2s __attribute__((ext_vector_type(2))); __builtin_nontemporal_store((u32x2s){o.x, o.y}, (u32x2s*)((bf16*)(F.ws + WS_YM) + (size_t)(base_e + r0 + row) * D + 128 * cs + 32 * wc + 16 * n + 4 * fq)); }
                    }
                } }
        }
    }
    asm volatile("s_waitcnt vmcnt(0) lgkmcnt(0)" ::: "memory"); __syncthreads();
#undef MOE_DMA_A
#undef MOE_DMA_B
#undef MOE_DMA_BS
#undef MOE_LDA
#undef MOE_MMA
}
}
__device__ __forceinline__ void fast_moe_up(Frame& F, int l) { moe::moe_phase<0>(F, l); }
__device__ __forceinline__ void fast_moe_down(Frame& F, int l) { moe::moe_phase<1>(F, l); }
struct RowOrder {
    pg8::StaticOrder so; bool latent_only;
    __device__ void init(bool lat, int N, int G, int c) { latent_only = lat; so.init(lat ? NB * SEQ : M, N, G, c); }
    __device__ bool next(int i, pg8::Unit& u) const { if (!so.next(i, u)) return false; if (latent_only) u.pm = (u.pm >> 3) * 9 + 1 + (u.pm & 7); return true; }
    __device__ __forceinline__ void a_ready(const pg8::Unit&) const {}
    __device__ __forceinline__ void done(const pg8::Unit&) const {}
};
struct EpiF32 {
    static constexpr int MIDK = 0; static constexpr bool PERM = false, AFTER_DRAIN = false;
    float* O; int ldc;
    __device__ __forceinline__ void operator()(const pg8::f32x4 (&acc)[2][2][4][2], const pg8::Unit& u, int wr, int wc, int fr, int fq) const {
        const int row0 = u.pm * 256 + wr * 64 + fr, col0 = u.pn * 256 + wc * 32 + 4 * fq;
#pragma unroll
        for (int ai = 0; ai < 2; ++ai)
#pragma unroll
            for (int m = 0; m < 4; ++m) { float* rowp = O + (size_t)(row0 + ai * 128 + m * 16) * ldc + col0;
#pragma unroll
                for (int bj = 0; bj < 2; ++bj)
#pragma unroll
                    for (int n = 0; n < 2; ++n) *(pg8::f32x4*)(rowp + bj * 128 + n * 16) = acc[ai][bj][m][n]; }
    }
};
template <int PASS>
struct EpiGate {
    static constexpr int MIDK = 0; static constexpr bool PERM = false, AFTER_DRAIN = false;
    const bf16* G; bf16* O;
    __device__ __forceinline__ void operator()(const pg8::f32x4 (&acc)[2][2][4][2], const pg8::Unit& u, int wr, int wc, int fr, int fq) const {
        asm volatile("" : "+v"(fr), "+v"(fq));
        const int row0 = u.pm * 256 + wr * 64 + fr, col0 = u.pn * 256 + wc * 32 + 4 * fq;
#pragma unroll
        for (int ai = 0; ai < 2; ++ai) {
            uint2 gv[4][2][2], tv[4][2][2];
#pragma unroll
            for (int m = 0; m < 4; ++m) { const size_t off = (size_t)(row0 + ai * 128 + m * 16) * D + col0;
#pragma unroll
                for (int bj = 0; bj < 2; ++bj)
#pragma unroll
                    for (int n = 0; n < 2; ++n) { gv[m][bj][n] = *(const uint2*)(G + off + bj * 128 + n * 16); if (PASS == 2) tv[m][bj][n] = *(const uint2*)(O + off + bj * 128 + n * 16); } }
#pragma unroll
            for (int m = 0; m < 4; ++m) { const size_t off = (size_t)(row0 + ai * 128 + m * 16) * D + col0;
#pragma unroll
                for (int bj = 0; bj < 2; ++bj)
#pragma unroll
                    for (int n = 0; n < 2; ++n) { const uint2 g2 = gv[m][bj][n];
                        pg8::f32x4 g = {__builtin_bit_cast(float, g2.x << 16), __builtin_bit_cast(float, g2.x & 0xffff0000u), __builtin_bit_cast(float, g2.y << 16), __builtin_bit_cast(float, g2.y & 0xffff0000u)};
                        pg8::f32x4 v = g * acc[ai][bj][m][n];
                        if (PASS == 2) { const uint2 t2 = tv[m][bj][n];
                            v += (pg8::f32x4){__builtin_bit_cast(float, t2.x << 16), __builtin_bit_cast(float, t2.x & 0xffff0000u), __builtin_bit_cast(float, t2.y << 16), __builtin_bit_cast(float, t2.y & 0xffff0000u)}; }
                        uint2 o; o.x = pg8::cvt_pk_bf16(v[0], v[1]); o.y = pg8::cvt_pk_bf16(v[2], v[3]); *(uint2*)(O + off + bj * 128 + n * 16) = o; } }
            asm volatile("" ::: "memory");
        }
    }
};
struct EpiGateK {
    static constexpr int MIDK = 16; static constexpr bool PERM = false, AFTER_DRAIN = false;
    const bf16* GA; const bf16* GB; bf16* O;
    __device__ __forceinline__ void mid(pg8::f32x4 (&acc)[2][2][4][2], const pg8::Unit& u, int wr, int wc, int fr, int fq) const {
        asm volatile("" : "+v"(fr), "+v"(fq));
        const int row0 = u.pm * 256 + wr * 64 + fr, col0 = u.pn * 256 + wc * 32 + 4 * fq;
#pragma unroll
        for (int ai = 0; ai < 2; ++ai) {
            uint2 av[4][2][2], bv[4][2][2];
#pragma unroll
            for (int m = 0; m < 4; ++m) { const size_t off = (size_t)(row0 + ai * 128 + m * 16) * D + col0;
#pragma unroll
                for (int bj = 0; bj < 2; ++bj)
#pragma unroll
                    for (int n = 0; n < 2; ++n) { av[m][bj][n] = *(const uint2*)(GA + off + bj * 128 + n * 16); bv[m][bj][n] = *(const uint2*)(GB + off + bj * 128 + n * 16); } }
#pragma unroll
            for (int m = 0; m < 4; ++m)
#pragma unroll
                for (int bj = 0; bj < 2; ++bj)
#pragma unroll
                    for (int n = 0; n < 2; ++n) { const uint2 a2 = av[m][bj][n], b2 = bv[m][bj][n];
                        const pg8::f32x4 ga = {__builtin_bit_cast(float, a2.x << 16), __builtin_bit_cast(float, a2.x & 0xffff0000u), __builtin_bit_cast(float, a2.y << 16), __builtin_bit_cast(float, a2.y & 0xffff0000u)};
                        const pg8::f32x4 gb = {__builtin_bit_cast(float, b2.x << 16), __builtin_bit_cast(float, b2.x & 0xffff0000u), __builtin_bit_cast(float, b2.y << 16), __builtin_bit_cast(float, b2.y & 0xffff0000u)};
#pragma unroll
                        for (int e = 0; e < 4; ++e) acc[ai][bj][m][n][e] *= ga[e] * __builtin_amdgcn_rcpf(fmaxf(gb[e], 1.0e-30f)); }
        }
    }
    __device__ __forceinline__ void operator()(const pg8::f32x4 (&acc)[2][2][4][2], const pg8::Unit& u, int wr, int wc, int fr, int fq) const {
        asm volatile("" : "+v"(fr), "+v"(fq));
        const int row0 = u.pm * 256 + wr * 64 + fr, col0 = u.pn * 256 + wc * 32 + 4 * fq;
#pragma unroll
        for (int ai = 0; ai < 2; ++ai) {
            uint2 bv[4][2][2];
#pragma unroll
            for (int m = 0; m < 4; ++m) { const size_t off = (size_t)(row0 + ai * 128 + m * 16) * D + col0;
#pragma unroll
                for (int bj = 0; bj < 2; ++bj)
#pragma unroll
                    for (int n = 0; n < 2; ++n) bv[m][bj][n] = *(const uint2*)(GB + off + bj * 128 + n * 16); }
#pragma unroll
            for (int m = 0; m < 4; ++m) { const size_t off = (size_t)(row0 + ai * 128 + m * 16) * D + col0;
#pragma unroll
                for (int bj = 0; bj < 2; ++bj)
#pragma unroll
                    for (int n = 0; n < 2; ++n) { const uint2 b2 = bv[m][bj][n];
                        const pg8::f32x4 gb = {__builtin_bit_cast(float, b2.x << 16), __builtin_bit_cast(float, b2.x & 0xffff0000u), __builtin_bit_cast(float, b2.y << 16), __builtin_bit_cast(float, b2.y & 0xffff0000u)};
                        const pg8::f32x4 v = gb * acc[ai][bj][m][n];
                        uint2 o; o.x = pg8::cvt_pk_bf16(v[0], v[1]); o.y = pg8::cvt_pk_bf16(v[2], v[3]); *(uint2*)(O + off + bj * 128 + n * 16) = o; } }
        }
    }
};
struct EpiRes {
    static constexpr int MIDK = 0; static constexpr bool PERM = false, AFTER_DRAIN = false;
    float* X; const float* g1l;
    __device__ __forceinline__ void operator()(const pg8::f32x4 (&acc)[2][2][4][2], const pg8::Unit& u, int wr, int wc, int fr, int fq) const {
        asm volatile("" : "+v"(fr), "+v"(fq));
        const int row0 = u.pm * 256 + wr * 64 + fr, col0 = u.pn * 256 + wc * 32 + 4 * fq;
        const float* g1 = g1l + (size_t)((u.pm % 9 == 0) ? 4 : u.pm / 9) * MODW + col0;
        pg8::f32x4 gv[2][2];
#pragma unroll
        for (int bj = 0; bj < 2; ++bj)
#pragma unroll
            for (int n = 0; n < 2; ++n) gv[bj][n] = *(const pg8::f32x4*)(g1 + bj * 128 + n * 16);
#pragma unroll
        for (int ai = 0; ai < 2; ++ai) {
            pg8::f32x4 xv[4][2][2];
#pragma unroll
            for (int m = 0; m < 4; ++m) { const float* rowp = X + (size_t)(row0 + ai * 128 + m * 16) * D + col0;
#pragma unroll
                for (int bj = 0; bj < 2; ++bj)
#pragma unroll
                    for (int n = 0; n < 2; ++n) xv[m][bj][n] = *(const pg8::f32x4*)(rowp + bj * 128 + n * 16); }
#pragma unroll
            for (int m = 0; m < 4; ++m) { float* rowp = X + (size_t)(row0 + ai * 128 + m * 16) * D + col0;
#pragma unroll
                for (int bj = 0; bj < 2; ++bj)
#pragma unroll
                    for (int n = 0; n < 2; ++n) *(pg8::f32x4*)(rowp + bj * 128 + n * 16) = xv[m][bj][n] + gv[bj][n] * acc[ai][bj][m][n]; }
            asm volatile("" ::: "memory");
        }
    }
};
struct EpiInproj {
    static constexpr int MIDK = 0; static constexpr bool PERM = false, AFTER_DRAIN = false;
    unsigned char* ws; const float* qn; const float* kn; LAS float* xs;
    __device__ __forceinline__ void operator()(const pg8::f32x4 (&acc)[2][2][4][2], const pg8::Unit& u, int wr, int wc, int fr, int fq) const {
        asm volatile("" : "+v"(fr), "+v"(fq));
        const int pn = u.pn; bf16* dst; int ldo, kind; const float* nw = nullptr;
        if (pn < 4) { dst = (bf16*)(ws + WS_QA) + pn * 256; ldo = QW; kind = 0; nw = qn; }
        else if (pn == 4) { dst = (bf16*)(ws + WS_KA); ldo = KW; kind = 0; nw = kn; }
        else if (pn == 5) { dst = (bf16*)(ws + WS_VA); ldo = KW; kind = 2; }
        else if (pn < 10) { dst = (bf16*)(ws + WS_QB) + (pn - 6) * 256; ldo = QW; kind = 1; }
        else if (pn == 10) { dst = (bf16*)(ws + WS_KB); ldo = KW; kind = 1; }
        else if (pn == 11) { dst = (bf16*)(ws + WS_VB); ldo = KW; kind = 2; }
        else if (pn < 20) { dst = (bf16*)(ws + WS_GA) + (pn - 12) * 256; ldo = D; kind = 3; }
        else { dst = (bf16*)(ws + WS_GB) + (pn - 20) * 256; ldo = D; kind = 3; }
        const int rt0 = wr * 64 + fr;
        const int cw = 32 * wc + 4 * fq;
        const int tb = u.pm % 9; const bool rope = (kind < 2) && (tb != 0);
        if (kind == 0) {
#pragma unroll
            for (int ai = 0; ai < 2; ++ai)
#pragma unroll
                for (int m = 0; m < 4; ++m)
#pragma unroll
                    for (int bj = 0; bj < 2; ++bj) { const pg8::f32x4 a = acc[ai][bj][m][0], b = acc[ai][bj][m][1];
                        float ss = (a[0] * a[0] + a[1] * a[1]) + (a[2] * a[2] + a[3] * a[3]) + (b[0] * b[0] + b[1] * b[1]) + (b[2] * b[2] + b[3] * b[3]);
                        ss += __shfl_xor(ss, 16); ss += __shfl_xor(ss, 32);
                        if (fq == 0) xs[(bj * 256 + rt0 + 128 * ai + 16 * m) * 4 + wc] = ss; }
            asm volatile("s_waitcnt lgkmcnt(0)" ::: "memory"); __builtin_amdgcn_s_barrier(); asm volatile("" ::: "memory");
        }
        pg8::f32x4 w1 = {1.f, 1.f, 1.f, 1.f}, w2 = w1;
        if (kind == 0) { const int d1 = 64 * (wc >> 1) + 16 * (wc & 1) + 4 * fq; w1 = *(const pg8::f32x4*)(nw + d1); w2 = *(const pg8::f32x4*)(nw + d1 + 32); }
        const float* RT = (const float*)(ws + WS_ROPE) + 16 * (wc & 1) + 4 * fq;
#pragma unroll
        for (int ai = 0; ai < 2; ++ai)
#pragma unroll
            for (int m = 0; m < 4; ++m) {
                const int rt = rt0 + 128 * ai + 16 * m;
                pg8::f32x4 cs = {1.f, 1.f, 1.f, 1.f}, sn = {0.f, 0.f, 0.f, 0.f};
                if (rope) { const int s = (tb - 1) * 256 + rt; const int pos = (wc >> 1) ? (s & 63) : (s >> 6); cs = *(const pg8::f32x4*)(RT + pos * 32); sn = *(const pg8::f32x4*)(RT + 2048 + pos * 32); }
                bf16* rowp = dst + (size_t)(u.pm * 256 + rt) * ldo + cw;
#pragma unroll
                for (int bj = 0; bj < 2; ++bj) {
                    pg8::f32x4 x1 = acc[ai][bj][m][0], x2 = acc[ai][bj][m][1];
                    if (kind == 0) { const pg8::f32x4 p = *(const LAS pg8::f32x4*)(xs + (bj * 256 + rt) * 4); const float r = 1.0f / sqrtf(((p[0] + p[1]) + (p[2] + p[3])) * (1.0f / HD) + EPS); x1 = x1 * r * w1; x2 = x2 * r * w2; }
                    if (kind < 2) { const pg8::f32x4 o1 = x1 * cs - x2 * sn, o2 = x1 * sn + x2 * cs; x1 = o1; x2 = o2; }
                    if (kind == 3) {
#pragma unroll
                        for (int e = 0; e < 4; ++e) { x1[e] = 1.f / (1.f + __expf(-x1[e])); x2[e] = 1.f / (1.f + __expf(-x2[e])); } }
                    uint2 o; o.x = pg8::cvt_pk_bf16(x1[0], x1[1]); o.y = pg8::cvt_pk_bf16(x1[2], x1[3]); *(uint2*)(rowp + bj * 128) = o;
                    o.x = pg8::cvt_pk_bf16(x2[0], x2[1]); o.y = pg8::cvt_pk_bf16(x2[2], x2[3]); *(uint2*)(rowp + bj * 128 + 16) = o;
                }
                asm volatile("" ::: "memory");
            }
    }
};
__device__ __forceinline__ void fast_inproj(Frame& F, int l) {
    pg8::Gemm g{(const bf16*)(F.ws + WS_HA), (const bf16*)(F.ws + WS_WIN) + (size_t)l * INC * D, M, INC, D, D, D};
    RowOrder S; S.init(false, INC, F.G, (int)blockIdx.x);
    if constexpr (FUSE_POST) { EpiInproj E{F.ws, INP(IN_QNA) + l * HD, INP(IN_KNA) + l * HD, (LAS float*)(F.lds + XS_OFF)};
        pg8::gemm_phase<EpiInproj, RowOrder, true, true>(F.lds + RING_OFF, g, S, E); }
    else { EpiF32 E{(float*)(F.ws + WS_P), INC};
        pg8::gemm_phase<EpiF32, RowOrder, true, true>(F.lds + RING_OFF, g, S, E); }
}
__device__ __forceinline__ void fast_br(Frame& F, int l) {
    const bool lat = (l == DEPTH - 1);
    if constexpr (FUSE_GATE && GATE_MIDK) {
        pg8::Gemm g{(const bf16*)(F.ws + WS_YAB), (const bf16*)(F.ws + WS_WBR) + (size_t)l * D * D, M, D, D, D, D};
        RowOrder S; S.init(lat, D, F.G, (int)blockIdx.x); EpiGateK E{(const bf16*)(F.ws + WS_GA), (const bf16*)(F.ws + WS_GB), (bf16*)(F.ws + WS_MB)};
        pg8::gemm_phase<EpiGateK, RowOrder, true, true>(F.lds + RING_OFF, g, S, E);
    } else if constexpr (FUSE_GATE) {
        { pg8::Gemm g{(const bf16*)(F.ws + WS_YAB), (const bf16*)(F.ws + WS_WBR) + (size_t)l * D * D, M, D, QW, D, D};
          RowOrder S; S.init(lat, D, F.G, (int)blockIdx.x); EpiGate<1> E{(const bf16*)(F.ws + WS_GA), (bf16*)(F.ws + WS_MB)};
          pg8::gemm_phase<EpiGate<1>, RowOrder, true, true>(F.lds + RING_OFF, g, S, E); }
        { pg8::Gemm g{(const bf16*)(F.ws + WS_YAB) + QW, (const bf16*)(F.ws + WS_WBR) + (size_t)l * D * D + QW, M, D, QW, D, D};
          RowOrder S; S.init(lat, D, F.G, (int)blockIdx.x); EpiGate<2> E{(const bf16*)(F.ws + WS_GB), (bf16*)(F.ws + WS_MB)};
          pg8::gemm_phase<EpiGate<2>, RowOrder, true, true>(F.lds + RING_OFF, g, S, E); }
    } else {
        { pg8::Gemm g{(const bf16*)(F.ws + WS_YAB), (const bf16*)(F.ws + WS_WBR) + (size_t)l * D * D, M, D, QW, D, D};
          RowOrder S; S.init(lat, D, F.G, (int)blockIdx.x); EpiF32 E{(float*)(F.ws + WS_T1), D};
          pg8::gemm_phase<EpiF32, RowOrder, true, true>(F.lds + RING_OFF, g, S, E); }
        { pg8::Gemm g{(const bf16*)(F.ws + WS_YAB) + QW, (const bf16*)(F.ws + WS_WBR) + (size_t)l * D * D + QW, M, D, QW, D, D};
          RowOrder S; S.init(lat, D, F.G, (int)blockIdx.x); EpiF32 E{(float*)(F.ws + WS_T2), D};
          pg8::gemm_phase<EpiF32, RowOrder, true, true>(F.lds + RING_OFF, g, S, E); }
    }
}
template <bool DRY>
__device__ __forceinline__ void fast_out(Frame& F, int l) {
    const bool lat = (l == DEPTH - 1);
    pg8::Gemm g{(const bf16*)(F.ws + WS_MB), (const bf16*)(F.ws + WS_WOUT) + (size_t)l * D * D, M, D, D, D, D};
    RowOrder S; S.init(lat, D, F.G, (int)blockIdx.x);
    if constexpr (FUSE_RES && !DRY) { EpiRes E{(float*)(F.ws + WS_XW), (const float*)(F.ws + WS_MOD) + (size_t)l * 5 * MODW + 2 * D};
        pg8::gemm_phase<EpiRes, RowOrder, true, true>(F.lds + RING_OFF, g, S, E); }
    else { EpiF32 E{(float*)(F.ws + WS_T3), D};
        pg8::gemm_phase<EpiF32, RowOrder, true, true>(F.lds + RING_OFF, g, S, E); }
}
constexpr int PH_P0 = 0, PH_P0B = 1, PH_L0 = 2, PH_PER_LAYER = 11, PH_FINAL = PH_L0 + PH_PER_LAYER * DEPTH, NPH = PH_FINAL + 1;
enum { L_NORM1 = 0, L_INPROJ = 1, L_POST = 2, L_ATTN = 3, L_BR = 4, L_GATE = 5, L_OUT = 6, L_NORM2R = 7, L_COMPACT = 8, L_UP = 9, L_DOWN = 10 };
struct Args { const float* in[NIN]; float* out; unsigned char* ws; int ph_lo, ph_hi, li, pad; };

__global__ void __launch_bounds__(NWAVES * 64, 2) mk_fwd(Args args) {
    extern __shared__ __attribute__((aligned(16))) unsigned char lds[];
    Frame F;
    F.lds = (LAS unsigned char*)lds;
    F.MISC = (volatile LAS unsigned*)(F.lds + MISC_OFF);
    F.tid = threadIdx.x; F.lane = F.tid & 63; F.wave = __builtin_amdgcn_readfirstlane(F.tid >> 6);
    F.G = gridDim.x; { const int bx = blockIdx.x; F.vcu = (F.G % 8 == 0) ? (bx % 8) * (F.G / 8) + bx / 8 : bx; }
    F.ws = args.ws; F.out = args.out; F.ctl = (gu32*)(args.ws + WS_CTL);
    for (int u = F.tid; u < (LDS_BYTES - LDSCTL_OFF) / 4; u += NWAVES * 64) ((LAS unsigned*)(F.lds + LDSCTL_OFF))[u] = 0u;
    __syncthreads();
    if (F.tid < NIN) ((LAS cfptr*)(F.lds + LDSCTL_OFF + 256))[F.tid] = args.in[F.tid];
    __syncthreads();
    XcdBarrier bar = xcd_barrier_post((unsigned*)(F.ctl + CW_BAR) + args.li * XCD_BAR_WORDS, F.MISC + 8);
    const int lo = args.ph_lo, hi = args.ph_hi;
    const int nrep2 = 2 + args.pad;
#define IN(k) (lo <= (k) && (k) < hi)
#if TPROBE >= 0
#define TSTAMP(k) do { if (blockIdx.x == TPROBE_BLK && F.tid == 0) ((volatile LAS unsigned long long*)(F.lds + LDSCTL_OFF + 800))[(k) + 1] = __builtin_amdgcn_s_memrealtime(); } while (0)
#else
#define TSTAMP(k) do { } while (0)
#endif
#if TPROBE >= 300
#define TSTAMPX(slot, l_) do { if (F.tid == 0 && (l_) == 1) { const unsigned long long tn_ = __builtin_amdgcn_s_memrealtime(); if (blockIdx.x == TPROBE_BLK) ((volatile LAS unsigned long long*)(F.lds + LDSCTL_OFF + 800))[slot] = tn_; atomicMax((unsigned*)F.ctl + 200000 + 512, ((unsigned)tn_ << 8) | (unsigned)blockIdx.x); } } while (0)
#else
#define TSTAMPX(slot, l_) do { } while (0)
#endif
#define SEAM(k) do { if (IN(k) && IN((k) + 1)) { xcd_barrier(bar); if (REPMASK & (1 << 12)) xcd_barrier(bar); } TSTAMP(k); } while (0)
    TSTAMP(-1);

    if (IN(PH_P0)) { p0_prologue(F); if (REPMASK & (1 << 10)) { __syncthreads(); p0_prologue(F); } }
    SEAM(PH_P0);
    if (IN(PH_P0B)) p0b_reduce(F);
    SEAM(PH_P0B);
#define LAYER_PROGRAM(l) do { constexpr int pb = PH_L0 + PH_PER_LAYER * (l); \
        if (IN(pb + L_NORM1)) { ph_norm1<false>(F, (l)); if (REPMASK & (1 << L_NORM1)) ph_norm1<true>(F, (l)); } \
        SEAM(pb + L_NORM1); \
        if (IN(pb + L_INPROJ)) { if constexpr (FAST_INPROJ) { fast_inproj(F, (l)); if (REPMASK & (1 << L_INPROJ)) fast_inproj(F, (l)); } } \
        SEAM(pb + L_INPROJ); \
        if (IN(pb + L_POST)) { if constexpr (!FUSE_POST) { ph_post(F, (l)); if (REPMASK & (1 << L_POST)) ph_post(F, (l)); } } \
        if constexpr (!FUSE_POST) SEAM(pb + L_POST); \
        if (IN(pb + L_ATTN)) { if constexpr (FAST_ATTN) { _Pragma("nounroll") for (int rep_ = 0; rep_ < ((REPMASK & (1 << L_ATTN)) ? nrep2 : 1); ++rep_) fast_attn(F, (l)); } } \
        SEAM(pb + L_ATTN); \
        if (IN(pb + L_BR)) { if constexpr (FAST_BR) { _Pragma("nounroll") for (int rep_ = 0; rep_ < ((REPMASK & (1 << L_BR)) ? nrep2 : 1); ++rep_) fast_br(F, (l)); } } \
        SEAM(pb + L_BR); \
        if (IN(pb + L_GATE)) { if constexpr (!FUSE_GATE) ph_gate(F, (l)); } \
        if constexpr (!FUSE_GATE) SEAM(pb + L_GATE); \
        if (IN(pb + L_OUT)) { if constexpr (FAST_OUT) { if (REPMASK & (1 << L_OUT)) fast_out<true>(F, (l)); fast_out<false>(F, (l)); TSTAMPX(27, (l)); } } \
        SEAM(pb + L_OUT); \
        if (IN(pb + L_NORM2R)) { if (REPMASK & (1 << L_NORM2R)) ph_norm2_router<!FUSE_RES, true>(F, (l)); ph_norm2_router<!FUSE_RES, false>(F, (l)); } \
        SEAM(pb + L_NORM2R); \
        if (IN(pb + L_COMPACT)) ph_compact(F, (l)); \
        SEAM(pb + L_COMPACT); \
        if (IN(pb + L_UP)) { if constexpr (FAST_UP) { fast_moe_up(F, (l)); } } \
        SEAM(pb + L_UP); \
        if (IN(pb + L_DOWN)) { if constexpr (FAST_DOWN) { fast_moe_down(F, (l)); } } \
        SEAM(pb + L_DOWN); } while (0)
    LAYER_PROGRAM(0);
    LAYER_PROGRAM(1);
#undef LAYER_PROGRAM
    if (IN(PH_FINAL)) { ph_final(F); if (REPMASK & (1 << 11)) ph_final(F); }
#if TPROBE >= 0
    if (blockIdx.x == TPROBE_BLK && F.tid == 0) { volatile LAS unsigned long long* ts = (volatile LAS unsigned long long*)(F.lds + LDSCTL_OFF + 800);
        const unsigned long long dt = (TPROBE == 302) ? (unsigned long long)(((const unsigned*)F.ctl)[200000 + 512] & 255u) * 100ull : (TPROBE == 303) ? (unsigned long long)((((const unsigned*)F.ctl)[200000 + 512] >> 8) - (((unsigned)ts[18]) & 0xffffffu)) & 0xffffffull : (TPROBE == 300) ? ts[27] - ts[18] : (TPROBE == 301) ? ts[20] - ts[27] : (TPROBE >= 200) ? (unsigned long long)(((const unsigned*)F.ctl)[200000 + 64 * (TPROBE - 200)] - (unsigned)ts[0]) : (TPROBE >= 100) ? ts[26] : ts[(TPROBE_HI < 0 ? 0 : TPROBE_HI) + 1] - ts[TPROBE >= 100 ? 0 : TPROBE], t0 = __builtin_amdgcn_s_memrealtime();
        while (__builtin_amdgcn_s_memrealtime() - t0 < 4ull * dt) __builtin_amdgcn_s_sleep(8); }
#endif
#if CNTPROBE
    xcd_barrier(bar);
    if (blockIdx.x == 0) {
        const unsigned* cnt = (const unsigned*)F.ctl + CW_CNT + (CNTPROBE_L) * 64; unsigned mx = 0, mn = 1u << 30, big = 0, big2 = 0;
        for (int e = 0; e < NE; ++e) { const unsigned c = cnt[e]; mx = c > mx ? c : mx; mn = c < mn ? c : mn; big += c > 384 ? 1 : 0; big2 += c > 512 ? 1 : 0; }
        const float val = CNTPROBE == 1 ? (float)mx : CNTPROBE == 2 ? (float)big : CNTPROBE == 3 ? (float)mn : (float)big2;
        const float c1 = sqrtf(val);
        for (size_t i = F.tid; i < (size_t)NB * SEQ * D; i += NWAVES * 64) F.out[i] = c1;
    }
#endif
#undef IN
#undef SEAM
}

static bool phase_is_naive(int ph) {
    if (ph < PH_L0 || ph == PH_FINAL) return false;
    const int k = (ph - PH_L0) % PH_PER_LAYER;
    switch (k) { case L_INPROJ: return !FAST_INPROJ; case L_ATTN: return !FAST_ATTN; case L_BR: return !FAST_BR; case L_OUT: return !FAST_OUT; case L_UP: return !FAST_UP; case L_DOWN: return !FAST_DOWN; default: return false; }
}
extern "C" void kernel_launch(void* const* d_in, const int* in_sizes, int n_in, void* d_out, int out_size, void* d_ws, size_t ws_size, hipStream_t stream) {
    static int grid = 0;
    if (grid == 0) {
        if (n_in != NIN || in_sizes[0] != NB * SEQ * D || out_size != NB * SEQ * D || ws_size < WS_END) { fprintf(stderr, "kernel_launch: shape/workspace mismatch (n_in %d, ws %zu)\n", n_in, ws_size); grid = -1; return; }
        int dev = 0, cus = 0, per_cu = 0;
        if (hipGetDevice(&dev) != hipSuccess || hipDeviceGetAttribute(&cus, hipDeviceAttributeMultiprocessorCount, dev) != hipSuccess) { grid = -1; return; }
        if (hipFuncSetAttribute((const void*)mk_fwd, hipFuncAttributeMaxDynamicSharedMemorySize, LDS_BYTES) != hipSuccess) { fprintf(stderr, "kernel_launch: hipFuncSetAttribute failed\n"); grid = -1; return; }
        if (hipOccupancyMaxActiveBlocksPerMultiprocessor(&per_cu, (const void*)mk_fwd, NWAVES * 64, LDS_BYTES) != hipSuccess || per_cu < 1) fprintf(stderr, "kernel_launch: occupancy query reports %d\n", per_cu);
        (void)hipGetLastError();
        grid = cus;
    }
    if (grid < 0) return;
    unsigned char* ws = (unsigned char*)d_ws;
    (void)hipMemsetAsync(ws + WS_CTL, 0, CTL_ZERO_BYTES, stream);
    Args a{};
    for (int i = 0; i < NIN; ++i) a.in[i] = (const float*)d_in[i];
    a.out = (float*)d_out; a.ws = ws;
    const float* const* in = (const float* const*)d_in;
    int li = 0, lo = -1;
    for (int ph = 0; ph < NPH; ++ph) {
        const bool nv = phase_is_naive(ph);
        if (!nv && lo < 0) lo = ph;
        if (nv || ph == NPH - 1) {
            if (lo >= 0) { a.ph_lo = lo; a.ph_hi = nv ? ph : ph + 1; a.li = li++; hipLaunchKernelGGL(mk_fwd, dim3(grid), dim3(NWAVES * 64), LDS_BYTES, stream, a); lo = -1; }
            if (nv) {
                const int l = (ph - PH_L0) / PH_PER_LAYER, k = (ph - PH_L0) % PH_PER_LAYER;
                const unsigned* cnt = (const unsigned*)ws + CW_CNT + l * 64;
                if (k == L_INPROJ) hipLaunchKernelGGL(naive_gemm<1>, dim3(INC / 64, M / 32), dim3(64, 4), 0, stream, (const bf16*)(ws + WS_HA), D, in[IN_WIN] + (size_t)l * D * INC, INC, (float*)(ws + WS_P), INC, D);
                else if (k == L_ATTN) { const int wq = (l < DEPTH - 1) ? 1 : 0; const long items = (long)NB * NH * (wq ? TT : SEQ);
                    hipLaunchKernelGGL(naive_attn, dim3((unsigned)((items + 3) / 4)), dim3(256), 0, stream, (const bf16*)(ws + WS_QA), (const bf16*)(ws + WS_KA), (const bf16*)(ws + WS_VA), (bf16*)(ws + WS_YAB), (const float*)nullptr, 0, wq);
                    hipLaunchKernelGGL(naive_attn, dim3((unsigned)((items + 3) / 4)), dim3(256), 0, stream, (const bf16*)(ws + WS_QB), (const bf16*)(ws + WS_KB), (const bf16*)(ws + WS_VB), (bf16*)(ws + WS_YAB) + QW, in[IN_SINK] + l * NH, 1, wq); }
                else if (k == L_BR) { hipLaunchKernelGGL(naive_gemm<0>, dim3(D / 64, M / 32), dim3(64, 4), 0, stream, (const bf16*)(ws + WS_YAB), D, in[IN_WBRA] + (size_t)l * QW * D, D, (float*)(ws + WS_T1), D, QW);
                    hipLaunchKernelGGL(naive_gemm<0>, dim3(D / 64, M / 32), dim3(64, 4), 0, stream, (const bf16*)(ws + WS_YAB) + QW, D, in[IN_WBRB] + (size_t)l * QW * D, D, (float*)(ws + WS_T2), D, QW); }
                else if (k == L_OUT) hipLaunchKernelGGL(naive_gemm<0>, dim3(D / 64, M / 32), dim3(64, 4), 0, stream, (const bf16*)(ws + WS_MB), D, in[IN_WOUT] + (size_t)l * D * D, D, (float*)(ws + WS_T3), D, D);
                else if (k == L_UP) hipLaunchKernelGGL(naive_moe_up, dim3(DE / 64, 2 * M / 4), dim3(64, 4), 0, stream, (const bf16*)(ws + WS_HA), in[IN_W1] + (size_t)l * NE * D * DE, in[IN_W3] + (size_t)l * NE * D * DE, cnt, (const unsigned*)(ws + WS_LIST) + (size_t)l * NE * M, (bf16*)(ws + WS_HB));
                else if (k == L_DOWN) hipLaunchKernelGGL(naive_moe_down, dim3(D / 64, 2 * M / 4), dim3(64, 4), 0, stream, (const bf16*)(ws + WS_HB), in[IN_W2] + (size_t)l * NE * DE * D, cnt, (bf16*)(ws + WS_YM));
            }
        }
    }
    const hipError_t le = hipPeekAtLastError();
    if (le != hipSuccess) fprintf(stderr, "kernel_launch: launch failed: %s\n", hipGetErrorName(le));
}
```

```cpp
#include <hip/hip_runtime.h>
#include <cstdio>
#include <cstdint>

constexpr int D = 2048, NB = 4, SEQ = 2048, CTX = 256, TT = CTX + SEQ, M = NB * TT, DEPTH = 2;
constexpr int HD = 128, NH = 8, NKV = 2, GRIDW = 64;
constexpr int QW = NH * HD, KW = NKV * HD;
constexpr int INC = 2 * QW + 4 * KW + 2 * D;
constexpr int OFF_QA = 0, OFF_KA = 1024, OFF_VA = 1280, OFF_QB = 1536, OFF_KB = 2560, OFF_VB = 2816, OFF_GA = 3072, OFF_GB = 5120;
constexpr int NE = 64, NG = 8, EPG = 8, DE = 512;
constexpr float EPS = 1e-6f;
constexpr float ATTN_SCALE = 0.08838834764831845f;
constexpr int MODW = 6 * D;
constexpr int NIN = 23;

__host__ __device__ __forceinline__ int perm_d2j(int d) { return 32 * (2 * (d >> 6) + ((d >> 4) & 1)) + 16 * ((d >> 5) & 1) + (d & 15); }
__host__ __device__ __forceinline__ int perm_j2d(int j) { const int wc = j >> 5, n = (j >> 4) & 1, t = j & 15; return 64 * (wc >> 1) + 32 * n + 16 * (wc & 1) + t; }
__host__ __device__ __forceinline__ bool inproj_roped(int c) { return (c < OFF_VA) || (c >= OFF_QB && c < OFF_VB); }
__host__ __device__ __forceinline__ int inproj_src_col(int c) { return inproj_roped(c) ? (c & ~127) + perm_j2d(c & 127) : c; }
__host__ __device__ __forceinline__ int inproj_dst_col(int n) { return inproj_roped(n) ? (n & ~127) + perm_d2j(n & 127) : n; }

constexpr size_t MiB = 1u << 20;
constexpr size_t WS_CTL = 0, CTL_ZERO_BYTES = 1 * MiB;
constexpr size_t WS_MOD = 1 * MiB;
constexpr size_t WS_ROPE = 1 * MiB + 512 * 1024;
constexpr size_t WS_TOK = 2 * MiB;
constexpr size_t WS_LIST = 3 * MiB;
constexpr size_t WS_WIN = 8 * MiB;
constexpr size_t WS_WBR = 64 * MiB;
constexpr size_t WS_WOUT = 80 * MiB;
constexpr size_t WS_XW = 96 * MiB;
constexpr size_t WS_HA = 168 * MiB;
constexpr size_t WS_QA = 204 * MiB, WS_KA = 222 * MiB, WS_VA = 227 * MiB, WS_QB = 232 * MiB, WS_KB = 250 * MiB, WS_VB = 255 * MiB;
constexpr size_t WS_GA = 260 * MiB, WS_GB = 296 * MiB;
constexpr size_t WS_YAB = 332 * MiB;
constexpr size_t WS_MB = 368 * MiB;
constexpr size_t WS_HB = 404 * MiB;
constexpr size_t WS_YM = 424 * MiB;
constexpr size_t WS_P = 496 * MiB;
constexpr size_t WS_MODP = 964 * MiB;
constexpr size_t WS_WR = 740 * MiB;
constexpr size_t WS_T1 = 748 * MiB, WS_T2 = 820 * MiB, WS_T3 = 892 * MiB;
constexpr size_t WS_END = 996 * MiB;
constexpr int CW_TMO = 0, CW_CODE = 1;
constexpr int CW_BAR = 4096;
constexpr int CW_CNT = 131072;
constexpr int MAX_LAUNCH = 32;

constexpr int RING_OFF = 0, RING_BYTES = 131072;
constexpr int XS_OFF = 131072, XS_BYTES = 16384;
constexpr int LDSCTL_OFF = 162816, MISC_OFF = LDSCTL_OFF;
constexpr int LDS_BYTES = 163840;
constexpr int NWAVES = 8;
constexpr bool FAST_INPROJ = true, FAST_ATTN = true, FAST_BR = true, FAST_OUT = true, FAST_UP = true, FAST_DOWN = true;
constexpr bool FUSE_POST = true, FUSE_GATE = true, FUSE_RES = true, GATE_MIDK = true;
#ifndef REPMASK
#define REPMASK 0
#endif
#ifndef CNTPROBE
#define CNTPROBE 0
#define CNTPROBE_L 0
#endif
#ifndef MOEVAR
#define MOEVAR 0
#endif
#ifndef TPROBE
#define TPROBE -1
#define TPROBE_HI -1
#endif
#ifndef TPROBE_BLK
#define TPROBE_BLK 0
#endif
namespace pg8 {
#define PG8_LAS __attribute__((address_space(3)))
typedef unsigned short bf16_t;
typedef short bf16x8 __attribute__((ext_vector_type(8)));
typedef float f32x4 __attribute__((ext_vector_type(4)));
typedef unsigned u32x4 __attribute__((ext_vector_type(4)));
constexpr int BM = 256, BK = 64, HALF = 128, HTB = HALF * BK * 2  , STAGE_BYTES = 8 * HTB, NXCD = 8, WGM = 8;

__host__ __device__ __forceinline__ int lds_byte(int r, int c) { const int st = (r >> 4) * 2 + (c >> 5), rr = r & 15, cc = c & 31, ob = rr * 64 + cc * 2; return st * 1024 + (ob ^ (((ob >> 9) & 1) << 5)); }
__host__ __device__ __forceinline__ void stage_rc(int b, int& R, int& C) { const int st = b / 1024, sb = b % 1024, swz = sb ^ (((sb >> 9) & 1) << 5); R = (st >> 1) * 16 + swz / 64; C = (st & 1) * 32 + (swz % 64) / 2; }
__host__ __device__ __forceinline__ int perm32(int rho) { const int n = rho >> 4, i = rho & 15; return 8 * (i >> 2) + 4 * n + (i & 3); }

struct Unit { int pm, pn; };
struct Gemm { const bf16_t* A; const bf16_t* Bt; int M, N, K, lda, ldb; };

struct StaticOrder {
    int nM, nN, nwg, G, c;
    __host__ __device__ void init(int M, int N, int G_, int c_) { nM = M / BM; nN = N / BM; nwg = nM * nN; G = G_; c = c_; }
    __host__ __device__ bool next(int i, Unit& u) const {
        const long L = (long)i * G + c; if (L >= nwg) return false;
        int wgid = (int)L; { const int q = nwg / NXCD, r = nwg % NXCD, xcd = wgid % NXCD, off = wgid / NXCD; wgid = (xcd < r ? xcd * (q + 1) : r * (q + 1) + (xcd - r) * q) + off; }
        const int nig = WGM * nN, gid = wgid / nig, fm = gid * WGM, gsz = (nM - fm) < WGM ? (nM - fm) : WGM;
        u.pm = fm + ((wgid % nig) % gsz); u.pn = (wgid % nig) / gsz; return true;
    }
    __device__ __forceinline__ void a_ready(const Unit&) const {}
    __device__ __forceinline__ void done(const Unit&) const {}
};

__device__ __forceinline__ unsigned cvt_pk_bf16(float lo, float hi) { unsigned r; asm volatile("v_cvt_pk_bf16_f32 %0, %1, %2" : "=v"(r) : "v"(lo), "v"(hi)); return r; }
typedef float f32x2 __attribute__((ext_vector_type(2)));
__device__ __forceinline__ f32x2 gelu_pk(f32x2 v) {
    const f32x2 av = __builtin_elementwise_abs(v), d = av * 0.2316418882f + 1.0f;
    f32x2 t; t.x = __builtin_amdgcn_rcpf(d.x); t.y = __builtin_amdgcn_rcpf(d.y);
    f32x2 q = t * 0.5307027145f + (-0.7265760135f); q = q * t + 0.7107068705f; q = q * t + (-0.142248368f); q = q * t + 0.127414796f; q = q * t;
    const f32x2 s = (v * v) * (-0.72134752044f);
    f32x2 e; e.x = __builtin_amdgcn_exp2f(s.x); e.y = __builtin_amdgcn_exp2f(s.y);
    const f32x2 m = v * (q * e), r = v - m;
    f32x2 o; o.x = v.x < 0.f ? m.x : r.x; o.y = v.y < 0.f ? m.y : r.y; return o;
}

template <int ACT  > struct EpiBf16 {
    static constexpr int MIDK = 0; static constexpr bool PERM = true, AFTER_DRAIN = false; static_assert(ACT == 0 || ACT == 1, "EpiBf16: ACT is 0 (none) or 1 (gelu_pk)");
    bf16_t* O; int ldc; const float* bias; int split_cols; size_t split_stride; float scale0;
    __device__ __forceinline__ void operator()(const f32x4 (&acc)[2][2][4][2], const Unit& u, int wr, int wc, int fr, int fq) const {
        const int row0 = u.pm * BM + wr * 64 + fr; int colt = u.pn * BM; bf16_t* base = O;
        float sc = 1.f; if (split_cols) { const int t = colt / split_cols; base += (size_t)t * split_stride; colt -= t * split_cols; if (t == 0) sc = scale0; }
        const int col0 = colt + wc * 32 + 8 * fq, bcol0 = u.pn * BM + wc * 32 + 8 * fq;
        f32x4 bv[2][2];
#pragma unroll
        for (int bj = 0; bj < 2; ++bj)
#pragma unroll
            for (int n = 0; n < 2; ++n) bv[bj][n] = bias ? *(const f32x4*)(bias + bcol0 + bj * HALF + 4 * n) : (f32x4){0.f, 0.f, 0.f, 0.f};
#pragma unroll
        for (int ai = 0; ai < 2; ++ai)
#pragma unroll
            for (int m = 0; m < 4; ++m) { bf16_t* rowp = base + (size_t)(row0 + ai * HALF + m * 16) * ldc + col0;
#pragma unroll
                for (int bj = 0; bj < 2; ++bj) { f32x4 v0 = acc[ai][bj][m][0] + bv[bj][0], v1 = acc[ai][bj][m][1] + bv[bj][1];
                    if (ACT == 1) { f32x2 a = gelu_pk((f32x2){v0[0], v0[1]}), b = gelu_pk((f32x2){v0[2], v0[3]}), c = gelu_pk((f32x2){v1[0], v1[1]}), d = gelu_pk((f32x2){v1[2], v1[3]});
                        v0 = (f32x4){a.x, a.y, b.x, b.y}; v1 = (f32x4){c.x, c.y, d.x, d.y}; }
                    v0 = v0 * sc; v1 = v1 * sc; u32x4 w; w.x = cvt_pk_bf16(v0[0], v0[1]); w.y = cvt_pk_bf16(v0[2], v0[3]); w.z = cvt_pk_bf16(v1[0], v1[1]); w.w = cvt_pk_bf16(v1[2], v1[3]);
                    *(u32x4*)(rowp + bj * HALF) = w; } }
    }
};

struct PanelStats {
    unsigned* xbuf;
    unsigned* cnt;
    unsigned* tmo;
    int ntn; float eps;
    unsigned code;
    __device__ __forceinline__ bool run(const f32x4 (&v)[2][2][4][2], const Unit& u, int wr, int wc, int fr, int fq, PG8_LAS unsigned char* lds, int wid, int lane) const {
        typedef float f32x2v __attribute__((ext_vector_type(2)));
        PG8_LAS f32x2v* P = (PG8_LAS f32x2v*)lds;
        PG8_LAS f32x2v* S = (PG8_LAS f32x2v*)(lds + 8192);
        PG8_LAS unsigned* flag = (PG8_LAS unsigned*)(lds + 8192 + 2048);
#pragma unroll
        for (int ai = 0; ai < 2; ++ai)
#pragma unroll
            for (int m = 0; m < 4; ++m) {
                float s = 0.f;
#pragma unroll
                for (int bj = 0; bj < 2; ++bj)
#pragma unroll
                    for (int n = 0; n < 2; ++n) { const f32x4 x = v[ai][bj][m][n]; s += (x[0] + x[1]) + (x[2] + x[3]); }
                s += __shfl_xor(s, 16); s += __shfl_xor(s, 32);
                const float mw = s * (1.0f / 64.0f); float q = 0.f;
#pragma unroll
                for (int bj = 0; bj < 2; ++bj)
#pragma unroll
                    for (int n = 0; n < 2; ++n) { const f32x4 d = v[ai][bj][m][n] - mw; q += (d[0] * d[0] + d[1] * d[1]) + (d[2] * d[2] + d[3] * d[3]); }
                q += __shfl_xor(q, 16); q += __shfl_xor(q, 32);
                if (fq == 0) P[(ai * HALF + wr * 64 + m * 16 + fr) * 4 + wc] = (f32x2v){mw, q};
            }
        asm volatile("s_waitcnt lgkmcnt(0)" ::: "memory"); __builtin_amdgcn_s_barrier(); asm volatile("" ::: "memory");
#if defined(BROKEN_EXCHANGE_NO_WAIT)
#warning BROKEN CONTROL BUILD: the row-statistics exchange does not wait; results are wrong by design
        if (blockIdx.x >= 64) { const long long t0_ = clock64(); while (clock64() - t0_ < 60000) __builtin_amdgcn_s_sleep(8); }
#endif
        const int row = wid * 32 + (lane & 31);
        if (lane < 32) {
            const f32x2v a = P[row * 4 + 0], b = P[row * 4 + 1], c = P[row * 4 + 2], d = P[row * 4 + 3];
            const float mt = (a.x + b.x + c.x + d.x) * 0.25f;
            const float da = a.x - mt, db = b.x - mt, dc = c.x - mt, dd = d.x - mt;
            const float m2 = (a.y + b.y) + (c.y + d.y) + 64.0f * ((da * da + db * db) + (dc * dc + dd * dd));
            unsigned long long* slot = (unsigned long long*)xbuf + ((size_t)(u.pm * BM + row) * 4 + u.pn);
            __hip_atomic_store(slot, ((unsigned long long)__float_as_uint(m2) << 32) | __float_as_uint(mt), __ATOMIC_RELAXED, __HIP_MEMORY_SCOPE_AGENT);
        }
        asm volatile("s_waitcnt vmcnt(0)" ::: "memory");
        if (lane == 0) __hip_atomic_fetch_add(cnt + 64 * u.pm, 1u, __ATOMIC_RELAXED, __HIP_MEMORY_SCOPE_AGENT);
        if (wid == 0) {
            bool dead = false; const unsigned long long t0 = __builtin_amdgcn_s_memrealtime(); const unsigned want = 8u * (unsigned)ntn;
            for (;;) {
#if defined(BROKEN_EXCHANGE_NO_WAIT)
                break;
#endif
                if ((unsigned)__builtin_amdgcn_readfirstlane(__hip_atomic_load(cnt + 64 * u.pm, __ATOMIC_RELAXED, __HIP_MEMORY_SCOPE_AGENT)) >= want) break;
                if (__builtin_amdgcn_s_memrealtime() - t0 > 2000000ull) {
                    if (lane == 0) { unsigned expect = 0u; __hip_atomic_compare_exchange_strong(tmo + 1, &expect, code | (unsigned)(u.pm & 0xff), __ATOMIC_RELAXED, __ATOMIC_RELAXED, __HIP_MEMORY_SCOPE_AGENT);
                                     __hip_atomic_store(tmo, 1u, __ATOMIC_RELAXED, __HIP_MEMORY_SCOPE_AGENT); }
                    dead = true; break; }
                __builtin_amdgcn_s_sleep(2);
            }
            __builtin_amdgcn_fence(__ATOMIC_ACQUIRE, "agent");
            if (lane == 0) flag[0] = dead ? 1u : 0u;
        }
        asm volatile("s_waitcnt vmcnt(0) lgkmcnt(0)" ::: "memory"); __builtin_amdgcn_s_barrier(); asm volatile("" ::: "memory");
        const bool bad = flag[0] != 0u;
        if (lane < 32) {
            const unsigned long long* slot = (const unsigned long long*)xbuf + (size_t)(u.pm * BM + row) * 4; float mt[4], m2[4]; float ms = 0.f;
#pragma unroll
            for (int t = 0; t < 4; ++t) { if (t < ntn) { const unsigned long long w = __hip_atomic_load(slot + t, __ATOMIC_RELAXED, __HIP_MEMORY_SCOPE_AGENT); mt[t] = __uint_as_float((unsigned)w); m2[t] = __uint_as_float((unsigned)(w >> 32)); } else { mt[t] = 0.f; m2[t] = 0.f; } ms += mt[t]; }
            const float mean = ms / (float)ntn; float q = 0.f;
#pragma unroll
            for (int t = 0; t < 4; ++t) if (t < ntn) { const float dm = mt[t] - mean; q += m2[t] + 256.0f * dm * dm; }
            S[row] = (f32x2v){mean, 1.0f / sqrtf(q / (256.0f * (float)ntn) + eps)};
        }
        asm volatile("s_waitcnt lgkmcnt(0)" ::: "memory"); __builtin_amdgcn_s_barrier(); asm volatile("" ::: "memory");
        return bad;
    }
};
struct EpiLnRes {
    static constexpr int MIDK = 0; static constexpr bool PERM = false, AFTER_DRAIN = true;
    const float* base; float* out; int ldc; const float* bias; PanelStats st; unsigned poison;
    __device__ __forceinline__ void fused(f32x4 (&acc)[2][2][4][2], const Unit& u, int wr, int wc, int fr, int fq, PG8_LAS unsigned char* lds, int wid, int lane) const {
        typedef float f32x2v __attribute__((ext_vector_type(2)));
        const PG8_LAS f32x2v* S = (const PG8_LAS f32x2v*)(lds + 8192);
        const int col0 = u.pn * BM + wc * 32 + 4 * fq;
#pragma unroll
        for (int bj = 0; bj < 2; ++bj)
#pragma unroll
            for (int n = 0; n < 2; ++n) { const f32x4 bv = bias ? *(const f32x4*)(bias + col0 + bj * HALF + n * 16) : (f32x4){0.f, 0.f, 0.f, 0.f};
#pragma unroll
                for (int ai = 0; ai < 2; ++ai)
#pragma unroll
                    for (int m = 0; m < 4; ++m) acc[ai][bj][m][n] += bv; }
        f32x4 pre[4][2][2];
#pragma unroll
        for (int m = 0; m < 4; ++m) { const size_t off = (size_t)(u.pm * BM + wr * 64 + m * 16 + fr) * ldc + col0;
#pragma unroll
            for (int bj = 0; bj < 2; ++bj)
#pragma unroll
                for (int n = 0; n < 2; ++n) pre[m][bj][n] = *(const f32x4*)(base + off + bj * HALF + n * 16); }
        const bool bad = st.run(acc, u, wr, wc, fr, fq, lds, wid, lane) || poison != 0u;
        const float qnan = __builtin_nanf("");
#pragma unroll
        for (int ai = 0; ai < 2; ++ai)
#pragma unroll
            for (int m = 0; m < 4; ++m) { const int r = ai * HALF + wr * 64 + m * 16 + fr; const f32x2v sr = S[r]; const size_t off = (size_t)(u.pm * BM + r) * ldc + col0;
#pragma unroll
                for (int bj = 0; bj < 2; ++bj)
#pragma unroll
                    for (int n = 0; n < 2; ++n) { const f32x4 bs = ai == 0 ? pre[m][bj][n] : *(const f32x4*)(base + off + bj * HALF + n * 16); f32x4 o = bs + (acc[ai][bj][m][n] - sr.x) * sr.y;
                        if (bad) o = (f32x4){qnan, qnan, qnan, qnan}; *(f32x4*)(out + off + bj * HALF + n * 16) = o; }
                if (m & 1) asm volatile("" ::: "memory"); }
    }
};
struct EpiLnResLn {
    static constexpr int MIDK = 0; static constexpr bool PERM = false, AFTER_DRAIN = true;
    const float* base; float* out; bf16_t* xn; int ldc; const float* bias; PanelStats st1, st2; unsigned poison;
    __device__ __forceinline__ void fused(f32x4 (&acc)[2][2][4][2], const Unit& u, int wr, int wc, int fr, int fq, PG8_LAS unsigned char* lds, int wid, int lane) const {
        typedef float f32x2v __attribute__((ext_vector_type(2))); typedef unsigned u32x2v __attribute__((ext_vector_type(2)));
        const PG8_LAS f32x2v* S = (const PG8_LAS f32x2v*)(lds + 8192);
        const int col0 = u.pn * BM + wc * 32 + 4 * fq;
#pragma unroll
        for (int bj = 0; bj < 2; ++bj)
#pragma unroll
            for (int n = 0; n < 2; ++n) { const f32x4 bv = bias ? *(const f32x4*)(bias + col0 + bj * HALF + n * 16) : (f32x4){0.f, 0.f, 0.f, 0.f};
#pragma unroll
                for (int ai = 0; ai < 2; ++ai)
#pragma unroll
                    for (int m = 0; m < 4; ++m) acc[ai][bj][m][n] += bv; }
        bool bad = st1.run(acc, u, wr, wc, fr, fq, lds, wid, lane) || poison != 0u;
        const float qnan = __builtin_nanf("");
#pragma unroll
        for (int ai = 0; ai < 2; ++ai)
#pragma unroll
            for (int m = 0; m < 4; ++m) { const int r = ai * HALF + wr * 64 + m * 16 + fr; const f32x2v sr = S[r]; const size_t off = (size_t)(u.pm * BM + r) * ldc + col0;
#pragma unroll
                for (int bj = 0; bj < 2; ++bj)
#pragma unroll
                    for (int n = 0; n < 2; ++n) { const f32x4 bs = *(const f32x4*)(base + off + bj * HALF + n * 16); acc[ai][bj][m][n] = bs + (acc[ai][bj][m][n] - sr.x) * sr.y; }
                asm volatile("" : "+v"(acc[ai][0][m][0]), "+v"(acc[ai][0][m][1]), "+v"(acc[ai][1][m][0]), "+v"(acc[ai][1][m][1]));
                if (m & 1) asm volatile("" ::: "memory"); }
        const bool bad1 = bad;
        bad = st2.run(acc, u, wr, wc, fr, fq, lds, wid, lane) || bad;
#pragma unroll
        for (int ai = 0; ai < 2; ++ai)
#pragma unroll
            for (int m = 0; m < 4; ++m) { const int r = ai * HALF + wr * 64 + m * 16 + fr; const f32x2v sr = S[r]; const size_t off = (size_t)(u.pm * BM + r) * ldc + col0;
#pragma unroll
                for (int bj = 0; bj < 2; ++bj)
#pragma unroll
                    for (int n = 0; n < 2; ++n) { const f32x4 x1 = acc[ai][bj][m][n]; *(f32x4*)(out + off + bj * HALF + n * 16) = bad1 ? (f32x4){qnan, qnan, qnan, qnan} : x1;
                        const f32x4 o = (x1 - sr.x) * sr.y; u32x2v w; w.x = cvt_pk_bf16(o[0], o[1]); w.y = cvt_pk_bf16(o[2], o[3]);
                        if (bad) { w.x = 0x7fc07fc0u; w.y = 0x7fc07fc0u; } *(u32x2v*)(xn + off + bj * HALF + n * 16) = w; }
                asm volatile("" ::: "memory"); }
    }
};

template <class Epi, class Sched, bool ALIGN_EPI = false, bool SP2 = false>
__device__ __forceinline__ void gemm_phase(PG8_LAS unsigned char* lds, const Gemm g, const Sched& S, const Epi& E) {
    const int tid = threadIdx.x, wid = __builtin_amdgcn_readfirstlane(tid >> 6), lane = tid & 63, wr = wid >> 2, wc = wid & 3, fr = lane & 15, fq = lane >> 4;
    const int K = g.K, nt = K / BK;
    unsigned voffA[2], voffB[2];
#pragma unroll
    for (int i = 0; i < 2; ++i) { int R, C; stage_rc(tid * 16 + i * 8192, R, C); const int Rb = Epi::PERM ? ((R & ~31) + perm32(R & 31)) : R;
        voffA[i] = (unsigned)(R * g.lda + C) * 2u; voffB[i] = (unsigned)(Rb * g.ldb + C) * 2u; }
    const size_t kstep = (size_t)(BK * 2);
    const size_t hstepA = (size_t)HALF * g.lda * 2, hstepB = (size_t)HALF * g.ldb * 2;
    const size_t tstepA = 2 * hstepA, tstepB = 2 * hstepB;
    const unsigned ldsw = (unsigned)wid * 1024u;
    const int aoff = lds_byte(wr * 64 + fr, fq * 8), boff = lds_byte(wc * 32 + fr, fq * 8);
#define PG8_SA(b, h) (((b) * 2 + (h)) * HTB)
#define PG8_SB(b, h) ((4 + (b) * 2 + (h)) * HTB)
#define PG8_STAGE(bufoff, gbase, voff) do { _Pragma("unroll") for (int _i = 0; _i < 2; ++_i) \
        __builtin_amdgcn_global_load_lds((const unsigned*)((const char*)(gbase) + (voff)[_i]), (PG8_LAS unsigned*)(lds + (bufoff) + ldsw + _i * 8192), 16, 0, 0); } while (0)
#define PG8_LDA(dst, b, h) do { _Pragma("unroll") for (int m = 0; m < 4; ++m) _Pragma("unroll") for (int k = 0; k < 2; ++k) dst[m][k] = *(const PG8_LAS bf16x8*)(lds + PG8_SA(b, h) + aoff + m * 2048 + k * 1024); } while (0)
#define PG8_LDB(dst, b, h) do { _Pragma("unroll") for (int n = 0; n < 2; ++n) _Pragma("unroll") for (int k = 0; k < 2; ++k) dst[n][k] = *(const PG8_LAS bf16x8*)(lds + PG8_SB(b, h) + boff + n * 2048 + k * 1024); } while (0)
#define PG8_MMA(ai, bj, At, Bt) do { __builtin_amdgcn_s_setprio(1); _Pragma("unroll") for (int m = 0; m < 4; ++m) _Pragma("unroll") for (int n = 0; n < 2; ++n) _Pragma("unroll") for (int k = 0; k < 2; ++k) \
        acc[ai][bj][m][n] = __builtin_amdgcn_mfma_f32_16x16x32_bf16(Bt[n][k], At[m][k], acc[ai][bj][m][n], 0, 0, 0); __builtin_amdgcn_s_setprio(0); } while (0)
#define PG8_WAIT_V(n) asm volatile("s_waitcnt vmcnt(" #n ")" ::: "memory")
#define PG8_WAIT_L(n) asm volatile("s_waitcnt lgkmcnt(" #n ")" ::: "memory")
#define PG8_BAR __builtin_amdgcn_s_barrier()
#define PG8_SCHED __builtin_amdgcn_sched_barrier(0)
    Unit cur, nxt; int ui = 0;
    if (!S.next(0, cur)) return;
    f32x4 acc[2][2][4][2];
#pragma unroll
    for (int a = 0; a < 2; ++a)
#pragma unroll
        for (int b = 0; b < 2; ++b)
#pragma unroll
            for (int m = 0; m < 4; ++m)
#pragma unroll
                for (int n = 0; n < 2; ++n) acc[a][b][m][n] = (f32x4){0.f, 0.f, 0.f, 0.f};
    bf16x8 At[4][2], B0[2][2], B1[2][2];
    const char* cA = (const char*)g.A + (size_t)cur.pm * tstepA; const char* cB = (const char*)g.Bt + (size_t)cur.pn * tstepB;
    S.a_ready(cur);
    if constexpr (SP2) {
        PG8_STAGE(PG8_SB(0, 0), cB, voffB); PG8_STAGE(PG8_SB(0, 1), cB + hstepB, voffB); PG8_STAGE(PG8_SA(0, 0), cA, voffA); PG8_STAGE(PG8_SA(0, 1), cA + hstepA, voffA);
        if (wr == 1) PG8_BAR;
        PG8_WAIT_V(2); PG8_BAR;
        PG8_STAGE(PG8_SB(1, 0), cB + kstep, voffB); PG8_STAGE(PG8_SA(1, 0), cA + kstep, voffA); PG8_STAGE(PG8_SB(1, 1), cB + hstepB + kstep, voffB);
        PG8_WAIT_V(6); PG8_BAR;
    } else {
        PG8_STAGE(PG8_SB(0, 0), cB, voffB); PG8_STAGE(PG8_SA(0, 0), cA, voffA); PG8_STAGE(PG8_SB(0, 1), cB + hstepB, voffB); PG8_STAGE(PG8_SA(0, 1), cA + hstepA, voffA);
        if (wr == 1) PG8_BAR;
        PG8_WAIT_V(4); PG8_BAR;
        PG8_STAGE(PG8_SB(1, 0), cB + kstep, voffB); PG8_STAGE(PG8_SA(1, 0), cA + kstep, voffA); PG8_STAGE(PG8_SB(1, 1), cB + hstepB + kstep, voffB);
        PG8_WAIT_V(6); PG8_BAR;
    }
    for (;;) {
        const bool has_next = S.next(ui + 1, nxt);
        const char* nA = has_next ? (const char*)g.A + (size_t)nxt.pm * tstepA : cA; const char* nB = has_next ? (const char*)g.Bt + (size_t)nxt.pn * tstepB : cB;
        for (int t = 0; t < nt; t += 2) {
            if constexpr (Epi::MIDK > 0) { if (t == Epi::MIDK) E.mid(acc, cur, wr, wc, fr, fq); }
            const bool last = (t == nt - 2);
            const char* a1 = cA + (size_t)(t + 1) * kstep;
            const char* a2 = last ? nA : cA + (size_t)(t + 2) * kstep; const char* b2 = last ? nB : cB + (size_t)(t + 2) * kstep;
            const char* a3 = a2 + kstep; const char* b3 = b2 + kstep;
            if (last && has_next) S.a_ready(nxt);
            if constexpr (SP2) {
            PG8_LDB(B0, 0, 0); PG8_LDB(B1, 0, 1); PG8_SCHED; PG8_LDA(At, 0, 0); PG8_STAGE(PG8_SA(1, 1), a1 + hstepA, voffA);
            PG8_WAIT_V(8); PG8_WAIT_L(0); PG8_BAR; PG8_MMA(0, 0, At, B0); PG8_MMA(0, 1, At, B1); PG8_BAR; PG8_SCHED;
            PG8_LDA(At, 0, 1); PG8_STAGE(PG8_SB(0, 0), b2, voffB); PG8_STAGE(PG8_SB(0, 1), b2 + hstepB, voffB); PG8_STAGE(PG8_SA(0, 0), a2, voffA);
            PG8_WAIT_V(8); PG8_WAIT_L(0); PG8_BAR; PG8_MMA(1, 0, At, B0); PG8_MMA(1, 1, At, B1); PG8_BAR; PG8_SCHED;
            PG8_LDB(B0, 1, 0); PG8_LDB(B1, 1, 1); PG8_SCHED; PG8_LDA(At, 1, 0); PG8_STAGE(PG8_SA(0, 1), a2 + hstepA, voffA);
            PG8_WAIT_V(8); PG8_WAIT_L(0); PG8_BAR; PG8_MMA(0, 0, At, B0); PG8_MMA(0, 1, At, B1); PG8_BAR; PG8_SCHED;
            PG8_LDA(At, 1, 1); PG8_STAGE(PG8_SB(1, 0), b3, voffB); PG8_STAGE(PG8_SB(1, 1), b3 + hstepB, voffB); PG8_STAGE(PG8_SA(1, 0), a3, voffA);
            PG8_WAIT_V(8); PG8_WAIT_L(0); PG8_BAR; PG8_MMA(1, 0, At, B0); PG8_MMA(1, 1, At, B1); PG8_BAR; PG8_SCHED;
            } else {
            PG8_LDB(B0, 0, 0); PG8_SCHED; PG8_LDA(At, 0, 0); PG8_STAGE(PG8_SA(1, 1), a1 + hstepA, voffA);
            PG8_WAIT_L(8); PG8_BAR; PG8_WAIT_L(0); PG8_MMA(0, 0, At, B0); PG8_BAR; PG8_SCHED;
            PG8_LDB(B1, 0, 1); PG8_STAGE(PG8_SB(0, 0), b2, voffB);
            PG8_BAR; PG8_WAIT_L(0); PG8_MMA(0, 1, At, B1); PG8_BAR;
            PG8_LDA(At, 0, 1); PG8_STAGE(PG8_SA(0, 0), a2, voffA);
            PG8_BAR; PG8_WAIT_L(0); PG8_MMA(1, 0, At, B0); PG8_BAR; PG8_SCHED;
            PG8_STAGE(PG8_SB(0, 1), b2 + hstepB, voffB);
            PG8_WAIT_V(6); PG8_BAR; PG8_MMA(1, 1, At, B1); PG8_BAR;
            PG8_LDB(B0, 1, 0); PG8_SCHED; PG8_LDA(At, 1, 0); PG8_STAGE(PG8_SA(0, 1), a2 + hstepA, voffA);
            PG8_WAIT_L(8); PG8_BAR; PG8_WAIT_L(0); PG8_MMA(0, 0, At, B0); PG8_BAR; PG8_SCHED;
            PG8_LDB(B1, 1, 1); PG8_STAGE(PG8_SB(1, 0), b3, voffB);
            PG8_BAR; PG8_WAIT_L(0); PG8_MMA(0, 1, At, B1); PG8_BAR;
            PG8_LDA(At, 1, 1); PG8_STAGE(PG8_SA(1, 0), a3, voffA);
            PG8_BAR; PG8_WAIT_L(0); PG8_MMA(1, 0, At, B0); PG8_BAR; PG8_SCHED;
            PG8_STAGE(PG8_SB(1, 1), b3 + hstepB, voffB);
            PG8_WAIT_V(6); PG8_BAR; PG8_MMA(1, 1, At, B1); PG8_BAR;
            }
        }
        if constexpr (ALIGN_EPI) { if (wr == 0) PG8_BAR; }
        if constexpr (!Epi::AFTER_DRAIN) { E(acc, cur, wr, wc, fr, fq); S.done(cur); }
        if (!has_next) break;
#pragma unroll
        for (int a = 0; a < 2; ++a)
#pragma unroll
            for (int b = 0; b < 2; ++b)
#pragma unroll
                for (int m = 0; m < 4; ++m)
#pragma unroll
                    for (int n = 0; n < 2; ++n) acc[a][b][m][n] = (f32x4){0.f, 0.f, 0.f, 0.f};
        cur = nxt; cA = nA; cB = nB; ++ui;
        if constexpr (ALIGN_EPI) { if (wr == 1) PG8_BAR; }
    }
    PG8_WAIT_V(0);
    if constexpr (!ALIGN_EPI) { if (wr == 0) PG8_BAR; }
    PG8_BAR;
    if constexpr (Epi::AFTER_DRAIN) { E.fused(acc, cur, wr, wc, fr, fq, lds, wid, lane); S.done(cur); }
#undef PG8_SA
#undef PG8_SB
#undef PG8_STAGE
#undef PG8_LDA
#undef PG8_LDB
#undef PG8_MMA
#undef PG8_WAIT_V
#undef PG8_WAIT_L
#undef PG8_BAR
#undef PG8_SCHED
}
}
#define GAS __attribute__((address_space(1)))
#define LAS __attribute__((address_space(3)))
typedef unsigned short bf16;
typedef unsigned v4u __attribute__((ext_vector_type(4)));
typedef float f32x4 __attribute__((ext_vector_type(4)));
typedef short bf16x8 __attribute__((ext_vector_type(8)));
typedef GAS unsigned gu32;
typedef GAS unsigned long long gu64;
#define RLX_AGENT __ATOMIC_RELAXED, __HIP_MEMORY_SCOPE_AGENT
#define LDS_WAIT() asm volatile("s_waitcnt lgkmcnt(0)" ::: "memory")
#define VM_WAIT() asm volatile("s_waitcnt vmcnt(0)" ::: "memory")
__device__ __forceinline__ unsigned long long rt() { return __builtin_amdgcn_s_memrealtime(); }
__device__ __forceinline__ unsigned f2bf(float f) { unsigned u = __builtin_bit_cast(unsigned, f); return (u + 0x7fffu + ((u >> 16) & 1u)) >> 16; }
__device__ __forceinline__ unsigned pk2(float lo, float hi) { return f2bf(lo) | (f2bf(hi) << 16); }

#define XB_TMO      128
#define XB_XCNT(j)  (256  + 64 * (j))
#define XB_XSUB(j)  (1280 + 64 * (j))
#define XB_XGEN(j)  (2304 + 64 * (j))
#define XB_TOP      3328
#define XB_TOPGEN   3392
#define XCD_BAR_WORDS 3456
#define XB_SPIN_CAP (1u << 18)

__device__ __forceinline__ unsigned xb_ld(unsigned* p)              { return __hip_atomic_load(p, __ATOMIC_RELAXED, __HIP_MEMORY_SCOPE_AGENT); }
__device__ __forceinline__ unsigned xb_add(unsigned* p, unsigned v) { return __hip_atomic_fetch_add(p, v, __ATOMIC_RELAXED, __HIP_MEMORY_SCOPE_AGENT); }
__device__ __forceinline__ unsigned xb_xcc_id() { return (unsigned)__builtin_amdgcn_s_getreg((3 << 11) | 20) & 0xFu; }
#define XB_SPIN(cond, bar) do { unsigned _sp = 0; while (cond) { __builtin_amdgcn_s_sleep(1); \
    if ((++_sp & 255u) == 0u) { if (xb_ld(&(bar)[XB_TMO])) break; if (_sp > XB_SPIN_CAP) { atomicAdd(&(bar)[XB_TMO], 1u); break; } } } } while (0)

struct XcdBarrier {
    unsigned* bar; unsigned x;
    volatile LAS unsigned* st;
};

__device__ __forceinline__ XcdBarrier xcd_barrier_post(unsigned* bar, volatile LAS unsigned* st) {
    XcdBarrier b; b.bar = bar; b.x = xb_xcc_id(); b.st = st;
    if (threadIdx.x == 0) (void)xb_add(&bar[XB_XCNT(b.x)], 1u);
    return b;
}
__device__ __forceinline__ void xcd_barrier_complete(unsigned* bar, unsigned x, unsigned& nloc, unsigned& nx) {
    const unsigned G = gridDim.x * gridDim.y * gridDim.z;
    unsigned sum, cnt, mine, sp = 0u;
    for (;;) {
        sum = 0u; cnt = 0u; mine = 0u;
#pragma unroll
        for (unsigned j = 0; j < 16; ++j) { const unsigned c = xb_ld(&bar[XB_XCNT(j)]); sum += c; cnt += (c > 0u) ? 1u : 0u; mine = (j == x) ? c : mine; }
        if (sum == G) break;
        __builtin_amdgcn_s_sleep(1);
        if ((++sp & 255u) == 0u) { if (xb_ld(&bar[XB_TMO])) break; if (sp > XB_SPIN_CAP) { atomicAdd(&bar[XB_TMO], 1u); break; } }
    }
    nloc = mine > 0u ? mine : 1u; nx = cnt > 0u ? cnt : 1u;
}

__device__ __forceinline__ void xcd_barrier(const XcdBarrier& b) {
    asm volatile("s_waitcnt vmcnt(0)" ::: "memory");
    __syncthreads();
    if (threadIdx.x == 0) {
        unsigned* bar = b.bar;
        __builtin_amdgcn_s_waitcnt(0);
        unsigned nloc = b.st[0], nx = b.st[1];
        if (nloc == 0u) { xcd_barrier_complete(bar, b.x, nloc, nx); b.st[0] = nloc; b.st[1] = nx; }
        const unsigned old = xb_add(&bar[XB_XSUB(b.x)], 1u);
        const unsigned gen = old / nloc;
        if (old + 1u == (gen + 1u) * nloc) {
            __builtin_amdgcn_fence(__ATOMIC_RELEASE, "agent");
            asm volatile("s_waitcnt vmcnt(0)" ::: "memory");
            const unsigned og = xb_add(&bar[XB_TOP], 1u);
            const unsigned tg = og / nx;
            if (og + 1u == (tg + 1u) * nx) xb_add(&bar[XB_TOPGEN], 1u);
            else XB_SPIN(xb_ld(&bar[XB_TOPGEN]) == tg, bar);
            __builtin_amdgcn_fence(__ATOMIC_ACQUIRE, "agent");
            xb_add(&bar[XB_XGEN(b.x)], 1u);
            asm volatile("s_waitcnt vmcnt(0)" ::: "memory");
        } else {
            XB_SPIN(xb_ld(&bar[XB_XGEN(b.x)]) == gen, bar);
            __builtin_amdgcn_fence(__ATOMIC_ACQUIRE, "agent");
            asm volatile("s_waitcnt vmcnt(0)" ::: "memory");
        }
    }
    __syncthreads();
}
typedef float f32x4v __attribute__((ext_vector_type(4)));
struct Frame {
    LAS unsigned char* lds;
    volatile LAS unsigned* MISC;
    gu32* ctl;
    int tid, lane, wave, G, vcu;
    float* out; unsigned char* ws;
};
typedef const float* cfptr;
#define INP(i) (((const LAS cfptr*)(F.lds + LDSCTL_OFF + 256))[i])
#define IN_X 0
#define IN_C 1
#define IN_CTX 2
#define IN_CCTX 3
#define IN_WMOD 4
#define IN_BMOD 5
#define IN_NMIX 6
#define IN_NFFN 7
#define IN_WIN 8
#define IN_QNA 9
#define IN_KNA 10
#define IN_SINK 11
#define IN_WBRA 12
#define IN_WBRB 13
#define IN_WOUT 14
#define IN_WRG 15
#define IN_BRG 16
#define IN_WRE 17
#define IN_BRE 18
#define IN_W1 19
#define IN_W3 20
#define IN_W2 21
#define IN_NFIN 22

__device__ __forceinline__ float wave_sum(float v) {
#pragma unroll
    for (int o = 1; o < 64; o <<= 1) v += __shfl_xor(v, o);
    return v;
}
__device__ __forceinline__ float wave_max(float v) {
#pragma unroll
    for (int o = 1; o < 64; o <<= 1) v = fmaxf(v, __shfl_xor(v, o));
    return v;
}
__device__ __forceinline__ float bf2f(bf16 h) { return __builtin_bit_cast(float, (unsigned)h << 16); }
__device__ __forceinline__ int mod_row(int m) { return (m % TT) < CTX ? 4 : m / TT; }

__device__ __forceinline__ void compute_base(const unsigned* cnt, LAS unsigned* base, int tid) {
    if (tid < 64) {
        const unsigned c = __hip_atomic_load(cnt + tid, RLX_AGENT); unsigned v = c;
#pragma unroll
        for (int o = 1; o < 64; o <<= 1) { const unsigned t = __shfl_up(v, o); if (tid >= o) v += t; }
        base[tid] = v - c; if (tid == 63) base[64] = v;
    }
    __syncthreads();
}

template <int MODE>
__device__ __forceinline__ void tr_item(const float* W, int ldw, bf16* WT, int ldt, int koff, LAS float* scr, int kb, int nb, int lane) {
    const int k0 = 64 * kb, n0 = 32 * nb;
    const int lr = lane >> 3, lc = (lane & 7) * 4;
    f32x4v v[8];
#pragma unroll
    for (int i = 0; i < 8; ++i) v[i] = __builtin_nontemporal_load((const f32x4v*)(W + (size_t)(k0 + 8 * i + lr) * ldw + n0 + lc));
#pragma unroll
    for (int i = 0; i < 8; ++i) { LAS float* d = scr + (8 * i + lr) * 33 + lc; d[0] = v[i].x; d[1] = v[i].y; d[2] = v[i].z; d[3] = v[i].w; }
    LDS_WAIT(); asm volatile("" ::: "memory");
    const int c = lane & 7;
#pragma unroll
    for (int j = 0; j < 4; ++j) { const int n = (lane >> 3) + 8 * j; const LAS float* s = scr + (8 * c) * 33 + n;
        v4u o; o.x = pk2(s[0 * 33], s[1 * 33]); o.y = pk2(s[2 * 33], s[3 * 33]); o.z = pk2(s[4 * 33], s[5 * 33]); o.w = pk2(s[6 * 33], s[7 * 33]);
        const int drow = (MODE == 1) ? inproj_dst_col(n0 + n) : (n0 + n);
        *(GAS v4u*)(WT + (size_t)drow * ldt + koff + k0 + 8 * c) = o; }
    LDS_WAIT(); asm volatile("" ::: "memory");
}

__device__ __forceinline__ void p0_prologue(Frame& F) {
#if TPROBE >= 200
    if (F.tid == 0) atomicMax((unsigned*)F.ctl + 200000, (unsigned)__builtin_amdgcn_s_memrealtime());
#endif
    LAS float* sl = (LAS float*)(F.lds);
    LAS float* red = (LAS float*)(F.lds + 40960);
    for (int i = F.tid; i < 5 * D; i += NWAVES * 64) { const int r = i / D, k = i % D; const float v = r < 4 ? INP(IN_C)[r * D + k] : INP(IN_CCTX)[k]; sl[i] = v / (1.f + __expf(-v)); }
    __syncthreads();
#if TPROBE >= 200
    if (F.tid == 0) atomicMax((unsigned*)F.ctl + 200000 + 256, (unsigned)__builtin_amdgcn_s_memrealtime());
#endif
    float* MODP = (float*)(F.ws + WS_MODP);
    for (int u = F.vcu; u < 2 * 6 * 64; u += F.G) {
        const int l = u / (6 * 64), cb = (u / 64) % 6, kslc = u % 64, col = cb * 2048 + 4 * F.tid;
        const float* W = INP(IN_WMOD) + (size_t)l * D * MODW + (size_t)(kslc * 32) * MODW + col;
        f32x4v acc[5];
#pragma unroll
        for (int r = 0; r < 5; ++r) acc[r] = (f32x4v){0.f, 0.f, 0.f, 0.f};
#pragma unroll 16
        for (int kk = 0; kk < 32; ++kk) { const int k = kslc * 32 + kk; const f32x4v w = __builtin_nontemporal_load((const f32x4v*)(W + (size_t)kk * MODW));
#pragma unroll
            for (int r = 0; r < 5; ++r) acc[r] += sl[r * D + k] * w; }
#pragma unroll
        for (int r = 0; r < 5; ++r) *(f32x4v*)(MODP + ((size_t)(l * 64 + kslc) * 5 + r) * MODW + col) = acc[r];
    }
    __syncthreads();
#if TPROBE >= 200
    __syncthreads(); if (F.tid == 0) atomicMax((unsigned*)F.ctl + 200000 + 64, (unsigned)__builtin_amdgcn_s_memrealtime());
#endif
    if (F.vcu == 0) { float* RT = (float*)(F.ws + WS_ROPE);
        for (int i = F.tid; i < 64 * 32; i += NWAVES * 64) { const int pos = i >> 5, f = i & 31; const float freq = powf(10000.f, -(float)f / 32.f); const float ang = (float)pos * freq; RT[i] = cosf(ang); RT[2048 + i] = sinf(ang); } }
    { bf16* WRT = (bf16*)(F.ws + WS_WR);
      for (int it = F.vcu * NWAVES * 64 + F.tid; it < 2 * 80 * 256; it += F.G * NWAVES * 64) {
          const int l = it / (80 * 256), c = (it / 256) % 80, k0 = (it % 256) * 8;
          float wv[8];
#pragma unroll
          for (int i = 0; i < 8; ++i) wv[i] = c < 64 ? INP(IN_WRE)[((size_t)l * D + k0 + i) * NE + c] : (c < 72 ? INP(IN_WRG)[((size_t)l * D + k0 + i) * NG + (c - 64)] : 0.f);
          unsigned hi[4], lo[4];
#pragma unroll
          for (int i = 0; i < 4; ++i) { const unsigned h0 = f2bf(wv[2 * i]), h1 = f2bf(wv[2 * i + 1]); hi[i] = h0 | (h1 << 16);
              lo[i] = f2bf(wv[2 * i] - __builtin_bit_cast(float, h0 << 16)) | (f2bf(wv[2 * i + 1] - __builtin_bit_cast(float, h1 << 16)) << 16); }
          const int ko = k0 >> 3, sI = ko >> 2, fqI = ko & 3, cfI = c >> 4, frI = c & 15;
          *(v4u*)(WRT + ((((size_t)(l * 2 + 0) * 64 + sI) * 5 + cfI) * 64 + fqI * 16 + frI) * 8) = (v4u){hi[0], hi[1], hi[2], hi[3]};
          *(v4u*)(WRT + ((((size_t)(l * 2 + 1) * 64 + sI) * 5 + cfI) * 64 + fqI * 16 + frI) * 8) = (v4u){lo[0], lo[1], lo[2], lo[3]};
      } }
#if TPROBE >= 200
    __syncthreads(); if (F.tid == 0) atomicMax((unsigned*)F.ctl + 200000 + 128, (unsigned)__builtin_amdgcn_s_memrealtime());
#endif
    LAS float* scr = (LAS float*)(F.lds + F.wave * 16384);
    const int gw = F.vcu * NWAVES + F.wave, NGW = F.G * NWAVES;
    constexpr int I_IN = 32 * 224, I_BR = 16 * 64, I_OUT = 32 * 64, I_L = I_IN + 2 * I_BR + I_OUT;
    for (int it = gw; it < 2 * I_L; it += NGW) {
        const int l = it / I_L; int r = it % I_L;
        if (r < I_IN) { tr_item<1>(INP(IN_WIN) + (size_t)l * D * INC, INC, (bf16*)(F.ws + WS_WIN) + (size_t)l * INC * D, D, 0, scr, r / 224, r % 224, F.lane); continue; } r -= I_IN;
        if (r < I_BR) { tr_item<0>(INP(IN_WBRA) + (size_t)l * QW * D, D, (bf16*)(F.ws + WS_WBR) + (size_t)l * D * D, D, 0, scr, r / 64, r % 64, F.lane); continue; } r -= I_BR;
        if (r < I_BR) { tr_item<0>(INP(IN_WBRB) + (size_t)l * QW * D, D, (bf16*)(F.ws + WS_WBR) + (size_t)l * D * D, D, QW, scr, r / 64, r % 64, F.lane); continue; } r -= I_BR;
        tr_item<0>(INP(IN_WOUT) + (size_t)l * D * D, D, (bf16*)(F.ws + WS_WOUT) + (size_t)l * D * D, D, 0, scr, r / 64, r % 64, F.lane);
    }
#if TPROBE >= 200
    __syncthreads(); if (F.tid == 0) atomicMax((unsigned*)F.ctl + 200000 + 192, (unsigned)__builtin_amdgcn_s_memrealtime());
#endif
}

__device__ __forceinline__ void p0b_reduce(Frame& F) {
    const float* MODP = (const float*)(F.ws + WS_MODP); float* MOD = (float*)(F.ws + WS_MOD);
    for (int o = F.vcu * NWAVES * 64 + F.tid; o < 2 * 5 * (MODW / 4); o += F.G * NWAVES * 64) {
        const int l = o / (5 * (MODW / 4)), r = (o / (MODW / 4)) % 5, n = (o % (MODW / 4)) * 4;
        f32x4v a = *(const f32x4v*)(INP(IN_BMOD) + l * MODW + n);
#pragma unroll 16
        for (int k2 = 0; k2 < 64; ++k2) a += *(const f32x4v*)(MODP + ((size_t)(l * 64 + k2) * 5 + r) * MODW + n);
        *(f32x4v*)(MOD + (size_t)(l * 5 + r) * MODW + n) = a;
    }
}

__device__ __forceinline__ void moe_combine_add(Frame& F, int lp, int m, const LAS unsigned* base, f32x4v (&v)[8]) {
    const unsigned* TE = (const unsigned*)(F.ws + WS_TOK) + (size_t)lp * M * 2;
    const unsigned* TP = (const unsigned*)(F.ws + WS_TOK) + (size_t)(2 + lp) * M * 2;
    const float* TW = (const float*)(F.ws + WS_TOK) + (size_t)(4 + lp) * M * 2;
    const unsigned e0 = TE[m * 2], e1 = TE[m * 2 + 1];
    const unsigned s0 = base[e0] + TP[m * 2], s1 = base[e1] + TP[m * 2 + 1];
    const float w0 = TW[m * 2], w1 = TW[m * 2 + 1];
    const bf16* Y0 = (const bf16*)(F.ws + WS_YM) + (size_t)s0 * D; const bf16* Y1 = (const bf16*)(F.ws + WS_YM) + (size_t)s1 * D;
    const float* g2 = (const float*)(F.ws + WS_MOD) + (size_t)(lp * 5 + mod_row(m)) * MODW + 5 * D;
#pragma unroll
    for (int j = 0; j < 8; ++j) { const int col = 4 * (F.lane + 64 * j);
        const uint2 a = *(const uint2*)(Y0 + col), b = *(const uint2*)(Y1 + col); const f32x4v g = *(const f32x4v*)(g2 + col);
        f32x4v ya = {__builtin_bit_cast(float, a.x << 16), __builtin_bit_cast(float, a.x & 0xffff0000u), __builtin_bit_cast(float, a.y << 16), __builtin_bit_cast(float, a.y & 0xffff0000u)};
        f32x4v yb = {__builtin_bit_cast(float, b.x << 16), __builtin_bit_cast(float, b.x & 0xffff0000u), __builtin_bit_cast(float, b.y << 16), __builtin_bit_cast(float, b.y & 0xffff0000u)};
        v[j] += g * (w0 * ya + w1 * yb); }
}
__device__ __forceinline__ void store_bf16_row(bf16* dst, int lane, const f32x4v (&h)[8]) {
#pragma unroll
    for (int j = 0; j < 8; ++j) { uint2 o; o.x = pk2(h[j].x, h[j].y); o.y = pk2(h[j].z, h[j].w); *(uint2*)(dst + 4 * (lane + 64 * j)) = o; }
}
__device__ __forceinline__ float row_sumsq(const f32x4v (&v)[8]) {
    float s = 0.f;
#pragma unroll
    for (int j = 0; j < 8; ++j) s += (v[j].x * v[j].x + v[j].y * v[j].y) + (v[j].z * v[j].z + v[j].w * v[j].w);
    return wave_sum(s);
}

template <bool DRY>
__device__ __forceinline__ void ph_norm1(Frame& F, int l) {
    LAS unsigned* base = (LAS unsigned*)(F.lds);
    if (l > 0) compute_base((const unsigned*)F.ctl + CW_CNT + (l - 1) * 64, base, F.tid);
    const int gw = F.vcu * NWAVES + F.wave, NGW = F.G * NWAVES;
    float* XW = (float*)(F.ws + WS_XW); bf16* HA = (bf16*)(F.ws + (DRY ? WS_T2 : WS_HA)); float* XWo = (float*)(F.ws + (DRY ? WS_T1 : WS_XW));
    const float* nw = INP(IN_NMIX) + l * D;
#define N1_LOAD(m_, v_) do { const int b_ = (m_) / TT, t_ = (m_) % TT; \
        const float* src_ = (l == 0) ? (t_ < CTX ? INP(IN_CTX) + ((size_t)b_ * CTX + t_) * D : INP(IN_X) + ((size_t)b_ * SEQ + (t_ - CTX)) * D) : XW + (size_t)(m_) * D; \
        _Pragma("unroll") for (int j = 0; j < 8; ++j) v_[j] = *(const f32x4v*)(src_ + 4 * (F.lane + 64 * j)); } while (0)
#define N1_FINISH(m_, v_) do { \
        if (l > 0) moe_combine_add(F, l - 1, (m_), base, v_); \
        _Pragma("unroll") for (int j = 0; j < 8; ++j) *(f32x4v*)(XWo + (size_t)(m_) * D + 4 * (F.lane + 64 * j)) = v_[j]; \
        const float rstd = 1.0f / sqrtf(row_sumsq(v_) * (1.0f / D) + EPS); \
        const float* mod = (const float*)(F.ws + WS_MOD) + (size_t)(l * 5 + mod_row(m_)) * MODW; \
        f32x4v h[8]; \
        _Pragma("unroll") for (int j = 0; j < 8; ++j) { const int col = 4 * (F.lane + 64 * j); const f32x4v w = *(const f32x4v*)(nw + col), sh = *(const f32x4v*)(mod + col), sc = *(const f32x4v*)(mod + D + col); \
            h[j] = (v_[j] * rstd * w) * (1.0f + sc) + sh; } \
        store_bf16_row(HA + (size_t)(m_) * D, F.lane, h); } while (0)
    f32x4v va[8], vb[8];
    int m = gw; if (m < M) N1_LOAD(m, va);
    while (m < M) {
        const int m1 = m + NGW; if (m1 < M) N1_LOAD(m1, vb);
        N1_FINISH(m, va);
        if (m1 >= M) break;
        const int m2 = m1 + NGW; if (m2 < M) N1_LOAD(m2, va);
        N1_FINISH(m1, vb);
        m = m2;
    }
#undef N1_LOAD
#undef N1_FINISH
}

__device__ __forceinline__ void post_head(const float* P, bf16* dst, const float* nw, bool rope, int rowpos, int colpos, const float* RT, int lane) {
    const int wc = lane >> 4, tt = lane & 15, j0 = 32 * wc + tt, j1 = j0 + 16, d1 = 64 * (wc >> 1) + 16 * (wc & 1) + tt, d2 = d1 + 32;
    float x1 = P[j0], x2 = P[j1];
    if (nw) { const float ss = wave_sum(x1 * x1 + x2 * x2); const float r = 1.0f / sqrtf(ss * (1.0f / HD) + EPS); x1 = x1 * r * nw[d1]; x2 = x2 * r * nw[d2]; }
    if (rope) { const int pos = (wc >> 1) ? colpos : rowpos, fi = 16 * (wc & 1) + tt; const float cs = RT[pos * 32 + fi], sn = RT[2048 + pos * 32 + fi];
        const float o1 = x1 * cs - x2 * sn, o2 = x1 * sn + x2 * cs; x1 = o1; x2 = o2; }
    dst[j0] = (bf16)f2bf(x1); dst[j1] = (bf16)f2bf(x2);
}
__device__ __forceinline__ void ph_post(Frame& F, int l) {
    const int gw = F.vcu * NWAVES + F.wave, NGW = F.G * NWAVES;
    const float* RT = (const float*)(F.ws + WS_ROPE);
    const float* qn = INP(IN_QNA) + l * HD; const float* kn = INP(IN_KNA) + l * HD;
    for (int m = gw; m < M; m += NGW) {
        const int t = m % TT; const bool rope = t >= CTX; const int s = t - CTX, rowpos = rope ? s / GRIDW : 0, colpos = rope ? s % GRIDW : 0;
        const float* P = (const float*)(F.ws + WS_P) + (size_t)m * INC;
        for (int h = 0; h < NH; ++h) post_head(P + OFF_QA + h * HD, (bf16*)(F.ws + WS_QA) + (size_t)m * QW + h * HD, qn, rope, rowpos, colpos, RT, F.lane);
        for (int h = 0; h < NKV; ++h) post_head(P + OFF_KA + h * HD, (bf16*)(F.ws + WS_KA) + (size_t)m * KW + h * HD, kn, rope, rowpos, colpos, RT, F.lane);
        for (int h = 0; h < NH; ++h) post_head(P + OFF_QB + h * HD, (bf16*)(F.ws + WS_QB) + (size_t)m * QW + h * HD, nullptr, rope, rowpos, colpos, RT, F.lane);
        for (int h = 0; h < NKV; ++h) post_head(P + OFF_KB + h * HD, (bf16*)(F.ws + WS_KB) + (size_t)m * KW + h * HD, nullptr, rope, rowpos, colpos, RT, F.lane);
        { const f32x4v a = *(const f32x4v*)(P + OFF_VA + 4 * F.lane), b = *(const f32x4v*)(P + OFF_VB + 4 * F.lane); uint2 o; o.x = pk2(a.x, a.y); o.y = pk2(a.z, a.w); *(uint2*)((bf16*)(F.ws + WS_VA) + (size_t)m * KW + 4 * F.lane) = o;
          o.x = pk2(b.x, b.y); o.y = pk2(b.z, b.w); *(uint2*)((bf16*)(F.ws + WS_VB) + (size_t)m * KW + 4 * F.lane) = o; }
#pragma unroll
        for (int j = 0; j < 8; ++j) { const int col = 4 * (F.lane + 64 * j);
            const f32x4v a = *(const f32x4v*)(P + OFF_GA + col), b = *(const f32x4v*)(P + OFF_GB + col);
            uint2 o; o.x = pk2(1.f / (1.f + __expf(-a.x)), 1.f / (1.f + __expf(-a.y))); o.y = pk2(1.f / (1.f + __expf(-a.z)), 1.f / (1.f + __expf(-a.w))); *(uint2*)((bf16*)(F.ws + WS_GA) + (size_t)m * D + col) = o;
            o.x = pk2(1.f / (1.f + __expf(-b.x)), 1.f / (1.f + __expf(-b.y))); o.y = pk2(1.f / (1.f + __expf(-b.z)), 1.f / (1.f + __expf(-b.w))); *(uint2*)((bf16*)(F.ws + WS_GB) + (size_t)m * D + col) = o; }
    }
}

__device__ __forceinline__ void ph_gate(Frame& F, int l) {
    const int gw = F.vcu * NWAVES + F.wave, NGW = F.G * NWAVES;
    for (int m = gw; m < M; m += NGW) {
        if (l == DEPTH - 1 && (m % TT) < CTX) continue;
        const bf16* GA = (const bf16*)(F.ws + WS_GA) + (size_t)m * D; const bf16* GB = (const bf16*)(F.ws + WS_GB) + (size_t)m * D;
        const float* T1 = (const float*)(F.ws + WS_T1) + (size_t)m * D; const float* T2 = (const float*)(F.ws + WS_T2) + (size_t)m * D;
        f32x4v h[8];
#pragma unroll
        for (int j = 0; j < 8; ++j) { const int col = 4 * (F.lane + 64 * j); const uint2 a = *(const uint2*)(GA + col), b = *(const uint2*)(GB + col);
            const f32x4v ga = {__builtin_bit_cast(float, a.x << 16), __builtin_bit_cast(float, a.x & 0xffff0000u), __builtin_bit_cast(float, a.y << 16), __builtin_bit_cast(float, a.y & 0xffff0000u)};
            const f32x4v gb = {__builtin_bit_cast(float, b.x << 16), __builtin_bit_cast(float, b.x & 0xffff0000u), __builtin_bit_cast(float, b.y << 16), __builtin_bit_cast(float, b.y & 0xffff0000u)};
            h[j] = ga * *(const f32x4v*)(T1 + col) + gb * *(const f32x4v*)(T2 + col); }
        store_bf16_row((bf16*)(F.ws + WS_MB) + (size_t)m * D, F.lane, h);
    }
}

template <bool ADD_T3, bool DRY>
__device__ __forceinline__ void ph_norm2_router(Frame& F, int l) {
    typedef short bf16x8r __attribute__((ext_vector_type(8)));
    constexpr int HP = 4112;
    LAS unsigned char* hhi = F.lds; LAS unsigned char* hlo = F.lds + 16 * HP;
    float* XW = (float*)(F.ws + WS_XW); bf16* H2 = (bf16*)(F.ws + (DRY ? WS_T2 : WS_HA));
    const float* nw = INP(IN_NFFN) + l * D;
    const bf16* WRH = (const bf16*)(F.ws + WS_WR) + (size_t)(l * 2) * 80 * D; const bf16* WRL = WRH + (size_t)80 * D;
    const int nrows = (l == DEPTH - 1) ? NB * SEQ : M, niter = nrows / 16;
    unsigned* TE = (unsigned*)(F.ws + WS_TOK) + (size_t)l * M * 2; float* TW = (float*)(F.ws + WS_TOK) + (size_t)(4 + l) * M * 2;
    const int w = F.wave, lane = F.lane, fr = lane & 15, fq = lane >> 4;
#if TPROBE >= 100
    unsigned long long tacc1 = 0, tacc3 = 0, tacc5 = 0, tprev = __builtin_amdgcn_s_memrealtime();
#define SUBT(acc_) do { if (blockIdx.x == 0 && F.tid == 0 && l == 0) { const unsigned long long tn_ = __builtin_amdgcn_s_memrealtime(); acc_ += tn_ - tprev; tprev = tn_; } } while (0)
#else
#define SUBT(acc_) do { } while (0)
#endif
    f32x4v vrow[2][8];
#define N2_LOADROWS(it_) do { _Pragma("unroll") for (int rr_ = 0; rr_ < 2; ++rr_) { const int q_ = (it_) * 16 + 2 * w + rr_; const int m_ = (l == DEPTH - 1) ? (q_ / SEQ) * TT + CTX + (q_ % SEQ) : q_; \
        _Pragma("unroll") for (int j = 0; j < 8; ++j) vrow[rr_][j] = *(const f32x4v*)(XW + (size_t)m_ * D + 4 * (lane + 64 * j)); } } while (0)
    if (F.vcu < niter) N2_LOADROWS(F.vcu);
    for (int it = F.vcu; it < niter; it += F.G) {
        __syncthreads();
        if (it != F.vcu) N2_LOADROWS(it);
#pragma unroll
        for (int rr = 0; rr < 2; ++rr) {
            const int lr = 2 * w + rr, q = it * 16 + lr; const int m = (l == DEPTH - 1) ? (q / SEQ) * TT + CTX + (q % SEQ) : q;
            f32x4v v[8];
#pragma unroll
            for (int j = 0; j < 8; ++j) v[j] = vrow[rr][j];
            const float* mod = (const float*)(F.ws + WS_MOD) + (size_t)(l * 5 + mod_row(m)) * MODW;
            if (ADD_T3) { const float* T3 = (const float*)(F.ws + WS_T3) + (size_t)m * D;
#pragma unroll
                for (int j = 0; j < 8; ++j) { const int col = 4 * (lane + 64 * j); v[j] += *(const f32x4v*)(mod + 2 * D + col) * *(const f32x4v*)(T3 + col); *(f32x4v*)(XW + (size_t)m * D + col) = v[j]; } }
            const float rstd = 1.0f / sqrtf(row_sumsq(v) * (1.0f / D) + EPS);
            f32x4v h[8];
#pragma unroll
            for (int j = 0; j < 8; ++j) { const int col = 4 * (lane + 64 * j); const f32x4v ww = *(const f32x4v*)(nw + col), sh = *(const f32x4v*)(mod + 3 * D + col), sc = *(const f32x4v*)(mod + 4 * D + col);
                h[j] = (v[j] * rstd * ww) * (1.0f + sc) + sh;
                const unsigned a0 = f2bf(h[j].x), a1 = f2bf(h[j].y), a2 = f2bf(h[j].z), a3 = f2bf(h[j].w);
                typedef unsigned u32x2r __attribute__((ext_vector_type(2))); u32x2r hi2, lo2; hi2.x = a0 | (a1 << 16); hi2.y = a2 | (a3 << 16);
                lo2.x = f2bf(h[j].x - __builtin_bit_cast(float, a0 << 16)) | (f2bf(h[j].y - __builtin_bit_cast(float, a1 << 16)) << 16);
                lo2.y = f2bf(h[j].z - __builtin_bit_cast(float, a2 << 16)) | (f2bf(h[j].w - __builtin_bit_cast(float, a3 << 16)) << 16);
                *(LAS u32x2r*)(hhi + lr * HP + col * 2) = hi2; *(LAS u32x2r*)(hlo + lr * HP + col * 2) = lo2; }
            store_bf16_row(H2 + (size_t)m * D, lane, h);
        }
        __syncthreads(); SUBT(tacc1);
        {
            pg8::f32x4 acc[5];
#pragma unroll
            for (int cf = 0; cf < 5; ++cf) acc[cf] = (pg8::f32x4){0.f, 0.f, 0.f, 0.f};
            const __amdgpu_buffer_rsrc_t wrs = __builtin_amdgcn_make_buffer_rsrc((void*)WRH, 0, 2 * 80 * D * 2, 0x00020000);
            const unsigned wvo = (unsigned)lane * 16u;
            const LAS unsigned char* ah = hhi + fr * HP + (256 * w + 8 * fq) * 2; const LAS unsigned char* al = hlo + fr * HP + (256 * w + 8 * fq) * 2;
            bf16x8r Wh0[5], Wl0[5], Wh1[5], Wl1[5];
#define RT_LOADW(Wh, Wl, s_) do { _Pragma("unroll") for (int cf = 0; cf < 5; ++cf) { Wh[cf] = __builtin_bit_cast(bf16x8r, __builtin_amdgcn_raw_buffer_load_b128(wrs, wvo, ((8 * w + (s_)) * 5 + cf) * 1024, 0)); Wl[cf] = __builtin_bit_cast(bf16x8r, __builtin_amdgcn_raw_buffer_load_b128(wrs, wvo, ((64 + 8 * w + (s_)) * 5 + cf) * 1024, 0)); } } while (0)
#define RT_MMA(Wh, Wl, s_) do { const bf16x8r Hh = *(const LAS bf16x8r*)(ah + 64 * (s_)), Hl = *(const LAS bf16x8r*)(al + 64 * (s_)); \
            _Pragma("unroll") for (int cf = 0; cf < 5; ++cf) { acc[cf] = __builtin_amdgcn_mfma_f32_16x16x32_bf16(Wh[cf], Hh, acc[cf], 0, 0, 0); \
                acc[cf] = __builtin_amdgcn_mfma_f32_16x16x32_bf16(Wh[cf], Hl, acc[cf], 0, 0, 0); acc[cf] = __builtin_amdgcn_mfma_f32_16x16x32_bf16(Wl[cf], Hh, acc[cf], 0, 0, 0); } } while (0)
            RT_LOADW(Wh0, Wl0, 0);
#pragma unroll
            for (int s2 = 0; s2 < 8; s2 += 2) {
                RT_LOADW(Wh1, Wl1, s2 + 1); RT_MMA(Wh0, Wl0, s2);
                if (s2 + 2 < 8) RT_LOADW(Wh0, Wl0, s2 + 2);
                RT_MMA(Wh1, Wl1, s2 + 1);
            }
#undef RT_LOADW
#undef RT_MMA
            asm volatile("s_waitcnt lgkmcnt(0)" ::: "memory");
#pragma unroll
            for (int cf = 0; cf < 5; ++cf) *(LAS pg8::f32x4*)(hhi + fr * HP + 512 * w + (16 * cf + 4 * fq) * 4) = acc[cf];
        }
        __syncthreads(); SUBT(tacc3);
#pragma unroll 1
        for (int rr = 0; rr < 2; ++rr) {
            const int lr = 2 * w + rr, q = it * 16 + lr; const int m = (l == DEPTH - 1) ? (q / SEQ) * TT + CTX + (q % SEQ) : q;
            LAS float* elb = (LAS float*)(hlo + (2 * w + rr) * HP + 512 * w);
            float el = lane < 64 ? INP(IN_BRE)[l * NE + lane] : 0.f;
#pragma unroll
            for (int k2 = 0; k2 < 8; ++k2) el += *(const LAS float*)(hhi + lr * HP + 512 * k2 + lane * 4);
            elb[lane] = el;
            if (lane < 8) { float gl = INP(IN_BRG)[l * NG + lane];
#pragma unroll
                for (int k2 = 0; k2 < 8; ++k2) gl += *(const LAS float*)(hhi + lr * HP + 512 * k2 + (64 + lane) * 4);
                elb[64 + lane] = gl; }
            LDS_WAIT(); asm volatile("" ::: "memory");
            float gmax = elb[64]; int gi = 0;
#pragma unroll
            for (int i = 1; i < 8; ++i) { const float x = elb[64 + i]; if (x > gmax) { gmax = x; gi = i; } }
            float gs = 0.f;
#pragma unroll
            for (int i = 0; i < 8; ++i) gs += __expf(elb[64 + i] - gmax);
            const float pgv = 1.0f / gs;
            float v1 = elb[gi * 8]; int i1 = 0;
#pragma unroll
            for (int i = 1; i < 8; ++i) { const float x = elb[gi * 8 + i]; if (x > v1) { v1 = x; i1 = i; } }
            float v2 = -3.0e38f; int i2 = 0;
#pragma unroll
            for (int i = 0; i < 8; ++i) { const float x = elb[gi * 8 + i]; if (i != i1 && x > v2) { v2 = x; i2 = i; } }
            const float e2 = __expf(v2 - v1), s1 = 1.0f / (1.0f + e2), s2 = e2 * s1;
            if (lane == 0 && !DRY) {
                const unsigned ea = gi * 8 + i1, eb = gi * 8 + i2;
                TE[m * 2] = ea; TE[m * 2 + 1] = eb; TW[m * 2] = s1 * pgv; TW[m * 2 + 1] = s2 * pgv;
            }
        }
        SUBT(tacc5);
    }
#if TPROBE >= 100
    if (blockIdx.x == 0 && F.tid == 0 && l == 0) { volatile LAS unsigned long long* ts = (volatile LAS unsigned long long*)(F.lds + LDSCTL_OFF + 800); ts[26] = TPROBE == 100 ? tacc1 : TPROBE == 101 ? tacc3 : tacc5; }
#endif
#undef SUBT
}

__device__ __forceinline__ void ph_compact(Frame& F, int l) {
    LAS unsigned* wtot = (LAS unsigned*)(F.lds);
    const unsigned* TE = (const unsigned*)(F.ws + WS_TOK) + (size_t)l * M * 2; unsigned* TP = (unsigned*)(F.ws + WS_TOK) + (size_t)(2 + l) * M * 2;
    unsigned* LIST = (unsigned*)(F.ws + WS_LIST) + (size_t)l * NE * M; unsigned* cnt = (unsigned*)F.ctl + CW_CNT + l * 64;
    constexpr int TPT = M / (NWAVES * 64);
    for (int e = F.vcu; e < NE; e += F.G) {
        const int m0 = F.tid * TPT; unsigned c = 0;
        for (int i = 0; i < TPT; ++i) { const int m = m0 + i; const bool valid = (l < DEPTH - 1) || ((m % TT) >= CTX);
            const uint2 te = *(const uint2*)(TE + 2 * m); c += (valid && te.x == (unsigned)e) ? 1u : 0u; c += (valid && te.y == (unsigned)e) ? 1u : 0u; }
        unsigned v = c;
#pragma unroll
        for (int o = 1; o < 64; o <<= 1) { const unsigned t = __shfl_up(v, o); if (F.lane >= o) v += t; }
        if (F.lane == 63) wtot[F.wave] = v;
        __syncthreads();
        unsigned off = 0, tot = 0;
#pragma unroll
        for (int k2 = 0; k2 < NWAVES; ++k2) { const unsigned x = wtot[k2]; off += (k2 < F.wave) ? x : 0u; tot += x; }
        unsigned pos = off + v - c;
        for (int i = 0; i < TPT; ++i) { const int m = m0 + i; const bool valid = (l < DEPTH - 1) || ((m % TT) >= CTX);
            const uint2 te = *(const uint2*)(TE + 2 * m);
            if (valid && te.x == (unsigned)e) { LIST[(size_t)e * M + pos] = (unsigned)m; TP[2 * m] = pos; ++pos; }
            if (valid && te.y == (unsigned)e) { LIST[(size_t)e * M + pos] = (unsigned)m; TP[2 * m + 1] = pos; ++pos; } }
        if (F.tid == 0) cnt[e] = tot;
        __syncthreads();
    }
}

__device__ __forceinline__ void ph_final(Frame& F) {
    LAS unsigned* base = (LAS unsigned*)(F.lds);
    compute_base((const unsigned*)F.ctl + CW_CNT + (DEPTH - 1) * 64, base, F.tid);
    const int gw = F.vcu * NWAVES + F.wave, NGW = F.G * NWAVES;
    const float* XW = (const float*)(F.ws + WS_XW); const float* nw = INP(IN_NFIN);
    for (int q = gw; q < NB * SEQ; q += NGW) {
        const int m = (q / SEQ) * TT + CTX + (q % SEQ);
        f32x4v v[8];
#pragma unroll
        for (int j = 0; j < 8; ++j) v[j] = *(const f32x4v*)(XW + (size_t)m * D + 4 * (F.lane + 64 * j));
        moe_combine_add(F, DEPTH - 1, m, base, v);
        const float rstd = 1.0f / sqrtf(row_sumsq(v) * (1.0f / D) + EPS);
#pragma unroll
        for (int j = 0; j < 8; ++j) { const int col = 4 * (F.lane + 64 * j); *(f32x4v*)(F.out + (size_t)q * D + col) = v[j] * rstd * *(const f32x4v*)(nw + col); }
    }
}
template <int COLMAP>
__global__ void __launch_bounds__(256) naive_gemm(const bf16* A, int lda, const float* W, int ldw, float* Cc, int ldc, int K) {
    const int n = blockIdx.x * 64 + threadIdx.x, m0 = blockIdx.y * 32 + threadIdx.y * 8;
    const int sc = COLMAP ? inproj_src_col(n) : n;
    float acc[8];
#pragma unroll
    for (int i = 0; i < 8; ++i) acc[i] = 0.f;
    for (int k = 0; k < K; ++k) { const float w = W[(size_t)k * ldw + sc];
#pragma unroll
        for (int i = 0; i < 8; ++i) acc[i] += bf2f(A[(size_t)(m0 + i) * lda + k]) * w; }
#pragma unroll
    for (int i = 0; i < 8; ++i) Cc[(size_t)(m0 + i) * ldc + n] = acc[i];
}

__global__ void __launch_bounds__(256) naive_attn(const bf16* Q, const bf16* K, const bf16* V, bf16* Y, const float* sink, int mode, int with_ctx_q) {
    __shared__ float sc[4][TT]; __shared__ float qs[4][HD];
    const int wave = threadIdx.x >> 6, lane = threadIdx.x & 63;
    const int nq = with_ctx_q ? TT : SEQ; const long item = (long)blockIdx.x * 4 + wave; if (item >= (long)NB * NH * nq) return;
    const int tq = (int)(item % nq) + (with_ctx_q ? 0 : CTX), h = (int)((item / nq) % NH), b = (int)(item / ((long)nq * NH)), kvh = h / (NH / NKV);
    const size_t m = (size_t)b * TT + tq;
    qs[wave][lane] = bf2f(Q[m * QW + h * HD + lane]); qs[wave][lane + 64] = bf2f(Q[m * QW + h * HD + lane + 64]);
    __builtin_amdgcn_wave_barrier(); asm volatile("s_waitcnt lgkmcnt(0)" ::: "memory");
    const bool isctx = tq < CTX; const int nk = isctx ? CTX : TT;
    float mx = -3.0e38f;
    for (int kk = lane; kk < nk; kk += 64) {
        bool valid = true;
        if (mode == 1 && !isctx && kk >= CTX) { const int dq = (tq - CTX) - (kk - CTX); valid = dq <= 128 && dq >= -128; }
        float s = -3.0e38f;
        if (valid) { const bf16* kr = K + ((size_t)b * TT + kk) * KW + kvh * HD; float dsum = 0.f;
            for (int d = 0; d < HD; ++d) dsum += bf2f(kr[d]) * qs[wave][d];
            s = dsum * ATTN_SCALE; }
        sc[wave][kk] = s; mx = fmaxf(mx, s);
    }
    mx = wave_max(mx);
    float sk = 0.f; if (mode == 1) { sk = sink[h]; mx = fmaxf(mx, sk); }
    float sum = 0.f;
    for (int kk = lane; kk < nk; kk += 64) { const float s = sc[wave][kk]; const float p = s > -1.0e38f ? __expf(s - mx) : 0.f; sc[wave][kk] = p; sum += p; }
    sum = wave_sum(sum); if (mode == 1) sum += __expf(sk - mx);
    asm volatile("s_waitcnt lgkmcnt(0)" ::: "memory"); __builtin_amdgcn_wave_barrier();
    float o0 = 0.f, o1 = 0.f;
    for (int kk = 0; kk < nk; ++kk) { const float p = sc[wave][kk]; const bf16* vr = V + ((size_t)b * TT + kk) * KW + kvh * HD; o0 += p * bf2f(vr[lane]); o1 += p * bf2f(vr[lane + 64]); }
    const float inv = 1.0f / sum;
    Y[m * D + h * HD + lane] = (bf16)f2bf(o0 * inv); Y[m * D + h * HD + lane + 64] = (bf16)f2bf(o1 * inv);
}

__global__ void __launch_bounds__(256) naive_moe_up(const bf16* H2, const float* w1, const float* w3, const unsigned* cnt, const unsigned* LIST, bf16* HB) {
    __shared__ unsigned base[65];
    const int tid = threadIdx.y * 64 + threadIdx.x;
    if (tid == 0) { unsigned a = 0; for (int e = 0; e < NE; ++e) { base[e] = a; a += cnt[e]; } base[64] = a; }
    __syncthreads();
    const unsigned slot = blockIdx.y * 4 + threadIdx.y; if (slot >= base[64]) return;
    int e = 0; while (base[e + 1] <= slot) ++e;
    const unsigned tok = LIST[(size_t)e * M + (slot - base[e])];
    const int j = blockIdx.x * 64 + threadIdx.x;
    const float* W1 = w1 + (size_t)e * D * DE + j; const float* W3 = w3 + (size_t)e * D * DE + j; const bf16* x = H2 + (size_t)tok * D;
    float a = 0.f, b = 0.f;
    for (int k = 0; k < D; ++k) { const float xv = bf2f(x[k]); a += xv * W1[(size_t)k * DE]; b += xv * W3[(size_t)k * DE]; }
    HB[(size_t)slot * DE + j] = (bf16)f2bf(a / (1.f + __expf(-a)) * b);
}
__global__ void __launch_bounds__(256) naive_moe_down(const bf16* HB, const float* w2, const unsigned* cnt, bf16* YM) {
    __shared__ unsigned base[65];
    const int tid = threadIdx.y * 64 + threadIdx.x;
    if (tid == 0) { unsigned a = 0; for (int e = 0; e < NE; ++e) { base[e] = a; a += cnt[e]; } base[64] = a; }
    __syncthreads();
    const unsigned slot = blockIdx.y * 4 + threadIdx.y; if (slot >= base[64]) return;
    int e = 0; while (base[e + 1] <= slot) ++e;
    const int col = blockIdx.x * 64 + threadIdx.x;
    const float* W2 = w2 + (size_t)e * DE * D + col; const bf16* hrow = HB + (size_t)slot * DE;
    float a = 0.f;
    for (int k = 0; k < DE; ++k) a += bf2f(hrow[k]) * W2[(size_t)k * D];
    YM[(size_t)slot * D + col] = (bf16)f2bf(a);
}
namespace att {
constexpr int NW = 8, QBLK = 32, KVBLK = 64;
constexpr float THR = 8.f;
constexpr int LDQ = QW, LDK = KW, LDO = D;
constexpr size_t SHM_V = KVBLK * HD * 2, SHM_K = KVBLK * HD * 2, SHM_ATTN = 2 * SHM_V + 2 * SHM_K + NW * 64 * 4;
using bf16x8 = __attribute__((ext_vector_type(8))) short;
using s16x4  = __attribute__((ext_vector_type(4))) short;
using f32x16 = __attribute__((ext_vector_type(16))) float;
using u32x4  = __attribute__((ext_vector_type(4))) unsigned;
#define KSWZ(row, colB) ((row) * 256 + ((colB) ^ (((row) & 7) << 4)))
#define SBAR() __builtin_amdgcn_sched_barrier(0)
__device__ __forceinline__ int crow(int r, int hi) { return (r & 3) + 8 * (r >> 2) + 4 * hi; }
__device__ __forceinline__ unsigned cvtpk(float lo, float hi) { unsigned r; asm volatile("v_cvt_pk_bf16_f32 %0, %1, %2" : "=v"(r) : "v"(lo), "v"(hi)); return r; }
__device__ __forceinline__ void partialSM(f32x16& p0, f32x16& p1, float& m_reg, float& mn, float& alpha) {
  constexpr float C = ATTN_SCALE * 1.4426950408889634f;
  float pmax = p0[0]; for (int r = 1; r < 16; ++r) pmax = fmaxf(pmax, p0[r]); for (int r = 0; r < 16; ++r) pmax = fmaxf(pmax, p1[r]);
  { auto rr = __builtin_amdgcn_permlane32_swap(__float_as_uint(pmax), __float_as_uint(pmax), false, false);
    pmax = fmaxf(__uint_as_float(rr[0]), __uint_as_float(rr[1])); }
  if (__builtin_expect(__all(pmax - m_reg <= THR / ATTN_SCALE), 1)) { mn = m_reg; alpha = 1.f; }
  else { mn = fmaxf(m_reg, pmax); alpha = __builtin_amdgcn_exp2f((m_reg - mn) * C); m_reg = mn; }
  float mnC = -mn * C;
  for (int r = 0; r < 16; ++r) p0[r] = fmaf(p0[r], C, mnC); for (int r = 0; r < 16; ++r) p1[r] = fmaf(p1[r], C, mnC);
  for (int r = 0; r < 16; ++r) p0[r] = __builtin_amdgcn_exp2f(p0[r]);
}
__device__ __forceinline__ void finishSM(f32x16& p0, f32x16& p1, float alpha, float& l_reg, bf16x8& pa0, bf16x8& pa1, bf16x8& pa2, bf16x8& pa3) {
  for (int r = 0; r < 16; ++r) p1[r] = __builtin_amdgcn_exp2f(p1[r]);
  float ps = 0; for (int r = 0; r < 16; ++r) ps += p0[r]; for (int r = 0; r < 16; ++r) ps += p1[r];
  { auto rr = __builtin_amdgcn_permlane32_swap(__float_as_uint(ps), __float_as_uint(ps), false, false);
    ps = __uint_as_float(rr[0]) + __uint_as_float(rr[1]); }
  l_reg = l_reg * alpha + ps;
#define PK4(P, BASE, OUT) do { unsigned a0 = cvtpk(P[BASE + 0], P[BASE + 1]), a1 = cvtpk(P[BASE + 2], P[BASE + 3]);   \
    unsigned b0 = cvtpk(P[BASE + 4], P[BASE + 5]), b1 = cvtpk(P[BASE + 6], P[BASE + 7]);                              \
    auto r0 = __builtin_amdgcn_permlane32_swap(a0, b0, false, false); auto r1 = __builtin_amdgcn_permlane32_swap(a1, b1, false, false); \
    u32x4 w = {r0[0], r1[0], r0[1], r1[1]}; OUT = *reinterpret_cast<bf16x8*>(&w); } while (0)
  PK4(p0, 0, pa0); PK4(p0, 8, pa1); PK4(p1, 0, pa2); PK4(p1, 8, pa3);
#undef PK4
}
__device__ __forceinline__ void qkt(f32x16& p0, f32x16& p1, const bf16* Ks, const bf16x8* qr, int r32, int hi) {
  p0 = f32x16{}; p1 = f32x16{};
  for (int d0 = 0; d0 < 8; ++d0) { int cb = (d0 * 16 + hi * 8) * 2;
    bf16x8 b0 = *reinterpret_cast<const bf16x8*>((const char*)Ks + KSWZ(r32, cb));
    bf16x8 b1 = *reinterpret_cast<const bf16x8*>((const char*)Ks + KSWZ(32 + r32, cb));
    p0 = __builtin_amdgcn_mfma_f32_32x32x16_bf16(b0, qr[d0], p0, 0, 0, 0);
    p1 = __builtin_amdgcn_mfma_f32_32x32x16_bf16(b1, qr[d0], p1, 0, 0, 0); }
}
__device__ __forceinline__ void wmask(f32x16& p0, f32x16& p1, int kb, int qpos, int hi) {
  const float NEG = -1.0e30f; const int d0 = kb + 4 * hi - qpos;
#pragma unroll
  for (int r = 0; r < 16; ++r) { const int dd = d0 + (r & 3) + 8 * (r >> 2); if (dd > 128 || dd < -128) p0[r] = NEG; if (dd + 32 > 128 || dd + 32 < -128) p1[r] = NEG; }
}
__device__ __forceinline__ int v_st(int k, int c) { const int kk = (k & ~0xC) | ((k & 4) << 1) | ((k & 8) >> 1); return ((kk >> 3) * 4 + (c >> 5)) * 512 + ((kk & 7) * 32 + (c & 31)) * 2; }
__device__ __forceinline__ int v_rd_base(int lane) { return ((lane & 3) << 3) | (((lane >> 2) & 3) << 6) | (((lane >> 4) & 1) << 5) | (((lane >> 5) & 1) << 8); }
constexpr int v_rd_off(int d0, int ks, int half) { return d0 * 512 + ks * 4096 + half * 2048; }
template <int OFF> __device__ __forceinline__ s16x4 tr_read(int vb) {
  s16x4 r; asm volatile("ds_read_b64_tr_b16 %0, %1 offset:%2" : "=&v"(r) : "v"(vb), "i"(OFF) : "memory"); return r;
}
template <int D0> __device__ __forceinline__ void pv_one(f32x16& od, int vb, bf16x8 pa0, bf16x8 pa1, bf16x8 pa2, bf16x8 pa3) {
  const s16x4 l0 = tr_read<v_rd_off(D0, 0, 0)>(vb), h0 = tr_read<v_rd_off(D0, 0, 1)>(vb), l1 = tr_read<v_rd_off(D0, 1, 0)>(vb), h1 = tr_read<v_rd_off(D0, 1, 1)>(vb);
  const s16x4 l2 = tr_read<v_rd_off(D0, 2, 0)>(vb), h2 = tr_read<v_rd_off(D0, 2, 1)>(vb), l3 = tr_read<v_rd_off(D0, 3, 0)>(vb), h3 = tr_read<v_rd_off(D0, 3, 1)>(vb);
  asm volatile("s_waitcnt lgkmcnt(0)" ::: "memory"); SBAR();
#define PK(L, H) (bf16x8){L[0], L[1], L[2], L[3], H[0], H[1], H[2], H[3]}
  od = __builtin_amdgcn_mfma_f32_32x32x16_bf16(pa0, PK(l0, h0), od, 0, 0, 0);
  od = __builtin_amdgcn_mfma_f32_32x32x16_bf16(pa1, PK(l1, h1), od, 0, 0, 0);
  od = __builtin_amdgcn_mfma_f32_32x32x16_bf16(pa2, PK(l2, h2), od, 0, 0, 0);
  od = __builtin_amdgcn_mfma_f32_32x32x16_bf16(pa3, PK(l3, h3), od, 0, 0, 0);
#undef PK
}
__device__ __forceinline__ void pv_d0(f32x16* o, int vb, bf16x8 pa0, bf16x8 pa1, bf16x8 pa2, bf16x8 pa3) {
  pv_one<0>(o[0], vb, pa0, pa1, pa2, pa3); pv_one<1>(o[1], vb, pa0, pa1, pa2, pa3); pv_one<2>(o[2], vb, pa0, pa1, pa2, pa3); pv_one<3>(o[3], vb, pa0, pa1, pa2, pa3);
}
__device__ __forceinline__ void attn_unit(const bool MASKED, const bf16* __restrict__ Qb, const bf16* __restrict__ Kh, const bf16* __restrict__ Vh, bf16* __restrict__ Ob,
                                          int NT, int klo, int q0, float m0, float l0, char* lds) {
  const int tid = threadIdx.x, wid = tid >> 6, lane = tid & 63, r32 = lane & 31, hi = lane >> 5;
  bf16* V_lds = (bf16*)lds; bf16* K_lds = (bf16*)(lds + 2 * SHM_V);
  float* ws = (float*)(lds + 2 * SHM_V + 2 * SHM_K) + wid * 64; float* li_l = ws; float* al_l = ws + 32;
  float m_reg = m0, l_reg = l0; f32x16 o[4] = {}; bf16x8 qr[8];
  const bf16* Qw = Qb + (long)(wid * QBLK + r32) * LDQ + hi * 8;
#pragma unroll
  for (int d0 = 0; d0 < 8; ++d0) qr[d0] = *reinterpret_cast<const bf16x8*>(Qw + d0 * 16);
  const int sr = tid >> 4, sc = (tid & 15) * 8, vst0 = v_st(sr, sc), vst1 = v_st(32 + sr, sc);
  const int vb0 = (int)(uintptr_t)V_lds + v_rd_base(lane);
  const int qpos = q0 + wid * QBLK + r32;
  struct { bf16x8 vs0, vs1, ks0, ks1; } sr_[2];
#define KROW(j) ((!MASKED || (j) < 4) ? 64 * (j) : CTX + klo + 64 * ((j) - 4))
#define SLOAD(i, j) do { const int k0_ = KROW(j); sr_[i].vs0 = *reinterpret_cast<const bf16x8*>(&Vh[(long)(k0_ + sr) * LDK + sc]); sr_[i].vs1 = *reinterpret_cast<const bf16x8*>(&Vh[(long)(k0_ + 32 + sr) * LDK + sc]); \
    sr_[i].ks0 = *reinterpret_cast<const bf16x8*>(&Kh[(long)(k0_ + sr) * LDK + sc]); sr_[i].ks1 = *reinterpret_cast<const bf16x8*>(&Kh[(long)(k0_ + 32 + sr) * LDK + sc]); } while (0)
#define SWRITE(b, i) do { *(bf16x8*)((char*)V_lds + (b) * SHM_V + vst0) = sr_[i].vs0;          \
    *(bf16x8*)((char*)V_lds + (b) * SHM_V + vst1) = sr_[i].vs1; int kc = sc * 2;               \
    *(bf16x8*)((char*)K_lds + (b) * SHM_K + KSWZ(sr, kc)) = sr_[i].ks0;                       \
    *(bf16x8*)((char*)K_lds + (b) * SHM_K + KSWZ(32 + sr, kc)) = sr_[i].ks1; } while (0)
#define SWAIT() asm volatile("s_waitcnt vmcnt(4)" ::: "memory")
#define RESC(a) do { if (__any((a) < 1.f)) { if (hi == 0) al_l[r32] = (a); asm volatile("s_waitcnt lgkmcnt(0)" ::: "memory"); \
    for (int d = 0; d < 4; ++d) for (int r = 0; r < 16; ++r) o[d][r] *= al_l[crow(r, hi)]; } } while (0)
#define WMASK(P0, P1, j) do { if (MASKED && (j) >= 4) wmask(P0, P1, klo + 64 * ((j) - 4), qpos, hi); } while (0)
  f32x16 pA0, pA1, pB0, pB1; float mnA, mnB, alA, alB; bf16x8 pa0, pa1, pa2, pa3;
  constexpr int SE = 0, SO = 1;
  __syncthreads();
  SLOAD(SE, 0); asm volatile("s_waitcnt vmcnt(0)" ::: "memory"); SWRITE(0, SE); __syncthreads();
  qkt(pA0, pA1, K_lds, qr, r32, hi); WMASK(pA0, pA1, 0); partialSM(pA0, pA1, m_reg, mnA, alA);
  SLOAD(SO, 1); if (2 < NT) SLOAD(SE, 2);
  SWAIT(); SWRITE(1, SO); __syncthreads();
  for (int j = 1; j + 1 < NT; j += 2) {
    SBAR(); qkt(pB0, pB1, (bf16*)((char*)K_lds + SHM_K), qr, r32, hi); WMASK(pB0, pB1, j);
    finishSM(pA0, pA1, alA, l_reg, pa0, pa1, pa2, pa3); SBAR();
    SLOAD(SO, j + 2); SBAR();
    pv_d0(o, vb0, pa0, pa1, pa2, pa3); partialSM(pB0, pB1, m_reg, mnB, alB);
    __syncthreads(); SWAIT(); SWRITE(0, SE);
    RESC(alB); __syncthreads();
    SBAR(); qkt(pA0, pA1, K_lds, qr, r32, hi); WMASK(pA0, pA1, j + 1);
    finishSM(pB0, pB1, alB, l_reg, pa0, pa1, pa2, pa3); SBAR();
    if (j + 3 < NT) SLOAD(SE, j + 3); SBAR();
    pv_d0(o, vb0 + (int)SHM_V, pa0, pa1, pa2, pa3); partialSM(pA0, pA1, m_reg, mnA, alA);
    __syncthreads(); SWAIT(); SWRITE(1, SO);
    RESC(alA); __syncthreads();
  }
  SBAR(); qkt(pB0, pB1, (bf16*)((char*)K_lds + SHM_K), qr, r32, hi); WMASK(pB0, pB1, NT - 1);
  finishSM(pA0, pA1, alA, l_reg, pa0, pa1, pa2, pa3); SBAR();
  pv_d0(o, vb0, pa0, pa1, pa2, pa3); partialSM(pB0, pB1, m_reg, mnB, alB);
  __syncthreads(); RESC(alB);
  finishSM(pB0, pB1, alB, l_reg, pa0, pa1, pa2, pa3); SBAR();
  pv_d0(o, vb0 + (int)SHM_V, pa0, pa1, pa2, pa3);
  if (hi == 0) li_l[r32] = l_reg; asm volatile("s_waitcnt lgkmcnt(0)" ::: "memory");
  float rli[16];
#pragma unroll
  for (int r = 0; r < 16; ++r) rli[r] = __builtin_amdgcn_rcpf(li_l[crow(r, hi)]);
  bf16* Ow = Ob + (long)(wid * QBLK) * LDO;
#pragma unroll
  for (int r = 0; r < 16; ++r) { int orow = crow(r, hi);
    for (int d0 = 0; d0 < 4; ++d0) Ow[(long)orow * LDO + d0 * 32 + r32] = (bf16)f2bf(o[d0][r] * rli[r]); }
#undef KROW
#undef SLOAD
#undef SWRITE
#undef SWAIT
#undef RESC
#undef WMASK
}
#undef KSWZ
#undef SBAR
}

__device__ __forceinline__ void fast_attn(Frame& F, int l) {
    char* lds = (char*)F.lds;
    const int nsub = (l < DEPTH - 1) ? 3 : 2;
    for (int u = (int)blockIdx.x; u < 256; u += F.G) {
        const int x = u & 7, y = u >> 3, b = x >> 1, kvh = x & 1, g = y >> 3, qb = y & 7, h = kvh * 4 + g;
        for (int s = 0; s < nsub; ++s) {
            if (s == 2 && qb != 0 && qb != 7) break;
            const bool mixB = (s == 1) || (s == 2 && qb == 7), ctxq = (s == 2);
            const size_t brow = (size_t)b * TT, qrow = ctxq ? brow : brow + CTX + 256 * qb;
            const bf16* Qp = (const bf16*)(F.ws + (mixB ? WS_QB : WS_QA)) + qrow * QW + h * HD;
            const bf16* Kp = (const bf16*)(F.ws + (mixB ? WS_KB : WS_KA)) + brow * KW + kvh * HD;
            const bf16* Vp = (const bf16*)(F.ws + (mixB ? WS_VB : WS_VA)) + brow * KW + kvh * HD;
            bf16* Op = (bf16*)(F.ws + WS_YAB) + qrow * D + (mixB ? QW : 0) + h * HD;
            const int q0 = 256 * qb, klo = q0 - 128 < 0 ? 0 : q0 - 128, khi = q0 + 384 > SEQ ? SEQ : q0 + 384;
            const int NT = ctxq ? CTX / 64 : (s == 0 ? TT / 64 : 4 + (khi - klo) / 64);
            const float m0 = mixB ? INP(IN_SINK)[l * NH + h] * (1.0f / ATTN_SCALE) : -1.0e30f, l0 = mixB ? 1.f : 0.f;
            att::attn_unit(s == 1, Qp, Kp, Vp, Op, NT, klo, q0, m0, l0, lds);
        }
    }
}
namespace moe {
typedef unsigned u32x4 __attribute__((ext_vector_type(4)));
using pg8::bf16x8; using pg8::f32x4;
#ifndef MOE_CAPT
#define MOE_CAPT 576
#endif
constexpr int CAPT = MOE_CAPT;
constexpr int B_STAGE = 16384, CAP = 576, NMF = CAP / 32, GS = 3, NGRP = NMF / GS;
static_assert(2 * (CAP / 16) * 1024 + 4 * B_STAGE <= LDSCTL_OFF && NGRP == 6, "MoE LDS map / group nest");
__device__ __forceinline__ void wait_vm1(int n) {
    switch (n) { case 0: asm volatile("s_waitcnt vmcnt(0)" ::: "memory"); break; case 1: asm volatile("s_waitcnt vmcnt(1)" ::: "memory"); break; case 2: asm volatile("s_waitcnt vmcnt(2)" ::: "memory"); break;
                 case 3: asm volatile("s_waitcnt vmcnt(3)" ::: "memory"); break; case 4: asm volatile("s_waitcnt vmcnt(4)" ::: "memory"); break; case 5: asm volatile("s_waitcnt vmcnt(5)" ::: "memory"); break;
                 case 6: asm volatile("s_waitcnt vmcnt(6)" ::: "memory"); break; default: asm volatile("s_waitcnt vmcnt(7)" ::: "memory"); break; }
}
__device__ __forceinline__ void wait_vm8(int n) {
    switch (n) { case 0: asm volatile("s_waitcnt vmcnt(0)" ::: "memory"); break; case 1: asm volatile("s_waitcnt vmcnt(8)" ::: "memory"); break; case 2: asm volatile("s_waitcnt vmcnt(16)" ::: "memory"); break;
                 case 3: asm volatile("s_waitcnt vmcnt(24)" ::: "memory"); break; case 4: asm volatile("s_waitcnt vmcnt(32)" ::: "memory"); break; case 5: asm volatile("s_waitcnt vmcnt(40)" ::: "memory"); break; default: asm volatile("s_waitcnt vmcnt(48)" ::: "memory"); break; }
}
__device__ __forceinline__ unsigned cvt_pk(float lo, float hi) { unsigned r; asm volatile("v_cvt_pk_bf16_f32 %0, %1, %2" : "=v"(r) : "v"(lo), "v"(hi)); return r; }
__device__ __forceinline__ int swz(int ob) { return ob ^ (((ob >> 9) & 1) << 5); }

template <int MODE>
__device__ __forceinline__ void moe_phase(Frame& F, int l) {
    LAS unsigned char* lds = F.lds;
    LAS unsigned* base = (LAS unsigned*)(F.lds + LDSCTL_OFF + 512);
    const unsigned* cnt = (const unsigned*)F.ctl + CW_CNT + l * 64;
    compute_base(cnt, base, F.tid);
    LAS unsigned char* order = (LAS unsigned char*)(F.lds + LDSCTL_OFF + 512 + 272);
    if (F.tid < NE) { const unsigned c = base[F.tid + 1] - base[F.tid]; int rank = 0;
        for (int e2 = 0; e2 < NE; ++e2) { const unsigned c2 = base[e2 + 1] - base[e2]; rank += (c2 > c || (c2 == c && e2 < F.tid)) ? 1 : 0; }
        order[rank] = (unsigned char)F.tid; }
    __syncthreads();
    constexpr int NCS = MODE == 0 ? 8 : 16, K = MODE == 0 ? D : DE, NT = K / 32, LDW = MODE == 0 ? DE : D, BKS = MODE == 0 ? 256 : 512;
    const int wid = F.wave, lane = F.lane, wr = wid >> 2, wc = wid & 3, fr = lane & 15, fq = lane >> 4;
    const int afo = swz(fr * 64 + fq * 16);
    const int sb = swz(lane * 16), drow = sb >> 6, dk = (sb & 63) >> 1;
    int bro[2];
#pragma unroll
    for (int j = 0; j < 2; ++j) bro[j] = (MODE == 0) ? j * 8192 + ((8 * fq) * 64 + 16 * wc + fr) * 4 : ((8 * fq) * 128 + 32 * wc + 16 * j + fr) * 4;
    const int bw = wid - 6;
    const unsigned bvo = (MODE == 0) ? (unsigned)((lane >> 4) * LDW + (lane & 15) * 4) * 4u : (unsigned)((lane >> 5) * LDW + (lane & 31) * 4) * 4u;
    const unsigned* LISTl = (const unsigned*)(F.ws + WS_LIST) + (size_t)l * NE * M;
    const __amdgpu_buffer_rsrc_t ars = __builtin_amdgcn_make_buffer_rsrc((void*)(F.ws + (MODE == 0 ? WS_HA : WS_HB)), 0, 0x7ffffff0, 0x00020000);
    constexpr int UREP = (REPMASK & (MODE == 0 ? (1 << 8) : (1 << 9))) ? 2 : 1;
    for (int u2 = F.vcu; u2 < UREP * NE * NCS; u2 += F.G) {
        const int u = u2 % (NE * NCS); const int cs = u % NCS; const bool rep = (UREP > 1) && (u2 >= NE * NCS);
        const int uq = u / NCS; int rnk;
        if (F.G * NCS >= NE * NCS / 2 && NE * NCS / F.G == 2) { const int slot = uq % (NE / 2), i = uq / (NE / 2); rnk = i == 0 ? slot : NE - 1 - slot; }
        else if (NE * NCS / F.G == 4 && NE % 4 == 0) { const int slot = uq % (NE / 4), i = uq / (NE / 4); rnk = i == 0 ? slot : i == 1 ? NE / 2 - 1 - slot : i == 2 ? NE / 2 + slot : NE - 1 - slot; }
        else rnk = uq;
        const int e = (int)order[rnk];
        const int n_e = (int)(base[e + 1] - base[e]), base_e = (int)base[e];
        const float* wbase;
        if (MODE == 0) wbase = ((bw == 1) ? INP(IN_W3) : INP(IN_W1)) + ((size_t)(l * NE + e) * D) * DE + 64 * cs;
        else           wbase = INP(IN_W2) + ((size_t)(l * NE + e) * DE) * D + 128 * cs + (size_t)(bw == 1 ? 16 : 0) * D;
        unsigned wlo_v = (unsigned)(unsigned long long)wbase, whi_v = (unsigned)((unsigned long long)wbase >> 32);
        asm volatile("" : "+v"(wlo_v), "+v"(whi_v));
        for (int r0 = 0; r0 < n_e; r0 += CAPT) {
            const int nrows = (n_e - r0) < CAPT ? (n_e - r0) : CAPT, nsub = (nrows + 15) >> 4;
            const int asz = nsub * 1024; const int na = (3 * asz + 6 * B_STAGE <= LDSCTL_OFF) ? 3 : 2;
            const int boff = na * asz; int nstg = (LDSCTL_OFF - boff) / B_STAGE; nstg = nstg > 8 ? 8 : nstg;
            int naw = 0;
#pragma unroll
            for (int j = 0; j < 7; ++j) naw += (wid + 6 * j < nsub) ? 1 : 0;
            unsigned aof[7];
#pragma unroll
            for (int j = 0; j < 7; ++j) { const int sx = wid + 6 * j; int r = 16 * sx + drow; if (r >= nrows) r = 0;
                if (MODE == 0) aof[j] = LISTl[(size_t)e * M + r0 + r] * (unsigned)(D * 2) + (unsigned)dk * 2u;
                else           aof[j] = (unsigned)(base_e + r0 + r) * (unsigned)(DE * 2) + (unsigned)dk * 2u; }
            f32x4 acc[NMF][2];
#pragma unroll
            for (int m = 0; m < NMF; ++m)
#pragma unroll
                for (int n = 0; n < 2; ++n) acc[m][n] = (f32x4){0.f, 0.f, 0.f, 0.f};
#define MOE_DMA_A(t, b) do { _Pragma("unroll") for (int j_ = 0; j_ < 7; ++j_) { const int s_ = wid + 6 * j_; if (s_ < nsub) \
        __builtin_amdgcn_raw_ptr_buffer_load_lds(ars, (LAS void*)(lds + (b) * asz + s_ * 1024), 16, aof[j_], (t) * 64, 0, 0); } } while (0)
#define MOE_DMA_B(t) do { unsigned lo_, hi_; asm volatile("v_readfirstlane_b32 %0, %2\n\tv_readfirstlane_b32 %1, %3" : "=s"(lo_), "=s"(hi_) : "v"(wlo_v), "v"(whi_v)); \
        const __amdgpu_buffer_rsrc_t wrs_ = __builtin_amdgcn_make_buffer_rsrc((void*)(((unsigned long long)hi_ << 32) | lo_), 0, 0x7ffffff0, 0x00020000); \
        LAS unsigned char* bst_ = lds + boff + ((t) % nstg) * B_STAGE + bw * 8192; \
        _Pragma("unroll") for (int i_ = 0; i_ < 8; ++i_) __builtin_amdgcn_raw_ptr_buffer_load_lds(wrs_, (LAS void*)(bst_ + i_ * 1024), 16, bvo, ((t) * 32 + (MODE == 0 ? 4 : 2) * i_) * (LDW * 4), 0, 2); } while (0)
#define MOE_DMA_BS(t, slot) do { unsigned lo_, hi_; asm volatile("v_readfirstlane_b32 %0, %2\n\tv_readfirstlane_b32 %1, %3" : "=s"(lo_), "=s"(hi_) : "v"(wlo_v), "v"(whi_v)); \
        const __amdgpu_buffer_rsrc_t wrs_ = __builtin_amdgcn_make_buffer_rsrc((void*)(((unsigned long long)hi_ << 32) | lo_), 0, 0x7ffffff0, 0x00020000); \
        LAS unsigned char* bst_ = lds + boff + (slot) * B_STAGE + bw * 8192; \
        _Pragma("unroll") for (int i_ = 0; i_ < 8; ++i_) __builtin_amdgcn_raw_ptr_buffer_load_lds(wrs_, (LAS void*)(bst_ + i_ * 1024), 16, bvo, ((t) * 32 + (MODE == 0 ? 4 : 2) * i_) * (LDW * 4), 0, 2); } while (0)
#define MOE_LDA(dst, g_) do { _Pragma("unroll") for (int q_ = 0; q_ < GS; ++q_) dst[q_] = *(const LAS bf16x8*)(Ab + (2 * (GS * (g_) + q_) + wr) * 1024 + afo); } while (0)
#define MOE_MMA(src, g_) do { _Pragma("unroll") for (int q_ = 0; q_ < GS; ++q_) _Pragma("unroll") for (int j_ = 0; j_ < 2; ++j_) \
        acc[GS * (g_) + q_][j_] = __builtin_amdgcn_mfma_f32_16x16x32_bf16(Bf[j_], src[q_], acc[GS * (g_) + q_][j_], 0, 0, 0); } while (0)
            asm volatile("s_waitcnt vmcnt(0) lgkmcnt(0)" ::: "memory"); __builtin_amdgcn_s_barrier(); asm volatile("" ::: "memory");
            if (wid < 6) { MOE_DMA_A(0, 0); if (na == 3 && NT > 1) MOE_DMA_A(1, 1); }
            else { for (int p = 0; p < nstg - 1 && p < NT; ++p) MOE_DMA_B(p); }
            const int ngrp = (nsub - wr + 2 * GS - 1) / (2 * GS);
            int abuf = 0, bslot = 0;
            for (int t = 0; t < NT; ++t) {
                if (wid < 6) { if (na == 3 && t + 1 < NT) wait_vm1(naw); else asm volatile("s_waitcnt vmcnt(0)" ::: "memory"); }
                else { const int rem = NT - 1 - t; wait_vm8(rem < nstg - 2 ? rem : nstg - 2); }
                asm volatile("s_waitcnt lgkmcnt(0)" ::: "memory"); __builtin_amdgcn_s_barrier(); asm volatile("" ::: "memory");
                if (wid < 6) { if (t + na - 1 < NT) { int nb = abuf + na - 1; nb = nb >= na ? nb - na : nb; MOE_DMA_A(t + na - 1, nb); } }
                else { if (t + nstg - 1 < NT) { int ns = bslot + nstg - 1; ns = ns >= nstg ? ns - nstg : ns; MOE_DMA_BS(t + nstg - 1, ns); } }
                const LAS unsigned char* Ab = lds + abuf * asz; const LAS unsigned char* Bb = lds + boff + bslot * B_STAGE;
                abuf = (abuf + 1 == na) ? 0 : abuf + 1; bslot = (bslot + 1 == nstg) ? 0 : bslot + 1;
                bf16x8 At0[GS], At1[GS], Bf[2]; float w0[8], w1[8];
#pragma unroll
                for (int i = 0; i < 8; ++i) w0[i] = *(const LAS float*)(Bb + bro[0] + i * BKS);
#pragma unroll
                for (int i = 0; i < 8; ++i) w1[i] = *(const LAS float*)(Bb + bro[1] + i * BKS);
                MOE_LDA(At0, 0);
                __builtin_amdgcn_sched_barrier(0);
                { u32x4 p; p.x = cvt_pk(w0[0], w0[1]); p.y = cvt_pk(w0[2], w0[3]); p.z = cvt_pk(w0[4], w0[5]); p.w = cvt_pk(w0[6], w0[7]); Bf[0] = __builtin_bit_cast(bf16x8, p);
                  p.x = cvt_pk(w1[0], w1[1]); p.y = cvt_pk(w1[2], w1[3]); p.z = cvt_pk(w1[4], w1[5]); p.w = cvt_pk(w1[6], w1[7]); Bf[1] = __builtin_bit_cast(bf16x8, p); }
                __builtin_amdgcn_sched_barrier(0);
                if (ngrp > 1) MOE_LDA(At1, 1);
                MOE_MMA(At0, 0);
                if (ngrp > 1) { if (ngrp > 2) MOE_LDA(At0, 2); MOE_MMA(At1, 1);
                    if (ngrp > 2) { if (ngrp > 3) MOE_LDA(At1, 3); MOE_MMA(At0, 2);
                        if (ngrp > 3) { if (ngrp > 4) MOE_LDA(At0, 4); MOE_MMA(At1, 3);
                            if (ngrp > 4) { if (ngrp > 5) MOE_LDA(At1, 5); MOE_MMA(At0, 4);
                                if (ngrp > 5) MOE_MMA(At1, 5); } } } }
            }
#pragma unroll
            for (int m = 0; m < NMF; ++m) { const int row = 16 * (2 * m + wr) + fr;
                if (row < nrows && !rep) {
                    if (MODE == 0) { const f32x4 x = acc[m][0], y = acc[m][1]; uint2 o;
                        o.x = cvt_pk(x[0] / (1.f + __expf(-x[0])) * y[0], x[1] / (1.f + __expf(-x[1])) * y[1]); o.y = cvt_pk(x[2] / (1.f + __expf(-x[2])) * y[2], x[3] / (1.f + __expf(-x[3])) * y[3]);
                        *(uint2*)((bf16*)(F.ws + WS_HB) + (size_t)(base_e + r0 + row) * DE + 64 * cs + 16 * wc + 4 * fq) = o;
                    } else {
#pragma unroll
                        for (int n = 0; n < 2; ++n) { const f32x4 x = acc[m][n]; uint2 o; o.x = cvt_pk(x[0], x[1]); o.y = cvt_pk(x[2], x[3]);
                            *(uint2*)((bf16*)(F.ws + WS_YM) + (size_t)(base_e + r0 + row) * D + 128 * cs + 32 * wc + 16 * n + 4 * fq) = o; }
                    }
                } }
        }
    }
    asm volatile("s_waitcnt vmcnt(0) lgkmcnt(0)" ::: "memory"); __syncthreads();
#undef MOE_DMA_A
#undef MOE_DMA_B
#undef MOE_DMA_BS
#undef MOE_LDA
#undef MOE_MMA
}
}
__device__ __forceinline__ void fast_moe_up(Frame& F, int l) { moe::moe_phase<0>(F, l); }
__device__ __forceinline__ void fast_moe_down(Frame& F, int l) { moe::moe_phase<1>(F, l); }
struct RowOrder {
    pg8::StaticOrder so; bool latent_only;
    __device__ void init(bool lat, int N, int G, int c) { latent_only = lat; so.init(lat ? NB * SEQ : M, N, G, c); }
    __device__ bool next(int i, pg8::Unit& u) const { if (!so.next(i, u)) return false; if (latent_only) u.pm = (u.pm >> 3) * 9 + 1 + (u.pm & 7); return true; }
    __device__ __forceinline__ void a_ready(const pg8::Unit&) const {}
    __device__ __forceinline__ void done(const pg8::Unit&) const {}
};
struct EpiF32 {
    static constexpr int MIDK = 0; static constexpr bool PERM = false, AFTER_DRAIN = false;
    float* O; int ldc;
    __device__ __forceinline__ void operator()(const pg8::f32x4 (&acc)[2][2][4][2], const pg8::Unit& u, int wr, int wc, int fr, int fq) const {
        const int row0 = u.pm * 256 + wr * 64 + fr, col0 = u.pn * 256 + wc * 32 + 4 * fq;
#pragma unroll
        for (int ai = 0; ai < 2; ++ai)
#pragma unroll
            for (int m = 0; m < 4; ++m) { float* rowp = O + (size_t)(row0 + ai * 128 + m * 16) * ldc + col0;
#pragma unroll
                for (int bj = 0; bj < 2; ++bj)
#pragma unroll
                    for (int n = 0; n < 2; ++n) *(pg8::f32x4*)(rowp + bj * 128 + n * 16) = acc[ai][bj][m][n]; }
    }
};
template <int PASS>
struct EpiGate {
    static constexpr int MIDK = 0; static constexpr bool PERM = false, AFTER_DRAIN = false;
    const bf16* G; bf16* O;
    __device__ __forceinline__ void operator()(const pg8::f32x4 (&acc)[2][2][4][2], const pg8::Unit& u, int wr, int wc, int fr, int fq) const {
        asm volatile("" : "+v"(fr), "+v"(fq));
        const int row0 = u.pm * 256 + wr * 64 + fr, col0 = u.pn * 256 + wc * 32 + 4 * fq;
#pragma unroll
        for (int ai = 0; ai < 2; ++ai) {
            uint2 gv[4][2][2], tv[4][2][2];
#pragma unroll
            for (int m = 0; m < 4; ++m) { const size_t off = (size_t)(row0 + ai * 128 + m * 16) * D + col0;
#pragma unroll
                for (int bj = 0; bj < 2; ++bj)
#pragma unroll
                    for (int n = 0; n < 2; ++n) { gv[m][bj][n] = *(const uint2*)(G + off + bj * 128 + n * 16); if (PASS == 2) tv[m][bj][n] = *(const uint2*)(O + off + bj * 128 + n * 16); } }
#pragma unroll
            for (int m = 0; m < 4; ++m) { const size_t off = (size_t)(row0 + ai * 128 + m * 16) * D + col0;
#pragma unroll
                for (int bj = 0; bj < 2; ++bj)
#pragma unroll
                    for (int n = 0; n < 2; ++n) { const uint2 g2 = gv[m][bj][n];
                        pg8::f32x4 g = {__builtin_bit_cast(float, g2.x << 16), __builtin_bit_cast(float, g2.x & 0xffff0000u), __builtin_bit_cast(float, g2.y << 16), __builtin_bit_cast(float, g2.y & 0xffff0000u)};
                        pg8::f32x4 v = g * acc[ai][bj][m][n];
                        if (PASS == 2) { const uint2 t2 = tv[m][bj][n];
                            v += (pg8::f32x4){__builtin_bit_cast(float, t2.x << 16), __builtin_bit_cast(float, t2.x & 0xffff0000u), __builtin_bit_cast(float, t2.y << 16), __builtin_bit_cast(float, t2.y & 0xffff0000u)}; }
                        uint2 o; o.x = pg8::cvt_pk_bf16(v[0], v[1]); o.y = pg8::cvt_pk_bf16(v[2], v[3]); *(uint2*)(O + off + bj * 128 + n * 16) = o; } }
            asm volatile("" ::: "memory");
        }
    }
};
struct EpiGateK {
    static constexpr int MIDK = 16; static constexpr bool PERM = false, AFTER_DRAIN = false;
    const bf16* GA; const bf16* GB; bf16* O;
    __device__ __forceinline__ void mid(pg8::f32x4 (&acc)[2][2][4][2], const pg8::Unit& u, int wr, int wc, int fr, int fq) const {
        asm volatile("" : "+v"(fr), "+v"(fq));
        const int row0 = u.pm * 256 + wr * 64 + fr, col0 = u.pn * 256 + wc * 32 + 4 * fq;
#pragma unroll
        for (int ai = 0; ai < 2; ++ai) {
            uint2 av[4][2][2], bv[4][2][2];
#pragma unroll
            for (int m = 0; m < 4; ++m) { const size_t off = (size_t)(row0 + ai * 128 + m * 16) * D + col0;
#pragma unroll
                for (int bj = 0; bj < 2; ++bj)
#pragma unroll
                    for (int n = 0; n < 2; ++n) { av[m][bj][n] = *(const uint2*)(GA + off + bj * 128 + n * 16); bv[m][bj][n] = *(const uint2*)(GB + off + bj * 128 + n * 16); } }
#pragma unroll
            for (int m = 0; m < 4; ++m)
#pragma unroll
                for (int bj = 0; bj < 2; ++bj)
#pragma unroll
                    for (int n = 0; n < 2; ++n) { const uint2 a2 = av[m][bj][n], b2 = bv[m][bj][n];
                        const pg8::f32x4 ga = {__builtin_bit_cast(float, a2.x << 16), __builtin_bit_cast(float, a2.x & 0xffff0000u), __builtin_bit_cast(float, a2.y << 16), __builtin_bit_cast(float, a2.y & 0xffff0000u)};
                        const pg8::f32x4 gb = {__builtin_bit_cast(float, b2.x << 16), __builtin_bit_cast(float, b2.x & 0xffff0000u), __builtin_bit_cast(float, b2.y << 16), __builtin_bit_cast(float, b2.y & 0xffff0000u)};
#pragma unroll
                        for (int e = 0; e < 4; ++e) acc[ai][bj][m][n][e] *= ga[e] * __builtin_amdgcn_rcpf(fmaxf(gb[e], 1.0e-30f)); }
        }
    }
    __device__ __forceinline__ void operator()(const pg8::f32x4 (&acc)[2][2][4][2], const pg8::Unit& u, int wr, int wc, int fr, int fq) const {
        asm volatile("" : "+v"(fr), "+v"(fq));
        const int row0 = u.pm * 256 + wr * 64 + fr, col0 = u.pn * 256 + wc * 32 + 4 * fq;
#pragma unroll
        for (int ai = 0; ai < 2; ++ai) {
            uint2 bv[4][2][2];
#pragma unroll
            for (int m = 0; m < 4; ++m) { const size_t off = (size_t)(row0 + ai * 128 + m * 16) * D + col0;
#pragma unroll
                for (int bj = 0; bj < 2; ++bj)
#pragma unroll
                    for (int n = 0; n < 2; ++n) bv[m][bj][n] = *(const uint2*)(GB + off + bj * 128 + n * 16); }
#pragma unroll
            for (int m = 0; m < 4; ++m) { const size_t off = (size_t)(row0 + ai * 128 + m * 16) * D + col0;
#pragma unroll
                for (int bj = 0; bj < 2; ++bj)
#pragma unroll
                    for (int n = 0; n < 2; ++n) { const uint2 b2 = bv[m][bj][n];
                        const pg8::f32x4 gb = {__builtin_bit_cast(float, b2.x << 16), __builtin_bit_cast(float, b2.x & 0xffff0000u), __builtin_bit_cast(float, b2.y << 16), __builtin_bit_cast(float, b2.y & 0xffff0000u)};
                        const pg8::f32x4 v = gb * acc[ai][bj][m][n];
                        uint2 o; o.x = pg8::cvt_pk_bf16(v[0], v[1]); o.y = pg8::cvt_pk_bf16(v[2], v[3]); *(uint2*)(O + off + bj * 128 + n * 16) = o; } }
        }
    }
};
struct EpiRes {
    static constexpr int MIDK = 0; static constexpr bool PERM = false, AFTER_DRAIN = false;
    float* X; const float* g1l;
    __device__ __forceinline__ void operator()(const pg8::f32x4 (&acc)[2][2][4][2], const pg8::Unit& u, int wr, int wc, int fr, int fq) const {
        asm volatile("" : "+v"(fr), "+v"(fq));
        const int row0 = u.pm * 256 + wr * 64 + fr, col0 = u.pn * 256 + wc * 32 + 4 * fq;
        const float* g1 = g1l + (size_t)((u.pm % 9 == 0) ? 4 : u.pm / 9) * MODW + col0;
        pg8::f32x4 gv[2][2];
#pragma unroll
        for (int bj = 0; bj < 2; ++bj)
#pragma unroll
            for (int n = 0; n < 2; ++n) gv[bj][n] = *(const pg8::f32x4*)(g1 + bj * 128 + n * 16);
#pragma unroll
        for (int ai = 0; ai < 2; ++ai) {
            pg8::f32x4 xv[4][2][2];
#pragma unroll
            for (int m = 0; m < 4; ++m) { const float* rowp = X + (size_t)(row0 + ai * 128 + m * 16) * D + col0;
#pragma unroll
                for (int bj = 0; bj < 2; ++bj)
#pragma unroll
                    for (int n = 0; n < 2; ++n) xv[m][bj][n] = *(const pg8::f32x4*)(rowp + bj * 128 + n * 16); }
#pragma unroll
            for (int m = 0; m < 4; ++m) { float* rowp = X + (size_t)(row0 + ai * 128 + m * 16) * D + col0;
#pragma unroll
                for (int bj = 0; bj < 2; ++bj)
#pragma unroll
                    for (int n = 0; n < 2; ++n) *(pg8::f32x4*)(rowp + bj * 128 + n * 16) = xv[m][bj][n] + gv[bj][n] * acc[ai][bj][m][n]; }
            asm volatile("" ::: "memory");
        }
    }
};
struct EpiInproj {
    static constexpr int MIDK = 0; static constexpr bool PERM = false, AFTER_DRAIN = false;
    unsigned char* ws; const float* qn; const float* kn; LAS float* xs;
    __device__ __forceinline__ void operator()(const pg8::f32x4 (&acc)[2][2][4][2], const pg8::Unit& u, int wr, int wc, int fr, int fq) const {
        asm volatile("" : "+v"(fr), "+v"(fq));
        const int pn = u.pn; bf16* dst; int ldo, kind; const float* nw = nullptr;
        if (pn < 4) { dst = (bf16*)(ws + WS_QA) + pn * 256; ldo = QW; kind = 0; nw = qn; }
        else if (pn == 4) { dst = (bf16*)(ws + WS_KA); ldo = KW; kind = 0; nw = kn; }
        else if (pn == 5) { dst = (bf16*)(ws + WS_VA); ldo = KW; kind = 2; }
        else if (pn < 10) { dst = (bf16*)(ws + WS_QB) + (pn - 6) * 256; ldo = QW; kind = 1; }
        else if (pn == 10) { dst = (bf16*)(ws + WS_KB); ldo = KW; kind = 1; }
        else if (pn == 11) { dst = (bf16*)(ws + WS_VB); ldo = KW; kind = 2; }
        else if (pn < 20) { dst = (bf16*)(ws + WS_GA) + (pn - 12) * 256; ldo = D; kind = 3; }
        else { dst = (bf16*)(ws + WS_GB) + (pn - 20) * 256; ldo = D; kind = 3; }
        const int rt0 = wr * 64 + fr;
        const int cw = 32 * wc + 4 * fq;
        const int tb = u.pm % 9; const bool rope = (kind < 2) && (tb != 0);
        if (kind == 0) {
#pragma unroll
            for (int ai = 0; ai < 2; ++ai)
#pragma unroll
                for (int m = 0; m < 4; ++m)
#pragma unroll
                    for (int bj = 0; bj < 2; ++bj) { const pg8::f32x4 a = acc[ai][bj][m][0], b = acc[ai][bj][m][1];
                        float ss = (a[0] * a[0] + a[1] * a[1]) + (a[2] * a[2] + a[3] * a[3]) + (b[0] * b[0] + b[1] * b[1]) + (b[2] * b[2] + b[3] * b[3]);
                        ss += __shfl_xor(ss, 16); ss += __shfl_xor(ss, 32);
                        if (fq == 0) xs[(bj * 256 + rt0 + 128 * ai + 16 * m) * 4 + wc] = ss; }
            asm volatile("s_waitcnt lgkmcnt(0)" ::: "memory"); __builtin_amdgcn_s_barrier(); asm volatile("" ::: "memory");
        }
        pg8::f32x4 w1 = {1.f, 1.f, 1.f, 1.f}, w2 = w1;
        if (kind == 0) { const int d1 = 64 * (wc >> 1) + 16 * (wc & 1) + 4 * fq; w1 = *(const pg8::f32x4*)(nw + d1); w2 = *(const pg8::f32x4*)(nw + d1 + 32); }
        const float* RT = (const float*)(ws + WS_ROPE) + 16 * (wc & 1) + 4 * fq;
#pragma unroll
        for (int ai = 0; ai < 2; ++ai)
#pragma unroll
            for (int m = 0; m < 4; ++m) {
                const int rt = rt0 + 128 * ai + 16 * m;
                pg8::f32x4 cs = {1.f, 1.f, 1.f, 1.f}, sn = {0.f, 0.f, 0.f, 0.f};
                if (rope) { const int s = (tb - 1) * 256 + rt; const int pos = (wc >> 1) ? (s & 63) : (s >> 6); cs = *(const pg8::f32x4*)(RT + pos * 32); sn = *(const pg8::f32x4*)(RT + 2048 + pos * 32); }
                bf16* rowp = dst + (size_t)(u.pm * 256 + rt) * ldo + cw;
#pragma unroll
                for (int bj = 0; bj < 2; ++bj) {
                    pg8::f32x4 x1 = acc[ai][bj][m][0], x2 = acc[ai][bj][m][1];
                    if (kind == 0) { const pg8::f32x4 p = *(const LAS pg8::f32x4*)(xs + (bj * 256 + rt) * 4); const float r = 1.0f / sqrtf(((p[0] + p[1]) + (p[2] + p[3])) * (1.0f / HD) + EPS); x1 = x1 * r * w1; x2 = x2 * r * w2; }
                    if (kind < 2) { const pg8::f32x4 o1 = x1 * cs - x2 * sn, o2 = x1 * sn + x2 * cs; x1 = o1; x2 = o2; }
                    if (kind == 3) {
#pragma unroll
                        for (int e = 0; e < 4; ++e) { x1[e] = 1.f / (1.f + __expf(-x1[e])); x2[e] = 1.f / (1.f + __expf(-x2[e])); } }
                    uint2 o; o.x = pg8::cvt_pk_bf16(x1[0], x1[1]); o.y = pg8::cvt_pk_bf16(x1[2], x1[3]); *(uint2*)(rowp + bj * 128) = o;
                    o.x = pg8::cvt_pk_bf16(x2[0], x2[1]); o.y = pg8::cvt_pk_bf16(x2[2], x2[3]); *(uint2*)(rowp + bj * 128 + 16) = o;
                }
                asm volatile("" ::: "memory");
            }
    }
};
__device__ __forceinline__ void fast_inproj(Frame& F, int l) {
    pg8::Gemm g{(const bf16*)(F.ws + WS_HA), (const bf16*)(F.ws + WS_WIN) + (size_t)l * INC * D, M, INC, D, D, D};
    RowOrder S; S.init(false, INC, F.G, (int)blockIdx.x);
    if constexpr (FUSE_POST) { EpiInproj E{F.ws, INP(IN_QNA) + l * HD, INP(IN_KNA) + l * HD, (LAS float*)(F.lds + XS_OFF)};
        pg8::gemm_phase<EpiInproj, RowOrder, true, true>(F.lds + RING_OFF, g, S, E); }
    else { EpiF32 E{(float*)(F.ws + WS_P), INC};
        pg8::gemm_phase<EpiF32, RowOrder, true, true>(F.lds + RING_OFF, g, S, E); }
}
__device__ __forceinline__ void fast_br(Frame& F, int l) {
    const bool lat = (l == DEPTH - 1);
    if constexpr (FUSE_GATE && GATE_MIDK) {
        pg8::Gemm g{(const bf16*)(F.ws + WS_YAB), (const bf16*)(F.ws + WS_WBR) + (size_t)l * D * D, M, D, D, D, D};
        RowOrder S; S.init(lat, D, F.G, (int)blockIdx.x); EpiGateK E{(const bf16*)(F.ws + WS_GA), (const bf16*)(F.ws + WS_GB), (bf16*)(F.ws + WS_MB)};
        pg8::gemm_phase<EpiGateK, RowOrder, true, true>(F.lds + RING_OFF, g, S, E);
    } else if constexpr (FUSE_GATE) {
        { pg8::Gemm g{(const bf16*)(F.ws + WS_YAB), (const bf16*)(F.ws + WS_WBR) + (size_t)l * D * D, M, D, QW, D, D};
          RowOrder S; S.init(lat, D, F.G, (int)blockIdx.x); EpiGate<1> E{(const bf16*)(F.ws + WS_GA), (bf16*)(F.ws + WS_MB)};
          pg8::gemm_phase<EpiGate<1>, RowOrder, true, true>(F.lds + RING_OFF, g, S, E); }
        { pg8::Gemm g{(const bf16*)(F.ws + WS_YAB) + QW, (const bf16*)(F.ws + WS_WBR) + (size_t)l * D * D + QW, M, D, QW, D, D};
          RowOrder S; S.init(lat, D, F.G, (int)blockIdx.x); EpiGate<2> E{(const bf16*)(F.ws + WS_GB), (bf16*)(F.ws + WS_MB)};
          pg8::gemm_phase<EpiGate<2>, RowOrder, true, true>(F.lds + RING_OFF, g, S, E); }
    } else {
        { pg8::Gemm g{(const bf16*)(F.ws + WS_YAB), (const bf16*)(F.ws + WS_WBR) + (size_t)l * D * D, M, D, QW, D, D};
          RowOrder S; S.init(lat, D, F.G, (int)blockIdx.x); EpiF32 E{(float*)(F.ws + WS_T1), D};
          pg8::gemm_phase<EpiF32, RowOrder, true, true>(F.lds + RING_OFF, g, S, E); }
        { pg8::Gemm g{(const bf16*)(F.ws + WS_YAB) + QW, (const bf16*)(F.ws + WS_WBR) + (size_t)l * D * D + QW, M, D, QW, D, D};
          RowOrder S; S.init(lat, D, F.G, (int)blockIdx.x); EpiF32 E{(float*)(F.ws + WS_T2), D};
          pg8::gemm_phase<EpiF32, RowOrder, true, true>(F.lds + RING_OFF, g, S, E); }
    }
}
template <bool DRY>
__device__ __forceinline__ void fast_out(Frame& F, int l) {
    const bool lat = (l == DEPTH - 1);
    pg8::Gemm g{(const bf16*)(F.ws + WS_MB), (const bf16*)(F.ws + WS_WOUT) + (size_t)l * D * D, M, D, D, D, D};
    RowOrder S; S.init(lat, D, F.G, (int)blockIdx.x);
    if constexpr (FUSE_RES && !DRY) { EpiRes E{(float*)(F.ws + WS_XW), (const float*)(F.ws + WS_MOD) + (size_t)l * 5 * MODW + 2 * D};
        pg8::gemm_phase<EpiRes, RowOrder, true, true>(F.lds + RING_OFF, g, S, E); }
    else { EpiF32 E{(float*)(F.ws + WS_T3), D};
        pg8::gemm_phase<EpiF32, RowOrder, true, true>(F.lds + RING_OFF, g, S, E); }
}
constexpr int PH_P0 = 0, PH_P0B = 1, PH_L0 = 2, PH_PER_LAYER = 11, PH_FINAL = PH_L0 + PH_PER_LAYER * DEPTH, NPH = PH_FINAL + 1;
enum { L_NORM1 = 0, L_INPROJ = 1, L_POST = 2, L_ATTN = 3, L_BR = 4, L_GATE = 5, L_OUT = 6, L_NORM2R = 7, L_COMPACT = 8, L_UP = 9, L_DOWN = 10 };
struct Args { const float* in[NIN]; float* out; unsigned char* ws; int ph_lo, ph_hi, li, pad; };

__global__ void __launch_bounds__(NWAVES * 64, 2) mk_fwd(Args args) {
    extern __shared__ __attribute__((aligned(16))) unsigned char lds[];
    Frame F;
    F.lds = (LAS unsigned char*)lds;
    F.MISC = (volatile LAS unsigned*)(F.lds + MISC_OFF);
    F.tid = threadIdx.x; F.lane = F.tid & 63; F.wave = __builtin_amdgcn_readfirstlane(F.tid >> 6);
    F.G = gridDim.x; { const int bx = blockIdx.x; F.vcu = (F.G % 8 == 0) ? (bx % 8) * (F.G / 8) + bx / 8 : bx; }
    F.ws = args.ws; F.out = args.out; F.ctl = (gu32*)(args.ws + WS_CTL);
    for (int u = F.tid; u < (LDS_BYTES - LDSCTL_OFF) / 4; u += NWAVES * 64) ((LAS unsigned*)(F.lds + LDSCTL_OFF))[u] = 0u;
    __syncthreads();
    if (F.tid < NIN) ((LAS cfptr*)(F.lds + LDSCTL_OFF + 256))[F.tid] = args.in[F.tid];
    __syncthreads();
    XcdBarrier bar = xcd_barrier_post((unsigned*)(F.ctl + CW_BAR) + args.li * XCD_BAR_WORDS, F.MISC + 8);
    const int lo = args.ph_lo, hi = args.ph_hi;
    const int nrep2 = 2 + args.pad;
#define IN(k) (lo <= (k) && (k) < hi)
#if TPROBE >= 0
#define TSTAMP(k) do { if (blockIdx.x == TPROBE_BLK && F.tid == 0) ((volatile LAS unsigned long long*)(F.lds + LDSCTL_OFF + 800))[(k) + 1] = __builtin_amdgcn_s_memrealtime(); } while (0)
#else
#define TSTAMP(k) do { } while (0)
#endif
#if TPROBE >= 300
#define TSTAMPX(slot, l_) do { if (F.tid == 0 && (l_) == 1) { const unsigned long long tn_ = __builtin_amdgcn_s_memrealtime(); if (blockIdx.x == TPROBE_BLK) ((volatile LAS unsigned long long*)(F.lds + LDSCTL_OFF + 800))[slot] = tn_; atomicMax((unsigned*)F.ctl + 200000 + 512, ((unsigned)tn_ << 8) | (unsigned)blockIdx.x); } } while (0)
#else
#define TSTAMPX(slot, l_) do { } while (0)
#endif
#define SEAM(k) do { if (IN(k) && IN((k) + 1)) { xcd_barrier(bar); if (REPMASK & (1 << 12)) xcd_barrier(bar); } TSTAMP(k); } while (0)
    TSTAMP(-1);

    if (IN(PH_P0)) { p0_prologue(F); if (REPMASK & (1 << 10)) { __syncthreads(); p0_prologue(F); } }
    SEAM(PH_P0);
    if (IN(PH_P0B)) p0b_reduce(F);
    SEAM(PH_P0B);
#define LAYER_PROGRAM(l) do { constexpr int pb = PH_L0 + PH_PER_LAYER * (l); \
        if (IN(pb + L_NORM1)) { ph_norm1<false>(F, (l)); if (REPMASK & (1 << L_NORM1)) ph_norm1<true>(F, (l)); } \
        SEAM(pb + L_NORM1); \
        if (IN(pb + L_INPROJ)) { if constexpr (FAST_INPROJ) { fast_inproj(F, (l)); if (REPMASK & (1 << L_INPROJ)) fast_inproj(F, (l)); } } \
        SEAM(pb + L_INPROJ); \
        if (IN(pb + L_POST)) { if constexpr (!FUSE_POST) { ph_post(F, (l)); if (REPMASK & (1 << L_POST)) ph_post(F, (l)); } } \
        if constexpr (!FUSE_POST) SEAM(pb + L_POST); \
        if (IN(pb + L_ATTN)) { if constexpr (FAST_ATTN) { _Pragma("nounroll") for (int rep_ = 0; rep_ < ((REPMASK & (1 << L_ATTN)) ? nrep2 : 1); ++rep_) fast_attn(F, (l)); } } \
        SEAM(pb + L_ATTN); \
        if (IN(pb + L_BR)) { if constexpr (FAST_BR) { _Pragma("nounroll") for (int rep_ = 0; rep_ < ((REPMASK & (1 << L_BR)) ? nrep2 : 1); ++rep_) fast_br(F, (l)); } } \
        SEAM(pb + L_BR); \
        if (IN(pb + L_GATE)) { if constexpr (!FUSE_GATE) ph_gate(F, (l)); } \
        if constexpr (!FUSE_GATE) SEAM(pb + L_GATE); \
        if (IN(pb + L_OUT)) { if constexpr (FAST_OUT) { if (REPMASK & (1 << L_OUT)) fast_out<true>(F, (l)); fast_out<false>(F, (l)); TSTAMPX(27, (l)); } } \
        SEAM(pb + L_OUT); \
        if (IN(pb + L_NORM2R)) { if (REPMASK & (1 << L_NORM2R)) ph_norm2_router<!FUSE_RES, true>(F, (l)); ph_norm2_router<!FUSE_RES, false>(F, (l)); } \
        SEAM(pb + L_NORM2R); \
        if (IN(pb + L_COMPACT)) ph_compact(F, (l)); \
        SEAM(pb + L_COMPACT); \
        if (IN(pb + L_UP)) { if constexpr (FAST_UP) { fast_moe_up(F, (l)); } } \
        SEAM(pb + L_UP); \
        if (IN(pb + L_DOWN)) { if constexpr (FAST_DOWN) { fast_moe_down(F, (l)); } } \
        SEAM(pb + L_DOWN); } while (0)
    LAYER_PROGRAM(0);
    LAYER_PROGRAM(1);
#undef LAYER_PROGRAM
    if (IN(PH_FINAL)) { ph_final(F); if (REPMASK & (1 << 11)) ph_final(F); }
#if TPROBE >= 0
    if (blockIdx.x == TPROBE_BLK && F.tid == 0) { volatile LAS unsigned long long* ts = (volatile LAS unsigned long long*)(F.lds + LDSCTL_OFF + 800);
        const unsigned long long dt = (TPROBE == 302) ? (unsigned long long)(((const unsigned*)F.ctl)[200000 + 512] & 255u) * 100ull : (TPROBE == 303) ? (unsigned long long)((((const unsigned*)F.ctl)[200000 + 512] >> 8) - (((unsigned)ts[18]) & 0xffffffu)) & 0xffffffull : (TPROBE == 300) ? ts[27] - ts[18] : (TPROBE == 301) ? ts[20] - ts[27] : (TPROBE >= 200) ? (unsigned long long)(((const unsigned*)F.ctl)[200000 + 64 * (TPROBE - 200)] - (unsigned)ts[0]) : (TPROBE >= 100) ? ts[26] : ts[(TPROBE_HI < 0 ? 0 : TPROBE_HI) + 1] - ts[TPROBE >= 100 ? 0 : TPROBE], t0 = __builtin_amdgcn_s_memrealtime();
        while (__builtin_amdgcn_s_memrealtime() - t0 < 4ull * dt) __builtin_amdgcn_s_sleep(8); }
#endif
#if CNTPROBE
    xcd_barrier(bar);
    if (blockIdx.x == 0) {
        const unsigned* cnt = (const unsigned*)F.ctl + CW_CNT + (CNTPROBE_L) * 64; unsigned mx = 0, mn = 1u << 30, big = 0, big2 = 0;
        for (int e = 0; e < NE; ++e) { const unsigned c = cnt[e]; mx = c > mx ? c : mx; mn = c < mn ? c : mn; big += c > 384 ? 1 : 0; big2 += c > 512 ? 1 : 0; }
        const float val = CNTPROBE == 1 ? (float)mx : CNTPROBE == 2 ? (float)big : CNTPROBE == 3 ? (float)mn : (float)big2;
        const float c1 = sqrtf(val);
        for (size_t i = F.tid; i < (size_t)NB * SEQ * D; i += NWAVES * 64) F.out[i] = c1;
    }
#endif
#undef IN
#undef SEAM
}

static bool phase_is_naive(int ph) {
    if (ph < PH_L0 || ph == PH_FINAL) return false;
    const int k = (ph - PH_L0) % PH_PER_LAYER;
    switch (k) { case L_INPROJ: return !FAST_INPROJ; case L_ATTN: return !FAST_ATTN; case L_BR: return !FAST_BR; case L_OUT: return !FAST_OUT; case L_UP: return !FAST_UP; case L_DOWN: return !FAST_DOWN; default: return false; }
}
extern "C" void kernel_launch(void* const* d_in, const int* in_sizes, int n_in, void* d_out, int out_size, void* d_ws, size_t ws_size, hipStream_t stream) {
    static int grid = 0;
    if (grid == 0) {
        if (n_in != NIN || in_sizes[0] != NB * SEQ * D || out_size != NB * SEQ * D || ws_size < WS_END) { fprintf(stderr, "kernel_launch: shape/workspace mismatch (n_in %d, ws %zu)\n", n_in, ws_size); grid = -1; return; }
        int dev = 0, cus = 0, per_cu = 0;
        if (hipGetDevice(&dev) != hipSuccess || hipDeviceGetAttribute(&cus, hipDeviceAttributeMultiprocessorCount, dev) != hipSuccess) { grid = -1; return; }
        if (hipFuncSetAttribute((const void*)mk_fwd, hipFuncAttributeMaxDynamicSharedMemorySize, LDS_BYTES) != hipSuccess) { fprintf(stderr, "kernel_launch: hipFuncSetAttribute failed\n"); grid = -1; return; }
        if (hipOccupancyMaxActiveBlocksPerMultiprocessor(&per_cu, (const void*)mk_fwd, NWAVES * 64, LDS_BYTES) != hipSuccess || per_cu < 1) fprintf(stderr, "kernel_launch: occupancy query reports %d\n", per_cu);
        (void)hipGetLastError();
        grid = cus;
    }
    if (grid < 0) return;
    unsigned char* ws = (unsigned char*)d_ws;
    (void)hipMemsetAsync(ws + WS_CTL, 0, CTL_ZERO_BYTES, stream);
    Args a{};
    for (int i = 0; i < NIN; ++i) a.in[i] = (const float*)d_in[i];
    a.out = (float*)d_out; a.ws = ws;
    const float* const* in = (const float* const*)d_in;
    int li = 0, lo = -1;
    for (int ph = 0; ph < NPH; ++ph) {
        const bool nv = phase_is_naive(ph);
        if (!nv && lo < 0) lo = ph;
        if (nv || ph == NPH - 1) {
            if (lo >= 0) { a.ph_lo = lo; a.ph_hi = nv ? ph : ph + 1; a.li = li++; hipLaunchKernelGGL(mk_fwd, dim3(grid), dim3(NWAVES * 64), LDS_BYTES, stream, a); lo = -1; }
            if (nv) {
                const int l = (ph - PH_L0) / PH_PER_LAYER, k = (ph - PH_L0) % PH_PER_LAYER;
                const unsigned* cnt = (const unsigned*)ws + CW_CNT + l * 64;
                if (k == L_INPROJ) hipLaunchKernelGGL(naive_gemm<1>, dim3(INC / 64, M / 32), dim3(64, 4), 0, stream, (const bf16*)(ws + WS_HA), D, in[IN_WIN] + (size_t)l * D * INC, INC, (float*)(ws + WS_P), INC, D);
                else if (k == L_ATTN) { const int wq = (l < DEPTH - 1) ? 1 : 0; const long items = (long)NB * NH * (wq ? TT : SEQ);
                    hipLaunchKernelGGL(naive_attn, dim3((unsigned)((items + 3) / 4)), dim3(256), 0, stream, (const bf16*)(ws + WS_QA), (const bf16*)(ws + WS_KA), (const bf16*)(ws + WS_VA), (bf16*)(ws + WS_YAB), (const float*)nullptr, 0, wq);
                    hipLaunchKernelGGL(naive_attn, dim3((unsigned)((items + 3) / 4)), dim3(256), 0, stream, (const bf16*)(ws + WS_QB), (const bf16*)(ws + WS_KB), (const bf16*)(ws + WS_VB), (bf16*)(ws + WS_YAB) + QW, in[IN_SINK] + l * NH, 1, wq); }
                else if (k == L_BR) { hipLaunchKernelGGL(naive_gemm<0>, dim3(D / 64, M / 32), dim3(64, 4), 0, stream, (const bf16*)(ws + WS_YAB), D, in[IN_WBRA] + (size_t)l * QW * D, D, (float*)(ws + WS_T1), D, QW);
                    hipLaunchKernelGGL(naive_gemm<0>, dim3(D / 64, M / 32), dim3(64, 4), 0, stream, (const bf16*)(ws + WS_YAB) + QW, D, in[IN_WBRB] + (size_t)l * QW * D, D, (float*)(ws + WS_T2), D, QW); }
                else if (k == L_OUT) hipLaunchKernelGGL(naive_gemm<0>, dim3(D / 64, M / 32), dim3(64, 4), 0, stream, (const bf16*)(ws + WS_MB), D, in[IN_WOUT] + (size_t)l * D * D, D, (float*)(ws + WS_T3), D, D);
                else if (k == L_UP) hipLaunchKernelGGL(naive_moe_up, dim3(DE / 64, 2 * M / 4), dim3(64, 4), 0, stream, (const bf16*)(ws + WS_HA), in[IN_W1] + (size_t)l * NE * D * DE, in[IN_W3] + (size_t)l * NE * D * DE, cnt, (const unsigned*)(ws + WS_LIST) + (size_t)l * NE * M, (bf16*)(ws + WS_HB));
                else if (k == L_DOWN) hipLaunchKernelGGL(naive_moe_down, dim3(D / 64, 2 * M / 4), dim3(64, 4), 0, stream, (const bf16*)(ws + WS_HB), in[IN_W2] + (size_t)l * NE * DE * D, cnt, (bf16*)(ws + WS_YM));
            }
        }
    }
    const hipError_t le = hipPeekAtLastError();
    if (le != hipSuccess) fprintf(stderr, "kernel_launch: launch failed: %s\n", hipGetErrorName(le));
}
```

```cpp
#include <hip/hip_runtime.h>
#include <cstdio>
#include <cstdint>

constexpr int D = 2048, NB = 4, SEQ = 2048, CTX = 256, TT = CTX + SEQ, M = NB * TT, DEPTH = 2;
constexpr int HD = 128, NH = 8, NKV = 2, GRIDW = 64;
constexpr int QW = NH * HD, KW = NKV * HD;
constexpr int INC = 2 * QW + 4 * KW + 2 * D;
constexpr int OFF_QA = 0, OFF_KA = 1024, OFF_VA = 1280, OFF_QB = 1536, OFF_KB = 2560, OFF_VB = 2816, OFF_GA = 3072, OFF_GB = 5120;
constexpr int NE = 64, NG = 8, EPG = 8, DE = 512;
constexpr float EPS = 1e-6f;
constexpr float ATTN_SCALE = 0.08838834764831845f;
constexpr int MODW = 6 * D;
constexpr int NIN = 23;

__host__ __device__ __forceinline__ int perm_d2j(int d) { return 32 * (2 * (d >> 6) + ((d >> 4) & 1)) + 16 * ((d >> 5) & 1) + (d & 15); }
__host__ __device__ __forceinline__ int perm_j2d(int j) { const int wc = j >> 5, n = (j >> 4) & 1, t = j & 15; return 64 * (wc >> 1) + 32 * n + 16 * (wc & 1) + t; }
__host__ __device__ __forceinline__ bool inproj_roped(int c) { return (c < OFF_VA) || (c >= OFF_QB && c < OFF_VB); }
__host__ __device__ __forceinline__ int inproj_src_col(int c) { return inproj_roped(c) ? (c & ~127) + perm_j2d(c & 127) : c; }
__host__ __device__ __forceinline__ int inproj_dst_col(int n) { return inproj_roped(n) ? (n & ~127) + perm_d2j(n & 127) : n; }

constexpr size_t MiB = 1u << 20;
constexpr size_t WS_CTL = 0, CTL_ZERO_BYTES = 1 * MiB;
constexpr size_t WS_MOD = 1 * MiB;
constexpr size_t WS_ROPE = 1 * MiB + 512 * 1024;
constexpr size_t WS_TOK = 2 * MiB;
constexpr size_t WS_LIST = 3 * MiB;
constexpr size_t WS_WIN = 8 * MiB;
constexpr size_t WS_WBR = 64 * MiB;
constexpr size_t WS_WOUT = 80 * MiB;
constexpr size_t WS_XW = 96 * MiB;
constexpr size_t WS_HA = 168 * MiB;
constexpr size_t WS_QA = 204 * MiB, WS_KA = 222 * MiB, WS_VA = 227 * MiB, WS_QB = 232 * MiB, WS_KB = 250 * MiB, WS_VB = 255 * MiB;
constexpr size_t WS_GA = 260 * MiB, WS_GB = 296 * MiB;
constexpr size_t WS_YAB = 332 * MiB;
constexpr size_t WS_MB = 368 * MiB;
constexpr size_t WS_HB = 404 * MiB;
constexpr size_t WS_YM = 424 * MiB;
constexpr size_t WS_P = 496 * MiB;
constexpr size_t WS_MODP = 964 * MiB;
constexpr size_t WS_WR = 740 * MiB;
constexpr size_t WS_T1 = 748 * MiB, WS_T2 = 820 * MiB, WS_T3 = 892 * MiB;
constexpr size_t WS_END = 996 * MiB;
constexpr int CW_TMO = 0, CW_CODE = 1;
constexpr int CW_BAR = 4096;
constexpr int CW_CNT = 131072;
constexpr int MAX_LAUNCH = 32;

constexpr int RING_OFF = 0, RING_BYTES = 131072;
constexpr int XS_OFF = 131072, XS_BYTES = 16384;
constexpr int LDSCTL_OFF = 162816, MISC_OFF = LDSCTL_OFF;
constexpr int LDS_BYTES = 163840;
constexpr int NWAVES = 8;
constexpr bool FAST_INPROJ = true, FAST_ATTN = true, FAST_BR = true, FAST_OUT = true, FAST_UP = true, FAST_DOWN = true;
constexpr bool FUSE_POST = true, FUSE_GATE = true, FUSE_RES = true, GATE_MIDK = true;
#ifndef REPMASK
#define REPMASK 0
#endif
#ifndef CNTPROBE
#define CNTPROBE 0
#define CNTPROBE_L 0
#endif
#ifndef MOEVAR
#define MOEVAR 0
#endif
#ifndef TPROBE
#define TPROBE -1
#define TPROBE_HI -1
#endif
#ifndef TPROBE_BLK
#define TPROBE_BLK 0
#endif
namespace pg8 {
#define PG8_LAS __attribute__((address_space(3)))
typedef unsigned short bf16_t;
typedef short bf16x8 __attribute__((ext_vector_type(8)));
typedef float f32x4 __attribute__((ext_vector_type(4)));
typedef unsigned u32x4 __attribute__((ext_vector_type(4)));
constexpr int BM = 256, BK = 64, HALF = 128, HTB = HALF * BK * 2  , STAGE_BYTES = 8 * HTB, NXCD = 8, WGM = 8;

__host__ __device__ __forceinline__ int lds_byte(int r, int c) { const int st = (r >> 4) * 2 + (c >> 5), rr = r & 15, cc = c & 31, ob = rr * 64 + cc * 2; return st * 1024 + (ob ^ (((ob >> 9) & 1) << 5)); }
__host__ __device__ __forceinline__ void stage_rc(int b, int& R, int& C) { const int st = b / 1024, sb = b % 1024, swz = sb ^ (((sb >> 9) & 1) << 5); R = (st >> 1) * 16 + swz / 64; C = (st & 1) * 32 + (swz % 64) / 2; }
__host__ __device__ __forceinline__ int perm32(int rho) { const int n = rho >> 4, i = rho & 15; return 8 * (i >> 2) + 4 * n + (i & 3); }

struct Unit { int pm, pn; };
struct Gemm { const bf16_t* A; const bf16_t* Bt; int M, N, K, lda, ldb; };

struct StaticOrder {
    int nM, nN, nwg, G, c;
    __host__ __device__ void init(int M, int N, int G_, int c_) { nM = M / BM; nN = N / BM; nwg = nM * nN; G = G_; c = c_; }
    __host__ __device__ bool next(int i, Unit& u) const {
        const long L = (long)i * G + c; if (L >= nwg) return false;
        int wgid = (int)L; { const int q = nwg / NXCD, r = nwg % NXCD, xcd = wgid % NXCD, off = wgid / NXCD; wgid = (xcd < r ? xcd * (q + 1) : r * (q + 1) + (xcd - r) * q) + off; }
        const int nig = WGM * nN, gid = wgid / nig, fm = gid * WGM, gsz = (nM - fm) < WGM ? (nM - fm) : WGM;
        u.pm = fm + ((wgid % nig) % gsz); u.pn = (wgid % nig) / gsz; return true;
    }
    __device__ __forceinline__ void a_ready(const Unit&) const {}
    __device__ __forceinline__ void done(const Unit&) const {}
};

__device__ __forceinline__ unsigned cvt_pk_bf16(float lo, float hi) { unsigned r; asm volatile("v_cvt_pk_bf16_f32 %0, %1, %2" : "=v"(r) : "v"(lo), "v"(hi)); return r; }
typedef float f32x2 __attribute__((ext_vector_type(2)));
__device__ __forceinline__ f32x2 gelu_pk(f32x2 v) {
    const f32x2 av = __builtin_elementwise_abs(v), d = av * 0.2316418882f + 1.0f;
    f32x2 t; t.x = __builtin_amdgcn_rcpf(d.x); t.y = __builtin_amdgcn_rcpf(d.y);
    f32x2 q = t * 0.5307027145f + (-0.7265760135f); q = q * t + 0.7107068705f; q = q * t + (-0.142248368f); q = q * t + 0.127414796f; q = q * t;
    const f32x2 s = (v * v) * (-0.72134752044f);
    f32x2 e; e.x = __builtin_amdgcn_exp2f(s.x); e.y = __builtin_amdgcn_exp2f(s.y);
    const f32x2 m = v * (q * e), r = v - m;
    f32x2 o; o.x = v.x < 0.f ? m.x : r.x; o.y = v.y < 0.f ? m.y : r.y; return o;
}

template <int ACT  > struct EpiBf16 {
    static constexpr int MIDK = 0; static constexpr bool PERM = true, AFTER_DRAIN = false; static_assert(ACT == 0 || ACT == 1, "EpiBf16: ACT is 0 (none) or 1 (gelu_pk)");
    bf16_t* O; int ldc; const float* bias; int split_cols; size_t split_stride; float scale0;
    __device__ __forceinline__ void operator()(const f32x4 (&acc)[2][2][4][2], const Unit& u, int wr, int wc, int fr, int fq) const {
        const int row0 = u.pm * BM + wr * 64 + fr; int colt = u.pn * BM; bf16_t* base = O;
        float sc = 1.f; if (split_cols) { const int t = colt / split_cols; base += (size_t)t * split_stride; colt -= t * split_cols; if (t == 0) sc = scale0; }
        const int col0 = colt + wc * 32 + 8 * fq, bcol0 = u.pn * BM + wc * 32 + 8 * fq;
        f32x4 bv[2][2];
#pragma unroll
        for (int bj = 0; bj < 2; ++bj)
#pragma unroll
            for (int n = 0; n < 2; ++n) bv[bj][n] = bias ? *(const f32x4*)(bias + bcol0 + bj * HALF + 4 * n) : (f32x4){0.f, 0.f, 0.f, 0.f};
#pragma unroll
        for (int ai = 0; ai < 2; ++ai)
#pragma unroll
            for (int m = 0; m < 4; ++m) { bf16_t* rowp = base + (size_t)(row0 + ai * HALF + m * 16) * ldc + col0;
#pragma unroll
                for (int bj = 0; bj < 2; ++bj) { f32x4 v0 = acc[ai][bj][m][0] + bv[bj][0], v1 = acc[ai][bj][m][1] + bv[bj][1];
                    if (ACT == 1) { f32x2 a = gelu_pk((f32x2){v0[0], v0[1]}), b = gelu_pk((f32x2){v0[2], v0[3]}), c = gelu_pk((f32x2){v1[0], v1[1]}), d = gelu_pk((f32x2){v1[2], v1[3]});
                        v0 = (f32x4){a.x, a.y, b.x, b.y}; v1 = (f32x4){c.x, c.y, d.x, d.y}; }
                    v0 = v0 * sc; v1 = v1 * sc; u32x4 w; w.x = cvt_pk_bf16(v0[0], v0[1]); w.y = cvt_pk_bf16(v0[2], v0[3]); w.z = cvt_pk_bf16(v1[0], v1[1]); w.w = cvt_pk_bf16(v1[2], v1[3]);
                    *(u32x4*)(rowp + bj * HALF) = w; } }
    }
};

struct PanelStats {
    unsigned* xbuf;
    unsigned* cnt;
    unsigned* tmo;
    int ntn; float eps;
    unsigned code;
    __device__ __forceinline__ bool run(const f32x4 (&v)[2][2][4][2], const Unit& u, int wr, int wc, int fr, int fq, PG8_LAS unsigned char* lds, int wid, int lane) const {
        typedef float f32x2v __attribute__((ext_vector_type(2)));
        PG8_LAS f32x2v* P = (PG8_LAS f32x2v*)lds;
        PG8_LAS f32x2v* S = (PG8_LAS f32x2v*)(lds + 8192);
        PG8_LAS unsigned* flag = (PG8_LAS unsigned*)(lds + 8192 + 2048);
#pragma unroll
        for (int ai = 0; ai < 2; ++ai)
#pragma unroll
            for (int m = 0; m < 4; ++m) {
                float s = 0.f;
#pragma unroll
                for (int bj = 0; bj < 2; ++bj)
#pragma unroll
                    for (int n = 0; n < 2; ++n) { const f32x4 x = v[ai][bj][m][n]; s += (x[0] + x[1]) + (x[2] + x[3]); }
                s += __shfl_xor(s, 16); s += __shfl_xor(s, 32);
                const float mw = s * (1.0f / 64.0f); float q = 0.f;
#pragma unroll
                for (int bj = 0; bj < 2; ++bj)
#pragma unroll
                    for (int n = 0; n < 2; ++n) { const f32x4 d = v[ai][bj][m][n] - mw; q += (d[0] * d[0] + d[1] * d[1]) + (d[2] * d[2] + d[3] * d[3]); }
                q += __shfl_xor(q, 16); q += __shfl_xor(q, 32);
                if (fq == 0) P[(ai * HALF + wr * 64 + m * 16 + fr) * 4 + wc] = (f32x2v){mw, q};
            }
        asm volatile("s_waitcnt lgkmcnt(0)" ::: "memory"); __builtin_amdgcn_s_barrier(); asm volatile("" ::: "memory");
#if defined(BROKEN_EXCHANGE_NO_WAIT)
#warning BROKEN CONTROL BUILD: the row-statistics exchange does not wait; results are wrong by design
        if (blockIdx.x >= 64) { const long long t0_ = clock64(); while (clock64() - t0_ < 60000) __builtin_amdgcn_s_sleep(8); }
#endif
        const int row = wid * 32 + (lane & 31);
        if (lane < 32) {
            const f32x2v a = P[row * 4 + 0], b = P[row * 4 + 1], c = P[row * 4 + 2], d = P[row * 4 + 3];
            const float mt = (a.x + b.x + c.x + d.x) * 0.25f;
            const float da = a.x - mt, db = b.x - mt, dc = c.x - mt, dd = d.x - mt;
            const float m2 = (a.y + b.y) + (c.y + d.y) + 64.0f * ((da * da + db * db) + (dc * dc + dd * dd));
            unsigned long long* slot = (unsigned long long*)xbuf + ((size_t)(u.pm * BM + row) * 4 + u.pn);
            __hip_atomic_store(slot, ((unsigned long long)__float_as_uint(m2) << 32) | __float_as_uint(mt), __ATOMIC_RELAXED, __HIP_MEMORY_SCOPE_AGENT);
        }
        asm volatile("s_waitcnt vmcnt(0)" ::: "memory");
        if (lane == 0) __hip_atomic_fetch_add(cnt + 64 * u.pm, 1u, __ATOMIC_RELAXED, __HIP_MEMORY_SCOPE_AGENT);
        if (wid == 0) {
            bool dead = false; const unsigned long long t0 = __builtin_amdgcn_s_memrealtime(); const unsigned want = 8u * (unsigned)ntn;
            for (;;) {
#if defined(BROKEN_EXCHANGE_NO_WAIT)
                break;
#endif
                if ((unsigned)__builtin_amdgcn_readfirstlane(__hip_atomic_load(cnt + 64 * u.pm, __ATOMIC_RELAXED, __HIP_MEMORY_SCOPE_AGENT)) >= want) break;
                if (__builtin_amdgcn_s_memrealtime() - t0 > 2000000ull) {
                    if (lane == 0) { unsigned expect = 0u; __hip_atomic_compare_exchange_strong(tmo + 1, &expect, code | (unsigned)(u.pm & 0xff), __ATOMIC_RELAXED, __ATOMIC_RELAXED, __HIP_MEMORY_SCOPE_AGENT);
                                     __hip_atomic_store(tmo, 1u, __ATOMIC_RELAXED, __HIP_MEMORY_SCOPE_AGENT); }
                    dead = true; break; }
                __builtin_amdgcn_s_sleep(2);
            }
            __builtin_amdgcn_fence(__ATOMIC_ACQUIRE, "agent");
            if (lane == 0) flag[0] = dead ? 1u : 0u;
        }
        asm volatile("s_waitcnt vmcnt(0) lgkmcnt(0)" ::: "memory"); __builtin_amdgcn_s_barrier(); asm volatile("" ::: "memory");
        const bool bad = flag[0] != 0u;
        if (lane < 32) {
            const unsigned long long* slot = (const unsigned long long*)xbuf + (size_t)(u.pm * BM + row) * 4; float mt[4], m2[4]; float ms = 0.f;
#pragma unroll
            for (int t = 0; t < 4; ++t) { if (t < ntn) { const unsigned long long w = __hip_atomic_load(slot + t, __ATOMIC_RELAXED, __HIP_MEMORY_SCOPE_AGENT); mt[t] = __uint_as_float((unsigned)w); m2[t] = __uint_as_float((unsigned)(w >> 32)); } else { mt[t] = 0.f; m2[t] = 0.f; } ms += mt[t]; }
            const float mean = ms / (float)ntn; float q = 0.f;
#pragma unroll
            for (int t = 0; t < 4; ++t) if (t < ntn) { const float dm = mt[t] - mean; q += m2[t] + 256.0f * dm * dm; }
            S[row] = (f32x2v){mean, 1.0f / sqrtf(q / (256.0f * (float)ntn) + eps)};
        }
        asm volatile("s_waitcnt lgkmcnt(0)" ::: "memory"); __builtin_amdgcn_s_barrier(); asm volatile("" ::: "memory");
        return bad;
    }
};
struct EpiLnRes {
    static constexpr int MIDK = 0; static constexpr bool PERM = false, AFTER_DRAIN = true;
    const float* base; float* out; int ldc; const float* bias; PanelStats st; unsigned poison;
    __device__ __forceinline__ void fused(f32x4 (&acc)[2][2][4][2], const Unit& u, int wr, int wc, int fr, int fq, PG8_LAS unsigned char* lds, int wid, int lane) const {
        typedef float f32x2v __attribute__((ext_vector_type(2)));
        const PG8_LAS f32x2v* S = (const PG8_LAS f32x2v*)(lds + 8192);
        const int col0 = u.pn * BM + wc * 32 + 4 * fq;
#pragma unroll
        for (int bj = 0; bj < 2; ++bj)
#pragma unroll
            for (int n = 0; n < 2; ++n) { const f32x4 bv = bias ? *(const f32x4*)(bias + col0 + bj * HALF + n * 16) : (f32x4){0.f, 0.f, 0.f, 0.f};
#pragma unroll
                for (int ai = 0; ai < 2; ++ai)
#pragma unroll
                    for (int m = 0; m < 4; ++m) acc[ai][bj][m][n] += bv; }
        f32x4 pre[4][2][2];
#pragma unroll
        for (int m = 0; m < 4; ++m) { const size_t off = (size_t)(u.pm * BM + wr * 64 + m * 16 + fr) * ldc + col0;
#pragma unroll
            for (int bj = 0; bj < 2; ++bj)
#pragma unroll
                for (int n = 0; n < 2; ++n) pre[m][bj][n] = *(const f32x4*)(base + off + bj * HALF + n * 16); }
        const bool bad = st.run(acc, u, wr, wc, fr, fq, lds, wid, lane) || poison != 0u;
        const float qnan = __builtin_nanf("");
#pragma unroll
        for (int ai = 0; ai < 2; ++ai)
#pragma unroll
            for (int m = 0; m < 4; ++m) { const int r = ai * HALF + wr * 64 + m * 16 + fr; const f32x2v sr = S[r]; const size_t off = (size_t)(u.pm * BM + r) * ldc + col0;
#pragma unroll
                for (int bj = 0; bj < 2; ++bj)
#pragma unroll
                    for (int n = 0; n < 2; ++n) { const f32x4 bs = ai == 0 ? pre[m][bj][n] : *(const f32x4*)(base + off + bj * HALF + n * 16); f32x4 o = bs + (acc[ai][bj][m][n] - sr.x) * sr.y;
                        if (bad) o = (f32x4){qnan, qnan, qnan, qnan}; *(f32x4*)(out + off + bj * HALF + n * 16) = o; }
                if (m & 1) asm volatile("" ::: "memory"); }
    }
};
struct EpiLnResLn {
    static constexpr int MIDK = 0; static constexpr bool PERM = false, AFTER_DRAIN = true;
    const float* base; float* out; bf16_t* xn; int ldc; const float* bias; PanelStats st1, st2; unsigned poison;
    __device__ __forceinline__ void fused(f32x4 (&acc)[2][2][4][2], const Unit& u, int wr, int wc, int fr, int fq, PG8_LAS unsigned char* lds, int wid, int lane) const {
        typedef float f32x2v __attribute__((ext_vector_type(2))); typedef unsigned u32x2v __attribute__((ext_vector_type(2)));
        const PG8_LAS f32x2v* S = (const PG8_LAS f32x2v*)(lds + 8192);
        const int col0 = u.pn * BM + wc * 32 + 4 * fq;
#pragma unroll
        for (int bj = 0; bj < 2; ++bj)
#pragma unroll
            for (int n = 0; n < 2; ++n) { const f32x4 bv = bias ? *(const f32x4*)(bias + col0 + bj * HALF + n * 16) : (f32x4){0.f, 0.f, 0.f, 0.f};
#pragma unroll
                for (int ai = 0; ai < 2; ++ai)
#pragma unroll
                    for (int m = 0; m < 4; ++m) acc[ai][bj][m][n] += bv; }
        bool bad = st1.run(acc, u, wr, wc, fr, fq, lds, wid, lane) || poison != 0u;
        const float qnan = __builtin_nanf("");
#pragma unroll
        for (int ai = 0; ai < 2; ++ai)
#pragma unroll
            for (int m = 0; m < 4; ++m) { const int r = ai * HALF + wr * 64 + m * 16 + fr; const f32x2v sr = S[r]; const size_t off = (size_t)(u.pm * BM + r) * ldc + col0;
#pragma unroll
                for (int bj = 0; bj < 2; ++bj)
#pragma unroll
                    for (int n = 0; n < 2; ++n) { const f32x4 bs = *(const f32x4*)(base + off + bj * HALF + n * 16); acc[ai][bj][m][n] = bs + (acc[ai][bj][m][n] - sr.x) * sr.y; }
                asm volatile("" : "+v"(acc[ai][0][m][0]), "+v"(acc[ai][0][m][1]), "+v"(acc[ai][1][m][0]), "+v"(acc[ai][1][m][1]));
                if (m & 1) asm volatile("" ::: "memory"); }
        const bool bad1 = bad;
        bad = st2.run(acc, u, wr, wc, fr, fq, lds, wid, lane) || bad;
#pragma unroll
        for (int ai = 0; ai < 2; ++ai)
#pragma unroll
            for (int m = 0; m < 4; ++m) { const int r = ai * HALF + wr * 64 + m * 16 + fr; const f32x2v sr = S[r]; const size_t off = (size_t)(u.pm * BM + r) * ldc + col0;
#pragma unroll
                for (int bj = 0; bj < 2; ++bj)
#pragma unroll
                    for (int n = 0; n < 2; ++n) { const f32x4 x1 = acc[ai][bj][m][n]; *(f32x4*)(out + off + bj * HALF + n * 16) = bad1 ? (f32x4){qnan, qnan, qnan, qnan} : x1;
                        const f32x4 o = (x1 - sr.x) * sr.y; u32x2v w; w.x = cvt_pk_bf16(o[0], o[1]); w.y = cvt_pk_bf16(o[2], o[3]);
                        if (bad) { w.x = 0x7fc07fc0u; w.y = 0x7fc07fc0u; } *(u32x2v*)(xn + off + bj * HALF + n * 16) = w; }
                asm volatile("" ::: "memory"); }
    }
};

template <class Epi, class Sched, bool ALIGN_EPI = false, bool SP2 = false>
__device__ __forceinline__ void gemm_phase(PG8_LAS unsigned char* lds, const Gemm g, const Sched& S, const Epi& E) {
    const int tid = threadIdx.x, wid = __builtin_amdgcn_readfirstlane(tid >> 6), lane = tid & 63, wr = wid >> 2, wc = wid & 3, fr = lane & 15, fq = lane >> 4;
    const int K = g.K, nt = K / BK;
    unsigned voffA[2], voffB[2];
#pragma unroll
    for (int i = 0; i < 2; ++i) { int R, C; stage_rc(tid * 16 + i * 8192, R, C); const int Rb = Epi::PERM ? ((R & ~31) + perm32(R & 31)) : R;
        voffA[i] = (unsigned)(R * g.lda + C) * 2u; voffB[i] = (unsigned)(Rb * g.ldb + C) * 2u; }
    const size_t kstep = (size_t)(BK * 2);
    const size_t hstepA = (size_t)HALF * g.lda * 2, hstepB = (size_t)HALF * g.ldb * 2;
    const size_t tstepA = 2 * hstepA, tstepB = 2 * hstepB;
    const unsigned ldsw = (unsigned)wid * 1024u;
    const int aoff = lds_byte(wr * 64 + fr, fq * 8), boff = lds_byte(wc * 32 + fr, fq * 8);
#define PG8_SA(b, h) (((b) * 2 + (h)) * HTB)
#define PG8_SB(b, h) ((4 + (b) * 2 + (h)) * HTB)
#define PG8_STAGE(bufoff, gbase, voff) do { _Pragma("unroll") for (int _i = 0; _i < 2; ++_i) \
        __builtin_amdgcn_global_load_lds((const unsigned*)((const char*)(gbase) + (voff)[_i]), (PG8_LAS unsigned*)(lds + (bufoff) + ldsw + _i * 8192), 16, 0, 0); } while (0)
#define PG8_LDA(dst, b, h) do { _Pragma("unroll") for (int m = 0; m < 4; ++m) _Pragma("unroll") for (int k = 0; k < 2; ++k) dst[m][k] = *(const PG8_LAS bf16x8*)(lds + PG8_SA(b, h) + aoff + m * 2048 + k * 1024); } while (0)
#define PG8_LDB(dst, b, h) do { _Pragma("unroll") for (int n = 0; n < 2; ++n) _Pragma("unroll") for (int k = 0; k < 2; ++k) dst[n][k] = *(const PG8_LAS bf16x8*)(lds + PG8_SB(b, h) + boff + n * 2048 + k * 1024); } while (0)
#define PG8_MMA(ai, bj, At, Bt) do { __builtin_amdgcn_s_setprio(1); _Pragma("unroll") for (int m = 0; m < 4; ++m) _Pragma("unroll") for (int n = 0; n < 2; ++n) _Pragma("unroll") for (int k = 0; k < 2; ++k) \
        acc[ai][bj][m][n] = __builtin_amdgcn_mfma_f32_16x16x32_bf16(Bt[n][k], At[m][k], acc[ai][bj][m][n], 0, 0, 0); __builtin_amdgcn_s_setprio(0); } while (0)
#define PG8_WAIT_V(n) asm volatile("s_waitcnt vmcnt(" #n ")" ::: "memory")
#define PG8_WAIT_L(n) asm volatile("s_waitcnt lgkmcnt(" #n ")" ::: "memory")
#define PG8_BAR __builtin_amdgcn_s_barrier()
#define PG8_SCHED __builtin_amdgcn_sched_barrier(0)
    Unit cur, nxt; int ui = 0;
    if (!S.next(0, cur)) return;
    f32x4 acc[2][2][4][2];
#pragma unroll
    for (int a = 0; a < 2; ++a)
#pragma unroll
        for (int b = 0; b < 2; ++b)
#pragma unroll
            for (int m = 0; m < 4; ++m)
#pragma unroll
                for (int n = 0; n < 2; ++n) acc[a][b][m][n] = (f32x4){0.f, 0.f, 0.f, 0.f};
    bf16x8 At[4][2], B0[2][2], B1[2][2];
    const char* cA = (const char*)g.A + (size_t)cur.pm * tstepA; const char* cB = (const char*)g.Bt + (size_t)cur.pn * tstepB;
    S.a_ready(cur);
    if constexpr (SP2) {
        PG8_STAGE(PG8_SB(0, 0), cB, voffB); PG8_STAGE(PG8_SB(0, 1), cB + hstepB, voffB); PG8_STAGE(PG8_SA(0, 0), cA, voffA); PG8_STAGE(PG8_SA(0, 1), cA + hstepA, voffA);
        if (wr == 1) PG8_BAR;
        PG8_WAIT_V(2); PG8_BAR;
        PG8_STAGE(PG8_SB(1, 0), cB + kstep, voffB); PG8_STAGE(PG8_SA(1, 0), cA + kstep, voffA); PG8_STAGE(PG8_SB(1, 1), cB + hstepB + kstep, voffB);
        PG8_WAIT_V(6); PG8_BAR;
    } else {
        PG8_STAGE(PG8_SB(0, 0), cB, voffB); PG8_STAGE(PG8_SA(0, 0), cA, voffA); PG8_STAGE(PG8_SB(0, 1), cB + hstepB, voffB); PG8_STAGE(PG8_SA(0, 1), cA + hstepA, voffA);
        if (wr == 1) PG8_BAR;
        PG8_WAIT_V(4); PG8_BAR;
        PG8_STAGE(PG8_SB(1, 0), cB + kstep, voffB); PG8_STAGE(PG8_SA(1, 0), cA + kstep, voffA); PG8_STAGE(PG8_SB(1, 1), cB + hstepB + kstep, voffB);
        PG8_WAIT_V(6); PG8_BAR;
    }
    for (;;) {
        const bool has_next = S.next(ui + 1, nxt);
        const char* nA = has_next ? (const char*)g.A + (size_t)nxt.pm * tstepA : cA; const char* nB = has_next ? (const char*)g.Bt + (size_t)nxt.pn * tstepB : cB;
        for (int t = 0; t < nt; t += 2) {
            if constexpr (Epi::MIDK > 0) { if (t == Epi::MIDK) E.mid(acc, cur, wr, wc, fr, fq); }
            const bool last = (t == nt - 2);
            const char* a1 = cA + (size_t)(t + 1) * kstep;
            const char* a2 = last ? nA : cA + (size_t)(t + 2) * kstep; const char* b2 = last ? nB : cB + (size_t)(t + 2) * kstep;
            const char* a3 = a2 + kstep; const char* b3 = b2 + kstep;
            if (last && has_next) S.a_ready(nxt);
            if constexpr (SP2) {
            PG8_LDB(B0, 0, 0); PG8_LDB(B1, 0, 1); PG8_SCHED; PG8_LDA(At, 0, 0); PG8_STAGE(PG8_SA(1, 1), a1 + hstepA, voffA);
            PG8_WAIT_V(8); PG8_WAIT_L(0); PG8_BAR; PG8_MMA(0, 0, At, B0); PG8_MMA(0, 1, At, B1); PG8_BAR; PG8_SCHED;
            PG8_LDA(At, 0, 1); PG8_STAGE(PG8_SB(0, 0), b2, voffB); PG8_STAGE(PG8_SB(0, 1), b2 + hstepB, voffB); PG8_STAGE(PG8_SA(0, 0), a2, voffA);
            PG8_WAIT_V(8); PG8_WAIT_L(0); PG8_BAR; PG8_MMA(1, 0, At, B0); PG8_MMA(1, 1, At, B1); PG8_BAR; PG8_SCHED;
            PG8_LDB(B0, 1, 0); PG8_LDB(B1, 1, 1); PG8_SCHED; PG8_LDA(At, 1, 0); PG8_STAGE(PG8_SA(0, 1), a2 + hstepA, voffA);
            PG8_WAIT_V(8); PG8_WAIT_L(0); PG8_BAR; PG8_MMA(0, 0, At, B0); PG8_MMA(0, 1, At, B1); PG8_BAR; PG8_SCHED;
            PG8_LDA(At, 1, 1); PG8_STAGE(PG8_SB(1, 0), b3, voffB); PG8_STAGE(PG8_SB(1, 1), b3 + hstepB, voffB); PG8_STAGE(PG8_SA(1, 0), a3, voffA);
            PG8_WAIT_V(8); PG8_WAIT_L(0); PG8_BAR; PG8_MMA(1, 0, At, B0); PG8_MMA(1, 1, At, B1); PG8_BAR; PG8_SCHED;
            } else {
            PG8_LDB(B0, 0, 0); PG8_SCHED; PG8_LDA(At, 0, 0); PG8_STAGE(PG8_SA(1, 1), a1 + hstepA, voffA);
            PG8_WAIT_L(8); PG8_BAR; PG8_WAIT_L(0); PG8_MMA(0, 0, At, B0); PG8_BAR; PG8_SCHED;
            PG8_LDB(B1, 0, 1); PG8_STAGE(PG8_SB(0, 0), b2, voffB);
            PG8_BAR; PG8_WAIT_L(0); PG8_MMA(0, 1, At, B1); PG8_BAR;
            PG8_LDA(At, 0, 1); PG8_STAGE(PG8_SA(0, 0), a2, voffA);
            PG8_BAR; PG8_WAIT_L(0); PG8_MMA(1, 0, At, B0); PG8_BAR; PG8_SCHED;
            PG8_STAGE(PG8_SB(0, 1), b2 + hstepB, voffB);
            PG8_WAIT_V(6); PG8_BAR; PG8_MMA(1, 1, At, B1); PG8_BAR;
            PG8_LDB(B0, 1, 0); PG8_SCHED; PG8_LDA(At, 1, 0); PG8_STAGE(PG8_SA(0, 1), a2 + hstepA, voffA);
            PG8_WAIT_L(8); PG8_BAR; PG8_WAIT_L(0); PG8_MMA(0, 0, At, B0); PG8_BAR; PG8_SCHED;
            PG8_LDB(B1, 1, 1); PG8_STAGE(PG8_SB(1, 0), b3, voffB);
            PG8_BAR; PG8_WAIT_L(0); PG8_MMA(0, 1, At, B1); PG8_BAR;
            PG8_LDA(At, 1, 1); PG8_STAGE(PG8_SA(1, 0), a3, voffA);
            PG8_BAR; PG8_WAIT_L(0); PG8_MMA(1, 0, At, B0); PG8_BAR; PG8_SCHED;
            PG8_STAGE(PG8_SB(1, 1), b3 + hstepB, voffB);
            PG8_WAIT_V(6); PG8_BAR; PG8_MMA(1, 1, At, B1); PG8_BAR;
            }
        }
        if constexpr (ALIGN_EPI) { if (wr == 0) PG8_BAR; }
        if constexpr (!Epi::AFTER_DRAIN) { E(acc, cur, wr, wc, fr, fq); S.done(cur); }
        if (!has_next) break;
#pragma unroll
        for (int a = 0; a < 2; ++a)
#pragma unroll
            for (int b = 0; b < 2; ++b)
#pragma unroll
                for (int m = 0; m < 4; ++m)
#pragma unroll
                    for (int n = 0; n < 2; ++n) acc[a][b][m][n] = (f32x4){0.f, 0.f, 0.f, 0.f};
        cur = nxt; cA = nA; cB = nB; ++ui;
        if constexpr (ALIGN_EPI) { if (wr == 1) PG8_BAR; }
    }
    PG8_WAIT_V(0);
    if constexpr (!ALIGN_EPI) { if (wr == 0) PG8_BAR; }
    PG8_BAR;
    if constexpr (Epi::AFTER_DRAIN) { E.fused(acc, cur, wr, wc, fr, fq, lds, wid, lane); S.done(cur); }
#undef PG8_SA
#undef PG8_SB
#undef PG8_STAGE
#undef PG8_LDA
#undef PG8_LDB
#undef PG8_MMA
#undef PG8_WAIT_V
#undef PG8_WAIT_L
#undef PG8_BAR
#undef PG8_SCHED
}
}
#define GAS __attribute__((address_space(1)))
#define LAS __attribute__((address_space(3)))
typedef unsigned short bf16;
typedef unsigned v4u __attribute__((ext_vector_type(4)));
typedef float f32x4 __attribute__((ext_vector_type(4)));
typedef short bf16x8 __attribute__((ext_vector_type(8)));
typedef GAS unsigned gu32;
typedef GAS unsigned long long gu64;
#define RLX_AGENT __ATOMIC_RELAXED, __HIP_MEMORY_SCOPE_AGENT
#define LDS_WAIT() asm volatile("s_waitcnt lgkmcnt(0)" ::: "memory")
#define VM_WAIT() asm volatile("s_waitcnt vmcnt(0)" ::: "memory")
__device__ __forceinline__ unsigned long long rt() { return __builtin_amdgcn_s_memrealtime(); }
__device__ __forceinline__ unsigned f2bf(float f) { unsigned u = __builtin_bit_cast(unsigned, f); return (u + 0x7fffu + ((u >> 16) & 1u)) >> 16; }
__device__ __forceinline__ unsigned pk2(float lo, float hi) { return f2bf(lo) | (f2bf(hi) << 16); }

#define XB_TMO      128
#define XB_XCNT(j)  (256  + 64 * (j))
#define XB_XSUB(j)  (1280 + 64 * (j))
#define XB_XGEN(j)  (2304 + 64 * (j))
#define XB_TOP      3328
#define XB_TOPGEN   3392
#define XCD_BAR_WORDS 3456
#define XB_SPIN_CAP (1u << 18)

__device__ __forceinline__ unsigned xb_ld(unsigned* p)              { return __hip_atomic_load(p, __ATOMIC_RELAXED, __HIP_MEMORY_SCOPE_AGENT); }
__device__ __forceinline__ unsigned xb_add(unsigned* p, unsigned v) { return __hip_atomic_fetch_add(p, v, __ATOMIC_RELAXED, __HIP_MEMORY_SCOPE_AGENT); }
__device__ __forceinline__ unsigned xb_xcc_id() { return (unsigned)__builtin_amdgcn_s_getreg((3 << 11) | 20) & 0xFu; }
#define XB_SPIN(cond, bar) do { unsigned _sp = 0; while (cond) { __builtin_amdgcn_s_sleep(1); \
    if ((++_sp & 255u) == 0u) { if (xb_ld(&(bar)[XB_TMO])) break; if (_sp > XB_SPIN_CAP) { atomicAdd(&(bar)[XB_TMO], 1u); break; } } } } while (0)

struct XcdBarrier {
    unsigned* bar; unsigned x;
    volatile LAS unsigned* st;
};

__device__ __forceinline__ XcdBarrier xcd_barrier_post(unsigned* bar, volatile LAS unsigned* st) {
    XcdBarrier b; b.bar = bar; b.x = xb_xcc_id(); b.st = st;
    if (threadIdx.x == 0) (void)xb_add(&bar[XB_XCNT(b.x)], 1u);
    return b;
}
__device__ __forceinline__ void xcd_barrier_complete(unsigned* bar, unsigned x, unsigned& nloc, unsigned& nx) {
    const unsigned G = gridDim.x * gridDim.y * gridDim.z;
    unsigned sum, cnt, mine, sp = 0u;
    for (;;) {
        sum = 0u; cnt = 0u; mine = 0u;
#pragma unroll
        for (unsigned j = 0; j < 16; ++j) { const unsigned c = xb_ld(&bar[XB_XCNT(j)]); sum += c; cnt += (c > 0u) ? 1u : 0u; mine = (j == x) ? c : mine; }
        if (sum == G) break;
        __builtin_amdgcn_s_sleep(1);
        if ((++sp & 255u) == 0u) { if (xb_ld(&bar[XB_TMO])) break; if (sp > XB_SPIN_CAP) { atomicAdd(&bar[XB_TMO], 1u); break; } }
    }
    nloc = mine > 0u ? mine : 1u; nx = cnt > 0u ? cnt : 1u;
}

__device__ __forceinline__ void xcd_barrier(const XcdBarrier& b) {
    asm volatile("s_waitcnt vmcnt(0)" ::: "memory");
    __syncthreads();
    if (threadIdx.x == 0) {
        unsigned* bar = b.bar;
        __builtin_amdgcn_s_waitcnt(0);
        unsigned nloc = b.st[0], nx = b.st[1];
        if (nloc == 0u) { xcd_barrier_complete(bar, b.x, nloc, nx); b.st[0] = nloc; b.st[1] = nx; }
        const unsigned old = xb_add(&bar[XB_XSUB(b.x)], 1u);
        const unsigned gen = old / nloc;
        if (old + 1u == (gen + 1u) * nloc) {
            __builtin_amdgcn_fence(__ATOMIC_RELEASE, "agent");
            asm volatile("s_waitcnt vmcnt(0)" ::: "memory");
            const unsigned og = xb_add(&bar[XB_TOP], 1u);
            const unsigned tg = og / nx;
            if (og + 1u == (tg + 1u) * nx) xb_add(&bar[XB_TOPGEN], 1u);
            else XB_SPIN(xb_ld(&bar[XB_TOPGEN]) == tg, bar);
            __builtin_amdgcn_fence(__ATOMIC_ACQUIRE, "agent");
            xb_add(&bar[XB_XGEN(b.x)], 1u);
            asm volatile("s_waitcnt vmcnt(0)" ::: "memory");
        } else {
            XB_SPIN(xb_ld(&bar[XB_XGEN(b.x)]) == gen, bar);
            __builtin_amdgcn_fence(__ATOMIC_ACQUIRE, "agent");
            asm volatile("s_waitcnt vmcnt(0)" ::: "memory");
        }
    }
    __syncthreads();
}
typedef float f32x4v __attribute__((ext_vector_type(4)));
struct Frame {
    LAS unsigned char* lds;
    volatile LAS unsigned* MISC;
    gu32* ctl;
    int tid, lane, wave, G, vcu;
    float* out; unsigned char* ws;
};
typedef const float* cfptr;
#define INP(i) (((const LAS cfptr*)(F.lds + LDSCTL_OFF + 256))[i])
#define IN_X 0
#define IN_C 1
#define IN_CTX 2
#define IN_CCTX 3
#define IN_WMOD 4
#define IN_BMOD 5
#define IN_NMIX 6
#define IN_NFFN 7
#define IN_WIN 8
#define IN_QNA 9
#define IN_KNA 10
#define IN_SINK 11
#define IN_WBRA 12
#define IN_WBRB 13
#define IN_WOUT 14
#define IN_WRG 15
#define IN_BRG 16
#define IN_WRE 17
#define IN_BRE 18
#define IN_W1 19
#define IN_W3 20
#define IN_W2 21
#define IN_NFIN 22

__device__ __forceinline__ float wave_sum(float v) {
#pragma unroll
    for (int o = 1; o < 64; o <<= 1) v += __shfl_xor(v, o);
    return v;
}
__device__ __forceinline__ float wave_max(float v) {
#pragma unroll
    for (int o = 1; o < 64; o <<= 1) v = fmaxf(v, __shfl_xor(v, o));
    return v;
}
__device__ __forceinline__ float bf2f(bf16 h) { return __builtin_bit_cast(float, (unsigned)h << 16); }
__device__ __forceinline__ int mod_row(int m) { return (m % TT) < CTX ? 4 : m / TT; }

__device__ __forceinline__ void compute_base(const unsigned* cnt, LAS unsigned* base, int tid) {
    if (tid < 64) {
        const unsigned c = __hip_atomic_load(cnt + tid, RLX_AGENT); unsigned v = c;
#pragma unroll
        for (int o = 1; o < 64; o <<= 1) { const unsigned t = __shfl_up(v, o); if (tid >= o) v += t; }
        base[tid] = v - c; if (tid == 63) base[64] = v;
    }
    __syncthreads();
}

template <int MODE>
__device__ __forceinline__ void tr_item(const float* W, int ldw, bf16* WT, int ldt, int koff, LAS float* scr, int kb, int nb, int lane) {
    const int k0 = 64 * kb, n0 = 32 * nb;
    const int lr = lane >> 3, lc = (lane & 7) * 4;
    f32x4v v[8];
#pragma unroll
    for (int i = 0; i < 8; ++i) v[i] = __builtin_nontemporal_load((const f32x4v*)(W + (size_t)(k0 + 8 * i + lr) * ldw + n0 + lc));
#pragma unroll
    for (int i = 0; i < 8; ++i) { LAS float* d = scr + (8 * i + lr) * 33 + lc; d[0] = v[i].x; d[1] = v[i].y; d[2] = v[i].z; d[3] = v[i].w; }
    LDS_WAIT(); asm volatile("" ::: "memory");
    const int c = lane & 7;
#pragma unroll
    for (int j = 0; j < 4; ++j) { const int n = (lane >> 3) + 8 * j; const LAS float* s = scr + (8 * c) * 33 + n;
        v4u o; o.x = pk2(s[0 * 33], s[1 * 33]); o.y = pk2(s[2 * 33], s[3 * 33]); o.z = pk2(s[4 * 33], s[5 * 33]); o.w = pk2(s[6 * 33], s[7 * 33]);
        const int drow = (MODE == 1) ? inproj_dst_col(n0 + n) : (n0 + n);
        *(GAS v4u*)(WT + (size_t)drow * ldt + koff + k0 + 8 * c) = o; }
    LDS_WAIT(); asm volatile("" ::: "memory");
}

__device__ __forceinline__ void p0_prologue(Frame& F) {
#if TPROBE >= 200
    if (F.tid == 0) atomicMax((unsigned*)F.ctl + 200000, (unsigned)__builtin_amdgcn_s_memrealtime());
#endif
    LAS float* sl = (LAS float*)(F.lds);
    LAS float* red = (LAS float*)(F.lds + 40960);
    for (int i = F.tid; i < 5 * D; i += NWAVES * 64) { const int r = i / D, k = i % D; const float v = r < 4 ? INP(IN_C)[r * D + k] : INP(IN_CCTX)[k]; sl[i] = v / (1.f + __expf(-v)); }
    __syncthreads();
#if TPROBE >= 200
    if (F.tid == 0) atomicMax((unsigned*)F.ctl + 200000 + 256, (unsigned)__builtin_amdgcn_s_memrealtime());
#endif
    float* MODP = (float*)(F.ws + WS_MODP);
    for (int u = F.vcu; u < 2 * 6 * 64; u += F.G) {
        const int l = u / (6 * 64), cb = (u / 64) % 6, kslc = u % 64, col = cb * 2048 + 4 * F.tid;
        const float* W = INP(IN_WMOD) + (size_t)l * D * MODW + (size_t)(kslc * 32) * MODW + col;
        f32x4v acc[5];
#pragma unroll
        for (int r = 0; r < 5; ++r) acc[r] = (f32x4v){0.f, 0.f, 0.f, 0.f};
#pragma unroll 16
        for (int kk = 0; kk < 32; ++kk) { const int k = kslc * 32 + kk; const f32x4v w = __builtin_nontemporal_load((const f32x4v*)(W + (size_t)kk * MODW));
#pragma unroll
            for (int r = 0; r < 5; ++r) acc[r] += sl[r * D + k] * w; }
#pragma unroll
        for (int r = 0; r < 5; ++r) *(f32x4v*)(MODP + ((size_t)(l * 64 + kslc) * 5 + r) * MODW + col) = acc[r];
    }
    __syncthreads();
#if TPROBE >= 200
    __syncthreads(); if (F.tid == 0) atomicMax((unsigned*)F.ctl + 200000 + 64, (unsigned)__builtin_amdgcn_s_memrealtime());
#endif
    if (F.vcu == 0) { float* RT = (float*)(F.ws + WS_ROPE);
        for (int i = F.tid; i < 64 * 32; i += NWAVES * 64) { const int pos = i >> 5, f = i & 31; const float freq = powf(10000.f, -(float)f / 32.f); const float ang = (float)pos * freq; RT[i] = cosf(ang); RT[2048 + i] = sinf(ang); } }
    { bf16* WRT = (bf16*)(F.ws + WS_WR);
      for (int it = F.vcu * NWAVES * 64 + F.tid; it < 2 * 80 * 256; it += F.G * NWAVES * 64) {
          const int l = it / (80 * 256), c = (it / 256) % 80, k0 = (it % 256) * 8;
          float wv[8];
#pragma unroll
          for (int i = 0; i < 8; ++i) wv[i] = c < 64 ? INP(IN_WRE)[((size_t)l * D + k0 + i) * NE + c] : (c < 72 ? INP(IN_WRG)[((size_t)l * D + k0 + i) * NG + (c - 64)] : 0.f);
          unsigned hi[4], lo[4];
#pragma unroll
          for (int i = 0; i < 4; ++i) { const unsigned h0 = f2bf(wv[2 * i]), h1 = f2bf(wv[2 * i + 1]); hi[i] = h0 | (h1 << 16);
              lo[i] = f2bf(wv[2 * i] - __builtin_bit_cast(float, h0 << 16)) | (f2bf(wv[2 * i + 1] - __builtin_bit_cast(float, h1 << 16)) << 16); }
          const int ko = k0 >> 3, sI = ko >> 2, fqI = ko & 3, cfI = c >> 4, frI = c & 15;
          *(v4u*)(WRT + ((((size_t)(l * 2 + 0) * 64 + sI) * 5 + cfI) * 64 + fqI * 16 + frI) * 8) = (v4u){hi[0], hi[1], hi[2], hi[3]};
          *(v4u*)(WRT + ((((size_t)(l * 2 + 1) * 64 + sI) * 5 + cfI) * 64 + fqI * 16 + frI) * 8) = (v4u){lo[0], lo[1], lo[2], lo[3]};
      } }
#if TPROBE >= 200
    __syncthreads(); if (F.tid == 0) atomicMax((unsigned*)F.ctl + 200000 + 128, (unsigned)__builtin_amdgcn_s_memrealtime());
#endif
    LAS float* scr = (LAS float*)(F.lds + F.wave * 16384);
    const int gw = F.vcu * NWAVES + F.wave, NGW = F.G * NWAVES;
    constexpr int I_IN = 32 * 224, I_BR = 16 * 64, I_OUT = 32 * 64, I_L = I_IN + 2 * I_BR + I_OUT;
    for (int it = gw; it < 2 * I_L; it += NGW) {
        const int l = it / I_L; int r = it % I_L;
        if (r < I_IN) { tr_item<1>(INP(IN_WIN) + (size_t)l * D * INC, INC, (bf16*)(F.ws + WS_WIN) + (size_t)l * INC * D, D, 0, scr, r / 224, r % 224, F.lane); continue; } r -= I_IN;
        if (r < I_BR) { tr_item<0>(INP(IN_WBRA) + (size_t)l * QW * D, D, (bf16*)(F.ws + WS_WBR) + (size_t)l * D * D, D, 0, scr, r / 64, r % 64, F.lane); continue; } r -= I_BR;
        if (r < I_BR) { tr_item<0>(INP(IN_WBRB) + (size_t)l * QW * D, D, (bf16*)(F.ws + WS_WBR) + (size_t)l * D * D, D, QW, scr, r / 64, r % 64, F.lane); continue; } r -= I_BR;
        tr_item<0>(INP(IN_WOUT) + (size_t)l * D * D, D, (bf16*)(F.ws + WS_WOUT) + (size_t)l * D * D, D, 0, scr, r / 64, r % 64, F.lane);
    }
#if TPROBE >= 200
    __syncthreads(); if (F.tid == 0) atomicMax((unsigned*)F.ctl + 200000 + 192, (unsigned)__builtin_amdgcn_s_memrealtime());
#endif
}

__device__ __forceinline__ void p0b_reduce(Frame& F) {
    const float* MODP = (const float*)(F.ws + WS_MODP); float* MOD = (float*)(F.ws + WS_MOD);
    for (int o = F.vcu * NWAVES * 64 + F.tid; o < 2 * 5 * (MODW / 4); o += F.G * NWAVES * 64) {
        const int l = o / (5 * (MODW / 4)), r = (o / (MODW / 4)) % 5, n = (o % (MODW / 4)) * 4;
        f32x4v a = *(const f32x4v*)(INP(IN_BMOD) + l * MODW + n);
#pragma unroll 16
        for (int k2 = 0; k2 < 64; ++k2) a += *(const f32x4v*)(MODP + ((size_t)(l * 64 + k2) * 5 + r) * MODW + n);
        *(f32x4v*)(MOD + (size_t)(l * 5 + r) * MODW + n) = a;
    }
}

__device__ __forceinline__ void moe_combine_add(Frame& F, int lp, int m, const LAS unsigned* base, f32x4v (&v)[8]) {
    const unsigned* TE = (const unsigned*)(F.ws + WS_TOK) + (size_t)lp * M * 2;
    const unsigned* TP = (const unsigned*)(F.ws + WS_TOK) + (size_t)(2 + lp) * M * 2;
    const float* TW = (const float*)(F.ws + WS_TOK) + (size_t)(4 + lp) * M * 2;
    const unsigned e0 = TE[m * 2], e1 = TE[m * 2 + 1];
    const unsigned s0 = base[e0] + TP[m * 2], s1 = base[e1] + TP[m * 2 + 1];
    const float w0 = TW[m * 2], w1 = TW[m * 2 + 1];
    const bf16* Y0 = (const bf16*)(F.ws + WS_YM) + (size_t)s0 * D; const bf16* Y1 = (const bf16*)(F.ws + WS_YM) + (size_t)s1 * D;
    const float* g2 = (const float*)(F.ws + WS_MOD) + (size_t)(lp * 5 + mod_row(m)) * MODW + 5 * D;
#pragma unroll
    for (int j = 0; j < 8; ++j) { const int col = 4 * (F.lane + 64 * j);
        const uint2 a = *(const uint2*)(Y0 + col), b = *(const uint2*)(Y1 + col); const f32x4v g = *(const f32x4v*)(g2 + col);
        f32x4v ya = {__builtin_bit_cast(float, a.x << 16), __builtin_bit_cast(float, a.x & 0xffff0000u), __builtin_bit_cast(float, a.y << 16), __builtin_bit_cast(float, a.y & 0xffff0000u)};
        f32x4v yb = {__builtin_bit_cast(float, b.x << 16), __builtin_bit_cast(float, b.x & 0xffff0000u), __builtin_bit_cast(float, b.y << 16), __builtin_bit_cast(float, b.y & 0xffff0000u)};
        v[j] += g * (w0 * ya + w1 * yb); }
}
__device__ __forceinline__ void store_bf16_row(bf16* dst, int lane, const f32x4v (&h)[8]) {
#pragma unroll
    for (int j = 0; j < 8; ++j) { uint2 o; o.x = pk2(h[j].x, h[j].y); o.y = pk2(h[j].z, h[j].w); *(uint2*)(dst + 4 * (lane + 64 * j)) = o; }
}
__device__ __forceinline__ float row_sumsq(const f32x4v (&v)[8]) {
    float s = 0.f;
#pragma unroll
    for (int j = 0; j < 8; ++j) s += (v[j].x * v[j].x + v[j].y * v[j].y) + (v[j].z * v[j].z + v[j].w * v[j].w);
    return wave_sum(s);
}

template <bool DRY>
__device__ __forceinline__ void ph_norm1(Frame& F, int l) {
    LAS unsigned* base = (LAS unsigned*)(F.lds);
    if (l > 0) compute_base((const unsigned*)F.ctl + CW_CNT + (l - 1) * 64, base, F.tid);
    const int gw = F.vcu * NWAVES + F.wave, NGW = F.G * NWAVES;
    float* XW = (float*)(F.ws + WS_XW); bf16* HA = (bf16*)(F.ws + (DRY ? WS_T2 : WS_HA)); float* XWo = (float*)(F.ws + (DRY ? WS_T1 : WS_XW));
    const float* nw = INP(IN_NMIX) + l * D;
#define N1_LOAD(m_, v_) do { const int b_ = (m_) / TT, t_ = (m_) % TT; \
        const float* src_ = (l == 0) ? (t_ < CTX ? INP(IN_CTX) + ((size_t)b_ * CTX + t_) * D : INP(IN_X) + ((size_t)b_ * SEQ + (t_ - CTX)) * D) : XW + (size_t)(m_) * D; \
        _Pragma("unroll") for (int j = 0; j < 8; ++j) v_[j] = *(const f32x4v*)(src_ + 4 * (F.lane + 64 * j)); } while (0)
#define N1_FINISH(m_, v_) do { \
        if (l > 0) moe_combine_add(F, l - 1, (m_), base, v_); \
        _Pragma("unroll") for (int j = 0; j < 8; ++j) *(f32x4v*)(XWo + (size_t)(m_) * D + 4 * (F.lane + 64 * j)) = v_[j]; \
        const float rstd = 1.0f / sqrtf(row_sumsq(v_) * (1.0f / D) + EPS); \
        const float* mod = (const float*)(F.ws + WS_MOD) + (size_t)(l * 5 + mod_row(m_)) * MODW; \
        f32x4v h[8]; \
        _Pragma("unroll") for (int j = 0; j < 8; ++j) { const int col = 4 * (F.lane + 64 * j); const f32x4v w = *(const f32x4v*)(nw + col), sh = *(const f32x4v*)(mod + col), sc = *(const f32x4v*)(mod + D + col); \
            h[j] = (v_[j] * rstd * w) * (1.0f + sc) + sh; } \
        store_bf16_row(HA + (size_t)(m_) * D, F.lane, h); } while (0)
    f32x4v va[8], vb[8];
    int m = gw; if (m < M) N1_LOAD(m, va);
    while (m < M) {
        const int m1 = m + NGW; if (m1 < M) N1_LOAD(m1, vb);
        N1_FINISH(m, va);
        if (m1 >= M) break;
        const int m2 = m1 + NGW; if (m2 < M) N1_LOAD(m2, va);
        N1_FINISH(m1, vb);
        m = m2;
    }
#undef N1_LOAD
#undef N1_FINISH
}

__device__ __forceinline__ void post_head(const float* P, bf16* dst, const float* nw, bool rope, int rowpos, int colpos, const float* RT, int lane) {
    const int wc = lane >> 4, tt = lane & 15, j0 = 32 * wc + tt, j1 = j0 + 16, d1 = 64 * (wc >> 1) + 16 * (wc & 1) + tt, d2 = d1 + 32;
    float x1 = P[j0], x2 = P[j1];
    if (nw) { const float ss = wave_sum(x1 * x1 + x2 * x2); const float r = 1.0f / sqrtf(ss * (1.0f / HD) + EPS); x1 = x1 * r * nw[d1]; x2 = x2 * r * nw[d2]; }
    if (rope) { const int pos = (wc >> 1) ? colpos : rowpos, fi = 16 * (wc & 1) + tt; const float cs = RT[pos * 32 + fi], sn = RT[2048 + pos * 32 + fi];
        const float o1 = x1 * cs - x2 * sn, o2 = x1 * sn + x2 * cs; x1 = o1; x2 = o2; }
    dst[j0] = (bf16)f2bf(x1); dst[j1] = (bf16)f2bf(x2);
}
__device__ __forceinline__ void ph_post(Frame& F, int l) {
    const int gw = F.vcu * NWAVES + F.wave, NGW = F.G * NWAVES;
    const float* RT = (const float*)(F.ws + WS_ROPE);
    const float* qn = INP(IN_QNA) + l * HD; const float* kn = INP(IN_KNA) + l * HD;
    for (int m = gw; m < M; m += NGW) {
        const int t = m % TT; const bool rope = t >= CTX; const int s = t - CTX, rowpos = rope ? s / GRIDW : 0, colpos = rope ? s % GRIDW : 0;
        const float* P = (const float*)(F.ws + WS_P) + (size_t)m * INC;
        for (int h = 0; h < NH; ++h) post_head(P + OFF_QA + h * HD, (bf16*)(F.ws + WS_QA) + (size_t)m * QW + h * HD, qn, rope, rowpos, colpos, RT, F.lane);
        for (int h = 0; h < NKV; ++h) post_head(P + OFF_KA + h * HD, (bf16*)(F.ws + WS_KA) + (size_t)m * KW + h * HD, kn, rope, rowpos, colpos, RT, F.lane);
        for (int h = 0; h < NH; ++h) post_head(P + OFF_QB + h * HD, (bf16*)(F.ws + WS_QB) + (size_t)m * QW + h * HD, nullptr, rope, rowpos, colpos, RT, F.lane);
        for (int h = 0; h < NKV; ++h) post_head(P + OFF_KB + h * HD, (bf16*)(F.ws + WS_KB) + (size_t)m * KW + h * HD, nullptr, rope, rowpos, colpos, RT, F.lane);
        { const f32x4v a = *(const f32x4v*)(P + OFF_VA + 4 * F.lane), b = *(const f32x4v*)(P + OFF_VB + 4 * F.lane); uint2 o; o.x = pk2(a.x, a.y); o.y = pk2(a.z, a.w); *(uint2*)((bf16*)(F.ws + WS_VA) + (size_t)m * KW + 4 * F.lane) = o;
          o.x = pk2(b.x, b.y); o.y = pk2(b.z, b.w); *(uint2*)((bf16*)(F.ws + WS_VB) + (size_t)m * KW + 4 * F.lane) = o; }
#pragma unroll
        for (int j = 0; j < 8; ++j) { const int col = 4 * (F.lane + 64 * j);
            const f32x4v a = *(const f32x4v*)(P + OFF_GA + col), b = *(const f32x4v*)(P + OFF_GB + col);
            uint2 o; o.x = pk2(1.f / (1.f + __expf(-a.x)), 1.f / (1.f + __expf(-a.y))); o.y = pk2(1.f / (1.f + __expf(-a.z)), 1.f / (1.f + __expf(-a.w))); *(uint2*)((bf16*)(F.ws + WS_GA) + (size_t)m * D + col) = o;
            o.x = pk2(1.f / (1.f + __expf(-b.x)), 1.f / (1.f + __expf(-b.y))); o.y = pk2(1.f / (1.f + __expf(-b.z)), 1.f / (1.f + __expf(-b.w))); *(uint2*)((bf16*)(F.ws + WS_GB) + (size_t)m * D + col) = o; }
    }
}

__device__ __forceinline__ void ph_gate(Frame& F, int l) {
    const int gw = F.vcu * NWAVES + F.wave, NGW = F.G * NWAVES;
    for (int m = gw; m < M; m += NGW) {
        if (l == DEPTH - 1 && (m % TT) < CTX) continue;
        const bf16* GA = (const bf16*)(F.ws + WS_GA) + (size_t)m * D; const bf16* GB = (const bf16*)(F.ws + WS_GB) + (size_t)m * D;
        const float* T1 = (const float*)(F.ws + WS_T1) + (size_t)m * D; const float* T2 = (const float*)(F.ws + WS_T2) + (size_t)m * D;
        f32x4v h[8];
#pragma unroll
        for (int j = 0; j < 8; ++j) { const int col = 4 * (F.lane + 64 * j); const uint2 a = *(const uint2*)(GA + col), b = *(const uint2*)(GB + col);
            const f32x4v ga = {__builtin_bit_cast(float, a.x << 16), __builtin_bit_cast(float, a.x & 0xffff0000u), __builtin_bit_cast(float, a.y << 16), __builtin_bit_cast(float, a.y & 0xffff0000u)};
            const f32x4v gb = {__builtin_bit_cast(float, b.x << 16), __builtin_bit_cast(float, b.x & 0xffff0000u), __builtin_bit_cast(float, b.y << 16), __builtin_bit_cast(float, b.y & 0xffff0000u)};
            h[j] = ga * *(const f32x4v*)(T1 + col) + gb * *(const f32x4v*)(T2 + col); }
        store_bf16_row((bf16*)(F.ws + WS_MB) + (size_t)m * D, F.lane, h);
    }
}

template <bool ADD_T3, bool DRY>
__device__ __forceinline__ void ph_norm2_router(Frame& F, int l) {
    typedef short bf16x8r __attribute__((ext_vector_type(8)));
    constexpr int HP = 4112;
    LAS unsigned char* hhi = F.lds; LAS unsigned char* hlo = F.lds + 16 * HP;
    float* XW = (float*)(F.ws + WS_XW); bf16* H2 = (bf16*)(F.ws + (DRY ? WS_T2 : WS_HA));
    const float* nw = INP(IN_NFFN) + l * D;
    const bf16* WRH = (const bf16*)(F.ws + WS_WR) + (size_t)(l * 2) * 80 * D; const bf16* WRL = WRH + (size_t)80 * D;
    const int nrows = (l == DEPTH - 1) ? NB * SEQ : M, niter = nrows / 16;
    unsigned* TE = (unsigned*)(F.ws + WS_TOK) + (size_t)l * M * 2; float* TW = (float*)(F.ws + WS_TOK) + (size_t)(4 + l) * M * 2;
    const int w = F.wave, lane = F.lane, fr = lane & 15, fq = lane >> 4;
#if TPROBE >= 100
    unsigned long long tacc1 = 0, tacc3 = 0, tacc5 = 0, tprev = __builtin_amdgcn_s_memrealtime();
#define SUBT(acc_) do { if (blockIdx.x == 0 && F.tid == 0 && l == 0) { const unsigned long long tn_ = __builtin_amdgcn_s_memrealtime(); acc_ += tn_ - tprev; tprev = tn_; } } while (0)
#else
#define SUBT(acc_) do { } while (0)
#endif
    f32x4v vrow[2][8];
#define N2_LOADROWS(it_) do { _Pragma("unroll") for (int rr_ = 0; rr_ < 2; ++rr_) { const int q_ = (it_) * 16 + 2 * w + rr_; const int m_ = (l == DEPTH - 1) ? (q_ / SEQ) * TT + CTX + (q_ % SEQ) : q_; \
        _Pragma("unroll") for (int j = 0; j < 8; ++j) vrow[rr_][j] = *(const f32x4v*)(XW + (size_t)m_ * D + 4 * (lane + 64 * j)); } } while (0)
    if (F.vcu < niter) N2_LOADROWS(F.vcu);
    for (int it = F.vcu; it < niter; it += F.G) {
        __syncthreads();
        if (it != F.vcu) N2_LOADROWS(it);
#pragma unroll
        for (int rr = 0; rr < 2; ++rr) {
            const int lr = 2 * w + rr, q = it * 16 + lr; const int m = (l == DEPTH - 1) ? (q / SEQ) * TT + CTX + (q % SEQ) : q;
            f32x4v v[8];
#pragma unroll
            for (int j = 0; j < 8; ++j) v[j] = vrow[rr][j];
            const float* mod = (const float*)(F.ws + WS_MOD) + (size_t)(l * 5 + mod_row(m)) * MODW;
            if (ADD_T3) { const float* T3 = (const float*)(F.ws + WS_T3) + (size_t)m * D;
#pragma unroll
                for (int j = 0; j < 8; ++j) { const int col = 4 * (lane + 64 * j); v[j] += *(const f32x4v*)(mod + 2 * D + col) * *(const f32x4v*)(T3 + col); *(f32x4v*)(XW + (size_t)m * D + col) = v[j]; } }
            const float rstd = 1.0f / sqrtf(row_sumsq(v) * (1.0f / D) + EPS);
            f32x4v h[8];
#pragma unroll
            for (int j = 0; j < 8; ++j) { const int col = 4 * (lane + 64 * j); const f32x4v ww = *(const f32x4v*)(nw + col), sh = *(const f32x4v*)(mod + 3 * D + col), sc = *(const f32x4v*)(mod + 4 * D + col);
                h[j] = (v[j] * rstd * ww) * (1.0f + sc) + sh;
                const unsigned a0 = f2bf(h[j].x), a1 = f2bf(h[j].y), a2 = f2bf(h[j].z), a3 = f2bf(h[j].w);
                typedef unsigned u32x2r __attribute__((ext_vector_type(2))); u32x2r hi2, lo2; hi2.x = a0 | (a1 << 16); hi2.y = a2 | (a3 << 16);
                lo2.x = f2bf(h[j].x - __builtin_bit_cast(float, a0 << 16)) | (f2bf(h[j].y - __builtin_bit_cast(float, a1 << 16)) << 16);
                lo2.y = f2bf(h[j].z - __builtin_bit_cast(float, a2 << 16)) | (f2bf(h[j].w - __builtin_bit_cast(float, a3 << 16)) << 16);
                *(LAS u32x2r*)(hhi + lr * HP + col * 2) = hi2; *(LAS u32x2r*)(hlo + lr * HP + col * 2) = lo2; }
            store_bf16_row(H2 + (size_t)m * D, lane, h);
        }
        __syncthreads(); SUBT(tacc1);
        {
            pg8::f32x4 acc[5];
#pragma unroll
            for (int cf = 0; cf < 5; ++cf) acc[cf] = (pg8::f32x4){0.f, 0.f, 0.f, 0.f};
            const __amdgpu_buffer_rsrc_t wrs = __builtin_amdgcn_make_buffer_rsrc((void*)WRH, 0, 2 * 80 * D * 2, 0x00020000);
            const unsigned wvo = (unsigned)lane * 16u;
            const LAS unsigned char* ah = hhi + fr * HP + (256 * w + 8 * fq) * 2; const LAS unsigned char* al = hlo + fr * HP + (256 * w + 8 * fq) * 2;
            bf16x8r Wh0[5], Wl0[5], Wh1[5], Wl1[5];
#define RT_LOADW(Wh, Wl, s_) do { _Pragma("unroll") for (int cf = 0; cf < 5; ++cf) { Wh[cf] = __builtin_bit_cast(bf16x8r, __builtin_amdgcn_raw_buffer_load_b128(wrs, wvo, ((8 * w + (s_)) * 5 + cf) * 1024, 0)); Wl[cf] = __builtin_bit_cast(bf16x8r, __builtin_amdgcn_raw_buffer_load_b128(wrs, wvo, ((64 + 8 * w + (s_)) * 5 + cf) * 1024, 0)); } } while (0)
#define RT_MMA(Wh, Wl, s_) do { const bf16x8r Hh = *(const LAS bf16x8r*)(ah + 64 * (s_)), Hl = *(const LAS bf16x8r*)(al + 64 * (s_)); \
            _Pragma("unroll") for (int cf = 0; cf < 5; ++cf) { acc[cf] = __builtin_amdgcn_mfma_f32_16x16x32_bf16(Wh[cf], Hh, acc[cf], 0, 0, 0); \
                acc[cf] = __builtin_amdgcn_mfma_f32_16x16x32_bf16(Wh[cf], Hl, acc[cf], 0, 0, 0); acc[cf] = __builtin_amdgcn_mfma_f32_16x16x32_bf16(Wl[cf], Hh, acc[cf], 0, 0, 0); } } while (0)
            RT_LOADW(Wh0, Wl0, 0);
#pragma unroll
            for (int s2 = 0; s2 < 8; s2 += 2) {
                RT_LOADW(Wh1, Wl1, s2 + 1); RT_MMA(Wh0, Wl0, s2);
                if (s2 + 2 < 8) RT_LOADW(Wh0, Wl0, s2 + 2);
                RT_MMA(Wh1, Wl1, s2 + 1);
            }
#undef RT_LOADW
#undef RT_MMA
            asm volatile("s_waitcnt lgkmcnt(0)" ::: "memory");
#pragma unroll
            for (int cf = 0; cf < 5; ++cf) *(LAS pg8::f32x4*)(hhi + fr * HP + 512 * w + (16 * cf + 4 * fq) * 4) = acc[cf];
        }
        __syncthreads(); SUBT(tacc3);
#pragma unroll 1
        for (int rr = 0; rr < 2; ++rr) {
            const int lr = 2 * w + rr, q = it * 16 + lr; const int m = (l == DEPTH - 1) ? (q / SEQ) * TT + CTX + (q % SEQ) : q;
            LAS float* elb = (LAS float*)(hlo + (2 * w + rr) * HP + 512 * w);
            float el = lane < 64 ? INP(IN_BRE)[l * NE + lane] : 0.f;
#pragma unroll
            for (int k2 = 0; k2 < 8; ++k2) el += *(const LAS float*)(hhi + lr * HP + 512 * k2 + lane * 4);
            elb[lane] = el;
            if (lane < 8) { float gl = INP(IN_BRG)[l * NG + lane];
#pragma unroll
                for (int k2 = 0; k2 < 8; ++k2) gl += *(const LAS float*)(hhi + lr * HP + 512 * k2 + (64 + lane) * 4);
                elb[64 + lane] = gl; }
            LDS_WAIT(); asm volatile("" ::: "memory");
            float gmax = elb[64]; int gi = 0;
#pragma unroll
            for (int i = 1; i < 8; ++i) { const float x = elb[64 + i]; if (x > gmax) { gmax = x; gi = i; } }
            float gs = 0.f;
#pragma unroll
            for (int i = 0; i < 8; ++i) gs += __expf(elb[64 + i] - gmax);
            const float pgv = 1.0f / gs;
            float v1 = elb[gi * 8]; int i1 = 0;
#pragma unroll
            for (int i = 1; i < 8; ++i) { const float x = elb[gi * 8 + i]; if (x > v1) { v1 = x; i1 = i; } }
            float v2 = -3.0e38f; int i2 = 0;
#pragma unroll
            for (int i = 0; i < 8; ++i) { const float x = elb[gi * 8 + i]; if (i != i1 && x > v2) { v2 = x; i2 = i; } }
            const float e2 = __expf(v2 - v1), s1 = 1.0f / (1.0f + e2), s2 = e2 * s1;
            if (lane == 0 && !DRY) {
                const unsigned ea = gi * 8 + i1, eb = gi * 8 + i2;
                TE[m * 2] = ea; TE[m * 2 + 1] = eb; TW[m * 2] = s1 * pgv; TW[m * 2 + 1] = s2 * pgv;
            }
        }
        SUBT(tacc5);
    }
#if TPROBE >= 100
    if (blockIdx.x == 0 && F.tid == 0 && l == 0) { volatile LAS unsigned long long* ts = (volatile LAS unsigned long long*)(F.lds + LDSCTL_OFF + 800); ts[26] = TPROBE == 100 ? tacc1 : TPROBE == 101 ? tacc3 : tacc5; }
#endif
#undef SUBT
}

__device__ __forceinline__ void ph_compact(Frame& F, int l) {
    LAS unsigned* wtot = (LAS unsigned*)(F.lds);
    const unsigned* TE = (const unsigned*)(F.ws + WS_TOK) + (size_t)l * M * 2; unsigned* TP = (unsigned*)(F.ws + WS_TOK) + (size_t)(2 + l) * M * 2;
    unsigned* LIST = (unsigned*)(F.ws + WS_LIST) + (size_t)l * NE * M; unsigned* cnt = (unsigned*)F.ctl + CW_CNT + l * 64;
    constexpr int TPT = M / (NWAVES * 64);
    for (int e = F.vcu; e < NE; e += F.G) {
        const int m0 = F.tid * TPT; unsigned c = 0;
        for (int i = 0; i < TPT; ++i) { const int m = m0 + i; const bool valid = (l < DEPTH - 1) || ((m % TT) >= CTX);
            const uint2 te = *(const uint2*)(TE + 2 * m); c += (valid && te.x == (unsigned)e) ? 1u : 0u; c += (valid && te.y == (unsigned)e) ? 1u : 0u; }
        unsigned v = c;
#pragma unroll
        for (int o = 1; o < 64; o <<= 1) { const unsigned t = __shfl_up(v, o); if (F.lane >= o) v += t; }
        if (F.lane == 63) wtot[F.wave] = v;
        __syncthreads();
        unsigned off = 0, tot = 0;
#pragma unroll
        for (int k2 = 0; k2 < NWAVES; ++k2) { const unsigned x = wtot[k2]; off += (k2 < F.wave) ? x : 0u; tot += x; }
        unsigned pos = off + v - c;
        for (int i = 0; i < TPT; ++i) { const int m = m0 + i; const bool valid = (l < DEPTH - 1) || ((m % TT) >= CTX);
            const uint2 te = *(const uint2*)(TE + 2 * m);
            if (valid && te.x == (unsigned)e) { LIST[(size_t)e * M + pos] = (unsigned)m; TP[2 * m] = pos; ++pos; }
            if (valid && te.y == (unsigned)e) { LIST[(size_t)e * M + pos] = (unsigned)m; TP[2 * m + 1] = pos; ++pos; } }
        if (F.tid == 0) cnt[e] = tot;
        __syncthreads();
    }
}

__device__ __forceinline__ void ph_final(Frame& F) {
    LAS unsigned* base = (LAS unsigned*)(F.lds);
    compute_base((const unsigned*)F.ctl + CW_CNT + (DEPTH - 1) * 64, base, F.tid);
    const int gw = F.vcu * NWAVES + F.wave, NGW = F.G * NWAVES;
    const float* XW = (const float*)(F.ws + WS_XW); const float* nw = INP(IN_NFIN);
    for (int q = gw; q < NB * SEQ; q += NGW) {
        const int m = (q / SEQ) * TT + CTX + (q % SEQ);
        f32x4v v[8];
#pragma unroll
        for (int j = 0; j < 8; ++j) v[j] = *(const f32x4v*)(XW + (size_t)m * D + 4 * (F.lane + 64 * j));
        moe_combine_add(F, DEPTH - 1, m, base, v);
        const float rstd = 1.0f / sqrtf(row_sumsq(v) * (1.0f / D) + EPS);
#pragma unroll
        for (int j = 0; j < 8; ++j) { const int col = 4 * (F.lane + 64 * j); *(f32x4v*)(F.out + (size_t)q * D + col) = v[j] * rstd * *(const f32x4v*)(nw + col); }
    }
}
template <int COLMAP>
__global__ void __launch_bounds__(256) naive_gemm(const bf16* A, int lda, const float* W, int ldw, float* Cc, int ldc, int K) {
    const int n = blockIdx.x * 64 + threadIdx.x, m0 = blockIdx.y * 32 + threadIdx.y * 8;
    const int sc = COLMAP ? inproj_src_col(n) : n;
    float acc[8];
#pragma unroll
    for (int i = 0; i < 8; ++i) acc[i] = 0.f;
    for (int k = 0; k < K; ++k) { const float w = W[(size_t)k * ldw + sc];
#pragma unroll
        for (int i = 0; i < 8; ++i) acc[i] += bf2f(A[(size_t)(m0 + i) * lda + k]) * w; }
#pragma unroll
    for (int i = 0; i < 8; ++i) Cc[(size_t)(m0 + i) * ldc + n] = acc[i];
}

__global__ void __launch_bounds__(256) naive_attn(const bf16* Q, const bf16* K, const bf16* V, bf16* Y, const float* sink, int mode, int with_ctx_q) {
    __shared__ float sc[4][TT]; __shared__ float qs[4][HD];
    const int wave = threadIdx.x >> 6, lane = threadIdx.x & 63;
    const int nq = with_ctx_q ? TT : SEQ; const long item = (long)blockIdx.x * 4 + wave; if (item >= (long)NB * NH * nq) return;
    const int tq = (int)(item % nq) + (with_ctx_q ? 0 : CTX), h = (int)((item / nq) % NH), b = (int)(item / ((long)nq * NH)), kvh = h / (NH / NKV);
    const size_t m = (size_t)b * TT + tq;
    qs[wave][lane] = bf2f(Q[m * QW + h * HD + lane]); qs[wave][lane + 64] = bf2f(Q[m * QW + h * HD + lane + 64]);
    __builtin_amdgcn_wave_barrier(); asm volatile("s_waitcnt lgkmcnt(0)" ::: "memory");
    const bool isctx = tq < CTX; const int nk = isctx ? CTX : TT;
    float mx = -3.0e38f;
    for (int kk = lane; kk < nk; kk += 64) {
        bool valid = true;
        if (mode == 1 && !isctx && kk >= CTX) { const int dq = (tq - CTX) - (kk - CTX); valid = dq <= 128 && dq >= -128; }
        float s = -3.0e38f;
        if (valid) { const bf16* kr = K + ((size_t)b * TT + kk) * KW + kvh * HD; float dsum = 0.f;
            for (int d = 0; d < HD; ++d) dsum += bf2f(kr[d]) * qs[wave][d];
            s = dsum * ATTN_SCALE; }
        sc[wave][kk] = s; mx = fmaxf(mx, s);
    }
    mx = wave_max(mx);
    float sk = 0.f; if (mode == 1) { sk = sink[h]; mx = fmaxf(mx, sk); }
    float sum = 0.f;
    for (int kk = lane; kk < nk; kk += 64) { const float s = sc[wave][kk]; const float p = s > -1.0e38f ? __expf(s - mx) : 0.f; sc[wave][kk] = p; sum += p; }
    sum = wave_sum(sum); if (mode == 1) sum += __expf(sk - mx);
    asm volatile("s_waitcnt lgkmcnt(0)" ::: "memory"); __builtin_amdgcn_wave_barrier();
    float o0 = 0.f, o1 = 0.f;
    for (int kk = 0; kk < nk; ++kk) { const float p = sc[wave][kk]; const bf16* vr = V + ((size_t)b * TT + kk) * KW + kvh * HD; o0 += p * bf2f(vr[lane]); o1 += p * bf2f(vr[lane + 64]); }
    const float inv = 1.0f / sum;
    Y[m * D + h * HD + lane] = (bf16)f2bf(o0 * inv); Y[m * D + h * HD + lane + 64] = (bf16)f2bf(o1 * inv);
}

__global__ void __launch_bounds__(256) naive_moe_up(const bf16* H2, const float* w1, const float* w3, const unsigned* cnt, const unsigned* LIST, bf16* HB) {
    __shared__ unsigned base[65];
    const int tid = threadIdx.y * 64 + threadIdx.x;
    if (tid == 0) { unsigned a = 0; for (int e = 0; e < NE; ++e) { base[e] = a; a += cnt[e]; } base[64] = a; }
    __syncthreads();
    const unsigned slot = blockIdx.y * 4 + threadIdx.y; if (slot >= base[64]) return;
    int e = 0; while (base[e + 1] <= slot) ++e;
    const unsigned tok = LIST[(size_t)e * M + (slot - base[e])];
    const int j = blockIdx.x * 64 + threadIdx.x;
    const float* W1 = w1 + (size_t)e * D * DE + j; const float* W3 = w3 + (size_t)e * D * DE + j; const bf16* x = H2 + (size_t)tok * D;
    float a = 0.f, b = 0.f;
    for (int k = 0; k < D; ++k) { const float xv = bf2f(x[k]); a += xv * W1[(size_t)k * DE]; b += xv * W3[(size_t)k * DE]; }
    HB[(size_t)slot * DE + j] = (bf16)f2bf(a / (1.f + __expf(-a)) * b);
}
__global__ void __launch_bounds__(256) naive_moe_down(const bf16* HB, const float* w2, const unsigned* cnt, bf16* YM) {
    __shared__ unsigned base[65];
    const int tid = threadIdx.y * 64 + threadIdx.x;
    if (tid == 0) { unsigned a = 0; for (int e = 0; e < NE; ++e) { base[e] = a; a += cnt[e]; } base[64] = a; }
    __syncthreads();
    const unsigned slot = blockIdx.y * 4 + threadIdx.y; if (slot >= base[64]) return;
    int e = 0; while (base[e + 1] <= slot) ++e;
    const int col = blockIdx.x * 64 + threadIdx.x;
    const float* W2 = w2 + (size_t)e * DE * D + col; const bf16* hrow = HB + (size_t)slot * DE;
    float a = 0.f;
    for (int k = 0; k < DE; ++k) a += bf2f(hrow[k]) * W2[(size_t)k * D];
    YM[(size_t)slot * D + col] = (bf16)f2bf(a);
}
namespace att {
constexpr int NW = 8, QBLK = 32, KVBLK = 64;
constexpr float THR = 8.f;
constexpr int LDQ = QW, LDK = KW, LDO = D;
constexpr size_t SHM_V = KVBLK * HD * 2, SHM_K = KVBLK * HD * 2, SHM_ATTN = 2 * SHM_V + 2 * SHM_K + NW * 64 * 4;
using bf16x8 = __attribute__((ext_vector_type(8))) short;
using s16x4  = __attribute__((ext_vector_type(4))) short;
using f32x16 = __attribute__((ext_vector_type(16))) float;
using u32x4  = __attribute__((ext_vector_type(4))) unsigned;
#define KSWZ(row, colB) ((row) * 256 + ((colB) ^ (((row) & 7) << 4)))
#define SBAR() __builtin_amdgcn_sched_barrier(0)
__device__ __forceinline__ int crow(int r, int hi) { return (r & 3) + 8 * (r >> 2) + 4 * hi; }
__device__ __forceinline__ unsigned cvtpk(float lo, float hi) { unsigned r; asm volatile("v_cvt_pk_bf16_f32 %0, %1, %2" : "=v"(r) : "v"(lo), "v"(hi)); return r; }
__device__ __forceinline__ void partialSM(f32x16& p0, f32x16& p1, float& m_reg, float& mn, float& alpha) {
  constexpr float C = ATTN_SCALE * 1.4426950408889634f;
  float pmax = p0[0]; for (int r = 1; r < 16; ++r) pmax = fmaxf(pmax, p0[r]); for (int r = 0; r < 16; ++r) pmax = fmaxf(pmax, p1[r]);
  { auto rr = __builtin_amdgcn_permlane32_swap(__float_as_uint(pmax), __float_as_uint(pmax), false, false);
    pmax = fmaxf(__uint_as_float(rr[0]), __uint_as_float(rr[1])); }
  if (__builtin_expect(__all(pmax - m_reg <= THR / ATTN_SCALE), 1)) { mn = m_reg; alpha = 1.f; }
  else { mn = fmaxf(m_reg, pmax); alpha = __builtin_amdgcn_exp2f((m_reg - mn) * C); m_reg = mn; }
  float mnC = -mn * C;
  for (int r = 0; r < 16; ++r) p0[r] = fmaf(p0[r], C, mnC); for (int r = 0; r < 16; ++r) p1[r] = fmaf(p1[r], C, mnC);
  for (int r = 0; r < 16; ++r) p0[r] = __builtin_amdgcn_exp2f(p0[r]);
}
__device__ __forceinline__ void finishSM(f32x16& p0, f32x16& p1, float alpha, float& l_reg, bf16x8& pa0, bf16x8& pa1, bf16x8& pa2, bf16x8& pa3) {
  for (int r = 0; r < 16; ++r) p1[r] = __builtin_amdgcn_exp2f(p1[r]);
  float ps = 0; for (int r = 0; r < 16; ++r) ps += p0[r]; for (int r = 0; r < 16; ++r) ps += p1[r];
  { auto rr = __builtin_amdgcn_permlane32_swap(__float_as_uint(ps), __float_as_uint(ps), false, false);
    ps = __uint_as_float(rr[0]) + __uint_as_float(rr[1]); }
  l_reg = l_reg * alpha + ps;
#define PK4(P, BASE, OUT) do { unsigned a0 = cvtpk(P[BASE + 0], P[BASE + 1]), a1 = cvtpk(P[BASE + 2], P[BASE + 3]);   \
    unsigned b0 = cvtpk(P[BASE + 4], P[BASE + 5]), b1 = cvtpk(P[BASE + 6], P[BASE + 7]);                              \
    auto r0 = __builtin_amdgcn_permlane32_swap(a0, b0, false, false); auto r1 = __builtin_amdgcn_permlane32_swap(a1, b1, false, false); \
    u32x4 w = {r0[0], r1[0], r0[1], r1[1]}; OUT = *reinterpret_cast<bf16x8*>(&w); } while (0)
  PK4(p0, 0, pa0); PK4(p0, 8, pa1); PK4(p1, 0, pa2); PK4(p1, 8, pa3);
#undef PK4
}
__device__ __forceinline__ void qkt(f32x16& p0, f32x16& p1, const bf16* Ks, const bf16x8* qr, int r32, int hi) {
  p0 = f32x16{}; p1 = f32x16{};
  for (int d0 = 0; d0 < 8; ++d0) { int cb = (d0 * 16 + hi * 8) * 2;
    bf16x8 b0 = *reinterpret_cast<const bf16x8*>((const char*)Ks + KSWZ(r32, cb));
    bf16x8 b1 = *reinterpret_cast<const bf16x8*>((const char*)Ks + KSWZ(32 + r32, cb));
    p0 = __builtin_amdgcn_mfma_f32_32x32x16_bf16(b0, qr[d0], p0, 0, 0, 0);
    p1 = __builtin_amdgcn_mfma_f32_32x32x16_bf16(b1, qr[d0], p1, 0, 0, 0); }
}
__device__ __forceinline__ void wmask(f32x16& p0, f32x16& p1, int kb, int qpos, int hi) {
  const float NEG = -1.0e30f; const int d0 = kb + 4 * hi - qpos;
#pragma unroll
  for (int r = 0; r < 16; ++r) { const int dd = d0 + (r & 3) + 8 * (r >> 2); if (dd > 128 || dd < -128) p0[r] = NEG; if (dd + 32 > 128 || dd + 32 < -128) p1[r] = NEG; }
}
__device__ __forceinline__ int v_st(int k, int c) { const int kk = (k & ~0xC) | ((k & 4) << 1) | ((k & 8) >> 1); return ((kk >> 3) * 4 + (c >> 5)) * 512 + ((kk & 7) * 32 + (c & 31)) * 2; }
__device__ __forceinline__ int v_rd_base(int lane) { return ((lane & 3) << 3) | (((lane >> 2) & 3) << 6) | (((lane >> 4) & 1) << 5) | (((lane >> 5) & 1) << 8); }
constexpr int v_rd_off(int d0, int ks, int half) { return d0 * 512 + ks * 4096 + half * 2048; }
template <int OFF> __device__ __forceinline__ s16x4 tr_read(int vb) {
  s16x4 r; asm volatile("ds_read_b64_tr_b16 %0, %1 offset:%2" : "=&v"(r) : "v"(vb), "i"(OFF) : "memory"); return r;
}
template <int D0> __device__ __forceinline__ void pv_one(f32x16& od, int vb, bf16x8 pa0, bf16x8 pa1, bf16x8 pa2, bf16x8 pa3) {
  const s16x4 l0 = tr_read<v_rd_off(D0, 0, 0)>(vb), h0 = tr_read<v_rd_off(D0, 0, 1)>(vb), l1 = tr_read<v_rd_off(D0, 1, 0)>(vb), h1 = tr_read<v_rd_off(D0, 1, 1)>(vb);
  const s16x4 l2 = tr_read<v_rd_off(D0, 2, 0)>(vb), h2 = tr_read<v_rd_off(D0, 2, 1)>(vb), l3 = tr_read<v_rd_off(D0, 3, 0)>(vb), h3 = tr_read<v_rd_off(D0, 3, 1)>(vb);
  asm volatile("s_waitcnt lgkmcnt(0)" ::: "memory"); SBAR();
#define PK(L, H) (bf16x8){L[0], L[1], L[2], L[3], H[0], H[1], H[2], H[3]}
  od = __builtin_amdgcn_mfma_f32_32x32x16_bf16(pa0, PK(l0, h0), od, 0, 0, 0);
  od = __builtin_amdgcn_mfma_f32_32x32x16_bf16(pa1, PK(l1, h1), od, 0, 0, 0);
  od = __builtin_amdgcn_mfma_f32_32x32x16_bf16(pa2, PK(l2, h2), od, 0, 0, 0);
  od = __builtin_amdgcn_mfma_f32_32x32x16_bf16(pa3, PK(l3, h3), od, 0, 0, 0);
#undef PK
}
__device__ __forceinline__ void pv_d0(f32x16* o, int vb, bf16x8 pa0, bf16x8 pa1, bf16x8 pa2, bf16x8 pa3) {
  pv_one<0>(o[0], vb, pa0, pa1, pa2, pa3); pv_one<1>(o[1], vb, pa0, pa1, pa2, pa3); pv_one<2>(o[2], vb, pa0, pa1, pa2, pa3); pv_one<3>(o[3], vb, pa0, pa1, pa2, pa3);
}
__device__ __forceinline__ void attn_unit(const bool MASKED, const bf16* __restrict__ Qb, const bf16* __restrict__ Kh, const bf16* __restrict__ Vh, bf16* __restrict__ Ob,
                                          int NT, int klo, int q0, float m0, float l0, char* lds) {
  const int tid = threadIdx.x, wid = tid >> 6, lane = tid & 63, r32 = lane & 31, hi = lane >> 5;
  bf16* V_lds = (bf16*)lds; bf16* K_lds = (bf16*)(lds + 2 * SHM_V);
  float* ws = (float*)(lds + 2 * SHM_V + 2 * SHM_K) + wid * 64; float* li_l = ws; float* al_l = ws + 32;
  float m_reg = m0, l_reg = l0; f32x16 o[4] = {}; bf16x8 qr[8];
  const bf16* Qw = Qb + (long)(wid * QBLK + r32) * LDQ + hi * 8;
#pragma unroll
  for (int d0 = 0; d0 < 8; ++d0) qr[d0] = *reinterpret_cast<const bf16x8*>(Qw + d0 * 16);
  const int sr = tid >> 4, sc = (tid & 15) * 8, vst0 = v_st(sr, sc), vst1 = v_st(32 + sr, sc);
  const int vb0 = (int)(uintptr_t)V_lds + v_rd_base(lane);
  const int qpos = q0 + wid * QBLK + r32;
  struct { bf16x8 vs0, vs1, ks0, ks1; } sr_[2];
#define KROW(j) ((!MASKED || (j) < 4) ? 64 * (j) : CTX + klo + 64 * ((j) - 4))
#define SLOAD(i, j) do { const int k0_ = KROW(j); sr_[i].vs0 = *reinterpret_cast<const bf16x8*>(&Vh[(long)(k0_ + sr) * LDK + sc]); sr_[i].vs1 = *reinterpret_cast<const bf16x8*>(&Vh[(long)(k0_ + 32 + sr) * LDK + sc]); \
    sr_[i].ks0 = *reinterpret_cast<const bf16x8*>(&Kh[(long)(k0_ + sr) * LDK + sc]); sr_[i].ks1 = *reinterpret_cast<const bf16x8*>(&Kh[(long)(k0_ + 32 + sr) * LDK + sc]); } while (0)
#define SWRITE(b, i) do { *(bf16x8*)((char*)V_lds + (b) * SHM_V + vst0) = sr_[i].vs0;          \
    *(bf16x8*)((char*)V_lds + (b) * SHM_V + vst1) = sr_[i].vs1; int kc = sc * 2;               \
    *(bf16x8*)((char*)K_lds + (b) * SHM_K + KSWZ(sr, kc)) = sr_[i].ks0;                       \
    *(bf16x8*)((char*)K_lds + (b) * SHM_K + KSWZ(32 + sr, kc)) = sr_[i].ks1; } while (0)
#define SWAIT() asm volatile("s_waitcnt vmcnt(4)" ::: "memory")
#define RESC(a) do { if (__any((a) < 1.f)) { if (hi == 0) al_l[r32] = (a); asm volatile("s_waitcnt lgkmcnt(0)" ::: "memory"); \
    for (int d = 0; d < 4; ++d) for (int r = 0; r < 16; ++r) o[d][r] *= al_l[crow(r, hi)]; } } while (0)
#define WMASK(P0, P1, j) do { if (MASKED && (j) >= 4) wmask(P0, P1, klo + 64 * ((j) - 4), qpos, hi); } while (0)
  f32x16 pA0, pA1, pB0, pB1; float mnA, mnB, alA, alB; bf16x8 pa0, pa1, pa2, pa3;
  constexpr int SE = 0, SO = 1;
  __syncthreads();
  SLOAD(SE, 0); asm volatile("s_waitcnt vmcnt(0)" ::: "memory"); SWRITE(0, SE); __syncthreads();
  qkt(pA0, pA1, K_lds, qr, r32, hi); WMASK(pA0, pA1, 0); partialSM(pA0, pA1, m_reg, mnA, alA);
  SLOAD(SO, 1); if (2 < NT) SLOAD(SE, 2);
  SWAIT(); SWRITE(1, SO); __syncthreads();
  for (int j = 1; j + 1 < NT; j += 2) {
    SBAR(); qkt(pB0, pB1, (bf16*)((char*)K_lds + SHM_K), qr, r32, hi); WMASK(pB0, pB1, j);
    finishSM(pA0, pA1, alA, l_reg, pa0, pa1, pa2, pa3); SBAR();
    SLOAD(SO, j + 2); SBAR();
    pv_d0(o, vb0, pa0, pa1, pa2, pa3); partialSM(pB0, pB1, m_reg, mnB, alB);
    __syncthreads(); SWAIT(); SWRITE(0, SE);
    RESC(alB); __syncthreads();
    SBAR(); qkt(pA0, pA1, K_lds, qr, r32, hi); WMASK(pA0, pA1, j + 1);
    finishSM(pB0, pB1, alB, l_reg, pa0, pa1, pa2, pa3); SBAR();
    if (j + 3 < NT) SLOAD(SE, j + 3); SBAR();
    pv_d0(o, vb0 + (int)SHM_V, pa0, pa1, pa2, pa3); partialSM(pA0, pA1, m_reg, mnA, alA);
    __syncthreads(); SWAIT(); SWRITE(1, SO);
    RESC(alA); __syncthreads();
  }
  SBAR(); qkt(pB0, pB1, (bf16*)((char*)K_lds + SHM_K), qr, r32, hi); WMASK(pB0, pB1, NT - 1);
  finishSM(pA0, pA1, alA, l_reg, pa0, pa1, pa2, pa3); SBAR();
  pv_d0(o, vb0, pa0, pa1, pa2, pa3); partialSM(pB0, pB1, m_reg, mnB, alB);
  __syncthreads(); RESC(alB);
  finishSM(pB0, pB1, alB, l_reg, pa0, pa1, pa2, pa3); SBAR();
  pv_d0(o, vb0 + (int)SHM_V, pa0, pa1, pa2, pa3);
  if (hi == 0) li_l[r32] = l_reg; asm volatile("s_waitcnt lgkmcnt(0)" ::: "memory");
  float rli[16];
#pragma unroll
  for (int r = 0; r < 16; ++r) rli[r] = __builtin_amdgcn_rcpf(li_l[crow(r, hi)]);
  bf16* Ow = Ob + (long)(wid * QBLK) * LDO;
#pragma unroll
  for (int r = 0; r < 16; ++r) { int orow = crow(r, hi);
    for (int d0 = 0; d0 < 4; ++d0) Ow[(long)orow * LDO + d0 * 32 + r32] = (bf16)f2bf(o[d0][r] * rli[r]); }
#undef KROW
#undef SLOAD
#undef SWRITE
#undef SWAIT
#undef RESC
#undef WMASK
}
#undef KSWZ
#undef SBAR
}

__device__ __forceinline__ void fast_attn(Frame& F, int l) {
    char* lds = (char*)F.lds;
    const int nsub = (l < DEPTH - 1) ? 3 : 2;
    for (int u = (int)blockIdx.x; u < 256; u += F.G) {
        const int x = u & 7, y = u >> 3, b = x >> 1, kvh = x & 1, g = y >> 3, qb = y & 7, h = kvh * 4 + g;
        for (int s = 0; s < nsub; ++s) {
            if (s == 2 && qb != 0 && qb != 7) break;
            const bool mixB = (s == 1) || (s == 2 && qb == 7), ctxq = (s == 2);
            const size_t brow = (size_t)b * TT, qrow = ctxq ? brow : brow + CTX + 256 * qb;
            const bf16* Qp = (const bf16*)(F.ws + (mixB ? WS_QB : WS_QA)) + qrow * QW + h * HD;
            const bf16* Kp = (const bf16*)(F.ws + (mixB ? WS_KB : WS_KA)) + brow * KW + kvh * HD;
            const bf16* Vp = (const bf16*)(F.ws + (mixB ? WS_VB : WS_VA)) + brow * KW + kvh * HD;
            bf16* Op = (bf16*)(F.ws + WS_YAB) + qrow * D + (mixB ? QW : 0) + h * HD;
            const int q0 = 256 * qb, klo = q0 - 128 < 0 ? 0 : q0 - 128, khi = q0 + 384 > SEQ ? SEQ : q0 + 384;
            const int NT = ctxq ? CTX / 64 : (s == 0 ? TT / 64 : 4 + (khi - klo) / 64);
            const float m0 = mixB ? INP(IN_SINK)[l * NH + h] * (1.0f / ATTN_SCALE) : -1.0e30f, l0 = mixB ? 1.f : 0.f;
            att::attn_unit(s == 1, Qp, Kp, Vp, Op, NT, klo, q0, m0, l0, lds);
        }
    }
}
namespace moe {
typedef unsigned u32x4 __attribute__((ext_vector_type(4)));
using pg8::bf16x8; using pg8::f32x4;
#ifndef MOE_CAPT
#define MOE_CAPT 576
#endif
constexpr int CAPT = MOE_CAPT;
constexpr int B_STAGE = 16896, B_PART = 8448, CAP = 576;
constexpr int NMF = CAP / 32, GS = 3, NGRP = NMF / GS;
static_assert(2 * (CAP / 16) * 1024 + 4 * B_STAGE <= LDSCTL_OFF && NGRP == 6, "MoE LDS map / group nest");
__device__ __forceinline__ void wait_vm1(int n) {
    switch (n) { case 0: asm volatile("s_waitcnt vmcnt(0)" ::: "memory"); break; case 1: asm volatile("s_waitcnt vmcnt(1)" ::: "memory"); break; case 2: asm volatile("s_waitcnt vmcnt(2)" ::: "memory"); break;
                 case 3: asm volatile("s_waitcnt vmcnt(3)" ::: "memory"); break; case 4: asm volatile("s_waitcnt vmcnt(4)" ::: "memory"); break; case 5: asm volatile("s_waitcnt vmcnt(5)" ::: "memory"); break;
                 case 6: asm volatile("s_waitcnt vmcnt(6)" ::: "memory"); break; default: asm volatile("s_waitcnt vmcnt(7)" ::: "memory"); break; }
}
__device__ __forceinline__ void wait_vm8(int n) {
    switch (n) { case 0: asm volatile("s_waitcnt vmcnt(0)" ::: "memory"); break; case 1: asm volatile("s_waitcnt vmcnt(8)" ::: "memory"); break; case 2: asm volatile("s_waitcnt vmcnt(16)" ::: "memory"); break;
                 case 3: asm volatile("s_waitcnt vmcnt(24)" ::: "memory"); break; case 4: asm volatile("s_waitcnt vmcnt(32)" ::: "memory"); break; case 5: asm volatile("s_waitcnt vmcnt(40)" ::: "memory"); break; default: asm volatile("s_waitcnt vmcnt(48)" ::: "memory"); break; }
}
__device__ __forceinline__ unsigned cvt_pk(float lo, float hi) { unsigned r; asm volatile("v_cvt_pk_bf16_f32 %0, %1, %2" : "=v"(r) : "v"(lo), "v"(hi)); return r; }
__device__ __forceinline__ int swz(int ob) { return ob ^ (((ob >> 9) & 1) << 5); }

template <int MODE>
__device__ __forceinline__ void moe_phase(Frame& F, int l) {
    LAS unsigned char* lds = F.lds;
    LAS unsigned* base = (LAS unsigned*)(F.lds + LDSCTL_OFF + 512);
    const unsigned* cnt = (const unsigned*)F.ctl + CW_CNT + l * 64;
    compute_base(cnt, base, F.tid);
    LAS unsigned char* order = (LAS unsigned char*)(F.lds + LDSCTL_OFF + 512 + 272);
    if (F.tid < NE) { const unsigned c = base[F.tid + 1] - base[F.tid]; int rank = 0;
        for (int e2 = 0; e2 < NE; ++e2) { const unsigned c2 = base[e2 + 1] - base[e2]; rank += (c2 > c || (c2 == c && e2 < F.tid)) ? 1 : 0; }
        order[rank] = (unsigned char)F.tid; }
    __syncthreads();
    constexpr int NCS = MODE == 0 ? 8 : 16, K = MODE == 0 ? D : DE, NT = K / 32, LDW = MODE == 0 ? DE : D, BKS = MODE == 0 ? 256 : 512;
    const int wid = F.wave, lane = F.lane, wr = wid >> 2, wc = wid & 3, fr = lane & 15, fq = lane >> 4;
    const int afo = swz(fr * 64 + fq * 16);
    const int sb = swz(lane * 16), drow = sb >> 6, dk = (sb & 63) >> 1;
    int bro[2];
#pragma unroll
    for (int j = 0; j < 2; ++j) bro[j] = ((MODE == 0) ? j * B_PART + ((8 * fq) * 64 + 16 * wc + fr) * 4 : ((8 * fq) * 128 + 32 * wc + 16 * j + fr) * 4) + fq * 64;
    const int bw = wid - 6;
    const unsigned bvo = (MODE == 0) ? (unsigned)((lane >> 4) * LDW + (lane & 15) * 4) * 4u : (unsigned)((lane >> 5) * LDW + (lane & 31) * 4) * 4u;
    const unsigned* LISTl = (const unsigned*)(F.ws + WS_LIST) + (size_t)l * NE * M;
    const __amdgpu_buffer_rsrc_t ars = __builtin_amdgcn_make_buffer_rsrc((void*)(F.ws + (MODE == 0 ? WS_HA : WS_HB)), 0, 0x7ffffff0, 0x00020000);
    constexpr int UREP = (REPMASK & (MODE == 0 ? (1 << 8) : (1 << 9))) ? 2 : 1;
    for (int u2 = F.vcu; u2 < UREP * NE * NCS; u2 += F.G) {
        const int u = u2 % (NE * NCS); const int cs = u % NCS; const bool rep = (UREP > 1) && (u2 >= NE * NCS);
        const int uq = u / NCS; int rnk;
        if (F.G * NCS >= NE * NCS / 2 && NE * NCS / F.G == 2) { const int slot = uq % (NE / 2), i = uq / (NE / 2); rnk = i == 0 ? slot : NE - 1 - slot; }
        else if (NE * NCS / F.G == 4 && NE % 4 == 0) { const int slot = uq % (NE / 4), i = uq / (NE / 4); rnk = i == 0 ? slot : i == 1 ? NE / 2 - 1 - slot : i == 2 ? NE / 2 + slot : NE - 1 - slot; }
        else rnk = uq;
        const int e = (int)order[rnk];
        const int n_e = (int)(base[e + 1] - base[e]), base_e = (int)base[e];
        const float* wbase;
        if (MODE == 0) wbase = ((bw == 1) ? INP(IN_W3) : INP(IN_W1)) + ((size_t)(l * NE + e) * D) * DE + 64 * cs;
        else           wbase = INP(IN_W2) + ((size_t)(l * NE + e) * DE) * D + 128 * cs + (size_t)(bw == 1 ? 16 : 0) * D;
        unsigned wlo_v = (unsigned)(unsigned long long)wbase, whi_v = (unsigned)((unsigned long long)wbase >> 32);
        asm volatile("" : "+v"(wlo_v), "+v"(whi_v));
        for (int r0 = 0; r0 < n_e; r0 += CAPT) {
            const int nrows = (n_e - r0) < CAPT ? (n_e - r0) : CAPT, nsub = (nrows + 15) >> 4;
            const int asz = nsub * 1024; const int na = 2;
            const int boff = na * asz; int nstg = (LDSCTL_OFF - boff) / B_STAGE; nstg = nstg > 8 ? 8 : nstg;
            int naw = 0;
#pragma unroll
            for (int j = 0; j < 7; ++j) naw += (wid + 6 * j < nsub) ? 1 : 0;
            unsigned aof[7];
#pragma unroll
            for (int j = 0; j < 7; ++j) { const int sx = wid + 6 * j; int r = 16 * sx + drow; if (r >= nrows) r = 0;
                if (MODE == 0) aof[j] = LISTl[(size_t)e * M + r0 + r] * (unsigned)(D * 2) + (unsigned)dk * 2u;
                else           aof[j] = (unsigned)(base_e + r0 + r) * (unsigned)(DE * 2) + (unsigned)dk * 2u; }
            f32x4 acc[NMF][2];
#pragma unroll
            for (int m = 0; m < NMF; ++m)
#pragma unroll
                for (int n = 0; n < 2; ++n) acc[m][n] = (f32x4){0.f, 0.f, 0.f, 0.f};
#define MOE_DMA_A(t, b) do { _Pragma("unroll") for (int j_ = 0; j_ < 7; ++j_) { const int s_ = wid + 6 * j_; if (s_ < nsub) \
        __builtin_amdgcn_raw_ptr_buffer_load_lds(ars, (LAS void*)(lds + (b) * asz + s_ * 1024), 16, aof[j_], (t) * 64, 0, 0); } } while (0)
#define MOE_DMA_B(t) do { unsigned lo_, hi_; asm volatile("v_readfirstlane_b32 %0, %2\n\tv_readfirstlane_b32 %1, %3" : "=s"(lo_), "=s"(hi_) : "v"(wlo_v), "v"(whi_v)); \
        const __amdgpu_buffer_rsrc_t wrs_ = __builtin_amdgcn_make_buffer_rsrc((void*)(((unsigned long long)hi_ << 32) | lo_), 0, 0x7ffffff0, 0x00020000); \
        LAS unsigned char* bst_ = lds + boff + ((t) % nstg) * B_STAGE + (MODE == 0 ? bw * B_PART : bw * 8192 + bw * 128); \
        _Pragma("unroll") for (int i_ = 0; i_ < 8; ++i_) __builtin_amdgcn_raw_ptr_buffer_load_lds(wrs_, (LAS void*)(bst_ + i_ * 1024 + (MODE == 0 ? (i_ >> 1) : (i_ >> 2)) * 64), 16, bvo, ((t) * 32 + (MODE == 0 ? 4 : 2) * i_) * (LDW * 4), 0, 2); } while (0)
#define MOE_DMA_BS(t, slot) do { unsigned lo_, hi_; asm volatile("v_readfirstlane_b32 %0, %2\n\tv_readfirstlane_b32 %1, %3" : "=s"(lo_), "=s"(hi_) : "v"(wlo_v), "v"(whi_v)); \
        const __amdgpu_buffer_rsrc_t wrs_ = __builtin_amdgcn_make_buffer_rsrc((void*)(((unsigned long long)hi_ << 32) | lo_), 0, 0x7ffffff0, 0x00020000); \
        LAS unsigned char* bst_ = lds + boff + (slot) * B_STAGE + (MODE == 0 ? bw * B_PART : bw * 8192 + bw * 128); \
        _Pragma("unroll") for (int i_ = 0; i_ < 8; ++i_) __builtin_amdgcn_raw_ptr_buffer_load_lds(wrs_, (LAS void*)(bst_ + i_ * 1024 + (MODE == 0 ? (i_ >> 1) : (i_ >> 2)) * 64), 16, bvo, ((t) * 32 + (MODE == 0 ? 4 : 2) * i_) * (LDW * 4), 0, 2); } while (0)
#define MOE_LDA(dst, g_) do { _Pragma("unroll") for (int q_ = 0; q_ < GS; ++q_) dst[q_] = *(const LAS bf16x8*)(Ab + (2 * (GS * (g_) + q_) + wr) * 1024 + afo); } while (0)
#define MOE_MMA(src, g_) do { _Pragma("unroll") for (int q_ = 0; q_ < GS; ++q_) _Pragma("unroll") for (int j_ = 0; j_ < 2; ++j_) \
        acc[GS * (g_) + q_][j_] = __builtin_amdgcn_mfma_f32_16x16x32_bf16(Bf[j_], src[q_], acc[GS * (g_) + q_][j_], 0, 0, 0); } while (0)
            asm volatile("s_waitcnt vmcnt(0) lgkmcnt(0)" ::: "memory"); __builtin_amdgcn_s_barrier(); asm volatile("" ::: "memory");
            if (wid < 6) { MOE_DMA_A(0, 0); if (na == 3 && NT > 1) MOE_DMA_A(1, 1); }
            else { for (int p = 0; p < nstg - 1 && p < NT; ++p) MOE_DMA_B(p); }
            const int ngrp = (nsub - wr + 2 * GS - 1) / (2 * GS);
            int abuf = 0, bslot = 0;
            for (int t = 0; t < NT; ++t) {
                if (wid < 6) { if (na == 3 && t + 1 < NT) wait_vm1(naw); else asm volatile("s_waitcnt vmcnt(0)" ::: "memory"); }
                else { const int rem = NT - 1 - t; wait_vm8(rem < nstg - 2 ? rem : nstg - 2); }
                asm volatile("s_waitcnt lgkmcnt(0)" ::: "memory"); __builtin_amdgcn_s_barrier(); asm volatile("" ::: "memory");
                if (wid < 6) { if (t + na - 1 < NT) { int nb = abuf + na - 1; nb = nb >= na ? nb - na : nb; MOE_DMA_A(t + na - 1, nb); } }
                else { if (t + nstg - 1 < NT) { int ns = bslot + nstg - 1; ns = ns >= nstg ? ns - nstg : ns; MOE_DMA_BS(t + nstg - 1, ns); } }
                const LAS unsigned char* Ab = lds + abuf * asz; const LAS unsigned char* Bb = lds + boff + bslot * B_STAGE;
                abuf = (abuf + 1 == na) ? 0 : abuf + 1; bslot = (bslot + 1 == nstg) ? 0 : bslot + 1;
                bf16x8 At0[GS], At1[GS], Bf[2]; float w0[8], w1[8];
#pragma unroll
                for (int i = 0; i < 8; ++i) w0[i] = *(const LAS float*)(Bb + bro[0] + i * BKS);
#pragma unroll
                for (int i = 0; i < 8; ++i) w1[i] = *(const LAS float*)(Bb + bro[1] + i * BKS);
                MOE_LDA(At0, 0);
                __builtin_amdgcn_sched_barrier(0);
                { u32x4 p; p.x = cvt_pk(w0[0], w0[1]); p.y = cvt_pk(w0[2], w0[3]); p.z = cvt_pk(w0[4], w0[5]); p.w = cvt_pk(w0[6], w0[7]); Bf[0] = __builtin_bit_cast(bf16x8, p);
                  p.x = cvt_pk(w1[0], w1[1]); p.y = cvt_pk(w1[2], w1[3]); p.z = cvt_pk(w1[4], w1[5]); p.w = cvt_pk(w1[6], w1[7]); Bf[1] = __builtin_bit_cast(bf16x8, p); }
                __builtin_amdgcn_sched_barrier(0);
                if (ngrp > 1) MOE_LDA(At1, 1);
                MOE_MMA(At0, 0);
                if (ngrp > 1) { if (ngrp > 2) MOE_LDA(At0, 2); MOE_MMA(At1, 1);
                    if (ngrp > 2) { if (ngrp > 3) MOE_LDA(At1, 3); MOE_MMA(At0, 2);
                        if (ngrp > 3) { if (ngrp > 4) MOE_LDA(At0, 4); MOE_MMA(At1, 3);
                            if (ngrp > 4) { if (ngrp > 5) MOE_LDA(At1, 5); MOE_MMA(At0, 4);
                                if (ngrp > 5) MOE_MMA(At1, 5); } } } }
            }
#pragma unroll
            for (int m = 0; m < NMF; ++m) { const int row = 16 * (2 * m + wr) + fr;
                if (row < nrows && !rep) {
                    if (MODE == 0) { const f32x4 x = acc[m][0], y = acc[m][1]; uint2 o;
                        o.x = cvt_pk(x[0] / (1.f + __expf(-x[0])) * y[0], x[1] / (1.f + __expf(-x[1])) * y[1]); o.y = cvt_pk(x[2] / (1.f + __expf(-x[2])) * y[2], x[3] / (1.f + __expf(-x[3])) * y[3]);
                        *(uint2*)((bf16*)(F.ws + WS_HB) + (size_t)(base_e + r0 + row) * DE + 64 * cs + 16 * wc + 4 * fq) = o;
                    } else {
#pragma unroll
                        for (int n = 0; n < 2; ++n) { const f32x4 x = acc[m][n]; uint2 o; o.x = cvt_pk(x[0], x[1]); o.y = cvt_pk(x[2], x[3]);
                            *(uint2*)((bf16*)(F.ws + WS_YM) + (size_t)(base_e + r0 + row) * D + 128 * cs + 32 * wc + 16 * n + 4 * fq) = o; }
                    }
                } }
        }
    }
    asm volatile("s_waitcnt vmcnt(0) lgkmcnt(0)" ::: "memory"); __syncthreads();
#undef MOE_DMA_A
#undef MOE_DMA_B
#undef MOE_DMA_BS
#undef MOE_LDA
#undef MOE_MMA
}
}
__device__ __forceinline__ void fast_moe_up(Frame& F, int l) { moe::moe_phase<0>(F, l); }
__device__ __forceinline__ void fast_moe_down(Frame& F, int l) { moe::moe_phase<1>(F, l); }
struct RowOrder {
    pg8::StaticOrder so; bool latent_only;
    __device__ void init(bool lat, int N, int G, int c) { latent_only = lat; so.init(lat ? NB * SEQ : M, N, G, c); }
    __device__ bool next(int i, pg8::Unit& u) const { if (!so.next(i, u)) return false; if (latent_only) u.pm = (u.pm >> 3) * 9 + 1 + (u.pm & 7); return true; }
    __device__ __forceinline__ void a_ready(const pg8::Unit&) const {}
    __device__ __forceinline__ void done(const pg8::Unit&) const {}
};
struct EpiF32 {
    static constexpr int MIDK = 0; static constexpr bool PERM = false, AFTER_DRAIN = false;
    float* O; int ldc;
    __device__ __forceinline__ void operator()(const pg8::f32x4 (&acc)[2][2][4][2], const pg8::Unit& u, int wr, int wc, int fr, int fq) const {
        const int row0 = u.pm * 256 + wr * 64 + fr, col0 = u.pn * 256 + wc * 32 + 4 * fq;
#pragma unroll
        for (int ai = 0; ai < 2; ++ai)
#pragma unroll
            for (int m = 0; m < 4; ++m) { float* rowp = O + (size_t)(row0 + ai * 128 + m * 16) * ldc + col0;
#pragma unroll
                for (int bj = 0; bj < 2; ++bj)
#pragma unroll
                    for (int n = 0; n < 2; ++n) *(pg8::f32x4*)(rowp + bj * 128 + n * 16) = acc[ai][bj][m][n]; }
    }
};
template <int PASS>
struct EpiGate {
    static constexpr int MIDK = 0; static constexpr bool PERM = false, AFTER_DRAIN = false;
    const bf16* G; bf16* O;
    __device__ __forceinline__ void operator()(const pg8::f32x4 (&acc)[2][2][4][2], const pg8::Unit& u, int wr, int wc, int fr, int fq) const {
        asm volatile("" : "+v"(fr), "+v"(fq));
        const int row0 = u.pm * 256 + wr * 64 + fr, col0 = u.pn * 256 + wc * 32 + 4 * fq;
#pragma unroll
        for (int ai = 0; ai < 2; ++ai) {
            uint2 gv[4][2][2], tv[4][2][2];
#pragma unroll
            for (int m = 0; m < 4; ++m) { const size_t off = (size_t)(row0 + ai * 128 + m * 16) * D + col0;
#pragma unroll
                for (int bj = 0; bj < 2; ++bj)
#pragma unroll
                    for (int n = 0; n < 2; ++n) { gv[m][bj][n] = *(const uint2*)(G + off + bj * 128 + n * 16); if (PASS == 2) tv[m][bj][n] = *(const uint2*)(O + off + bj * 128 + n * 16); } }
#pragma unroll
            for (int m = 0; m < 4; ++m) { const size_t off = (size_t)(row0 + ai * 128 + m * 16) * D + col0;
#pragma unroll
                for (int bj = 0; bj < 2; ++bj)
#pragma unroll
                    for (int n = 0; n < 2; ++n) { const uint2 g2 = gv[m][bj][n];
                        pg8::f32x4 g = {__builtin_bit_cast(float, g2.x << 16), __builtin_bit_cast(float, g2.x & 0xffff0000u), __builtin_bit_cast(float, g2.y << 16), __builtin_bit_cast(float, g2.y & 0xffff0000u)};
                        pg8::f32x4 v = g * acc[ai][bj][m][n];
                        if (PASS == 2) { const uint2 t2 = tv[m][bj][n];
                            v += (pg8::f32x4){__builtin_bit_cast(float, t2.x << 16), __builtin_bit_cast(float, t2.x & 0xffff0000u), __builtin_bit_cast(float, t2.y << 16), __builtin_bit_cast(float, t2.y & 0xffff0000u)}; }
                        uint2 o; o.x = pg8::cvt_pk_bf16(v[0], v[1]); o.y = pg8::cvt_pk_bf16(v[2], v[3]); *(uint2*)(O + off + bj * 128 + n * 16) = o; } }
            asm volatile("" ::: "memory");
        }
    }
};
struct EpiGateK {
    static constexpr int MIDK = 16; static constexpr bool PERM = false, AFTER_DRAIN = false;
    const bf16* GA; const bf16* GB; bf16* O;
    __device__ __forceinline__ void mid(pg8::f32x4 (&acc)[2][2][4][2], const pg8::Unit& u, int wr, int wc, int fr, int fq) const {
        asm volatile("" : "+v"(fr), "+v"(fq));
        const int row0 = u.pm * 256 + wr * 64 + fr, col0 = u.pn * 256 + wc * 32 + 4 * fq;
#pragma unroll
        for (int ai = 0; ai < 2; ++ai) {
            uint2 av[4][2][2], bv[4][2][2];
#pragma unroll
            for (int m = 0; m < 4; ++m) { const size_t off = (size_t)(row0 + ai * 128 + m * 16) * D + col0;
#pragma unroll
                for (int bj = 0; bj < 2; ++bj)
#pragma unroll
                    for (int n = 0; n < 2; ++n) { av[m][bj][n] = *(const uint2*)(GA + off + bj * 128 + n * 16); bv[m][bj][n] = *(const uint2*)(GB + off + bj * 128 + n * 16); } }
#pragma unroll
            for (int m = 0; m < 4; ++m)
#pragma unroll
                for (int bj = 0; bj < 2; ++bj)
#pragma unroll
                    for (int n = 0; n < 2; ++n) { const uint2 a2 = av[m][bj][n], b2 = bv[m][bj][n];
                        const pg8::f32x4 ga = {__builtin_bit_cast(float, a2.x << 16), __builtin_bit_cast(float, a2.x & 0xffff0000u), __builtin_bit_cast(float, a2.y << 16), __builtin_bit_cast(float, a2.y & 0xffff0000u)};
                        const pg8::f32x4 gb = {__builtin_bit_cast(float, b2.x << 16), __builtin_bit_cast(float, b2.x & 0xffff0000u), __builtin_bit_cast(float, b2.y << 16), __builtin_bit_cast(float, b2.y & 0xffff0000u)};
#pragma unroll
                        for (int e = 0; e < 4; ++e) acc[ai][bj][m][n][e] *= ga[e] * __builtin_amdgcn_rcpf(fmaxf(gb[e], 1.0e-30f)); }
        }
    }
    __device__ __forceinline__ void operator()(const pg8::f32x4 (&acc)[2][2][4][2], const pg8::Unit& u, int wr, int wc, int fr, int fq) const {
        asm volatile("" : "+v"(fr), "+v"(fq));
        const int row0 = u.pm * 256 + wr * 64 + fr, col0 = u.pn * 256 + wc * 32 + 4 * fq;
#pragma unroll
        for (int ai = 0; ai < 2; ++ai) {
            uint2 bv[4][2][2];
#pragma unroll
            for (int m = 0; m < 4; ++m) { const size_t off = (size_t)(row0 + ai * 128 + m * 16) * D + col0;
#pragma unroll
                for (int bj = 0; bj < 2; ++bj)
#pragma unroll
                    for (int n = 0; n < 2; ++n) bv[m][bj][n] = *(const uint2*)(GB + off + bj * 128 + n * 16); }
#pragma unroll
            for (int m = 0; m < 4; ++m) { const size_t off = (size_t)(row0 + ai * 128 + m * 16) * D + col0;
#pragma unroll
                for (int bj = 0; bj < 2; ++bj)
#pragma unroll
                    for (int n = 0; n < 2; ++n) { const uint2 b2 = bv[m][bj][n];
                        const pg8::f32x4 gb = {__builtin_bit_cast(float, b2.x << 16), __builtin_bit_cast(float, b2.x & 0xffff0000u), __builtin_bit_cast(float, b2.y << 16), __builtin_bit_cast(float, b2.y & 0xffff0000u)};
                        const pg8::f32x4 v = gb * acc[ai][bj][m][n];
                        uint2 o; o.x = pg8::cvt_pk_bf16(v[0], v[1]); o.y = pg8::cvt_pk_bf16(v[2], v[3]); *(uint2*)(O + off + bj * 128 + n * 16) = o; } }
        }
    }
};
struct EpiRes {
    static constexpr int MIDK = 0; static constexpr bool PERM = false, AFTER_DRAIN = false;
    float* X; const float* g1l;
    __device__ __forceinline__ void operator()(const pg8::f32x4 (&acc)[2][2][4][2], const pg8::Unit& u, int wr, int wc, int fr, int fq) const {
        asm volatile("" : "+v"(fr), "+v"(fq));
        const int row0 = u.pm * 256 + wr * 64 + fr, col0 = u.pn * 256 + wc * 32 + 4 * fq;
        const float* g1 = g1l + (size_t)((u.pm % 9 == 0) ? 4 : u.pm / 9) * MODW + col0;
        pg8::f32x4 gv[2][2];
#pragma unroll
        for (int bj = 0; bj < 2; ++bj)
#pragma unroll
            for (int n = 0; n < 2; ++n) gv[bj][n] = *(const pg8::f32x4*)(g1 + bj * 128 + n * 16);
#pragma unroll
        for (int ai = 0; ai < 2; ++ai) {
            pg8::f32x4 xv[4][2][2];
#pragma unroll
            for (int m = 0; m < 4; ++m) { const float* rowp = X + (size_t)(row0 + ai * 128 + m * 16) * D + col0;
#pragma unroll
                for (int bj = 0; bj < 2; ++bj)
#pragma unroll
                    for (int n = 0; n < 2; ++n) xv[m][bj][n] = *(const pg8::f32x4*)(rowp + bj * 128 + n * 16); }
#pragma unroll
            for (int m = 0; m < 4; ++m) { float* rowp = X + (size_t)(row0 + ai * 128 + m * 16) * D + col0;
#pragma unroll
                for (int bj = 0; bj < 2; ++bj)
#pragma unroll
                    for (int n = 0; n < 2; ++n) *(pg8::f32x4*)(rowp + bj * 128 + n * 16) = xv[m][bj][n] + gv[bj][n] * acc[ai][bj][m][n]; }
            asm volatile("" ::: "memory");
        }
    }
};
struct EpiInproj {
    static constexpr int MIDK = 0; static constexpr bool PERM = false, AFTER_DRAIN = false;
    unsigned char* ws; const float* qn; const float* kn; LAS float* xs;
    __device__ __forceinline__ void operator()(const pg8::f32x4 (&acc)[2][2][4][2], const pg8::Unit& u, int wr, int wc, int fr, int fq) const {
        asm volatile("" : "+v"(fr), "+v"(fq));
        const int pn = u.pn; bf16* dst; int ldo, kind; const float* nw = nullptr;
        if (pn < 4) { dst = (bf16*)(ws + WS_QA) + pn * 256; ldo = QW; kind = 0; nw = qn; }
        else if (pn == 4) { dst = (bf16*)(ws + WS_KA); ldo = KW; kind = 0; nw = kn; }
        else if (pn == 5) { dst = (bf16*)(ws + WS_VA); ldo = KW; kind = 2; }
        else if (pn < 10) { dst = (bf16*)(ws + WS_QB) + (pn - 6) * 256; ldo = QW; kind = 1; }
        else if (pn == 10) { dst = (bf16*)(ws + WS_KB); ldo = KW; kind = 1; }
        else if (pn == 11) { dst = (bf16*)(ws + WS_VB); ldo = KW; kind = 2; }
        else if (pn < 20) { dst = (bf16*)(ws + WS_GA) + (pn - 12) * 256; ldo = D; kind = 3; }
        else { dst = (bf16*)(ws + WS_GB) + (pn - 20) * 256; ldo = D; kind = 3; }
        const int rt0 = wr * 64 + fr;
        const int cw = 32 * wc + 4 * fq;
        const int tb = u.pm % 9; const bool rope = (kind < 2) && (tb != 0);
        if (kind == 0) {
#pragma unroll
            for (int ai = 0; ai < 2; ++ai)
#pragma unroll
                for (int m = 0; m < 4; ++m)
#pragma unroll
                    for (int bj = 0; bj < 2; ++bj) { const pg8::f32x4 a = acc[ai][bj][m][0], b = acc[ai][bj][m][1];
                        float ss = (a[0] * a[0] + a[1] * a[1]) + (a[2] * a[2] + a[3] * a[3]) + (b[0] * b[0] + b[1] * b[1]) + (b[2] * b[2] + b[3] * b[3]);
                        ss += __shfl_xor(ss, 16); ss += __shfl_xor(ss, 32);
                        if (fq == 0) xs[(bj * 256 + rt0 + 128 * ai + 16 * m) * 4 + wc] = ss; }
            asm volatile("s_waitcnt lgkmcnt(0)" ::: "memory"); __builtin_amdgcn_s_barrier(); asm volatile("" ::: "memory");
        }
        pg8::f32x4 w1 = {1.f, 1.f, 1.f, 1.f}, w2 = w1;
        if (kind == 0) { const int d1 = 64 * (wc >> 1) + 16 * (wc & 1) + 4 * fq; w1 = *(const pg8::f32x4*)(nw + d1); w2 = *(const pg8::f32x4*)(nw + d1 + 32); }
        const float* RT = (const float*)(ws + WS_ROPE) + 16 * (wc & 1) + 4 * fq;
#pragma unroll
        for (int ai = 0; ai < 2; ++ai)
#pragma unroll
            for (int m = 0; m < 4; ++m) {
                const int rt = rt0 + 128 * ai + 16 * m;
                pg8::f32x4 cs = {1.f, 1.f, 1.f, 1.f}, sn = {0.f, 0.f, 0.f, 0.f};
                if (rope) { const int s = (tb - 1) * 256 + rt; const int pos = (wc >> 1) ? (s & 63) : (s >> 6); cs = *(const pg8::f32x4*)(RT + pos * 32); sn = *(const pg8::f32x4*)(RT + 2048 + pos * 32); }
                bf16* rowp = dst + (size_t)(u.pm * 256 + rt) * ldo + cw;
#pragma unroll
                for (int bj = 0; bj < 2; ++bj) {
                    pg8::f32x4 x1 = acc[ai][bj][m][0], x2 = acc[ai][bj][m][1];
                    if (kind == 0) { const pg8::f32x4 p = *(const LAS pg8::f32x4*)(xs + (bj * 256 + rt) * 4); const float r = 1.0f / sqrtf(((p[0] + p[1]) + (p[2] + p[3])) * (1.0f / HD) + EPS); x1 = x1 * r * w1; x2 = x2 * r * w2; }
                    if (kind < 2) { const pg8::f32x4 o1 = x1 * cs - x2 * sn, o2 = x1 * sn + x2 * cs; x1 = o1; x2 = o2; }
                    if (kind == 3) {
#pragma unroll
                        for (int e = 0; e < 4; ++e) { x1[e] = 1.f / (1.f + __expf(-x1[e])); x2[e] = 1.f / (1.f + __expf(-x2[e])); } }
                    uint2 o; o.x = pg8::cvt_pk_bf16(x1[0], x1[1]); o.y = pg8::cvt_pk_bf16(x1[2], x1[3]); *(uint2*)(rowp + bj * 128) = o;
                    o.x = pg8::cvt_pk_bf16(x2[0], x2[1]); o.y = pg8::cvt_pk_bf16(x2[2], x2[3]); *(uint2*)(rowp + bj * 128 + 16) = o;
                }
                asm volatile("" ::: "memory");
            }
    }
};
__device__ __forceinline__ void fast_inproj(Frame& F, int l) {
    pg8::Gemm g{(const bf16*)(F.ws + WS_HA), (const bf16*)(F.ws + WS_WIN) + (size_t)l * INC * D, M, INC, D, D, D};
    RowOrder S; S.init(false, INC, F.G, (int)blockIdx.x);
    if constexpr (FUSE_POST) { EpiInproj E{F.ws, INP(IN_QNA) + l * HD, INP(IN_KNA) + l * HD, (LAS float*)(F.lds + XS_OFF)};
        pg8::gemm_phase<EpiInproj, RowOrder, true, true>(F.lds + RING_OFF, g, S, E); }
    else { EpiF32 E{(float*)(F.ws + WS_P), INC};
        pg8::gemm_phase<EpiF32, RowOrder, true, true>(F.lds + RING_OFF, g, S, E); }
}
__device__ __forceinline__ void fast_br(Frame& F, int l) {
    const bool lat = (l == DEPTH - 1);
    if constexpr (FUSE_GATE && GATE_MIDK) {
        pg8::Gemm g{(const bf16*)(F.ws + WS_YAB), (const bf16*)(F.ws + WS_WBR) + (size_t)l * D * D, M, D, D, D, D};
        RowOrder S; S.init(lat, D, F.G, (int)blockIdx.x); EpiGateK E{(const bf16*)(F.ws + WS_GA), (const bf16*)(F.ws + WS_GB), (bf16*)(F.ws + WS_MB)};
        pg8::gemm_phase<EpiGateK, RowOrder, true, true>(F.lds + RING_OFF, g, S, E);
    } else if constexpr (FUSE_GATE) {
        { pg8::Gemm g{(const bf16*)(F.ws + WS_YAB), (const bf16*)(F.ws + WS_WBR) + (size_t)l * D * D, M, D, QW, D, D};
          RowOrder S; S.init(lat, D, F.G, (int)blockIdx.x); EpiGate<1> E{(const bf16*)(F.ws + WS_GA), (bf16*)(F.ws + WS_MB)};
          pg8::gemm_phase<EpiGate<1>, RowOrder, true, true>(F.lds + RING_OFF, g, S, E); }
        { pg8::Gemm g{(const bf16*)(F.ws + WS_YAB) + QW, (const bf16*)(F.ws + WS_WBR) + (size_t)l * D * D + QW, M, D, QW, D, D};
          RowOrder S; S.init(lat, D, F.G, (int)blockIdx.x); EpiGate<2> E{(const bf16*)(F.ws + WS_GB), (bf16*)(F.ws + WS_MB)};
          pg8::gemm_phase<EpiGate<2>, RowOrder, true, true>(F.lds + RING_OFF, g, S, E); }
    } else {
        { pg8::Gemm g{(const bf16*)(F.ws + WS_YAB), (const bf16*)(F.ws + WS_WBR) + (size_t)l * D * D, M, D, QW, D, D};
          RowOrder S; S.init(lat, D, F.G, (int)blockIdx.x); EpiF32 E{(float*)(F.ws + WS_T1), D};
          pg8::gemm_phase<EpiF32, RowOrder, true, true>(F.lds + RING_OFF, g, S, E); }
        { pg8::Gemm g{(const bf16*)(F.ws + WS_YAB) + QW, (const bf16*)(F.ws + WS_WBR) + (size_t)l * D * D + QW, M, D, QW, D, D};
          RowOrder S; S.init(lat, D, F.G, (int)blockIdx.x); EpiF32 E{(float*)(F.ws + WS_T2), D};
          pg8::gemm_phase<EpiF32, RowOrder, true, true>(F.lds + RING_OFF, g, S, E); }
    }
}
template <bool DRY>
__device__ __forceinline__ void fast_out(Frame& F, int l) {
    const bool lat = (l == DEPTH - 1);
    pg8::Gemm g{(const bf16*)(F.ws + WS_MB), (const bf16*)(F.ws + WS_WOUT) + (size_t)l * D * D, M, D, D, D, D};
    RowOrder S; S.init(lat, D, F.G, (int)blockIdx.x);
    if constexpr (FUSE_RES && !DRY) { EpiRes E{(float*)(F.ws + WS_XW), (const float*)(F.ws + WS_MOD) + (size_t)l * 5 * MODW + 2 * D};
        pg8::gemm_phase<EpiRes, RowOrder, true, true>(F.lds + RING_OFF, g, S, E); }
    else { EpiF32 E{(float*)(F.ws + WS_T3), D};
        pg8::gemm_phase<EpiF32, RowOrder, true, true>(F.lds + RING_OFF, g, S, E); }
}
constexpr int PH_P0 = 0, PH_P0B = 1, PH_L0 = 2, PH_PER_LAYER = 11, PH_FINAL = PH_L0 + PH_PER_LAYER * DEPTH, NPH = PH_FINAL + 1;
enum { L_NORM1 = 0, L_INPROJ = 1, L_POST = 2, L_ATTN = 3, L_BR = 4, L_GATE = 5, L_OUT = 6, L_NORM2R = 7, L_COMPACT = 8, L_UP = 9, L_DOWN = 10 };
struct Args { const float* in[NIN]; float* out; unsigned char* ws; int ph_lo, ph_hi, li, pad; };

__global__ void __launch_bounds__(NWAVES * 64, 2) mk_fwd(Args args) {
    extern __shared__ __attribute__((aligned(16))) unsigned char lds[];
    Frame F;
    F.lds = (LAS unsigned char*)lds;
    F.MISC = (volatile LAS unsigned*)(F.lds + MISC_OFF);
    F.tid = threadIdx.x; F.lane = F.tid & 63; F.wave = __builtin_amdgcn_readfirstlane(F.tid >> 6);
    F.G = gridDim.x; { const int bx = blockIdx.x; F.vcu = (F.G % 8 == 0) ? (bx % 8) * (F.G / 8) + bx / 8 : bx; }
    F.ws = args.ws; F.out = args.out; F.ctl = (gu32*)(args.ws + WS_CTL);
    for (int u = F.tid; u < (LDS_BYTES - LDSCTL_OFF) / 4; u += NWAVES * 64) ((LAS unsigned*)(F.lds + LDSCTL_OFF))[u] = 0u;
    __syncthreads();
    if (F.tid < NIN) ((LAS cfptr*)(F.lds + LDSCTL_OFF + 256))[F.tid] = args.in[F.tid];
    __syncthreads();
    XcdBarrier bar = xcd_barrier_post((unsigned*)(F.ctl + CW_BAR) + args.li * XCD_BAR_WORDS, F.MISC + 8);
    const int lo = args.ph_lo, hi = args.ph_hi;
    const int nrep2 = 2 + args.pad;
#define IN(k) (lo <= (k) && (k) < hi)
#if TPROBE >= 0
#define TSTAMP(k) do { if (blockIdx.x == TPROBE_BLK && F.tid == 0) ((volatile LAS unsigned long long*)(F.lds + LDSCTL_OFF + 800))[(k) + 1] = __builtin_amdgcn_s_memrealtime(); } while (0)
#else
#define TSTAMP(k) do { } while (0)
#endif
#if TPROBE >= 300
#define TSTAMPX(slot, l_) do { if (F.tid == 0 && (l_) == 1) { const unsigned long long tn_ = __builtin_amdgcn_s_memrealtime(); if (blockIdx.x == TPROBE_BLK) ((volatile LAS unsigned long long*)(F.lds + LDSCTL_OFF + 800))[slot] = tn_; atomicMax((unsigned*)F.ctl + 200000 + 512, ((unsigned)tn_ << 8) | (unsigned)blockIdx.x); } } while (0)
#else
#define TSTAMPX(slot, l_) do { } while (0)
#endif
#define SEAM(k) do { if (IN(k) && IN((k) + 1)) { xcd_barrier(bar); if (REPMASK & (1 << 12)) xcd_barrier(bar); } TSTAMP(k); } while (0)
    TSTAMP(-1);

    if (IN(PH_P0)) { p0_prologue(F); if (REPMASK & (1 << 10)) { __syncthreads(); p0_prologue(F); } }
    SEAM(PH_P0);
    if (IN(PH_P0B)) p0b_reduce(F);
    SEAM(PH_P0B);
#define LAYER_PROGRAM(l) do { constexpr int pb = PH_L0 + PH_PER_LAYER * (l); \
        if (IN(pb + L_NORM1)) { ph_norm1<false>(F, (l)); if (REPMASK & (1 << L_NORM1)) ph_norm1<true>(F, (l)); } \
        SEAM(pb + L_NORM1); \
        if (IN(pb + L_INPROJ)) { if constexpr (FAST_INPROJ) { fast_inproj(F, (l)); if (REPMASK & (1 << L_INPROJ)) fast_inproj(F, (l)); } } \
        SEAM(pb + L_INPROJ); \
        if (IN(pb + L_POST)) { if constexpr (!FUSE_POST) { ph_post(F, (l)); if (REPMASK & (1 << L_POST)) ph_post(F, (l)); } } \
        if constexpr (!FUSE_POST) SEAM(pb + L_POST); \
        if (IN(pb + L_ATTN)) { if constexpr (FAST_ATTN) { _Pragma("nounroll") for (int rep_ = 0; rep_ < ((REPMASK & (1 << L_ATTN)) ? nrep2 : 1); ++rep_) fast_attn(F, (l)); } } \
        SEAM(pb + L_ATTN); \
        if (IN(pb + L_BR)) { if constexpr (FAST_BR) { _Pragma("nounroll") for (int rep_ = 0; rep_ < ((REPMASK & (1 << L_BR)) ? nrep2 : 1); ++rep_) fast_br(F, (l)); } } \
        SEAM(pb + L_BR); \
        if (IN(pb + L_GATE)) { if constexpr (!FUSE_GATE) ph_gate(F, (l)); } \
        if constexpr (!FUSE_GATE) SEAM(pb + L_GATE); \
        if (IN(pb + L_OUT)) { if constexpr (FAST_OUT) { if (REPMASK & (1 << L_OUT)) fast_out<true>(F, (l)); fast_out<false>(F, (l)); TSTAMPX(27, (l)); } } \
        SEAM(pb + L_OUT); \
        if (IN(pb + L_NORM2R)) { if (REPMASK & (1 << L_NORM2R)) ph_norm2_router<!FUSE_RES, true>(F, (l)); ph_norm2_router<!FUSE_RES, false>(F, (l)); } \
        SEAM(pb + L_NORM2R); \
        if (IN(pb + L_COMPACT)) ph_compact(F, (l)); \
        SEAM(pb + L_COMPACT); \
        if (IN(pb + L_UP)) { if constexpr (FAST_UP) { fast_moe_up(F, (l)); } } \
        SEAM(pb + L_UP); \
        if (IN(pb + L_DOWN)) { if constexpr (FAST_DOWN) { fast_moe_down(F, (l)); } } \
        SEAM(pb + L_DOWN); } while (0)
    LAYER_PROGRAM(0);
    LAYER_PROGRAM(1);
#undef LAYER_PROGRAM
    if (IN(PH_FINAL)) { ph_final(F); if (REPMASK & (1 << 11)) ph_final(F); }
#if TPROBE >= 0
    if (blockIdx.x == TPROBE_BLK && F.tid == 0) { volatile LAS unsigned long long* ts = (volatile LAS unsigned long long*)(F.lds + LDSCTL_OFF + 800);
        const unsigned long long dt = (TPROBE == 302) ? (unsigned long long)(((const unsigned*)F.ctl)[200000 + 512] & 255u) * 100ull : (TPROBE == 303) ? (unsigned long long)((((const unsigned*)F.ctl)[200000 + 512] >> 8) - (((unsigned)ts[18]) & 0xffffffu)) & 0xffffffull : (TPROBE == 300) ? ts[27] - ts[18] : (TPROBE == 301) ? ts[20] - ts[27] : (TPROBE >= 200) ? (unsigned long long)(((const unsigned*)F.ctl)[200000 + 64 * (TPROBE - 200)] - (unsigned)ts[0]) : (TPROBE >= 100) ? ts[26] : ts[(TPROBE_HI < 0 ? 0 : TPROBE_HI) + 1] - ts[TPROBE >= 100 ? 0 : TPROBE], t0 = __builtin_amdgcn_s_memrealtime();
        while (__builtin_amdgcn_s_memrealtime() - t0 < 4ull * dt) __builtin_amdgcn_s_sleep(8); }
#endif
#if CNTPROBE
    xcd_barrier(bar);
    if (blockIdx.x == 0) {
        const unsigned* cnt = (const unsigned*)F.ctl + CW_CNT + (CNTPROBE_L) * 64; unsigned mx = 0, mn = 1u << 30, big = 0, big2 = 0;
        for (int e = 0; e < NE; ++e) { const unsigned c = cnt[e]; mx = c > mx ? c : mx; mn = c < mn ? c : mn; big += c > 384 ? 1 : 0; big2 += c > 512 ? 1 : 0; }
        const float val = CNTPROBE == 1 ? (float)mx : CNTPROBE == 2 ? (float)big : CNTPROBE == 3 ? (float)mn : (float)big2;
        const float c1 = sqrtf(val);
        for (size_t i = F.tid; i < (size_t)NB * SEQ * D; i += NWAVES * 64) F.out[i] = c1;
    }
#endif
#undef IN
#undef SEAM
}

static bool phase_is_naive(int ph) {
    if (ph < PH_L0 || ph == PH_FINAL) return false;
    const int k = (ph - PH_L0) % PH_PER_LAYER;
    switch (k) { case L_INPROJ: return !FAST_INPROJ; case L_ATTN: return !FAST_ATTN; case L_BR: return !FAST_BR; case L_OUT: return !FAST_OUT; case L_UP: return !FAST_UP; case L_DOWN: return !FAST_DOWN; default: return false; }
}
extern "C" void kernel_launch(void* const* d_in, const int* in_sizes, int n_in, void* d_out, int out_size, void* d_ws, size_t ws_size, hipStream_t stream) {
    static int grid = 0;
    if (grid == 0) {
        if (n_in != NIN || in_sizes[0] != NB * SEQ * D || out_size != NB * SEQ * D || ws_size < WS_END) { fprintf(stderr, "kernel_launch: shape/workspace mismatch (n_in %d, ws %zu)\n", n_in, ws_size); grid = -1; return; }
        int dev = 0, cus = 0, per_cu = 0;
        if (hipGetDevice(&dev) != hipSuccess || hipDeviceGetAttribute(&cus, hipDeviceAttributeMultiprocessorCount, dev) != hipSuccess) { grid = -1; return; }
        if (hipFuncSetAttribute((const void*)mk_fwd, hipFuncAttributeMaxDynamicSharedMemorySize, LDS_BYTES) != hipSuccess) { fprintf(stderr, "kernel_launch: hipFuncSetAttribute failed\n"); grid = -1; return; }
        if (hipOccupancyMaxActiveBlocksPerMultiprocessor(&per_cu, (const void*)mk_fwd, NWAVES * 64, LDS_BYTES) != hipSuccess || per_cu < 1) fprintf(stderr, "kernel_launch: occupancy query reports %d\n", per_cu);
        (void)hipGetLastError();
        grid = cus;
    }
    if (grid < 0) return;
    unsigned char* ws = (unsigned char*)d_ws;
    (void)hipMemsetAsync(ws + WS_CTL, 0, CTL_ZERO_BYTES, stream);
    Args a{};
    for (int i = 0; i < NIN; ++i) a.in[i] = (const float*)d_in[i];
    a.out = (float*)d_out; a.ws = ws;
    const float* const* in = (const float* const*)d_in;
    int li = 0, lo = -1;
    for (int ph = 0; ph < NPH; ++ph) {
        const bool nv = phase_is_naive(ph);
        if (!nv && lo < 0) lo = ph;
        if (nv || ph == NPH - 1) {
            if (lo >= 0) { a.ph_lo = lo; a.ph_hi = nv ? ph : ph + 1; a.li = li++; hipLaunchKernelGGL(mk_fwd, dim3(grid), dim3(NWAVES * 64), LDS_BYTES, stream, a); lo = -1; }
            if (nv) {
                const int l = (ph - PH_L0) / PH_PER_LAYER, k = (ph - PH_L0) % PH_PER_LAYER;
                const unsigned* cnt = (const unsigned*)ws + CW_CNT + l * 64;
                if (k == L_INPROJ) hipLaunchKernelGGL(naive_gemm<1>, dim3(INC / 64, M / 32), dim3(64, 4), 0, stream, (const bf16*)(ws + WS_HA), D, in[IN_WIN] + (size_t)l * D * INC, INC, (float*)(ws + WS_P), INC, D);
                else if (k == L_ATTN) { const int wq = (l < DEPTH - 1) ? 1 : 0; const long items = (long)NB * NH * (wq ? TT : SEQ);
                    hipLaunchKernelGGL(naive_attn, dim3((unsigned)((items + 3) / 4)), dim3(256), 0, stream, (const bf16*)(ws + WS_QA), (const bf16*)(ws + WS_KA), (const bf16*)(ws + WS_VA), (bf16*)(ws + WS_YAB), (const float*)nullptr, 0, wq);
                    hipLaunchKernelGGL(naive_attn, dim3((unsigned)((items + 3) / 4)), dim3(256), 0, stream, (const bf16*)(ws + WS_QB), (const bf16*)(ws + WS_KB), (const bf16*)(ws + WS_VB), (bf16*)(ws + WS_YAB) + QW, in[IN_SINK] + l * NH, 1, wq); }
                else if (k == L_BR) { hipLaunchKernelGGL(naive_gemm<0>, dim3(D / 64, M / 32), dim3(64, 4), 0, stream, (const bf16*)(ws + WS_YAB), D, in[IN_WBRA] + (size_t)l * QW * D, D, (float*)(ws + WS_T1), D, QW);
                    hipLaunchKernelGGL(naive_gemm<0>, dim3(D / 64, M / 32), dim3(64, 4), 0, stream, (const bf16*)(ws + WS_YAB) + QW, D, in[IN_WBRB] + (size_t)l * QW * D, D, (float*)(ws + WS_T2), D, QW); }
                else if (k == L_OUT) hipLaunchKernelGGL(naive_gemm<0>, dim3(D / 64, M / 32), dim3(64, 4), 0, stream, (const bf16*)(ws + WS_MB), D, in[IN_WOUT] + (size_t)l * D * D, D, (float*)(ws + WS_T3), D, D);
                else if (k == L_UP) hipLaunchKernelGGL(naive_moe_up, dim3(DE / 64, 2 * M / 4), dim3(64, 4), 0, stream, (const bf16*)(ws + WS_HA), in[IN_W1] + (size_t)l * NE * D * DE, in[IN_W3] + (size_t)l * NE * D * DE, cnt, (const unsigned*)(ws + WS_LIST) + (size_t)l * NE * M, (bf16*)(ws + WS_HB));
                else if (k == L_DOWN) hipLaunchKernelGGL(naive_moe_down, dim3(D / 64, 2 * M / 4), dim3(64, 4), 0, stream, (const bf16*)(ws + WS_HB), in[IN_W2] + (size_t)l * NE * DE * D, cnt, (bf16*)(ws + WS_YM));
            }
        }
    }
    const hipError_t le = hipPeekAtLastError();
    if (le != hipSuccess) fprintf(stderr, "kernel_launch: launch failed: %s\n", hipGetErrorName(le));
}
```

```cpp
#include <hip/hip_runtime.h>
#include <cstdio>
#include <cstdint>

constexpr int D = 2048, NB = 4, SEQ = 2048, CTX = 256, TT = CTX + SEQ, M = NB * TT, DEPTH = 2;
constexpr int HD = 128, NH = 8, NKV = 2, GRIDW = 64;
constexpr int QW = NH * HD, KW = NKV * HD;
constexpr int INC = 2 * QW + 4 * KW + 2 * D;
constexpr int OFF_QA = 0, OFF_KA = 1024, OFF_VA = 1280, OFF_QB = 1536, OFF_KB = 2560, OFF_VB = 2816, OFF_GA = 3072, OFF_GB = 5120;
constexpr int NE = 64, NG = 8, EPG = 8, DE = 512;
constexpr float EPS = 1e-6f;
constexpr float ATTN_SCALE = 0.08838834764831845f;
constexpr int MODW = 6 * D;
constexpr int NIN = 23;

__host__ __device__ __forceinline__ int perm_d2j(int d) { return 32 * (2 * (d >> 6) + ((d >> 4) & 1)) + 16 * ((d >> 5) & 1) + (d & 15); }
__host__ __device__ __forceinline__ int perm_j2d(int j) { const int wc = j >> 5, n = (j >> 4) & 1, t = j & 15; return 64 * (wc >> 1) + 32 * n + 16 * (wc & 1) + t; }
__host__ __device__ __forceinline__ bool inproj_roped(int c) { return (c < OFF_VA) || (c >= OFF_QB && c < OFF_VB); }
__host__ __device__ __forceinline__ int inproj_src_col(int c) { return inproj_roped(c) ? (c & ~127) + perm_j2d(c & 127) : c; }
__host__ __device__ __forceinline__ int inproj_dst_col(int n) { return inproj_roped(n) ? (n & ~127) + perm_d2j(n & 127) : n; }

constexpr size_t MiB = 1u << 20;
constexpr size_t WS_CTL = 0, CTL_ZERO_BYTES = 1 * MiB;
constexpr size_t WS_MOD = 1 * MiB;
constexpr size_t WS_ROPE = 1 * MiB + 512 * 1024;
constexpr size_t WS_TOK = 2 * MiB;
constexpr size_t WS_LIST = 3 * MiB;
constexpr size_t WS_WIN = 8 * MiB;
constexpr size_t WS_WBR = 64 * MiB;
constexpr size_t WS_WOUT = 80 * MiB;
constexpr size_t WS_XW = 96 * MiB;
constexpr size_t WS_HA = 168 * MiB;
constexpr size_t WS_QA = 204 * MiB, WS_KA = 222 * MiB, WS_VA = 227 * MiB, WS_QB = 232 * MiB, WS_KB = 250 * MiB, WS_VB = 255 * MiB;
constexpr size_t WS_GA = 260 * MiB, WS_GB = 296 * MiB;
constexpr size_t WS_YAB = 332 * MiB;
constexpr size_t WS_MB = 368 * MiB;
constexpr size_t WS_HB = 404 * MiB;
constexpr size_t WS_YM = 424 * MiB;
constexpr size_t WS_P = 496 * MiB;
constexpr size_t WS_MODP = 964 * MiB;
constexpr size_t WS_WR = 740 * MiB;
constexpr size_t WS_T1 = 748 * MiB, WS_T2 = 820 * MiB, WS_T3 = 892 * MiB;
constexpr size_t WS_END = 996 * MiB;
constexpr int CW_TMO = 0, CW_CODE = 1;
constexpr int CW_BAR = 4096;
constexpr int CW_CNT = 131072;
constexpr int MAX_LAUNCH = 32;

constexpr int RING_OFF = 0, RING_BYTES = 131072;
constexpr int XS_OFF = 131072, XS_BYTES = 16384;
constexpr int LDSCTL_OFF = 162816, MISC_OFF = LDSCTL_OFF;
constexpr int LDS_BYTES = 163840;
constexpr int NWAVES = 8;
constexpr bool FAST_INPROJ = true, FAST_ATTN = true, FAST_BR = true, FAST_OUT = true, FAST_UP = true, FAST_DOWN = true;
constexpr bool FUSE_POST = true, FUSE_GATE = true, FUSE_RES = true, GATE_MIDK = true, P0_SPLIT = true;
#ifndef REPMASK
#define REPMASK 0
#endif
#ifndef CNTPROBE
#define CNTPROBE 0
#define CNTPROBE_L 0
#endif
#ifndef MOEVAR
#define MOEVAR 0
#endif
#ifndef TPROBE
#define TPROBE -1
#define TPROBE_HI -1
#endif
#ifndef TPROBE_BLK
#define TPROBE_BLK 0
#endif
namespace pg8 {
#define PG8_LAS __attribute__((address_space(3)))
typedef unsigned short bf16_t;
typedef short bf16x8 __attribute__((ext_vector_type(8)));
typedef float f32x4 __attribute__((ext_vector_type(4)));
typedef unsigned u32x4 __attribute__((ext_vector_type(4)));
constexpr int BM = 256, BK = 64, HALF = 128, HTB = HALF * BK * 2  , STAGE_BYTES = 8 * HTB, NXCD = 8, WGM = 8;

__host__ __device__ __forceinline__ int lds_byte(int r, int c) { const int st = (r >> 4) * 2 + (c >> 5), rr = r & 15, cc = c & 31, ob = rr * 64 + cc * 2; return st * 1024 + (ob ^ (((ob >> 9) & 1) << 5)); }
__host__ __device__ __forceinline__ void stage_rc(int b, int& R, int& C) { const int st = b / 1024, sb = b % 1024, swz = sb ^ (((sb >> 9) & 1) << 5); R = (st >> 1) * 16 + swz / 64; C = (st & 1) * 32 + (swz % 64) / 2; }
__host__ __device__ __forceinline__ int perm32(int rho) { const int n = rho >> 4, i = rho & 15; return 8 * (i >> 2) + 4 * n + (i & 3); }

struct Unit { int pm, pn; };
struct Gemm { const bf16_t* A; const bf16_t* Bt; int M, N, K, lda, ldb; };

struct StaticOrder {
    int nM, nN, nwg, G, c;
    __host__ __device__ void init(int M, int N, int G_, int c_) { nM = M / BM; nN = N / BM; nwg = nM * nN; G = G_; c = c_; }
    __host__ __device__ bool next(int i, Unit& u) const {
        const long L = (long)i * G + c; if (L >= nwg) return false;
        int wgid = (int)L; { const int q = nwg / NXCD, r = nwg % NXCD, xcd = wgid % NXCD, off = wgid / NXCD; wgid = (xcd < r ? xcd * (q + 1) : r * (q + 1) + (xcd - r) * q) + off; }
        const int nig = WGM * nN, gid = wgid / nig, fm = gid * WGM, gsz = (nM - fm) < WGM ? (nM - fm) : WGM;
        u.pm = fm + ((wgid % nig) % gsz); u.pn = (wgid % nig) / gsz; return true;
    }
    __device__ __forceinline__ void a_ready(const Unit&) const {}
    __device__ __forceinline__ void done(const Unit&) const {}
};

__device__ __forceinline__ unsigned cvt_pk_bf16(float lo, float hi) { unsigned r; asm volatile("v_cvt_pk_bf16_f32 %0, %1, %2" : "=v"(r) : "v"(lo), "v"(hi)); return r; }
typedef float f32x2 __attribute__((ext_vector_type(2)));
__device__ __forceinline__ f32x2 gelu_pk(f32x2 v) {
    const f32x2 av = __builtin_elementwise_abs(v), d = av * 0.2316418882f + 1.0f;
    f32x2 t; t.x = __builtin_amdgcn_rcpf(d.x); t.y = __builtin_amdgcn_rcpf(d.y);
    f32x2 q = t * 0.5307027145f + (-0.7265760135f); q = q * t + 0.7107068705f; q = q * t + (-0.142248368f); q = q * t + 0.127414796f; q = q * t;
    const f32x2 s = (v * v) * (-0.72134752044f);
    f32x2 e; e.x = __builtin_amdgcn_exp2f(s.x); e.y = __builtin_amdgcn_exp2f(s.y);
    const f32x2 m = v * (q * e), r = v - m;
    f32x2 o; o.x = v.x < 0.f ? m.x : r.x; o.y = v.y < 0.f ? m.y : r.y; return o;
}

template <int ACT  > struct EpiBf16 {
    static constexpr int MIDK = 0; static constexpr bool PERM = true, AFTER_DRAIN = false; static_assert(ACT == 0 || ACT == 1, "EpiBf16: ACT is 0 (none) or 1 (gelu_pk)");
    bf16_t* O; int ldc; const float* bias; int split_cols; size_t split_stride; float scale0;
    __device__ __forceinline__ void operator()(const f32x4 (&acc)[2][2][4][2], const Unit& u, int wr, int wc, int fr, int fq) const {
        const int row0 = u.pm * BM + wr * 64 + fr; int colt = u.pn * BM; bf16_t* base = O;
        float sc = 1.f; if (split_cols) { const int t = colt / split_cols; base += (size_t)t * split_stride; colt -= t * split_cols; if (t == 0) sc = scale0; }
        const int col0 = colt + wc * 32 + 8 * fq, bcol0 = u.pn * BM + wc * 32 + 8 * fq;
        f32x4 bv[2][2];
#pragma unroll
        for (int bj = 0; bj < 2; ++bj)
#pragma unroll
            for (int n = 0; n < 2; ++n) bv[bj][n] = bias ? *(const f32x4*)(bias + bcol0 + bj * HALF + 4 * n) : (f32x4){0.f, 0.f, 0.f, 0.f};
#pragma unroll
        for (int ai = 0; ai < 2; ++ai)
#pragma unroll
            for (int m = 0; m < 4; ++m) { bf16_t* rowp = base + (size_t)(row0 + ai * HALF + m * 16) * ldc + col0;
#pragma unroll
                for (int bj = 0; bj < 2; ++bj) { f32x4 v0 = acc[ai][bj][m][0] + bv[bj][0], v1 = acc[ai][bj][m][1] + bv[bj][1];
                    if (ACT == 1) { f32x2 a = gelu_pk((f32x2){v0[0], v0[1]}), b = gelu_pk((f32x2){v0[2], v0[3]}), c = gelu_pk((f32x2){v1[0], v1[1]}), d = gelu_pk((f32x2){v1[2], v1[3]});
                        v0 = (f32x4){a.x, a.y, b.x, b.y}; v1 = (f32x4){c.x, c.y, d.x, d.y}; }
                    v0 = v0 * sc; v1 = v1 * sc; u32x4 w; w.x = cvt_pk_bf16(v0[0], v0[1]); w.y = cvt_pk_bf16(v0[2], v0[3]); w.z = cvt_pk_bf16(v1[0], v1[1]); w.w = cvt_pk_bf16(v1[2], v1[3]);
                    *(u32x4*)(rowp + bj * HALF) = w; } }
    }
};

struct PanelStats {
    unsigned* xbuf;
    unsigned* cnt;
    unsigned* tmo;
    int ntn; float eps;
    unsigned code;
    __device__ __forceinline__ bool run(const f32x4 (&v)[2][2][4][2], const Unit& u, int wr, int wc, int fr, int fq, PG8_LAS unsigned char* lds, int wid, int lane) const {
        typedef float f32x2v __attribute__((ext_vector_type(2)));
        PG8_LAS f32x2v* P = (PG8_LAS f32x2v*)lds;
        PG8_LAS f32x2v* S = (PG8_LAS f32x2v*)(lds + 8192);
        PG8_LAS unsigned* flag = (PG8_LAS unsigned*)(lds + 8192 + 2048);
#pragma unroll
        for (int ai = 0; ai < 2; ++ai)
#pragma unroll
            for (int m = 0; m < 4; ++m) {
                float s = 0.f;
#pragma unroll
                for (int bj = 0; bj < 2; ++bj)
#pragma unroll
                    for (int n = 0; n < 2; ++n) { const f32x4 x = v[ai][bj][m][n]; s += (x[0] + x[1]) + (x[2] + x[3]); }
                s += __shfl_xor(s, 16); s += __shfl_xor(s, 32);
                const float mw = s * (1.0f / 64.0f); float q = 0.f;
#pragma unroll
                for (int bj = 0; bj < 2; ++bj)
#pragma unroll
                    for (int n = 0; n < 2; ++n) { const f32x4 d = v[ai][bj][m][n] - mw; q += (d[0] * d[0] + d[1] * d[1]) + (d[2] * d[2] + d[3] * d[3]); }
                q += __shfl_xor(q, 16); q += __shfl_xor(q, 32);
                if (fq == 0) P[(ai * HALF + wr * 64 + m * 16 + fr) * 4 + wc] = (f32x2v){mw, q};
            }
        asm volatile("s_waitcnt lgkmcnt(0)" ::: "memory"); __builtin_amdgcn_s_barrier(); asm volatile("" ::: "memory");
#if defined(BROKEN_EXCHANGE_NO_WAIT)
#warning BROKEN CONTROL BUILD: the row-statistics exchange does not wait; results are wrong by design
        if (blockIdx.x >= 64) { const long long t0_ = clock64(); while (clock64() - t0_ < 60000) __builtin_amdgcn_s_sleep(8); }
#endif
        const int row = wid * 32 + (lane & 31);
        if (lane < 32) {
            const f32x2v a = P[row * 4 + 0], b = P[row * 4 + 1], c = P[row * 4 + 2], d = P[row * 4 + 3];
            const float mt = (a.x + b.x + c.x + d.x) * 0.25f;
            const float da = a.x - mt, db = b.x - mt, dc = c.x - mt, dd = d.x - mt;
            const float m2 = (a.y + b.y) + (c.y + d.y) + 64.0f * ((da * da + db * db) + (dc * dc + dd * dd));
            unsigned long long* slot = (unsigned long long*)xbuf + ((size_t)(u.pm * BM + row) * 4 + u.pn);
            __hip_atomic_store(slot, ((unsigned long long)__float_as_uint(m2) << 32) | __float_as_uint(mt), __ATOMIC_RELAXED, __HIP_MEMORY_SCOPE_AGENT);
        }
        asm volatile("s_waitcnt vmcnt(0)" ::: "memory");
        if (lane == 0) __hip_atomic_fetch_add(cnt + 64 * u.pm, 1u, __ATOMIC_RELAXED, __HIP_MEMORY_SCOPE_AGENT);
        if (wid == 0) {
            bool dead = false; const unsigned long long t0 = __builtin_amdgcn_s_memrealtime(); const unsigned want = 8u * (unsigned)ntn;
            for (;;) {
#if defined(BROKEN_EXCHANGE_NO_WAIT)
                break;
#endif
                if ((unsigned)__builtin_amdgcn_readfirstlane(__hip_atomic_load(cnt + 64 * u.pm, __ATOMIC_RELAXED, __HIP_MEMORY_SCOPE_AGENT)) >= want) break;
                if (__builtin_amdgcn_s_memrealtime() - t0 > 2000000ull) {
                    if (lane == 0) { unsigned expect = 0u; __hip_atomic_compare_exchange_strong(tmo + 1, &expect, code | (unsigned)(u.pm & 0xff), __ATOMIC_RELAXED, __ATOMIC_RELAXED, __HIP_MEMORY_SCOPE_AGENT);
                                     __hip_atomic_store(tmo, 1u, __ATOMIC_RELAXED, __HIP_MEMORY_SCOPE_AGENT); }
                    dead = true; break; }
                __builtin_amdgcn_s_sleep(2);
            }
            __builtin_amdgcn_fence(__ATOMIC_ACQUIRE, "agent");
            if (lane == 0) flag[0] = dead ? 1u : 0u;
        }
        asm volatile("s_waitcnt vmcnt(0) lgkmcnt(0)" ::: "memory"); __builtin_amdgcn_s_barrier(); asm volatile("" ::: "memory");
        const bool bad = flag[0] != 0u;
        if (lane < 32) {
            const unsigned long long* slot = (const unsigned long long*)xbuf + (size_t)(u.pm * BM + row) * 4; float mt[4], m2[4]; float ms = 0.f;
#pragma unroll
            for (int t = 0; t < 4; ++t) { if (t < ntn) { const unsigned long long w = __hip_atomic_load(slot + t, __ATOMIC_RELAXED, __HIP_MEMORY_SCOPE_AGENT); mt[t] = __uint_as_float((unsigned)w); m2[t] = __uint_as_float((unsigned)(w >> 32)); } else { mt[t] = 0.f; m2[t] = 0.f; } ms += mt[t]; }
            const float mean = ms / (float)ntn; float q = 0.f;
#pragma unroll
            for (int t = 0; t < 4; ++t) if (t < ntn) { const float dm = mt[t] - mean; q += m2[t] + 256.0f * dm * dm; }
            S[row] = (f32x2v){mean, 1.0f / sqrtf(q / (256.0f * (float)ntn) + eps)};
        }
        asm volatile("s_waitcnt lgkmcnt(0)" ::: "memory"); __builtin_amdgcn_s_barrier(); asm volatile("" ::: "memory");
        return bad;
    }
};
struct EpiLnRes {
    static constexpr int MIDK = 0; static constexpr bool PERM = false, AFTER_DRAIN = true;
    const float* base; float* out; int ldc; const float* bias; PanelStats st; unsigned poison;
    __device__ __forceinline__ void fused(f32x4 (&acc)[2][2][4][2], const Unit& u, int wr, int wc, int fr, int fq, PG8_LAS unsigned char* lds, int wid, int lane) const {
        typedef float f32x2v __attribute__((ext_vector_type(2)));
        const PG8_LAS f32x2v* S = (const PG8_LAS f32x2v*)(lds + 8192);
        const int col0 = u.pn * BM + wc * 32 + 4 * fq;
#pragma unroll
        for (int bj = 0; bj < 2; ++bj)
#pragma unroll
            for (int n = 0; n < 2; ++n) { const f32x4 bv = bias ? *(const f32x4*)(bias + col0 + bj * HALF + n * 16) : (f32x4){0.f, 0.f, 0.f, 0.f};
#pragma unroll
                for (int ai = 0; ai < 2; ++ai)
#pragma unroll
                    for (int m = 0; m < 4; ++m) acc[ai][bj][m][n] += bv; }
        f32x4 pre[4][2][2];
#pragma unroll
        for (int m = 0; m < 4; ++m) { const size_t off = (size_t)(u.pm * BM + wr * 64 + m * 16 + fr) * ldc + col0;
#pragma unroll
            for (int bj = 0; bj < 2; ++bj)
#pragma unroll
                for (int n = 0; n < 2; ++n) pre[m][bj][n] = *(const f32x4*)(base + off + bj * HALF + n * 16); }
        const bool bad = st.run(acc, u, wr, wc, fr, fq, lds, wid, lane) || poison != 0u;
        const float qnan = __builtin_nanf("");
#pragma unroll
        for (int ai = 0; ai < 2; ++ai)
#pragma unroll
            for (int m = 0; m < 4; ++m) { const int r = ai * HALF + wr * 64 + m * 16 + fr; const f32x2v sr = S[r]; const size_t off = (size_t)(u.pm * BM + r) * ldc + col0;
#pragma unroll
                for (int bj = 0; bj < 2; ++bj)
#pragma unroll
                    for (int n = 0; n < 2; ++n) { const f32x4 bs = ai == 0 ? pre[m][bj][n] : *(const f32x4*)(base + off + bj * HALF + n * 16); f32x4 o = bs + (acc[ai][bj][m][n] - sr.x) * sr.y;
                        if (bad) o = (f32x4){qnan, qnan, qnan, qnan}; *(f32x4*)(out + off + bj * HALF + n * 16) = o; }
                if (m & 1) asm volatile("" ::: "memory"); }
    }
};
struct EpiLnResLn {
    static constexpr int MIDK = 0; static constexpr bool PERM = false, AFTER_DRAIN = true;
    const float* base; float* out; bf16_t* xn; int ldc; const float* bias; PanelStats st1, st2; unsigned poison;
    __device__ __forceinline__ void fused(f32x4 (&acc)[2][2][4][2], const Unit& u, int wr, int wc, int fr, int fq, PG8_LAS unsigned char* lds, int wid, int lane) const {
        typedef float f32x2v __attribute__((ext_vector_type(2))); typedef unsigned u32x2v __attribute__((ext_vector_type(2)));
        const PG8_LAS f32x2v* S = (const PG8_LAS f32x2v*)(lds + 8192);
        const int col0 = u.pn * BM + wc * 32 + 4 * fq;
#pragma unroll
        for (int bj = 0; bj < 2; ++bj)
#pragma unroll
            for (int n = 0; n < 2; ++n) { const f32x4 bv = bias ? *(const f32x4*)(bias + col0 + bj * HALF + n * 16) : (f32x4){0.f, 0.f, 0.f, 0.f};
#pragma unroll
                for (int ai = 0; ai < 2; ++ai)
#pragma unroll
                    for (int m = 0; m < 4; ++m) acc[ai][bj][m][n] += bv; }
        bool bad = st1.run(acc, u, wr, wc, fr, fq, lds, wid, lane) || poison != 0u;
        const float qnan = __builtin_nanf("");
#pragma unroll
        for (int ai = 0; ai < 2; ++ai)
#pragma unroll
            for (int m = 0; m < 4; ++m) { const int r = ai * HALF + wr * 64 + m * 16 + fr; const f32x2v sr = S[r]; const size_t off = (size_t)(u.pm * BM + r) * ldc + col0;
#pragma unroll
                for (int bj = 0; bj < 2; ++bj)
#pragma unroll
                    for (int n = 0; n < 2; ++n) { const f32x4 bs = *(const f32x4*)(base + off + bj * HALF + n * 16); acc[ai][bj][m][n] = bs + (acc[ai][bj][m][n] - sr.x) * sr.y; }
                asm volatile("" : "+v"(acc[ai][0][m][0]), "+v"(acc[ai][0][m][1]), "+v"(acc[ai][1][m][0]), "+v"(acc[ai][1][m][1]));
                if (m & 1) asm volatile("" ::: "memory"); }
        const bool bad1 = bad;
        bad = st2.run(acc, u, wr, wc, fr, fq, lds, wid, lane) || bad;
#pragma unroll
        for (int ai = 0; ai < 2; ++ai)
#pragma unroll
            for (int m = 0; m < 4; ++m) { const int r = ai * HALF + wr * 64 + m * 16 + fr; const f32x2v sr = S[r]; const size_t off = (size_t)(u.pm * BM + r) * ldc + col0;
#pragma unroll
                for (int bj = 0; bj < 2; ++bj)
#pragma unroll
                    for (int n = 0; n < 2; ++n) { const f32x4 x1 = acc[ai][bj][m][n]; *(f32x4*)(out + off + bj * HALF + n * 16) = bad1 ? (f32x4){qnan, qnan, qnan, qnan} : x1;
                        const f32x4 o = (x1 - sr.x) * sr.y; u32x2v w; w.x = cvt_pk_bf16(o[0], o[1]); w.y = cvt_pk_bf16(o[2], o[3]);
                        if (bad) { w.x = 0x7fc07fc0u; w.y = 0x7fc07fc0u; } *(u32x2v*)(xn + off + bj * HALF + n * 16) = w; }
                asm volatile("" ::: "memory"); }
    }
};

template <class Epi, class Sched, bool ALIGN_EPI = false, bool SP2 = false>
__device__ __forceinline__ void gemm_phase(PG8_LAS unsigned char* lds, const Gemm g, const Sched& S, const Epi& E) {
    const int tid = threadIdx.x, wid = __builtin_amdgcn_readfirstlane(tid >> 6), lane = tid & 63, wr = wid >> 2, wc = wid & 3, fr = lane & 15, fq = lane >> 4;
    const int K = g.K, nt = K / BK;
    unsigned voffA[2], voffB[2];
#pragma unroll
    for (int i = 0; i < 2; ++i) { int R, C; stage_rc(tid * 16 + i * 8192, R, C); const int Rb = Epi::PERM ? ((R & ~31) + perm32(R & 31)) : R;
        voffA[i] = (unsigned)(R * g.lda + C) * 2u; voffB[i] = (unsigned)(Rb * g.ldb + C) * 2u; }
    const size_t kstep = (size_t)(BK * 2);
    const size_t hstepA = (size_t)HALF * g.lda * 2, hstepB = (size_t)HALF * g.ldb * 2;
    const size_t tstepA = 2 * hstepA, tstepB = 2 * hstepB;
    const unsigned ldsw = (unsigned)wid * 1024u;
    const int aoff = lds_byte(wr * 64 + fr, fq * 8), boff = lds_byte(wc * 32 + fr, fq * 8);
#define PG8_SA(b, h) (((b) * 2 + (h)) * HTB)
#define PG8_SB(b, h) ((4 + (b) * 2 + (h)) * HTB)
#define PG8_STAGE(bufoff, gbase, voff) do { _Pragma("unroll") for (int _i = 0; _i < 2; ++_i) \
        __builtin_amdgcn_global_load_lds((const unsigned*)((const char*)(gbase) + (voff)[_i]), (PG8_LAS unsigned*)(lds + (bufoff) + ldsw + _i * 8192), 16, 0, 0); } while (0)
#define PG8_LDA(dst, b, h) do { _Pragma("unroll") for (int m = 0; m < 4; ++m) _Pragma("unroll") for (int k = 0; k < 2; ++k) dst[m][k] = *(const PG8_LAS bf16x8*)(lds + PG8_SA(b, h) + aoff + m * 2048 + k * 1024); } while (0)
#define PG8_LDB(dst, b, h) do { _Pragma("unroll") for (int n = 0; n < 2; ++n) _Pragma("unroll") for (int k = 0; k < 2; ++k) dst[n][k] = *(const PG8_LAS bf16x8*)(lds + PG8_SB(b, h) + boff + n * 2048 + k * 1024); } while (0)
#define PG8_MMA(ai, bj, At, Bt) do { __builtin_amdgcn_s_setprio(1); _Pragma("unroll") for (int m = 0; m < 4; ++m) _Pragma("unroll") for (int n = 0; n < 2; ++n) _Pragma("unroll") for (int k = 0; k < 2; ++k) \
        acc[ai][bj][m][n] = __builtin_amdgcn_mfma_f32_16x16x32_bf16(Bt[n][k], At[m][k], acc[ai][bj][m][n], 0, 0, 0); __builtin_amdgcn_s_setprio(0); } while (0)
#define PG8_WAIT_V(n) asm volatile("s_waitcnt vmcnt(" #n ")" ::: "memory")
#define PG8_WAIT_L(n) asm volatile("s_waitcnt lgkmcnt(" #n ")" ::: "memory")
#define PG8_BAR __builtin_amdgcn_s_barrier()
#define PG8_SCHED __builtin_amdgcn_sched_barrier(0)
    Unit cur, nxt; int ui = 0;
    if (!S.next(0, cur)) return;
    f32x4 acc[2][2][4][2];
#pragma unroll
    for (int a = 0; a < 2; ++a)
#pragma unroll
        for (int b = 0; b < 2; ++b)
#pragma unroll
            for (int m = 0; m < 4; ++m)
#pragma unroll
                for (int n = 0; n < 2; ++n) acc[a][b][m][n] = (f32x4){0.f, 0.f, 0.f, 0.f};
    bf16x8 At[4][2], B0[2][2], B1[2][2];
    const char* cA = (const char*)g.A + (size_t)cur.pm * tstepA; const char* cB = (const char*)g.Bt + (size_t)cur.pn * tstepB;
    S.a_ready(cur);
    if constexpr (SP2) {
        PG8_STAGE(PG8_SB(0, 0), cB, voffB); PG8_STAGE(PG8_SB(0, 1), cB + hstepB, voffB); PG8_STAGE(PG8_SA(0, 0), cA, voffA); PG8_STAGE(PG8_SA(0, 1), cA + hstepA, voffA);
        if (wr == 1) PG8_BAR;
        PG8_WAIT_V(2); PG8_BAR;
        PG8_STAGE(PG8_SB(1, 0), cB + kstep, voffB); PG8_STAGE(PG8_SA(1, 0), cA + kstep, voffA); PG8_STAGE(PG8_SB(1, 1), cB + hstepB + kstep, voffB);
        PG8_WAIT_V(6); PG8_BAR;
    } else {
        PG8_STAGE(PG8_SB(0, 0), cB, voffB); PG8_STAGE(PG8_SA(0, 0), cA, voffA); PG8_STAGE(PG8_SB(0, 1), cB + hstepB, voffB); PG8_STAGE(PG8_SA(0, 1), cA + hstepA, voffA);
        if (wr == 1) PG8_BAR;
        PG8_WAIT_V(4); PG8_BAR;
        PG8_STAGE(PG8_SB(1, 0), cB + kstep, voffB); PG8_STAGE(PG8_SA(1, 0), cA + kstep, voffA); PG8_STAGE(PG8_SB(1, 1), cB + hstepB + kstep, voffB);
        PG8_WAIT_V(6); PG8_BAR;
    }
    for (;;) {
        const bool has_next = S.next(ui + 1, nxt);
        const char* nA = has_next ? (const char*)g.A + (size_t)nxt.pm * tstepA : cA; const char* nB = has_next ? (const char*)g.Bt + (size_t)nxt.pn * tstepB : cB;
        for (int t = 0; t < nt; t += 2) {
            if constexpr (Epi::MIDK > 0) { if (t == Epi::MIDK) E.mid(acc, cur, wr, wc, fr, fq); }
            const bool last = (t == nt - 2);
            const char* a1 = cA + (size_t)(t + 1) * kstep;
            const char* a2 = last ? nA : cA + (size_t)(t + 2) * kstep; const char* b2 = last ? nB : cB + (size_t)(t + 2) * kstep;
            const char* a3 = a2 + kstep; const char* b3 = b2 + kstep;
            if (last && has_next) S.a_ready(nxt);
            if constexpr (SP2) {
            PG8_LDB(B0, 0, 0); PG8_LDB(B1, 0, 1); PG8_SCHED; PG8_LDA(At, 0, 0); PG8_STAGE(PG8_SA(1, 1), a1 + hstepA, voffA);
            PG8_WAIT_V(8); PG8_WAIT_L(0); PG8_BAR; PG8_MMA(0, 0, At, B0); PG8_MMA(0, 1, At, B1); PG8_BAR; PG8_SCHED;
            PG8_LDA(At, 0, 1); PG8_STAGE(PG8_SB(0, 0), b2, voffB); PG8_STAGE(PG8_SB(0, 1), b2 + hstepB, voffB); PG8_STAGE(PG8_SA(0, 0), a2, voffA);
            PG8_WAIT_V(8); PG8_WAIT_L(0); PG8_BAR; PG8_MMA(1, 0, At, B0); PG8_MMA(1, 1, At, B1); PG8_BAR; PG8_SCHED;
            PG8_LDB(B0, 1, 0); PG8_LDB(B1, 1, 1); PG8_SCHED; PG8_LDA(At, 1, 0); PG8_STAGE(PG8_SA(0, 1), a2 + hstepA, voffA);
            PG8_WAIT_V(8); PG8_WAIT_L(0); PG8_BAR; PG8_MMA(0, 0, At, B0); PG8_MMA(0, 1, At, B1); PG8_BAR; PG8_SCHED;
            PG8_LDA(At, 1, 1); PG8_STAGE(PG8_SB(1, 0), b3, voffB); PG8_STAGE(PG8_SB(1, 1), b3 + hstepB, voffB); PG8_STAGE(PG8_SA(1, 0), a3, voffA);
            PG8_WAIT_V(8); PG8_WAIT_L(0); PG8_BAR; PG8_MMA(1, 0, At, B0); PG8_MMA(1, 1, At, B1); PG8_BAR; PG8_SCHED;
            } else {
            PG8_LDB(B0, 0, 0); PG8_SCHED; PG8_LDA(At, 0, 0); PG8_STAGE(PG8_SA(1, 1), a1 + hstepA, voffA);
            PG8_WAIT_L(8); PG8_BAR; PG8_WAIT_L(0); PG8_MMA(0, 0, At, B0); PG8_BAR; PG8_SCHED;
            PG8_LDB(B1, 0, 1); PG8_STAGE(PG8_SB(0, 0), b2, voffB);
            PG8_BAR; PG8_WAIT_L(0); PG8_MMA(0, 1, At, B1); PG8_BAR;
            PG8_LDA(At, 0, 1); PG8_STAGE(PG8_SA(0, 0), a2, voffA);
            PG8_BAR; PG8_WAIT_L(0); PG8_MMA(1, 0, At, B0); PG8_BAR; PG8_SCHED;
            PG8_STAGE(PG8_SB(0, 1), b2 + hstepB, voffB);
            PG8_WAIT_V(6); PG8_BAR; PG8_MMA(1, 1, At, B1); PG8_BAR;
            PG8_LDB(B0, 1, 0); PG8_SCHED; PG8_LDA(At, 1, 0); PG8_STAGE(PG8_SA(0, 1), a2 + hstepA, voffA);
            PG8_WAIT_L(8); PG8_BAR; PG8_WAIT_L(0); PG8_MMA(0, 0, At, B0); PG8_BAR; PG8_SCHED;
            PG8_LDB(B1, 1, 1); PG8_STAGE(PG8_SB(1, 0), b3, voffB);
            PG8_BAR; PG8_WAIT_L(0); PG8_MMA(0, 1, At, B1); PG8_BAR;
            PG8_LDA(At, 1, 1); PG8_STAGE(PG8_SA(1, 0), a3, voffA);
            PG8_BAR; PG8_WAIT_L(0); PG8_MMA(1, 0, At, B0); PG8_BAR; PG8_SCHED;
            PG8_STAGE(PG8_SB(1, 1), b3 + hstepB, voffB);
            PG8_WAIT_V(6); PG8_BAR; PG8_MMA(1, 1, At, B1); PG8_BAR;
            }
        }
        if constexpr (ALIGN_EPI) { if (wr == 0) PG8_BAR; }
        if constexpr (!Epi::AFTER_DRAIN) { E(acc, cur, wr, wc, fr, fq); S.done(cur); }
        if (!has_next) break;
#pragma unroll
        for (int a = 0; a < 2; ++a)
#pragma unroll
            for (int b = 0; b < 2; ++b)
#pragma unroll
                for (int m = 0; m < 4; ++m)
#pragma unroll
                    for (int n = 0; n < 2; ++n) acc[a][b][m][n] = (f32x4){0.f, 0.f, 0.f, 0.f};
        cur = nxt; cA = nA; cB = nB; ++ui;
        if constexpr (ALIGN_EPI) { if (wr == 1) PG8_BAR; }
    }
    PG8_WAIT_V(0);
    if constexpr (!ALIGN_EPI) { if (wr == 0) PG8_BAR; }
    PG8_BAR;
    if constexpr (Epi::AFTER_DRAIN) { E.fused(acc, cur, wr, wc, fr, fq, lds, wid, lane); S.done(cur); }
#undef PG8_SA
#undef PG8_SB
#undef PG8_STAGE
#undef PG8_LDA
#undef PG8_LDB
#undef PG8_MMA
#undef PG8_WAIT_V
#undef PG8_WAIT_L
#undef PG8_BAR
#undef PG8_SCHED
}
}
#define GAS __attribute__((address_space(1)))
#define LAS __attribute__((address_space(3)))
typedef unsigned short bf16;
typedef unsigned v4u __attribute__((ext_vector_type(4)));
typedef float f32x4 __attribute__((ext_vector_type(4)));
typedef short bf16x8 __attribute__((ext_vector_type(8)));
typedef GAS unsigned gu32;
typedef GAS unsigned long long gu64;
#define RLX_AGENT __ATOMIC_RELAXED, __HIP_MEMORY_SCOPE_AGENT
#define LDS_WAIT() asm volatile("s_waitcnt lgkmcnt(0)" ::: "memory")
#define VM_WAIT() asm volatile("s_waitcnt vmcnt(0)" ::: "memory")
__device__ __forceinline__ unsigned long long rt() { return __builtin_amdgcn_s_memrealtime(); }
__device__ __forceinline__ unsigned f2bf(float f) { unsigned u = __builtin_bit_cast(unsigned, f); return (u + 0x7fffu + ((u >> 16) & 1u)) >> 16; }
__device__ __forceinline__ unsigned pk2(float lo, float hi) { return f2bf(lo) | (f2bf(hi) << 16); }

#define XB_TMO      128
#define XB_XCNT(j)  (256  + 64 * (j))
#define XB_XSUB(j)  (1280 + 64 * (j))
#define XB_XGEN(j)  (2304 + 64 * (j))
#define XB_TOP      3328
#define XB_TOPGEN   3392
#define XCD_BAR_WORDS 3456
#define XB_SPIN_CAP (1u << 18)

__device__ __forceinline__ unsigned xb_ld(unsigned* p)              { return __hip_atomic_load(p, __ATOMIC_RELAXED, __HIP_MEMORY_SCOPE_AGENT); }
__device__ __forceinline__ unsigned xb_add(unsigned* p, unsigned v) { return __hip_atomic_fetch_add(p, v, __ATOMIC_RELAXED, __HIP_MEMORY_SCOPE_AGENT); }
__device__ __forceinline__ unsigned xb_xcc_id() { return (unsigned)__builtin_amdgcn_s_getreg((3 << 11) | 20) & 0xFu; }
#define XB_SPIN(cond, bar) do { unsigned _sp = 0; while (cond) { __builtin_amdgcn_s_sleep(1); \
    if ((++_sp & 255u) == 0u) { if (xb_ld(&(bar)[XB_TMO])) break; if (_sp > XB_SPIN_CAP) { atomicAdd(&(bar)[XB_TMO], 1u); break; } } } } while (0)

struct XcdBarrier {
    unsigned* bar; unsigned x;
    volatile LAS unsigned* st;
};

__device__ __forceinline__ XcdBarrier xcd_barrier_post(unsigned* bar, volatile LAS unsigned* st) {
    XcdBarrier b; b.bar = bar; b.x = xb_xcc_id(); b.st = st;
    if (threadIdx.x == 0) (void)xb_add(&bar[XB_XCNT(b.x)], 1u);
    return b;
}
__device__ __forceinline__ void xcd_barrier_complete(unsigned* bar, unsigned x, unsigned& nloc, unsigned& nx) {
    const unsigned G = gridDim.x * gridDim.y * gridDim.z;
    unsigned sum, cnt, mine, sp = 0u;
    for (;;) {
        sum = 0u; cnt = 0u; mine = 0u;
#pragma unroll
        for (unsigned j = 0; j < 16; ++j) { const unsigned c = xb_ld(&bar[XB_XCNT(j)]); sum += c; cnt += (c > 0u) ? 1u : 0u; mine = (j == x) ? c : mine; }
        if (sum == G) break;
        __builtin_amdgcn_s_sleep(1);
        if ((++sp & 255u) == 0u) { if (xb_ld(&bar[XB_TMO])) break; if (sp > XB_SPIN_CAP) { atomicAdd(&bar[XB_TMO], 1u); break; } }
    }
    nloc = mine > 0u ? mine : 1u; nx = cnt > 0u ? cnt : 1u;
}

__device__ __forceinline__ void xcd_barrier(const XcdBarrier& b) {
    asm volatile("s_waitcnt vmcnt(0)" ::: "memory");
    __syncthreads();
    if (threadIdx.x == 0) {
        unsigned* bar = b.bar;
        __builtin_amdgcn_s_waitcnt(0);
        unsigned nloc = b.st[0], nx = b.st[1];
        if (nloc == 0u) { xcd_barrier_complete(bar, b.x, nloc, nx); b.st[0] = nloc; b.st[1] = nx; }
        const unsigned old = xb_add(&bar[XB_XSUB(b.x)], 1u);
        const unsigned gen = old / nloc;
        if (old + 1u == (gen + 1u) * nloc) {
            __builtin_amdgcn_fence(__ATOMIC_RELEASE, "agent");
            asm volatile("s_waitcnt vmcnt(0)" ::: "memory");
            const unsigned og = xb_add(&bar[XB_TOP], 1u);
            const unsigned tg = og / nx;
            if (og + 1u == (tg + 1u) * nx) xb_add(&bar[XB_TOPGEN], 1u);
            else XB_SPIN(xb_ld(&bar[XB_TOPGEN]) == tg, bar);
            __builtin_amdgcn_fence(__ATOMIC_ACQUIRE, "agent");
            xb_add(&bar[XB_XGEN(b.x)], 1u);
            asm volatile("s_waitcnt vmcnt(0)" ::: "memory");
        } else {
            XB_SPIN(xb_ld(&bar[XB_XGEN(b.x)]) == gen, bar);
            __builtin_amdgcn_fence(__ATOMIC_ACQUIRE, "agent");
            asm volatile("s_waitcnt vmcnt(0)" ::: "memory");
        }
    }
    __syncthreads();
}
typedef float f32x4v __attribute__((ext_vector_type(4)));
struct Frame {
    LAS unsigned char* lds;
    volatile LAS unsigned* MISC;
    gu32* ctl;
    int tid, lane, wave, G, vcu;
    float* out; unsigned char* ws;
};
typedef const float* cfptr;
#define INP(i) (((const LAS cfptr*)(F.lds + LDSCTL_OFF + 256))[i])
#define IN_X 0
#define IN_C 1
#define IN_CTX 2
#define IN_CCTX 3
#define IN_WMOD 4
#define IN_BMOD 5
#define IN_NMIX 6
#define IN_NFFN 7
#define IN_WIN 8
#define IN_QNA 9
#define IN_KNA 10
#define IN_SINK 11
#define IN_WBRA 12
#define IN_WBRB 13
#define IN_WOUT 14
#define IN_WRG 15
#define IN_BRG 16
#define IN_WRE 17
#define IN_BRE 18
#define IN_W1 19
#define IN_W3 20
#define IN_W2 21
#define IN_NFIN 22

__device__ __forceinline__ float wave_sum(float v) {
#pragma unroll
    for (int o = 1; o < 64; o <<= 1) v += __shfl_xor(v, o);
    return v;
}
__device__ __forceinline__ float wave_max(float v) {
#pragma unroll
    for (int o = 1; o < 64; o <<= 1) v = fmaxf(v, __shfl_xor(v, o));
    return v;
}
__device__ __forceinline__ float bf2f(bf16 h) { return __builtin_bit_cast(float, (unsigned)h << 16); }
__device__ __forceinline__ int mod_row(int m) { return (m % TT) < CTX ? 4 : m / TT; }

__device__ __forceinline__ void compute_base(const unsigned* cnt, LAS unsigned* base, int tid) {
    if (tid < 64) {
        const unsigned c = __hip_atomic_load(cnt + tid, RLX_AGENT); unsigned v = c;
#pragma unroll
        for (int o = 1; o < 64; o <<= 1) { const unsigned t = __shfl_up(v, o); if (tid >= o) v += t; }
        base[tid] = v - c; if (tid == 63) base[64] = v;
    }
    __syncthreads();
}

template <int MODE>
__device__ __forceinline__ void tr_item(const float* W, int ldw, bf16* WT, int ldt, int koff, LAS float* scr, int kb, int nb, int lane) {
    const int k0 = 64 * kb, n0 = 32 * nb;
    const int lr = lane >> 3, lc = (lane & 7) * 4;
    f32x4v v[8];
#pragma unroll
    for (int i = 0; i < 8; ++i) v[i] = __builtin_nontemporal_load((const f32x4v*)(W + (size_t)(k0 + 8 * i + lr) * ldw + n0 + lc));
#pragma unroll
    for (int i = 0; i < 8; ++i) { LAS float* d = scr + (8 * i + lr) * 33 + lc; d[0] = v[i].x; d[1] = v[i].y; d[2] = v[i].z; d[3] = v[i].w; }
    LDS_WAIT(); asm volatile("" ::: "memory");
    const int c = lane & 7;
#pragma unroll
    for (int j = 0; j < 4; ++j) { const int n = (lane >> 3) + 8 * j; const LAS float* s = scr + (8 * c) * 33 + n;
        v4u o; o.x = pk2(s[0 * 33], s[1 * 33]); o.y = pk2(s[2 * 33], s[3 * 33]); o.z = pk2(s[4 * 33], s[5 * 33]); o.w = pk2(s[6 * 33], s[7 * 33]);
        const int drow = (MODE == 1) ? inproj_dst_col(n0 + n) : (n0 + n);
        *(GAS v4u*)(WT + (size_t)drow * ldt + koff + k0 + 8 * c) = o; }
    LDS_WAIT(); asm volatile("" ::: "memory");
}

__device__ __forceinline__ void p0_work(Frame& F, int l_lo, int l_hi, int wk, int nwk, int parts, bool rope) {
    const int nl = l_hi - l_lo;
    if (parts & 1) {
        LAS float* sl = (LAS float*)(F.lds);
        for (int i = F.tid; i < 5 * D; i += NWAVES * 64) { const int r = i / D, k = i % D; const float v = r < 4 ? INP(IN_C)[r * D + k] : INP(IN_CCTX)[k]; sl[i] = v / (1.f + __expf(-v)); }
        __syncthreads();
        float* MODP = (float*)(F.ws + WS_MODP);
        for (int u = wk; u < nl * 6 * 64; u += nwk) {
            const int l = l_lo + u / (6 * 64), cb = (u / 64) % 6, kslc = u % 64, col = cb * 2048 + 4 * F.tid;
            const float* W = INP(IN_WMOD) + (size_t)l * D * MODW + (size_t)(kslc * 32) * MODW + col;
            f32x4v acc[5];
#pragma unroll
            for (int r = 0; r < 5; ++r) acc[r] = (f32x4v){0.f, 0.f, 0.f, 0.f};
#pragma unroll 16
            for (int kk = 0; kk < 32; ++kk) { const int k = kslc * 32 + kk; const f32x4v w = __builtin_nontemporal_load((const f32x4v*)(W + (size_t)kk * MODW));
#pragma unroll
                for (int r = 0; r < 5; ++r) acc[r] += sl[r * D + k] * w; }
#pragma unroll
            for (int r = 0; r < 5; ++r) *(f32x4v*)(MODP + ((size_t)(l * 64 + kslc) * 5 + r) * MODW + col) = acc[r];
        }
        __syncthreads();
        if (rope && wk == 0) { float* RT = (float*)(F.ws + WS_ROPE);
            for (int i = F.tid; i < 64 * 32; i += NWAVES * 64) { const int pos = i >> 5, f = i & 31; const float freq = powf(10000.f, -(float)f / 32.f); const float ang = (float)pos * freq; RT[i] = cosf(ang); RT[2048 + i] = sinf(ang); } }
        { bf16* WRT = (bf16*)(F.ws + WS_WR);
          for (int it = wk * NWAVES * 64 + F.tid; it < nl * 80 * 256; it += nwk * NWAVES * 64) {
              const int l = l_lo + it / (80 * 256), c = (it / 256) % 80, k0 = (it % 256) * 8;
              float wv[8];
#pragma unroll
              for (int i = 0; i < 8; ++i) wv[i] = c < 64 ? INP(IN_WRE)[((size_t)l * D + k0 + i) * NE + c] : (c < 72 ? INP(IN_WRG)[((size_t)l * D + k0 + i) * NG + (c - 64)] : 0.f);
              unsigned hi[4], lo[4];
#pragma unroll
              for (int i = 0; i < 4; ++i) { const unsigned h0 = f2bf(wv[2 * i]), h1 = f2bf(wv[2 * i + 1]); hi[i] = h0 | (h1 << 16);
                  lo[i] = f2bf(wv[2 * i] - __builtin_bit_cast(float, h0 << 16)) | (f2bf(wv[2 * i + 1] - __builtin_bit_cast(float, h1 << 16)) << 16); }
              const int ko = k0 >> 3, sI = ko >> 2, fqI = ko & 3, cfI = c >> 4, frI = c & 15;
              *(v4u*)(WRT + ((((size_t)(l * 2 + 0) * 64 + sI) * 5 + cfI) * 64 + fqI * 16 + frI) * 8) = (v4u){hi[0], hi[1], hi[2], hi[3]};
              *(v4u*)(WRT + ((((size_t)(l * 2 + 1) * 64 + sI) * 5 + cfI) * 64 + fqI * 16 + frI) * 8) = (v4u){lo[0], lo[1], lo[2], lo[3]};
          } }
    }
    if (parts & 2) {
        __syncthreads();
        LAS float* scr = (LAS float*)(F.lds + F.wave * 16384);
        const int gw = wk * NWAVES + F.wave, NGW = nwk * NWAVES;
        constexpr int I_IN = 32 * 224, I_BR = 16 * 64, I_OUT = 32 * 64, I_L = I_IN + 2 * I_BR + I_OUT;
        for (int it = gw; it < nl * I_L; it += NGW) {
            const int l = l_lo + it / I_L; int r = it % I_L;
            if (r < I_IN) { tr_item<1>(INP(IN_WIN) + (size_t)l * D * INC, INC, (bf16*)(F.ws + WS_WIN) + (size_t)l * INC * D, D, 0, scr, r / 224, r % 224, F.lane); continue; } r -= I_IN;
            if (r < I_BR) { tr_item<0>(INP(IN_WBRA) + (size_t)l * QW * D, D, (bf16*)(F.ws + WS_WBR) + (size_t)l * D * D, D, 0, scr, r / 64, r % 64, F.lane); continue; } r -= I_BR;
            if (r < I_BR) { tr_item<0>(INP(IN_WBRB) + (size_t)l * QW * D, D, (bf16*)(F.ws + WS_WBR) + (size_t)l * D * D, D, QW, scr, r / 64, r % 64, F.lane); continue; } r -= I_BR;
            tr_item<0>(INP(IN_WOUT) + (size_t)l * D * D, D, (bf16*)(F.ws + WS_WOUT) + (size_t)l * D * D, D, 0, scr, r / 64, r % 64, F.lane);
        }
        __syncthreads();
    }
}
__device__ __forceinline__ void p0b_reduce(Frame& F, int l_lo, int l_hi, int wk, int nwk) {
    const float* MODP = (const float*)(F.ws + WS_MODP); float* MOD = (float*)(F.ws + WS_MOD);
    for (int o = wk * NWAVES * 64 + F.tid; o < (l_hi - l_lo) * 5 * (MODW / 4); o += nwk * NWAVES * 64) {
        const int l = l_lo + o / (5 * (MODW / 4)), r = (o / (MODW / 4)) % 5, n = (o % (MODW / 4)) * 4;
        f32x4v a = *(const f32x4v*)(INP(IN_BMOD) + l * MODW + n);
#pragma unroll 16
        for (int k2 = 0; k2 < 64; ++k2) a += *(const f32x4v*)(MODP + ((size_t)(l * 64 + k2) * 5 + r) * MODW + n);
        *(f32x4v*)(MOD + (size_t)(l * 5 + r) * MODW + n) = a;
    }
}

__device__ __forceinline__ void moe_combine_add(Frame& F, int lp, int m, const LAS unsigned* base, f32x4v (&v)[8]) {
    const unsigned* TE = (const unsigned*)(F.ws + WS_TOK) + (size_t)lp * M * 2;
    const unsigned* TP = (const unsigned*)(F.ws + WS_TOK) + (size_t)(2 + lp) * M * 2;
    const float* TW = (const float*)(F.ws + WS_TOK) + (size_t)(4 + lp) * M * 2;
    const unsigned e0 = TE[m * 2], e1 = TE[m * 2 + 1];
    const unsigned s0 = base[e0] + TP[m * 2], s1 = base[e1] + TP[m * 2 + 1];
    const float w0 = TW[m * 2], w1 = TW[m * 2 + 1];
    const bf16* Y0 = (const bf16*)(F.ws + WS_YM) + (size_t)s0 * D; const bf16* Y1 = (const bf16*)(F.ws + WS_YM) + (size_t)s1 * D;
    const float* g2 = (const float*)(F.ws + WS_MOD) + (size_t)(lp * 5 + mod_row(m)) * MODW + 5 * D;
#pragma unroll
    for (int j = 0; j < 8; ++j) { const int col = 4 * (F.lane + 64 * j);
        const uint2 a = *(const uint2*)(Y0 + col), b = *(const uint2*)(Y1 + col); const f32x4v g = *(const f32x4v*)(g2 + col);
        f32x4v ya = {__builtin_bit_cast(float, a.x << 16), __builtin_bit_cast(float, a.x & 0xffff0000u), __builtin_bit_cast(float, a.y << 16), __builtin_bit_cast(float, a.y & 0xffff0000u)};
        f32x4v yb = {__builtin_bit_cast(float, b.x << 16), __builtin_bit_cast(float, b.x & 0xffff0000u), __builtin_bit_cast(float, b.y << 16), __builtin_bit_cast(float, b.y & 0xffff0000u)};
        v[j] += g * (w0 * ya + w1 * yb); }
}
__device__ __forceinline__ void store_bf16_row(bf16* dst, int lane, const f32x4v (&h)[8]) {
#pragma unroll
    for (int j = 0; j < 8; ++j) { uint2 o; o.x = pk2(h[j].x, h[j].y); o.y = pk2(h[j].z, h[j].w); *(uint2*)(dst + 4 * (lane + 64 * j)) = o; }
}
__device__ __forceinline__ float row_sumsq(const f32x4v (&v)[8]) {
    float s = 0.f;
#pragma unroll
    for (int j = 0; j < 8; ++j) s += (v[j].x * v[j].x + v[j].y * v[j].y) + (v[j].z * v[j].z + v[j].w * v[j].w);
    return wave_sum(s);
}

template <bool DRY>
__device__ __forceinline__ void ph_norm1(Frame& F, int l) {
    LAS unsigned* base = (LAS unsigned*)(F.lds);
    if (l > 0) compute_base((const unsigned*)F.ctl + CW_CNT + (l - 1) * 64, base, F.tid);
    const int gw = F.vcu * NWAVES + F.wave, NGW = F.G * NWAVES;
    float* XW = (float*)(F.ws + WS_XW); bf16* HA = (bf16*)(F.ws + (DRY ? WS_T2 : WS_HA)); float* XWo = (float*)(F.ws + (DRY ? WS_T1 : WS_XW));
    const float* nw = INP(IN_NMIX) + l * D;
#define N1_LOAD(m_, v_) do { const int b_ = (m_) / TT, t_ = (m_) % TT; \
        const float* src_ = (l == 0) ? (t_ < CTX ? INP(IN_CTX) + ((size_t)b_ * CTX + t_) * D : INP(IN_X) + ((size_t)b_ * SEQ + (t_ - CTX)) * D) : XW + (size_t)(m_) * D; \
        _Pragma("unroll") for (int j = 0; j < 8; ++j) v_[j] = *(const f32x4v*)(src_ + 4 * (F.lane + 64 * j)); } while (0)
#define N1_FINISH(m_, v_) do { \
        if (l > 0) moe_combine_add(F, l - 1, (m_), base, v_); \
        _Pragma("unroll") for (int j = 0; j < 8; ++j) *(f32x4v*)(XWo + (size_t)(m_) * D + 4 * (F.lane + 64 * j)) = v_[j]; \
        const float rstd = 1.0f / sqrtf(row_sumsq(v_) * (1.0f / D) + EPS); \
        const float* mod = (const float*)(F.ws + WS_MOD) + (size_t)(l * 5 + mod_row(m_)) * MODW; \
        f32x4v h[8]; \
        _Pragma("unroll") for (int j = 0; j < 8; ++j) { const int col = 4 * (F.lane + 64 * j); const f32x4v w = *(const f32x4v*)(nw + col), sh = *(const f32x4v*)(mod + col), sc = *(const f32x4v*)(mod + D + col); \
            h[j] = (v_[j] * rstd * w) * (1.0f + sc) + sh; } \
        store_bf16_row(HA + (size_t)(m_) * D, F.lane, h); } while (0)
    f32x4v va[8], vb[8];
    int m = gw; if (m < M) N1_LOAD(m, va);
    while (m < M) {
        const int m1 = m + NGW; if (m1 < M) N1_LOAD(m1, vb);
        N1_FINISH(m, va);
        if (m1 >= M) break;
        const int m2 = m1 + NGW; if (m2 < M) N1_LOAD(m2, va);
        N1_FINISH(m1, vb);
        m = m2;
    }
#undef N1_LOAD
#undef N1_FINISH
}

__device__ __forceinline__ void post_head(const float* P, bf16* dst, const float* nw, bool rope, int rowpos, int colpos, const float* RT, int lane) {
    const int wc = lane >> 4, tt = lane & 15, j0 = 32 * wc + tt, j1 = j0 + 16, d1 = 64 * (wc >> 1) + 16 * (wc & 1) + tt, d2 = d1 + 32;
    float x1 = P[j0], x2 = P[j1];
    if (nw) { const float ss = wave_sum(x1 * x1 + x2 * x2); const float r = 1.0f / sqrtf(ss * (1.0f / HD) + EPS); x1 = x1 * r * nw[d1]; x2 = x2 * r * nw[d2]; }
    if (rope) { const int pos = (wc >> 1) ? colpos : rowpos, fi = 16 * (wc & 1) + tt; const float cs = RT[pos * 32 + fi], sn = RT[2048 + pos * 32 + fi];
        const float o1 = x1 * cs - x2 * sn, o2 = x1 * sn + x2 * cs; x1 = o1; x2 = o2; }
    dst[j0] = (bf16)f2bf(x1); dst[j1] = (bf16)f2bf(x2);
}
__device__ __forceinline__ void ph_post(Frame& F, int l) {
    const int gw = F.vcu * NWAVES + F.wave, NGW = F.G * NWAVES;
    const float* RT = (const float*)(F.ws + WS_ROPE);
    const float* qn = INP(IN_QNA) + l * HD; const float* kn = INP(IN_KNA) + l * HD;
    for (int m = gw; m < M; m += NGW) {
        const int t = m % TT; const bool rope = t >= CTX; const int s = t - CTX, rowpos = rope ? s / GRIDW : 0, colpos = rope ? s % GRIDW : 0;
        const float* P = (const float*)(F.ws + WS_P) + (size_t)m * INC;
        for (int h = 0; h < NH; ++h) post_head(P + OFF_QA + h * HD, (bf16*)(F.ws + WS_QA) + (size_t)m * QW + h * HD, qn, rope, rowpos, colpos, RT, F.lane);
        for (int h = 0; h < NKV; ++h) post_head(P + OFF_KA + h * HD, (bf16*)(F.ws + WS_KA) + (size_t)m * KW + h * HD, kn, rope, rowpos, colpos, RT, F.lane);
        for (int h = 0; h < NH; ++h) post_head(P + OFF_QB + h * HD, (bf16*)(F.ws + WS_QB) + (size_t)m * QW + h * HD, nullptr, rope, rowpos, colpos, RT, F.lane);
        for (int h = 0; h < NKV; ++h) post_head(P + OFF_KB + h * HD, (bf16*)(F.ws + WS_KB) + (size_t)m * KW + h * HD, nullptr, rope, rowpos, colpos, RT, F.lane);
        { const f32x4v a = *(const f32x4v*)(P + OFF_VA + 4 * F.lane), b = *(const f32x4v*)(P + OFF_VB + 4 * F.lane); uint2 o; o.x = pk2(a.x, a.y); o.y = pk2(a.z, a.w); *(uint2*)((bf16*)(F.ws + WS_VA) + (size_t)m * KW + 4 * F.lane) = o;
          o.x = pk2(b.x, b.y); o.y = pk2(b.z, b.w); *(uint2*)((bf16*)(F.ws + WS_VB) + (size_t)m * KW + 4 * F.lane) = o; }
#pragma unroll
        for (int j = 0; j < 8; ++j) { const int col = 4 * (F.lane + 64 * j);
            const f32x4v a = *(const f32x4v*)(P + OFF_GA + col), b = *(const f32x4v*)(P + OFF_GB + col);
            uint2 o; o.x = pk2(1.f / (1.f + __expf(-a.x)), 1.f / (1.f + __expf(-a.y))); o.y = pk2(1.f / (1.f + __expf(-a.z)), 1.f / (1.f + __expf(-a.w))); *(uint2*)((bf16*)(F.ws + WS_GA) + (size_t)m * D + col) = o;
            o.x = pk2(1.f / (1.f + __expf(-b.x)), 1.f / (1.f + __expf(-b.y))); o.y = pk2(1.f / (1.f + __expf(-b.z)), 1.f / (1.f + __expf(-b.w))); *(uint2*)((bf16*)(F.ws + WS_GB) + (size_t)m * D + col) = o; }
    }
}

__device__ __forceinline__ void ph_gate(Frame& F, int l) {
    const int gw = F.vcu * NWAVES + F.wave, NGW = F.G * NWAVES;
    for (int m = gw; m < M; m += NGW) {
        if (l == DEPTH - 1 && (m % TT) < CTX) continue;
        const bf16* GA = (const bf16*)(F.ws + WS_GA) + (size_t)m * D; const bf16* GB = (const bf16*)(F.ws + WS_GB) + (size_t)m * D;
        const float* T1 = (const float*)(F.ws + WS_T1) + (size_t)m * D; const float* T2 = (const float*)(F.ws + WS_T2) + (size_t)m * D;
        f32x4v h[8];
#pragma unroll
        for (int j = 0; j < 8; ++j) { const int col = 4 * (F.lane + 64 * j); const uint2 a = *(const uint2*)(GA + col), b = *(const uint2*)(GB + col);
            const f32x4v ga = {__builtin_bit_cast(float, a.x << 16), __builtin_bit_cast(float, a.x & 0xffff0000u), __builtin_bit_cast(float, a.y << 16), __builtin_bit_cast(float, a.y & 0xffff0000u)};
            const f32x4v gb = {__builtin_bit_cast(float, b.x << 16), __builtin_bit_cast(float, b.x & 0xffff0000u), __builtin_bit_cast(float, b.y << 16), __builtin_bit_cast(float, b.y & 0xffff0000u)};
            h[j] = ga * *(const f32x4v*)(T1 + col) + gb * *(const f32x4v*)(T2 + col); }
        store_bf16_row((bf16*)(F.ws + WS_MB) + (size_t)m * D, F.lane, h);
    }
}

template <bool ADD_T3, bool DRY>
__device__ __forceinline__ void ph_norm2_router(Frame& F, int l) {
    typedef short bf16x8r __attribute__((ext_vector_type(8)));
    constexpr int HP = 4112;
    LAS unsigned char* hhi = F.lds; LAS unsigned char* hlo = F.lds + 16 * HP;
    float* XW = (float*)(F.ws + WS_XW); bf16* H2 = (bf16*)(F.ws + (DRY ? WS_T2 : WS_HA));
    const float* nw = INP(IN_NFFN) + l * D;
    const bf16* WRH = (const bf16*)(F.ws + WS_WR) + (size_t)(l * 2) * 80 * D; const bf16* WRL = WRH + (size_t)80 * D;
    const int nrows = (l == DEPTH - 1) ? NB * SEQ : M, niter = nrows / 16;
    unsigned* TE = (unsigned*)(F.ws + WS_TOK) + (size_t)l * M * 2; float* TW = (float*)(F.ws + WS_TOK) + (size_t)(4 + l) * M * 2;
    const int w = F.wave, lane = F.lane, fr = lane & 15, fq = lane >> 4;
#if TPROBE >= 100
    unsigned long long tacc1 = 0, tacc3 = 0, tacc5 = 0, tprev = __builtin_amdgcn_s_memrealtime();
#define SUBT(acc_) do { if (blockIdx.x == 0 && F.tid == 0 && l == 0) { const unsigned long long tn_ = __builtin_amdgcn_s_memrealtime(); acc_ += tn_ - tprev; tprev = tn_; } } while (0)
#else
#define SUBT(acc_) do { } while (0)
#endif
    f32x4v vrow[2][8];
#define N2_LOADROWS(it_) do { _Pragma("unroll") for (int rr_ = 0; rr_ < 2; ++rr_) { const int q_ = (it_) * 16 + 2 * w + rr_; const int m_ = (l == DEPTH - 1) ? (q_ / SEQ) * TT + CTX + (q_ % SEQ) : q_; \
        _Pragma("unroll") for (int j = 0; j < 8; ++j) vrow[rr_][j] = *(const f32x4v*)(XW + (size_t)m_ * D + 4 * (lane + 64 * j)); } } while (0)
    if (F.vcu < niter) N2_LOADROWS(F.vcu);
    for (int it = F.vcu; it < niter; it += F.G) {
        __syncthreads();
        if (it != F.vcu) N2_LOADROWS(it);
#pragma unroll
        for (int rr = 0; rr < 2; ++rr) {
            const int lr = 2 * w + rr, q = it * 16 + lr; const int m = (l == DEPTH - 1) ? (q / SEQ) * TT + CTX + (q % SEQ) : q;
            f32x4v v[8];
#pragma unroll
            for (int j = 0; j < 8; ++j) v[j] = vrow[rr][j];
            const float* mod = (const float*)(F.ws + WS_MOD) + (size_t)(l * 5 + mod_row(m)) * MODW;
            if (ADD_T3) { const float* T3 = (const float*)(F.ws + WS_T3) + (size_t)m * D;
#pragma unroll
                for (int j = 0; j < 8; ++j) { const int col = 4 * (lane + 64 * j); v[j] += *(const f32x4v*)(mod + 2 * D + col) * *(const f32x4v*)(T3 + col); *(f32x4v*)(XW + (size_t)m * D + col) = v[j]; } }
            const float rstd = 1.0f / sqrtf(row_sumsq(v) * (1.0f / D) + EPS);
            f32x4v h[8];
#pragma unroll
            for (int j = 0; j < 8; ++j) { const int col = 4 * (lane + 64 * j); const f32x4v ww = *(const f32x4v*)(nw + col), sh = *(const f32x4v*)(mod + 3 * D + col), sc = *(const f32x4v*)(mod + 4 * D + col);
                h[j] = (v[j] * rstd * ww) * (1.0f + sc) + sh;
                const unsigned a0 = f2bf(h[j].x), a1 = f2bf(h[j].y), a2 = f2bf(h[j].z), a3 = f2bf(h[j].w);
                typedef unsigned u32x2r __attribute__((ext_vector_type(2))); u32x2r hi2, lo2; hi2.x = a0 | (a1 << 16); hi2.y = a2 | (a3 << 16);
                lo2.x = f2bf(h[j].x - __builtin_bit_cast(float, a0 << 16)) | (f2bf(h[j].y - __builtin_bit_cast(float, a1 << 16)) << 16);
                lo2.y = f2bf(h[j].z - __builtin_bit_cast(float, a2 << 16)) | (f2bf(h[j].w - __builtin_bit_cast(float, a3 << 16)) << 16);
                *(LAS u32x2r*)(hhi + lr * HP + col * 2) = hi2; *(LAS u32x2r*)(hlo + lr * HP + col * 2) = lo2; }
            store_bf16_row(H2 + (size_t)m * D, lane, h);
        }
        __syncthreads(); SUBT(tacc1);
        {
            pg8::f32x4 acc[5];
#pragma unroll
            for (int cf = 0; cf < 5; ++cf) acc[cf] = (pg8::f32x4){0.f, 0.f, 0.f, 0.f};
            const __amdgpu_buffer_rsrc_t wrs = __builtin_amdgcn_make_buffer_rsrc((void*)WRH, 0, 2 * 80 * D * 2, 0x00020000);
            const unsigned wvo = (unsigned)lane * 16u;
            const LAS unsigned char* ah = hhi + fr * HP + (256 * w + 8 * fq) * 2; const LAS unsigned char* al = hlo + fr * HP + (256 * w + 8 * fq) * 2;
            bf16x8r Wh0[5], Wl0[5], Wh1[5], Wl1[5];
#define RT_LOADW(Wh, Wl, s_) do { _Pragma("unroll") for (int cf = 0; cf < 5; ++cf) { Wh[cf] = __builtin_bit_cast(bf16x8r, __builtin_amdgcn_raw_buffer_load_b128(wrs, wvo, ((8 * w + (s_)) * 5 + cf) * 1024, 0)); Wl[cf] = __builtin_bit_cast(bf16x8r, __builtin_amdgcn_raw_buffer_load_b128(wrs, wvo, ((64 + 8 * w + (s_)) * 5 + cf) * 1024, 0)); } } while (0)
#define RT_MMA(Wh, Wl, s_) do { const bf16x8r Hh = *(const LAS bf16x8r*)(ah + 64 * (s_)), Hl = *(const LAS bf16x8r*)(al + 64 * (s_)); \
            _Pragma("unroll") for (int cf = 0; cf < 5; ++cf) { acc[cf] = __builtin_amdgcn_mfma_f32_16x16x32_bf16(Wh[cf], Hh, acc[cf], 0, 0, 0); \
                acc[cf] = __builtin_amdgcn_mfma_f32_16x16x32_bf16(Wh[cf], Hl, acc[cf], 0, 0, 0); acc[cf] = __builtin_amdgcn_mfma_f32_16x16x32_bf16(Wl[cf], Hh, acc[cf], 0, 0, 0); } } while (0)
            RT_LOADW(Wh0, Wl0, 0);
#pragma unroll
            for (int s2 = 0; s2 < 8; s2 += 2) {
                RT_LOADW(Wh1, Wl1, s2 + 1); RT_MMA(Wh0, Wl0, s2);
                if (s2 + 2 < 8) RT_LOADW(Wh0, Wl0, s2 + 2);
                RT_MMA(Wh1, Wl1, s2 + 1);
            }
#undef RT_LOADW
#undef RT_MMA
            asm volatile("s_waitcnt lgkmcnt(0)" ::: "memory");
#pragma unroll
            for (int cf = 0; cf < 5; ++cf) *(LAS pg8::f32x4*)(hhi + fr * HP + 512 * w + (16 * cf + 4 * fq) * 4) = acc[cf];
        }
        __syncthreads(); SUBT(tacc3);
#pragma unroll 1
        for (int rr = 0; rr < 2; ++rr) {
            const int lr = 2 * w + rr, q = it * 16 + lr; const int m = (l == DEPTH - 1) ? (q / SEQ) * TT + CTX + (q % SEQ) : q;
            LAS float* elb = (LAS float*)(hlo + (2 * w + rr) * HP + 512 * w);
            float el = lane < 64 ? INP(IN_BRE)[l * NE + lane] : 0.f;
#pragma unroll
            for (int k2 = 0; k2 < 8; ++k2) el += *(const LAS float*)(hhi + lr * HP + 512 * k2 + lane * 4);
            elb[lane] = el;
            if (lane < 8) { float gl = INP(IN_BRG)[l * NG + lane];
#pragma unroll
                for (int k2 = 0; k2 < 8; ++k2) gl += *(const LAS float*)(hhi + lr * HP + 512 * k2 + (64 + lane) * 4);
                elb[64 + lane] = gl; }
            LDS_WAIT(); asm volatile("" ::: "memory");
            float gmax = elb[64]; int gi = 0;
#pragma unroll
            for (int i = 1; i < 8; ++i) { const float x = elb[64 + i]; if (x > gmax) { gmax = x; gi = i; } }
            float gs = 0.f;
#pragma unroll
            for (int i = 0; i < 8; ++i) gs += __expf(elb[64 + i] - gmax);
            const float pgv = 1.0f / gs;
            float v1 = elb[gi * 8]; int i1 = 0;
#pragma unroll
            for (int i = 1; i < 8; ++i) { const float x = elb[gi * 8 + i]; if (x > v1) { v1 = x; i1 = i; } }
            float v2 = -3.0e38f; int i2 = 0;
#pragma unroll
            for (int i = 0; i < 8; ++i) { const float x = elb[gi * 8 + i]; if (i != i1 && x > v2) { v2 = x; i2 = i; } }
            const float e2 = __expf(v2 - v1), s1 = 1.0f / (1.0f + e2), s2 = e2 * s1;
            if (lane == 0 && !DRY) {
                const unsigned ea = gi * 8 + i1, eb = gi * 8 + i2;
                TE[m * 2] = ea; TE[m * 2 + 1] = eb; TW[m * 2] = s1 * pgv; TW[m * 2 + 1] = s2 * pgv;
            }
        }
        SUBT(tacc5);
    }
#if TPROBE >= 100
    if (blockIdx.x == 0 && F.tid == 0 && l == 0) { volatile LAS unsigned long long* ts = (volatile LAS unsigned long long*)(F.lds + LDSCTL_OFF + 800); ts[26] = TPROBE == 100 ? tacc1 : TPROBE == 101 ? tacc3 : tacc5; }
#endif
#undef SUBT
}

__device__ __forceinline__ void ph_compact(Frame& F, int l) {
    LAS unsigned* wtot = (LAS unsigned*)(F.lds);
    const unsigned* TE = (const unsigned*)(F.ws + WS_TOK) + (size_t)l * M * 2; unsigned* TP = (unsigned*)(F.ws + WS_TOK) + (size_t)(2 + l) * M * 2;
    unsigned* LIST = (unsigned*)(F.ws + WS_LIST) + (size_t)l * NE * M; unsigned* cnt = (unsigned*)F.ctl + CW_CNT + l * 64;
    constexpr int TPT = M / (NWAVES * 64);
    for (int e = F.vcu; e < NE; e += F.G) {
        const int m0 = F.tid * TPT; unsigned c = 0;
        for (int i = 0; i < TPT; ++i) { const int m = m0 + i; const bool valid = (l < DEPTH - 1) || ((m % TT) >= CTX);
            const uint2 te = *(const uint2*)(TE + 2 * m); c += (valid && te.x == (unsigned)e) ? 1u : 0u; c += (valid && te.y == (unsigned)e) ? 1u : 0u; }
        unsigned v = c;
#pragma unroll
        for (int o = 1; o < 64; o <<= 1) { const unsigned t = __shfl_up(v, o); if (F.lane >= o) v += t; }
        if (F.lane == 63) wtot[F.wave] = v;
        __syncthreads();
        unsigned off = 0, tot = 0;
#pragma unroll
        for (int k2 = 0; k2 < NWAVES; ++k2) { const unsigned x = wtot[k2]; off += (k2 < F.wave) ? x : 0u; tot += x; }
        unsigned pos = off + v - c;
        for (int i = 0; i < TPT; ++i) { const int m = m0 + i; const bool valid = (l < DEPTH - 1) || ((m % TT) >= CTX);
            const uint2 te = *(const uint2*)(TE + 2 * m);
            if (valid && te.x == (unsigned)e) { LIST[(size_t)e * M + pos] = (unsigned)m; TP[2 * m] = pos; ++pos; }
            if (valid && te.y == (unsigned)e) { LIST[(size_t)e * M + pos] = (unsigned)m; TP[2 * m + 1] = pos; ++pos; } }
        if (F.tid == 0) cnt[e] = tot;
        __syncthreads();
    }
}

__device__ __forceinline__ void ph_final(Frame& F) {
    LAS unsigned* base = (LAS unsigned*)(F.lds);
    compute_base((const unsigned*)F.ctl + CW_CNT + (DEPTH - 1) * 64, base, F.tid);
    const int gw = F.vcu * NWAVES + F.wave, NGW = F.G * NWAVES;
    const float* XW = (const float*)(F.ws + WS_XW); const float* nw = INP(IN_NFIN);
    for (int q = gw; q < NB * SEQ; q += NGW) {
        const int m = (q / SEQ) * TT + CTX + (q % SEQ);
        f32x4v v[8];
#pragma unroll
        for (int j = 0; j < 8; ++j) v[j] = *(const f32x4v*)(XW + (size_t)m * D + 4 * (F.lane + 64 * j));
        moe_combine_add(F, DEPTH - 1, m, base, v);
        const float rstd = 1.0f / sqrtf(row_sumsq(v) * (1.0f / D) + EPS);
#pragma unroll
        for (int j = 0; j < 8; ++j) { const int col = 4 * (F.lane + 64 * j); *(f32x4v*)(F.out + (size_t)q * D + col) = v[j] * rstd * *(const f32x4v*)(nw + col); }
    }
}
template <int COLMAP>
__global__ void __launch_bounds__(256) naive_gemm(const bf16* A, int lda, const float* W, int ldw, float* Cc, int ldc, int K) {
    const int n = blockIdx.x * 64 + threadIdx.x, m0 = blockIdx.y * 32 + threadIdx.y * 8;
    const int sc = COLMAP ? inproj_src_col(n) : n;
    float acc[8];
#pragma unroll
    for (int i = 0; i < 8; ++i) acc[i] = 0.f;
    for (int k = 0; k < K; ++k) { const float w = W[(size_t)k * ldw + sc];
#pragma unroll
        for (int i = 0; i < 8; ++i) acc[i] += bf2f(A[(size_t)(m0 + i) * lda + k]) * w; }
#pragma unroll
    for (int i = 0; i < 8; ++i) Cc[(size_t)(m0 + i) * ldc + n] = acc[i];
}

__global__ void __launch_bounds__(256) naive_attn(const bf16* Q, const bf16* K, const bf16* V, bf16* Y, const float* sink, int mode, int with_ctx_q) {
    __shared__ float sc[4][TT]; __shared__ float qs[4][HD];
    const int wave = threadIdx.x >> 6, lane = threadIdx.x & 63;
    const int nq = with_ctx_q ? TT : SEQ; const long item = (long)blockIdx.x * 4 + wave; if (item >= (long)NB * NH * nq) return;
    const int tq = (int)(item % nq) + (with_ctx_q ? 0 : CTX), h = (int)((item / nq) % NH), b = (int)(item / ((long)nq * NH)), kvh = h / (NH / NKV);
    const size_t m = (size_t)b * TT + tq;
    qs[wave][lane] = bf2f(Q[m * QW + h * HD + lane]); qs[wave][lane + 64] = bf2f(Q[m * QW + h * HD + lane + 64]);
    __builtin_amdgcn_wave_barrier(); asm volatile("s_waitcnt lgkmcnt(0)" ::: "memory");
    const bool isctx = tq < CTX; const int nk = isctx ? CTX : TT;
    float mx = -3.0e38f;
    for (int kk = lane; kk < nk; kk += 64) {
        bool valid = true;
        if (mode == 1 && !isctx && kk >= CTX) { const int dq = (tq - CTX) - (kk - CTX); valid = dq <= 128 && dq >= -128; }
        float s = -3.0e38f;
        if (valid) { const bf16* kr = K + ((size_t)b * TT + kk) * KW + kvh * HD; float dsum = 0.f;
            for (int d = 0; d < HD; ++d) dsum += bf2f(kr[d]) * qs[wave][d];
            s = dsum * ATTN_SCALE; }
        sc[wave][kk] = s; mx = fmaxf(mx, s);
    }
    mx = wave_max(mx);
    float sk = 0.f; if (mode == 1) { sk = sink[h]; mx = fmaxf(mx, sk); }
    float sum = 0.f;
    for (int kk = lane; kk < nk; kk += 64) { const float s = sc[wave][kk]; const float p = s > -1.0e38f ? __expf(s - mx) : 0.f; sc[wave][kk] = p; sum += p; }
    sum = wave_sum(sum); if (mode == 1) sum += __expf(sk - mx);
    asm volatile("s_waitcnt lgkmcnt(0)" ::: "memory"); __builtin_amdgcn_wave_barrier();
    float o0 = 0.f, o1 = 0.f;
    for (int kk = 0; kk < nk; ++kk) { const float p = sc[wave][kk]; const bf16* vr = V + ((size_t)b * TT + kk) * KW + kvh * HD; o0 += p * bf2f(vr[lane]); o1 += p * bf2f(vr[lane + 64]); }
    const float inv = 1.0f / sum;
    Y[m * D + h * HD + lane] = (bf16)f2bf(o0 * inv); Y[m * D + h * HD + lane + 64] = (bf16)f2bf(o1 * inv);
}

__global__ void __launch_bounds__(256) naive_moe_up(const bf16* H2, const float* w1, const float* w3, const unsigned* cnt, const unsigned* LIST, bf16* HB) {
    __shared__ unsigned base[65];
    const int tid = threadIdx.y * 64 + threadIdx.x;
    if (tid == 0) { unsigned a = 0; for (int e = 0; e < NE; ++e) { base[e] = a; a += cnt[e]; } base[64] = a; }
    __syncthreads();
    const unsigned slot = blockIdx.y * 4 + threadIdx.y; if (slot >= base[64]) return;
    int e = 0; while (base[e + 1] <= slot) ++e;
    const unsigned tok = LIST[(size_t)e * M + (slot - base[e])];
    const int j = blockIdx.x * 64 + threadIdx.x;
    const float* W1 = w1 + (size_t)e * D * DE + j; const float* W3 = w3 + (size_t)e * D * DE + j; const bf16* x = H2 + (size_t)tok * D;
    float a = 0.f, b = 0.f;
    for (int k = 0; k < D; ++k) { const float xv = bf2f(x[k]); a += xv * W1[(size_t)k * DE]; b += xv * W3[(size_t)k * DE]; }
    HB[(size_t)slot * DE + j] = (bf16)f2bf(a / (1.f + __expf(-a)) * b);
}
__global__ void __launch_bounds__(256) naive_moe_down(const bf16* HB, const float* w2, const unsigned* cnt, bf16* YM) {
    __shared__ unsigned base[65];
    const int tid = threadIdx.y * 64 + threadIdx.x;
    if (tid == 0) { unsigned a = 0; for (int e = 0; e < NE; ++e) { base[e] = a; a += cnt[e]; } base[64] = a; }
    __syncthreads();
    const unsigned slot = blockIdx.y * 4 + threadIdx.y; if (slot >= base[64]) return;
    int e = 0; while (base[e + 1] <= slot) ++e;
    const int col = blockIdx.x * 64 + threadIdx.x;
    const float* W2 = w2 + (size_t)e * DE * D + col; const bf16* hrow = HB + (size_t)slot * DE;
    float a = 0.f;
    for (int k = 0; k < DE; ++k) a += bf2f(hrow[k]) * W2[(size_t)k * D];
    YM[(size_t)slot * D + col] = (bf16)f2bf(a);
}
namespace att {
constexpr int NW = 8, QBLK = 32, KVBLK = 64;
constexpr float THR = 8.f;
constexpr int LDQ = QW, LDK = KW, LDO = D;
constexpr size_t SHM_V = KVBLK * HD * 2, SHM_K = KVBLK * HD * 2, SHM_ATTN = 2 * SHM_V + 2 * SHM_K + NW * 64 * 4;
using bf16x8 = __attribute__((ext_vector_type(8))) short;
using s16x4  = __attribute__((ext_vector_type(4))) short;
using f32x16 = __attribute__((ext_vector_type(16))) float;
using u32x4  = __attribute__((ext_vector_type(4))) unsigned;
#define KSWZ(row, colB) ((row) * 256 + ((colB) ^ (((row) & 7) << 4)))
#define SBAR() __builtin_amdgcn_sched_barrier(0)
__device__ __forceinline__ int crow(int r, int hi) { return (r & 3) + 8 * (r >> 2) + 4 * hi; }
__device__ __forceinline__ unsigned cvtpk(float lo, float hi) { unsigned r; asm volatile("v_cvt_pk_bf16_f32 %0, %1, %2" : "=v"(r) : "v"(lo), "v"(hi)); return r; }
__device__ __forceinline__ void partialSM(f32x16& p0, f32x16& p1, float& m_reg, float& mn, float& alpha) {
  constexpr float C = ATTN_SCALE * 1.4426950408889634f;
  float pmax = p0[0]; for (int r = 1; r < 16; ++r) pmax = fmaxf(pmax, p0[r]); for (int r = 0; r < 16; ++r) pmax = fmaxf(pmax, p1[r]);
  { auto rr = __builtin_amdgcn_permlane32_swap(__float_as_uint(pmax), __float_as_uint(pmax), false, false);
    pmax = fmaxf(__uint_as_float(rr[0]), __uint_as_float(rr[1])); }
  if (__builtin_expect(__all(pmax - m_reg <= THR / ATTN_SCALE), 1)) { mn = m_reg; alpha = 1.f; }
  else { mn = fmaxf(m_reg, pmax); alpha = __builtin_amdgcn_exp2f((m_reg - mn) * C); m_reg = mn; }
  float mnC = -mn * C;
  for (int r = 0; r < 16; ++r) p0[r] = fmaf(p0[r], C, mnC); for (int r = 0; r < 16; ++r) p1[r] = fmaf(p1[r], C, mnC);
  for (int r = 0; r < 16; ++r) p0[r] = __builtin_amdgcn_exp2f(p0[r]);
}
__device__ __forceinline__ void finishSM(f32x16& p0, f32x16& p1, float alpha, float& l_reg, bf16x8& pa0, bf16x8& pa1, bf16x8& pa2, bf16x8& pa3) {
  for (int r = 0; r < 16; ++r) p1[r] = __builtin_amdgcn_exp2f(p1[r]);
  float ps = 0; for (int r = 0; r < 16; ++r) ps += p0[r]; for (int r = 0; r < 16; ++r) ps += p1[r];
  { auto rr = __builtin_amdgcn_permlane32_swap(__float_as_uint(ps), __float_as_uint(ps), false, false);
    ps = __uint_as_float(rr[0]) + __uint_as_float(rr[1]); }
  l_reg = l_reg * alpha + ps;
#define PK4(P, BASE, OUT) do { unsigned a0 = cvtpk(P[BASE + 0], P[BASE + 1]), a1 = cvtpk(P[BASE + 2], P[BASE + 3]);   \
    unsigned b0 = cvtpk(P[BASE + 4], P[BASE + 5]), b1 = cvtpk(P[BASE + 6], P[BASE + 7]);                              \
    auto r0 = __builtin_amdgcn_permlane32_swap(a0, b0, false, false); auto r1 = __builtin_amdgcn_permlane32_swap(a1, b1, false, false); \
    u32x4 w = {r0[0], r1[0], r0[1], r1[1]}; OUT = *reinterpret_cast<bf16x8*>(&w); } while (0)
  PK4(p0, 0, pa0); PK4(p0, 8, pa1); PK4(p1, 0, pa2); PK4(p1, 8, pa3);
#undef PK4
}
__device__ __forceinline__ void qkt(f32x16& p0, f32x16& p1, const bf16* Ks, const bf16x8* qr, int r32, int hi) {
  p0 = f32x16{}; p1 = f32x16{};
  for (int d0 = 0; d0 < 8; ++d0) { int cb = (d0 * 16 + hi * 8) * 2;
    bf16x8 b0 = *reinterpret_cast<const bf16x8*>((const char*)Ks + KSWZ(r32, cb));
    bf16x8 b1 = *reinterpret_cast<const bf16x8*>((const char*)Ks + KSWZ(32 + r32, cb));
    p0 = __builtin_amdgcn_mfma_f32_32x32x16_bf16(b0, qr[d0], p0, 0, 0, 0);
    p1 = __builtin_amdgcn_mfma_f32_32x32x16_bf16(b1, qr[d0], p1, 0, 0, 0); }
}
__device__ __forceinline__ void wmask(f32x16& p0, f32x16& p1, int kb, int qpos, int hi) {
  const float NEG = -1.0e30f; const int d0 = kb + 4 * hi - qpos;
#pragma unroll
  for (int r = 0; r < 16; ++r) { const int dd = d0 + (r & 3) + 8 * (r >> 2); if (dd > 128 || dd < -128) p0[r] = NEG; if (dd + 32 > 128 || dd + 32 < -128) p1[r] = NEG; }
}
__device__ __forceinline__ int v_st(int k, int c) { const int kk = (k & ~0xC) | ((k & 4) << 1) | ((k & 8) >> 1); return ((kk >> 3) * 4 + (c >> 5)) * 512 + ((kk & 7) * 32 + (c & 31)) * 2; }
__device__ __forceinline__ int v_rd_base(int lane) { return ((lane & 3) << 3) | (((lane >> 2) & 3) << 6) | (((lane >> 4) & 1) << 5) | (((lane >> 5) & 1) << 8); }
constexpr int v_rd_off(int d0, int ks, int half) { return d0 * 512 + ks * 4096 + half * 2048; }
template <int OFF> __device__ __forceinline__ s16x4 tr_read(int vb) {
  s16x4 r; asm volatile("ds_read_b64_tr_b16 %0, %1 offset:%2" : "=&v"(r) : "v"(vb), "i"(OFF) : "memory"); return r;
}
template <int D0> __device__ __forceinline__ void pv_one(f32x16& od, int vb, bf16x8 pa0, bf16x8 pa1, bf16x8 pa2, bf16x8 pa3) {
  const s16x4 l0 = tr_read<v_rd_off(D0, 0, 0)>(vb), h0 = tr_read<v_rd_off(D0, 0, 1)>(vb), l1 = tr_read<v_rd_off(D0, 1, 0)>(vb), h1 = tr_read<v_rd_off(D0, 1, 1)>(vb);
  const s16x4 l2 = tr_read<v_rd_off(D0, 2, 0)>(vb), h2 = tr_read<v_rd_off(D0, 2, 1)>(vb), l3 = tr_read<v_rd_off(D0, 3, 0)>(vb), h3 = tr_read<v_rd_off(D0, 3, 1)>(vb);
  asm volatile("s_waitcnt lgkmcnt(0)" ::: "memory"); SBAR();
#define PK(L, H) (bf16x8){L[0], L[1], L[2], L[3], H[0], H[1], H[2], H[3]}
  od = __builtin_amdgcn_mfma_f32_32x32x16_bf16(pa0, PK(l0, h0), od, 0, 0, 0);
  od = __builtin_amdgcn_mfma_f32_32x32x16_bf16(pa1, PK(l1, h1), od, 0, 0, 0);
  od = __builtin_amdgcn_mfma_f32_32x32x16_bf16(pa2, PK(l2, h2), od, 0, 0, 0);
  od = __builtin_amdgcn_mfma_f32_32x32x16_bf16(pa3, PK(l3, h3), od, 0, 0, 0);
#undef PK
}
__device__ __forceinline__ void pv_d0(f32x16* o, int vb, bf16x8 pa0, bf16x8 pa1, bf16x8 pa2, bf16x8 pa3) {
  pv_one<0>(o[0], vb, pa0, pa1, pa2, pa3); pv_one<1>(o[1], vb, pa0, pa1, pa2, pa3); pv_one<2>(o[2], vb, pa0, pa1, pa2, pa3); pv_one<3>(o[3], vb, pa0, pa1, pa2, pa3);
}
__device__ __forceinline__ void attn_unit(const bool MASKED, const bf16* __restrict__ Qb, const bf16* __restrict__ Kh, const bf16* __restrict__ Vh, bf16* __restrict__ Ob,
                                          int NT, int klo, int q0, float m0, float l0, char* lds) {
  const int tid = threadIdx.x, wid = tid >> 6, lane = tid & 63, r32 = lane & 31, hi = lane >> 5;
  bf16* V_lds = (bf16*)lds; bf16* K_lds = (bf16*)(lds + 2 * SHM_V);
  float* ws = (float*)(lds + 2 * SHM_V + 2 * SHM_K) + wid * 64; float* li_l = ws; float* al_l = ws + 32;
  float m_reg = m0, l_reg = l0; f32x16 o[4] = {}; bf16x8 qr[8];
  const bf16* Qw = Qb + (long)(wid * QBLK + r32) * LDQ + hi * 8;
#pragma unroll
  for (int d0 = 0; d0 < 8; ++d0) qr[d0] = *reinterpret_cast<const bf16x8*>(Qw + d0 * 16);
  const int sr = tid >> 4, sc = (tid & 15) * 8, vst0 = v_st(sr, sc), vst1 = v_st(32 + sr, sc);
  const int vb0 = (int)(uintptr_t)V_lds + v_rd_base(lane);
  const int qpos = q0 + wid * QBLK + r32;
  struct { bf16x8 vs0, vs1, ks0, ks1; } sr_[2];
#define KROW(j) ((!MASKED || (j) < 4) ? 64 * (j) : CTX + klo + 64 * ((j) - 4))
#define SLOAD(i, j) do { const int k0_ = KROW(j); sr_[i].vs0 = *reinterpret_cast<const bf16x8*>(&Vh[(long)(k0_ + sr) * LDK + sc]); sr_[i].vs1 = *reinterpret_cast<const bf16x8*>(&Vh[(long)(k0_ + 32 + sr) * LDK + sc]); \
    sr_[i].ks0 = *reinterpret_cast<const bf16x8*>(&Kh[(long)(k0_ + sr) * LDK + sc]); sr_[i].ks1 = *reinterpret_cast<const bf16x8*>(&Kh[(long)(k0_ + 32 + sr) * LDK + sc]); } while (0)
#define SWRITE(b, i) do { *(bf16x8*)((char*)V_lds + (b) * SHM_V + vst0) = sr_[i].vs0;          \
    *(bf16x8*)((char*)V_lds + (b) * SHM_V + vst1) = sr_[i].vs1; int kc = sc * 2;               \
    *(bf16x8*)((char*)K_lds + (b) * SHM_K + KSWZ(sr, kc)) = sr_[i].ks0;                       \
    *(bf16x8*)((char*)K_lds + (b) * SHM_K + KSWZ(32 + sr, kc)) = sr_[i].ks1; } while (0)
#define SWAIT() asm volatile("s_waitcnt vmcnt(4)" ::: "memory")
#define RESC(a) do { if (__any((a) < 1.f)) { if (hi == 0) al_l[r32] = (a); asm volatile("s_waitcnt lgkmcnt(0)" ::: "memory"); \
    for (int d = 0; d < 4; ++d) for (int r = 0; r < 16; ++r) o[d][r] *= al_l[crow(r, hi)]; } } while (0)
#define WMASK(P0, P1, j) do { if (MASKED && (j) >= 4) wmask(P0, P1, klo + 64 * ((j) - 4), qpos, hi); } while (0)
  f32x16 pA0, pA1, pB0, pB1; float mnA, mnB, alA, alB; bf16x8 pa0, pa1, pa2, pa3;
  constexpr int SE = 0, SO = 1;
  __syncthreads();
  SLOAD(SE, 0); asm volatile("s_waitcnt vmcnt(0)" ::: "memory"); SWRITE(0, SE); __syncthreads();
  qkt(pA0, pA1, K_lds, qr, r32, hi); WMASK(pA0, pA1, 0); partialSM(pA0, pA1, m_reg, mnA, alA);
  SLOAD(SO, 1); if (2 < NT) SLOAD(SE, 2);
  SWAIT(); SWRITE(1, SO); __syncthreads();
  for (int j = 1; j + 1 < NT; j += 2) {
    SBAR(); qkt(pB0, pB1, (bf16*)((char*)K_lds + SHM_K), qr, r32, hi); WMASK(pB0, pB1, j);
    finishSM(pA0, pA1, alA, l_reg, pa0, pa1, pa2, pa3); SBAR();
    SLOAD(SO, j + 2); SBAR();
    pv_d0(o, vb0, pa0, pa1, pa2, pa3); partialSM(pB0, pB1, m_reg, mnB, alB);
    __syncthreads(); SWAIT(); SWRITE(0, SE);
    RESC(alB); __syncthreads();
    SBAR(); qkt(pA0, pA1, K_lds, qr, r32, hi); WMASK(pA0, pA1, j + 1);
    finishSM(pB0, pB1, alB, l_reg, pa0, pa1, pa2, pa3); SBAR();
    if (j + 3 < NT) SLOAD(SE, j + 3); SBAR();
    pv_d0(o, vb0 + (int)SHM_V, pa0, pa1, pa2, pa3); partialSM(pA0, pA1, m_reg, mnA, alA);
    __syncthreads(); SWAIT(); SWRITE(1, SO);
    RESC(alA); __syncthreads();
  }
  SBAR(); qkt(pB0, pB1, (bf16*)((char*)K_lds + SHM_K), qr, r32, hi); WMASK(pB0, pB1, NT - 1);
  finishSM(pA0, pA1, alA, l_reg, pa0, pa1, pa2, pa3); SBAR();
  pv_d0(o, vb0, pa0, pa1, pa2, pa3); partialSM(pB0, pB1, m_reg, mnB, alB);
  __syncthreads(); RESC(alB);
  finishSM(pB0, pB1, alB, l_reg, pa0, pa1, pa2, pa3); SBAR();
  pv_d0(o, vb0 + (int)SHM_V, pa0, pa1, pa2, pa3);
  if (hi == 0) li_l[r32] = l_reg; asm volatile("s_waitcnt lgkmcnt(0)" ::: "memory");
  float rli[16];
#pragma unroll
  for (int r = 0; r < 16; ++r) rli[r] = __builtin_amdgcn_rcpf(li_l[crow(r, hi)]);
  bf16* Ow = Ob + (long)(wid * QBLK) * LDO;
#pragma unroll
  for (int r = 0; r < 16; ++r) { int orow = crow(r, hi);
    for (int d0 = 0; d0 < 4; ++d0) Ow[(long)orow * LDO + d0 * 32 + r32] = (bf16)f2bf(o[d0][r] * rli[r]); }
#undef KROW
#undef SLOAD
#undef SWRITE
#undef SWAIT
#undef RESC
#undef WMASK
}
#undef KSWZ
#undef SBAR
}

__device__ __forceinline__ void fast_attn(Frame& F, int l) {
    char* lds = (char*)F.lds;
    const int nsub = (l < DEPTH - 1) ? 3 : 2;
    for (int u = (int)blockIdx.x; u < 256; u += F.G) {
        const int x = u & 7, y = u >> 3, b = x >> 1, kvh = x & 1, g = y >> 3, qb = y & 7, h = kvh * 4 + g;
        for (int s = 0; s < nsub; ++s) {
            if (s == 2 && qb != 0 && qb != 7) break;
            const bool mixB = (s == 1) || (s == 2 && qb == 7), ctxq = (s == 2);
            const size_t brow = (size_t)b * TT, qrow = ctxq ? brow : brow + CTX + 256 * qb;
            const bf16* Qp = (const bf16*)(F.ws + (mixB ? WS_QB : WS_QA)) + qrow * QW + h * HD;
            const bf16* Kp = (const bf16*)(F.ws + (mixB ? WS_KB : WS_KA)) + brow * KW + kvh * HD;
            const bf16* Vp = (const bf16*)(F.ws + (mixB ? WS_VB : WS_VA)) + brow * KW + kvh * HD;
            bf16* Op = (bf16*)(F.ws + WS_YAB) + qrow * D + (mixB ? QW : 0) + h * HD;
            const int q0 = 256 * qb, klo = q0 - 128 < 0 ? 0 : q0 - 128, khi = q0 + 384 > SEQ ? SEQ : q0 + 384;
            const int NT = ctxq ? CTX / 64 : (s == 0 ? TT / 64 : 4 + (khi - klo) / 64);
            const float m0 = mixB ? INP(IN_SINK)[l * NH + h] * (1.0f / ATTN_SCALE) : -1.0e30f, l0 = mixB ? 1.f : 0.f;
            att::attn_unit(s == 1, Qp, Kp, Vp, Op, NT, klo, q0, m0, l0, lds);
        }
    }
}
namespace moe {
typedef unsigned u32x4 __attribute__((ext_vector_type(4)));
using pg8::bf16x8; using pg8::f32x4;
#ifndef MOE_CAPT
#define MOE_CAPT 576
#endif
constexpr int CAPT = MOE_CAPT;
constexpr int B_STAGE = 16896, B_PART = 8448, CAP = 576;
constexpr int NMF = CAP / 32, GS = 3, NGRP = NMF / GS;
static_assert(2 * (CAP / 16) * 1024 + 4 * B_STAGE <= LDSCTL_OFF && NGRP == 6, "MoE LDS map / group nest");
__device__ __forceinline__ void wait_vm1(int n) {
    switch (n) { case 0: asm volatile("s_waitcnt vmcnt(0)" ::: "memory"); break; case 1: asm volatile("s_waitcnt vmcnt(1)" ::: "memory"); break; case 2: asm volatile("s_waitcnt vmcnt(2)" ::: "memory"); break;
                 case 3: asm volatile("s_waitcnt vmcnt(3)" ::: "memory"); break; case 4: asm volatile("s_waitcnt vmcnt(4)" ::: "memory"); break; case 5: asm volatile("s_waitcnt vmcnt(5)" ::: "memory"); break;
                 case 6: asm volatile("s_waitcnt vmcnt(6)" ::: "memory"); break; default: asm volatile("s_waitcnt vmcnt(7)" ::: "memory"); break; }
}
__device__ __forceinline__ void wait_vm8(int n) {
    switch (n) { case 0: asm volatile("s_waitcnt vmcnt(0)" ::: "memory"); break; case 1: asm volatile("s_waitcnt vmcnt(8)" ::: "memory"); break; case 2: asm volatile("s_waitcnt vmcnt(16)" ::: "memory"); break;
                 case 3: asm volatile("s_waitcnt vmcnt(24)" ::: "memory"); break; case 4: asm volatile("s_waitcnt vmcnt(32)" ::: "memory"); break; case 5: asm volatile("s_waitcnt vmcnt(40)" ::: "memory"); break; default: asm volatile("s_waitcnt vmcnt(48)" ::: "memory"); break; }
}
__device__ __forceinline__ unsigned cvt_pk(float lo, float hi) { unsigned r; asm volatile("v_cvt_pk_bf16_f32 %0, %1, %2" : "=v"(r) : "v"(lo), "v"(hi)); return r; }
__device__ __forceinline__ int swz(int ob) { return ob ^ (((ob >> 9) & 1) << 5); }

template <int MODE>
__device__ __forceinline__ void moe_phase(Frame& F, int l) {
    LAS unsigned char* lds = F.lds;
    LAS unsigned* base = (LAS unsigned*)(F.lds + LDSCTL_OFF + 512);
    const unsigned* cnt = (const unsigned*)F.ctl + CW_CNT + l * 64;
    compute_base(cnt, base, F.tid);
    LAS unsigned char* order = (LAS unsigned char*)(F.lds + LDSCTL_OFF + 512 + 272);
    if (F.tid < NE) { const unsigned c = base[F.tid + 1] - base[F.tid]; int rank = 0;
        for (int e2 = 0; e2 < NE; ++e2) { const unsigned c2 = base[e2 + 1] - base[e2]; rank += (c2 > c || (c2 == c && e2 < F.tid)) ? 1 : 0; }
        order[rank] = (unsigned char)F.tid; }
    __syncthreads();
    constexpr int NCS = MODE == 0 ? 8 : 16, K = MODE == 0 ? D : DE, NT = K / 32, LDW = MODE == 0 ? DE : D, BKS = MODE == 0 ? 256 : 512;
    const int wid = F.wave, lane = F.lane, wr = wid >> 2, wc = wid & 3, fr = lane & 15, fq = lane >> 4;
    const int afo = swz(fr * 64 + fq * 16);
    const int sb = swz(lane * 16), drow = sb >> 6, dk = (sb & 63) >> 1;
    int bro[2];
#pragma unroll
    for (int j = 0; j < 2; ++j) bro[j] = ((MODE == 0) ? j * B_PART + ((8 * fq) * 64 + 16 * wc + fr) * 4 : ((8 * fq) * 128 + 32 * wc + 16 * j + fr) * 4) + fq * 64;
    const int bw = wid - 6;
    const unsigned bvo = (MODE == 0) ? (unsigned)((lane >> 4) * LDW + (lane & 15) * 4) * 4u : (unsigned)((lane >> 5) * LDW + (lane & 31) * 4) * 4u;
    const unsigned* LISTl = (const unsigned*)(F.ws + WS_LIST) + (size_t)l * NE * M;
    const __amdgpu_buffer_rsrc_t ars = __builtin_amdgcn_make_buffer_rsrc((void*)(F.ws + (MODE == 0 ? WS_HA : WS_HB)), 0, 0x7ffffff0, 0x00020000);
    constexpr int UREP = (REPMASK & (MODE == 0 ? (1 << 8) : (1 << 9))) ? 2 : 1;
    for (int u2 = F.vcu; u2 < UREP * NE * NCS; u2 += F.G) {
        const int u = u2 % (NE * NCS); const int cs = u % NCS; const bool rep = (UREP > 1) && (u2 >= NE * NCS);
        const int uq = u / NCS; int rnk;
        if (F.G * NCS >= NE * NCS / 2 && NE * NCS / F.G == 2) { const int slot = uq % (NE / 2), i = uq / (NE / 2); rnk = i == 0 ? slot : NE - 1 - slot; }
        else if (NE * NCS / F.G == 4 && NE % 4 == 0) { const int slot = uq % (NE / 4), i = uq / (NE / 4); rnk = i == 0 ? slot : i == 1 ? NE / 2 - 1 - slot : i == 2 ? NE / 2 + slot : NE - 1 - slot; }
        else rnk = uq;
        const int e = (int)order[rnk];
        const int n_e = (int)(base[e + 1] - base[e]), base_e = (int)base[e];
        const float* wbase;
        if (MODE == 0) wbase = ((bw == 1) ? INP(IN_W3) : INP(IN_W1)) + ((size_t)(l * NE + e) * D) * DE + 64 * cs;
        else           wbase = INP(IN_W2) + ((size_t)(l * NE + e) * DE) * D + 128 * cs + (size_t)(bw == 1 ? 16 : 0) * D;
        unsigned wlo_v = (unsigned)(unsigned long long)wbase, whi_v = (unsigned)((unsigned long long)wbase >> 32);
        asm volatile("" : "+v"(wlo_v), "+v"(whi_v));
        for (int r0 = 0; r0 < n_e; r0 += CAPT) {
            const int nrows = (n_e - r0) < CAPT ? (n_e - r0) : CAPT, nsub = (nrows + 15) >> 4;
            const int asz = nsub * 1024; const int na = 2;
            const int boff = na * asz; int nstg = (LDSCTL_OFF - boff) / B_STAGE; nstg = nstg > 8 ? 8 : nstg;
            int naw = 0;
#pragma unroll
            for (int j = 0; j < 7; ++j) naw += (wid + 6 * j < nsub) ? 1 : 0;
            unsigned aof[7];
#pragma unroll
            for (int j = 0; j < 7; ++j) { const int sx = wid + 6 * j; int r = 16 * sx + drow; if (r >= nrows) r = 0;
                if (MODE == 0) aof[j] = LISTl[(size_t)e * M + r0 + r] * (unsigned)(D * 2) + (unsigned)dk * 2u;
                else           aof[j] = (unsigned)(base_e + r0 + r) * (unsigned)(DE * 2) + (unsigned)dk * 2u; }
            f32x4 acc[NMF][2];
#pragma unroll
            for (int m = 0; m < NMF; ++m)
#pragma unroll
                for (int n = 0; n < 2; ++n) acc[m][n] = (f32x4){0.f, 0.f, 0.f, 0.f};
#define MOE_DMA_A(t, b) do { _Pragma("unroll") for (int j_ = 0; j_ < 7; ++j_) { const int s_ = wid + 6 * j_; if (s_ < nsub) \
        __builtin_amdgcn_raw_ptr_buffer_load_lds(ars, (LAS void*)(lds + (b) * asz + s_ * 1024), 16, aof[j_], (t) * 64, 0, 0); } } while (0)
#define MOE_DMA_B(t) do { unsigned lo_, hi_; asm volatile("v_readfirstlane_b32 %0, %2\n\tv_readfirstlane_b32 %1, %3" : "=s"(lo_), "=s"(hi_) : "v"(wlo_v), "v"(whi_v)); \
        const __amdgpu_buffer_rsrc_t wrs_ = __builtin_amdgcn_make_buffer_rsrc((void*)(((unsigned long long)hi_ << 32) | lo_), 0, 0x7ffffff0, 0x00020000); \
        LAS unsigned char* bst_ = lds + boff + ((t) % nstg) * B_STAGE + (MODE == 0 ? bw * B_PART : bw * 8192 + bw * 128); \
        _Pragma("unroll") for (int i_ = 0; i_ < 8; ++i_) __builtin_amdgcn_raw_ptr_buffer_load_lds(wrs_, (LAS void*)(bst_ + i_ * 1024 + (MODE == 0 ? (i_ >> 1) : (i_ >> 2)) * 64), 16, bvo, ((t) * 32 + (MODE == 0 ? 4 : 2) * i_) * (LDW * 4), 0, 2); } while (0)
#define MOE_DMA_BS(t, slot) do { unsigned lo_, hi_; asm volatile("v_readfirstlane_b32 %0, %2\n\tv_readfirstlane_b32 %1, %3" : "=s"(lo_), "=s"(hi_) : "v"(wlo_v), "v"(whi_v)); \
        const __amdgpu_buffer_rsrc_t wrs_ = __builtin_amdgcn_make_buffer_rsrc((void*)(((unsigned long long)hi_ << 32) | lo_), 0, 0x7ffffff0, 0x00020000); \
        LAS unsigned char* bst_ = lds + boff + (slot) * B_STAGE + (MODE == 0 ? bw * B_PART : bw * 8192 + bw * 128); \
        _Pragma("unroll") for (int i_ = 0; i_ < 8; ++i_) __builtin_amdgcn_raw_ptr_buffer_load_lds(wrs_, (LAS void*)(bst_ + i_ * 1024 + (MODE == 0 ? (i_ >> 1) : (i_ >> 2)) * 64), 16, bvo, ((t) * 32 + (MODE == 0 ? 4 : 2) * i_) * (LDW * 4), 0, 2); } while (0)
#define MOE_LDA(dst, g_) do { _Pragma("unroll") for (int q_ = 0; q_ < GS; ++q_) dst[q_] = *(const LAS bf16x8*)(Ab + (2 * (GS * (g_) + q_) + wr) * 1024 + afo); } while (0)
#define MOE_MMA(src, g_) do { _Pragma("unroll") for (int q_ = 0; q_ < GS; ++q_) _Pragma("unroll") for (int j_ = 0; j_ < 2; ++j_) \
        acc[GS * (g_) + q_][j_] = __builtin_amdgcn_mfma_f32_16x16x32_bf16(Bf[j_], src[q_], acc[GS * (g_) + q_][j_], 0, 0, 0); } while (0)
            asm volatile("s_waitcnt vmcnt(0) lgkmcnt(0)" ::: "memory"); __builtin_amdgcn_s_barrier(); asm volatile("" ::: "memory");
            if (wid < 6) { MOE_DMA_A(0, 0); if (na == 3 && NT > 1) MOE_DMA_A(1, 1); }
            else { for (int p = 0; p < nstg - 1 && p < NT; ++p) MOE_DMA_B(p); }
            const int ngrp = (nsub - wr + 2 * GS - 1) / (2 * GS);
            int abuf = 0, bslot = 0;
            for (int t = 0; t < NT; ++t) {
                if (wid < 6) { if (na == 3 && t + 1 < NT) wait_vm1(naw); else asm volatile("s_waitcnt vmcnt(0)" ::: "memory"); }
                else { const int rem = NT - 1 - t; wait_vm8(rem < nstg - 2 ? rem : nstg - 2); }
                asm volatile("s_waitcnt lgkmcnt(0)" ::: "memory"); __builtin_amdgcn_s_barrier(); asm volatile("" ::: "memory");
                if (wid < 6) { if (t + na - 1 < NT) { int nb = abuf + na - 1; nb = nb >= na ? nb - na : nb; MOE_DMA_A(t + na - 1, nb); } }
                else { if (t + nstg - 1 < NT) { int ns = bslot + nstg - 1; ns = ns >= nstg ? ns - nstg : ns; MOE_DMA_BS(t + nstg - 1, ns); } }
                const LAS unsigned char* Ab = lds + abuf * asz; const LAS unsigned char* Bb = lds + boff + bslot * B_STAGE;
                abuf = (abuf + 1 == na) ? 0 : abuf + 1; bslot = (bslot + 1 == nstg) ? 0 : bslot + 1;
                bf16x8 At0[GS], At1[GS], Bf[2]; float w0[8], w1[8];
#pragma unroll
                for (int i = 0; i < 8; ++i) w0[i] = *(const LAS float*)(Bb + bro[0] + i * BKS);
#pragma unroll
                for (int i = 0; i < 8; ++i) w1[i] = *(const LAS float*)(Bb + bro[1] + i * BKS);
                MOE_LDA(At0, 0);
                __builtin_amdgcn_sched_barrier(0);
                { u32x4 p; p.x = cvt_pk(w0[0], w0[1]); p.y = cvt_pk(w0[2], w0[3]); p.z = cvt_pk(w0[4], w0[5]); p.w = cvt_pk(w0[6], w0[7]); Bf[0] = __builtin_bit_cast(bf16x8, p);
                  p.x = cvt_pk(w1[0], w1[1]); p.y = cvt_pk(w1[2], w1[3]); p.z = cvt_pk(w1[4], w1[5]); p.w = cvt_pk(w1[6], w1[7]); Bf[1] = __builtin_bit_cast(bf16x8, p); }
                __builtin_amdgcn_sched_barrier(0);
                if (ngrp > 1) MOE_LDA(At1, 1);
                MOE_MMA(At0, 0);
                if (ngrp > 1) { if (ngrp > 2) MOE_LDA(At0, 2); MOE_MMA(At1, 1);
                    if (ngrp > 2) { if (ngrp > 3) MOE_LDA(At1, 3); MOE_MMA(At0, 2);
                        if (ngrp > 3) { if (ngrp > 4) MOE_LDA(At0, 4); MOE_MMA(At1, 3);
                            if (ngrp > 4) { if (ngrp > 5) MOE_LDA(At1, 5); MOE_MMA(At0, 4);
                                if (ngrp > 5) MOE_MMA(At1, 5); } } } }
            }
#pragma unroll
            for (int m = 0; m < NMF; ++m) { const int row = 16 * (2 * m + wr) + fr;
                if (row < nrows && !rep) {
                    if (MODE == 0) { const f32x4 x = acc[m][0], y = acc[m][1]; uint2 o;
                        o.x = cvt_pk(x[0] / (1.f + __expf(-x[0])) * y[0], x[1] / (1.f + __expf(-x[1])) * y[1]); o.y = cvt_pk(x[2] / (1.f + __expf(-x[2])) * y[2], x[3] / (1.f + __expf(-x[3])) * y[3]);
                        *(uint2*)((bf16*)(F.ws + WS_HB) + (size_t)(base_e + r0 + row) * DE + 64 * cs + 16 * wc + 4 * fq) = o;
                    } else {
#pragma unroll
                        for (int n = 0; n < 2; ++n) { const f32x4 x = acc[m][n]; uint2 o; o.x = cvt_pk(x[0], x[1]); o.y = cvt_pk(x[2], x[3]);
                            *(uint2*)((bf16*)(F.ws + WS_YM) + (size_t)(base_e + r0 + row) * D + 128 * cs + 32 * wc + 16 * n + 4 * fq) = o; }
                    }
                } }
        }
    }
    asm volatile("s_waitcnt vmcnt(0) lgkmcnt(0)" ::: "memory"); __syncthreads();
#undef MOE_DMA_A
#undef MOE_DMA_B
#undef MOE_DMA_BS
#undef MOE_LDA
#undef MOE_MMA
}
}
__device__ __forceinline__ void fast_moe_up(Frame& F, int l) { moe::moe_phase<0>(F, l); }
__device__ __forceinline__ void fast_moe_down(Frame& F, int l) { moe::moe_phase<1>(F, l); }
struct RowOrder {
    pg8::StaticOrder so; bool latent_only;
    __device__ void init(bool lat, int N, int G, int c) { latent_only = lat; so.init(lat ? NB * SEQ : M, N, G, c); }
    __device__ bool next(int i, pg8::Unit& u) const { if (!so.next(i, u)) return false; if (latent_only) u.pm = (u.pm >> 3) * 9 + 1 + (u.pm & 7); return true; }
    __device__ __forceinline__ void a_ready(const pg8::Unit&) const {}
    __device__ __forceinline__ void done(const pg8::Unit&) const {}
};
struct EpiF32 {
    static constexpr int MIDK = 0; static constexpr bool PERM = false, AFTER_DRAIN = false;
    float* O; int ldc;
    __device__ __forceinline__ void operator()(const pg8::f32x4 (&acc)[2][2][4][2], const pg8::Unit& u, int wr, int wc, int fr, int fq) const {
        const int row0 = u.pm * 256 + wr * 64 + fr, col0 = u.pn * 256 + wc * 32 + 4 * fq;
#pragma unroll
        for (int ai = 0; ai < 2; ++ai)
#pragma unroll
            for (int m = 0; m < 4; ++m) { float* rowp = O + (size_t)(row0 + ai * 128 + m * 16) * ldc + col0;
#pragma unroll
                for (int bj = 0; bj < 2; ++bj)
#pragma unroll
                    for (int n = 0; n < 2; ++n) *(pg8::f32x4*)(rowp + bj * 128 + n * 16) = acc[ai][bj][m][n]; }
    }
};
template <int PASS>
struct EpiGate {
    static constexpr int MIDK = 0; static constexpr bool PERM = false, AFTER_DRAIN = false;
    const bf16* G; bf16* O;
    __device__ __forceinline__ void operator()(const pg8::f32x4 (&acc)[2][2][4][2], const pg8::Unit& u, int wr, int wc, int fr, int fq) const {
        asm volatile("" : "+v"(fr), "+v"(fq));
        const int row0 = u.pm * 256 + wr * 64 + fr, col0 = u.pn * 256 + wc * 32 + 4 * fq;
#pragma unroll
        for (int ai = 0; ai < 2; ++ai) {
            uint2 gv[4][2][2], tv[4][2][2];
#pragma unroll
            for (int m = 0; m < 4; ++m) { const size_t off = (size_t)(row0 + ai * 128 + m * 16) * D + col0;
#pragma unroll
                for (int bj = 0; bj < 2; ++bj)
#pragma unroll
                    for (int n = 0; n < 2; ++n) { gv[m][bj][n] = *(const uint2*)(G + off + bj * 128 + n * 16); if (PASS == 2) tv[m][bj][n] = *(const uint2*)(O + off + bj * 128 + n * 16); } }
#pragma unroll
            for (int m = 0; m < 4; ++m) { const size_t off = (size_t)(row0 + ai * 128 + m * 16) * D + col0;
#pragma unroll
                for (int bj = 0; bj < 2; ++bj)
#pragma unroll
                    for (int n = 0; n < 2; ++n) { const uint2 g2 = gv[m][bj][n];
                        pg8::f32x4 g = {__builtin_bit_cast(float, g2.x << 16), __builtin_bit_cast(float, g2.x & 0xffff0000u), __builtin_bit_cast(float, g2.y << 16), __builtin_bit_cast(float, g2.y & 0xffff0000u)};
                        pg8::f32x4 v = g * acc[ai][bj][m][n];
                        if (PASS == 2) { const uint2 t2 = tv[m][bj][n];
                            v += (pg8::f32x4){__builtin_bit_cast(float, t2.x << 16), __builtin_bit_cast(float, t2.x & 0xffff0000u), __builtin_bit_cast(float, t2.y << 16), __builtin_bit_cast(float, t2.y & 0xffff0000u)}; }
                        uint2 o; o.x = pg8::cvt_pk_bf16(v[0], v[1]); o.y = pg8::cvt_pk_bf16(v[2], v[3]); *(uint2*)(O + off + bj * 128 + n * 16) = o; } }
            asm volatile("" ::: "memory");
        }
    }
};
struct EpiGateK {
    static constexpr int MIDK = 16; static constexpr bool PERM = false, AFTER_DRAIN = false;
    const bf16* GA; const bf16* GB; bf16* O;
    __device__ __forceinline__ void mid(pg8::f32x4 (&acc)[2][2][4][2], const pg8::Unit& u, int wr, int wc, int fr, int fq) const {
        asm volatile("" : "+v"(fr), "+v"(fq));
        const int row0 = u.pm * 256 + wr * 64 + fr, col0 = u.pn * 256 + wc * 32 + 4 * fq;
#pragma unroll
        for (int ai = 0; ai < 2; ++ai) {
            uint2 av[4][2][2], bv[4][2][2];
#pragma unroll
            for (int m = 0; m < 4; ++m) { const size_t off = (size_t)(row0 + ai * 128 + m * 16) * D + col0;
#pragma unroll
                for (int bj = 0; bj < 2; ++bj)
#pragma unroll
                    for (int n = 0; n < 2; ++n) { av[m][bj][n] = *(const uint2*)(GA + off + bj * 128 + n * 16); bv[m][bj][n] = *(const uint2*)(GB + off + bj * 128 + n * 16); } }
#pragma unroll
            for (int m = 0; m < 4; ++m)
#pragma unroll
                for (int bj = 0; bj < 2; ++bj)
#pragma unroll
                    for (int n = 0; n < 2; ++n) { const uint2 a2 = av[m][bj][n], b2 = bv[m][bj][n];
                        const pg8::f32x4 ga = {__builtin_bit_cast(float, a2.x << 16), __builtin_bit_cast(float, a2.x & 0xffff0000u), __builtin_bit_cast(float, a2.y << 16), __builtin_bit_cast(float, a2.y & 0xffff0000u)};
                        const pg8::f32x4 gb = {__builtin_bit_cast(float, b2.x << 16), __builtin_bit_cast(float, b2.x & 0xffff0000u), __builtin_bit_cast(float, b2.y << 16), __builtin_bit_cast(float, b2.y & 0xffff0000u)};
#pragma unroll
                        for (int e = 0; e < 4; ++e) acc[ai][bj][m][n][e] *= ga[e] * __builtin_amdgcn_rcpf(fmaxf(gb[e], 1.0e-30f)); }
        }
    }
    __device__ __forceinline__ void operator()(const pg8::f32x4 (&acc)[2][2][4][2], const pg8::Unit& u, int wr, int wc, int fr, int fq) const {
        asm volatile("" : "+v"(fr), "+v"(fq));
        const int row0 = u.pm * 256 + wr * 64 + fr, col0 = u.pn * 256 + wc * 32 + 4 * fq;
#pragma unroll
        for (int ai = 0; ai < 2; ++ai) {
            uint2 bv[4][2][2];
#pragma unroll
            for (int m = 0; m < 4; ++m) { const size_t off = (size_t)(row0 + ai * 128 + m * 16) * D + col0;
#pragma unroll
                for (int bj = 0; bj < 2; ++bj)
#pragma unroll
                    for (int n = 0; n < 2; ++n) bv[m][bj][n] = *(const uint2*)(GB + off + bj * 128 + n * 16); }
#pragma unroll
            for (int m = 0; m < 4; ++m) { const size_t off = (size_t)(row0 + ai * 128 + m * 16) * D + col0;
#pragma unroll
                for (int bj = 0; bj < 2; ++bj)
#pragma unroll
                    for (int n = 0; n < 2; ++n) { const uint2 b2 = bv[m][bj][n];
                        const pg8::f32x4 gb = {__builtin_bit_cast(float, b2.x << 16), __builtin_bit_cast(float, b2.x & 0xffff0000u), __builtin_bit_cast(float, b2.y << 16), __builtin_bit_cast(float, b2.y & 0xffff0000u)};
                        const pg8::f32x4 v = gb * acc[ai][bj][m][n];
                        uint2 o; o.x = pg8::cvt_pk_bf16(v[0], v[1]); o.y = pg8::cvt_pk_bf16(v[2], v[3]); *(uint2*)(O + off + bj * 128 + n * 16) = o; } }
        }
    }
};
struct EpiRes {
    static constexpr int MIDK = 0; static constexpr bool PERM = false, AFTER_DRAIN = false;
    float* X; const float* g1l;
    __device__ __forceinline__ void operator()(const pg8::f32x4 (&acc)[2][2][4][2], const pg8::Unit& u, int wr, int wc, int fr, int fq) const {
        asm volatile("" : "+v"(fr), "+v"(fq));
        const int row0 = u.pm * 256 + wr * 64 + fr, col0 = u.pn * 256 + wc * 32 + 4 * fq;
        const float* g1 = g1l + (size_t)((u.pm % 9 == 0) ? 4 : u.pm / 9) * MODW + col0;
        pg8::f32x4 gv[2][2];
#pragma unroll
        for (int bj = 0; bj < 2; ++bj)
#pragma unroll
            for (int n = 0; n < 2; ++n) gv[bj][n] = *(const pg8::f32x4*)(g1 + bj * 128 + n * 16);
#pragma unroll
        for (int ai = 0; ai < 2; ++ai) {
            pg8::f32x4 xv[4][2][2];
#pragma unroll
            for (int m = 0; m < 4; ++m) { const float* rowp = X + (size_t)(row0 + ai * 128 + m * 16) * D + col0;
#pragma unroll
                for (int bj = 0; bj < 2; ++bj)
#pragma unroll
                    for (int n = 0; n < 2; ++n) xv[m][bj][n] = *(const pg8::f32x4*)(rowp + bj * 128 + n * 16); }
#pragma unroll
            for (int m = 0; m < 4; ++m) { float* rowp = X + (size_t)(row0 + ai * 128 + m * 16) * D + col0;
#pragma unroll
                for (int bj = 0; bj < 2; ++bj)
#pragma unroll
                    for (int n = 0; n < 2; ++n) *(pg8::f32x4*)(rowp + bj * 128 + n * 16) = xv[m][bj][n] + gv[bj][n] * acc[ai][bj][m][n]; }
            asm volatile("" ::: "memory");
        }
    }
};
struct EpiInproj {
    static constexpr int MIDK = 0; static constexpr bool PERM = false, AFTER_DRAIN = false;
    unsigned char* ws; const float* qn; const float* kn; LAS float* xs;
    __device__ __forceinline__ void operator()(const pg8::f32x4 (&acc)[2][2][4][2], const pg8::Unit& u, int wr, int wc, int fr, int fq) const {
        asm volatile("" : "+v"(fr), "+v"(fq));
        const int pn = u.pn; bf16* dst; int ldo, kind; const float* nw = nullptr;
        if (pn < 4) { dst = (bf16*)(ws + WS_QA) + pn * 256; ldo = QW; kind = 0; nw = qn; }
        else if (pn == 4) { dst = (bf16*)(ws + WS_KA); ldo = KW; kind = 0; nw = kn; }
        else if (pn == 5) { dst = (bf16*)(ws + WS_VA); ldo = KW; kind = 2; }
        else if (pn < 10) { dst = (bf16*)(ws + WS_QB) + (pn - 6) * 256; ldo = QW; kind = 1; }
        else if (pn == 10) { dst = (bf16*)(ws + WS_KB); ldo = KW; kind = 1; }
        else if (pn == 11) { dst = (bf16*)(ws + WS_VB); ldo = KW; kind = 2; }
        else if (pn < 20) { dst = (bf16*)(ws + WS_GA) + (pn - 12) * 256; ldo = D; kind = 3; }
        else { dst = (bf16*)(ws + WS_GB) + (pn - 20) * 256; ldo = D; kind = 3; }
        const int rt0 = wr * 64 + fr;
        const int cw = 32 * wc + 4 * fq;
        const int tb = u.pm % 9; const bool rope = (kind < 2) && (tb != 0);
        if (kind == 0) {
#pragma unroll
            for (int ai = 0; ai < 2; ++ai)
#pragma unroll
                for (int m = 0; m < 4; ++m)
#pragma unroll
                    for (int bj = 0; bj < 2; ++bj) { const pg8::f32x4 a = acc[ai][bj][m][0], b = acc[ai][bj][m][1];
                        float ss = (a[0] * a[0] + a[1] * a[1]) + (a[2] * a[2] + a[3] * a[3]) + (b[0] * b[0] + b[1] * b[1]) + (b[2] * b[2] + b[3] * b[3]);
                        ss += __shfl_xor(ss, 16); ss += __shfl_xor(ss, 32);
                        if (fq == 0) xs[(bj * 256 + rt0 + 128 * ai + 16 * m) * 4 + wc] = ss; }
            asm volatile("s_waitcnt lgkmcnt(0)" ::: "memory"); __builtin_amdgcn_s_barrier(); asm volatile("" ::: "memory");
        }
        pg8::f32x4 w1 = {1.f, 1.f, 1.f, 1.f}, w2 = w1;
        if (kind == 0) { const int d1 = 64 * (wc >> 1) + 16 * (wc & 1) + 4 * fq; w1 = *(const pg8::f32x4*)(nw + d1); w2 = *(const pg8::f32x4*)(nw + d1 + 32); }
        const float* RT = (const float*)(ws + WS_ROPE) + 16 * (wc & 1) + 4 * fq;
#pragma unroll
        for (int ai = 0; ai < 2; ++ai)
#pragma unroll
            for (int m = 0; m < 4; ++m) {
                const int rt = rt0 + 128 * ai + 16 * m;
                pg8::f32x4 cs = {1.f, 1.f, 1.f, 1.f}, sn = {0.f, 0.f, 0.f, 0.f};
                if (rope) { const int s = (tb - 1) * 256 + rt; const int pos = (wc >> 1) ? (s & 63) : (s >> 6); cs = *(const pg8::f32x4*)(RT + pos * 32); sn = *(const pg8::f32x4*)(RT + 2048 + pos * 32); }
                bf16* rowp = dst + (size_t)(u.pm * 256 + rt) * ldo + cw;
#pragma unroll
                for (int bj = 0; bj < 2; ++bj) {
                    pg8::f32x4 x1 = acc[ai][bj][m][0], x2 = acc[ai][bj][m][1];
                    if (kind == 0) { const pg8::f32x4 p = *(const LAS pg8::f32x4*)(xs + (bj * 256 + rt) * 4); const float r = 1.0f / sqrtf(((p[0] + p[1]) + (p[2] + p[3])) * (1.0f / HD) + EPS); x1 = x1 * r * w1; x2 = x2 * r * w2; }
                    if (kind < 2) { const pg8::f32x4 o1 = x1 * cs - x2 * sn, o2 = x1 * sn + x2 * cs; x1 = o1; x2 = o2; }
                    if (kind == 3) {
#pragma unroll
                        for (int e = 0; e < 4; ++e) { x1[e] = 1.f / (1.f + __expf(-x1[e])); x2[e] = 1.f / (1.f + __expf(-x2[e])); } }
                    uint2 o; o.x = pg8::cvt_pk_bf16(x1[0], x1[1]); o.y = pg8::cvt_pk_bf16(x1[2], x1[3]); *(uint2*)(rowp + bj * 128) = o;
                    o.x = pg8::cvt_pk_bf16(x2[0], x2[1]); o.y = pg8::cvt_pk_bf16(x2[2], x2[3]); *(uint2*)(rowp + bj * 128 + 16) = o;
                }
                asm volatile("" ::: "memory");
            }
    }
};
__device__ __forceinline__ void fast_inproj(Frame& F, int l) {
    pg8::Gemm g{(const bf16*)(F.ws + WS_HA), (const bf16*)(F.ws + WS_WIN) + (size_t)l * INC * D, M, INC, D, D, D};
    RowOrder S; S.init(false, INC, F.G, (int)blockIdx.x);
    if constexpr (FUSE_POST) { EpiInproj E{F.ws, INP(IN_QNA) + l * HD, INP(IN_KNA) + l * HD, (LAS float*)(F.lds + XS_OFF)};
        pg8::gemm_phase<EpiInproj, RowOrder, true, true>(F.lds + RING_OFF, g, S, E); }
    else { EpiF32 E{(float*)(F.ws + WS_P), INC};
        pg8::gemm_phase<EpiF32, RowOrder, true, true>(F.lds + RING_OFF, g, S, E); }
}
__device__ __forceinline__ void fast_br(Frame& F, int l) {
    const bool lat = (l == DEPTH - 1);
    if constexpr (FUSE_GATE && GATE_MIDK) {
        pg8::Gemm g{(const bf16*)(F.ws + WS_YAB), (const bf16*)(F.ws + WS_WBR) + (size_t)l * D * D, M, D, D, D, D};
        RowOrder S; S.init(lat, D, F.G, (int)blockIdx.x); EpiGateK E{(const bf16*)(F.ws + WS_GA), (const bf16*)(F.ws + WS_GB), (bf16*)(F.ws + WS_MB)};
        pg8::gemm_phase<EpiGateK, RowOrder, true, true>(F.lds + RING_OFF, g, S, E);
    } else if constexpr (FUSE_GATE) {
        { pg8::Gemm g{(const bf16*)(F.ws + WS_YAB), (const bf16*)(F.ws + WS_WBR) + (size_t)l * D * D, M, D, QW, D, D};
          RowOrder S; S.init(lat, D, F.G, (int)blockIdx.x); EpiGate<1> E{(const bf16*)(F.ws + WS_GA), (bf16*)(F.ws + WS_MB)};
          pg8::gemm_phase<EpiGate<1>, RowOrder, true, true>(F.lds + RING_OFF, g, S, E); }
        { pg8::Gemm g{(const bf16*)(F.ws + WS_YAB) + QW, (const bf16*)(F.ws + WS_WBR) + (size_t)l * D * D + QW, M, D, QW, D, D};
          RowOrder S; S.init(lat, D, F.G, (int)blockIdx.x); EpiGate<2> E{(const bf16*)(F.ws + WS_GB), (bf16*)(F.ws + WS_MB)};
          pg8::gemm_phase<EpiGate<2>, RowOrder, true, true>(F.lds + RING_OFF, g, S, E); }
    } else {
        { pg8::Gemm g{(const bf16*)(F.ws + WS_YAB), (const bf16*)(F.ws + WS_WBR) + (size_t)l * D * D, M, D, QW, D, D};
          RowOrder S; S.init(lat, D, F.G, (int)blockIdx.x); EpiF32 E{(float*)(F.ws + WS_T1), D};
          pg8::gemm_phase<EpiF32, RowOrder, true, true>(F.lds + RING_OFF, g, S, E); }
        { pg8::Gemm g{(const bf16*)(F.ws + WS_YAB) + QW, (const bf16*)(F.ws + WS_WBR) + (size_t)l * D * D + QW, M, D, QW, D, D};
          RowOrder S; S.init(lat, D, F.G, (int)blockIdx.x); EpiF32 E{(float*)(F.ws + WS_T2), D};
          pg8::gemm_phase<EpiF32, RowOrder, true, true>(F.lds + RING_OFF, g, S, E); }
    }
}
template <bool DRY>
__device__ __forceinline__ void fast_out(Frame& F, int l) {
    const bool lat = (l == DEPTH - 1);
    pg8::Gemm g{(const bf16*)(F.ws + WS_MB), (const bf16*)(F.ws + WS_WOUT) + (size_t)l * D * D, M, D, D, D, D};
    RowOrder S; S.init(lat, D, F.G, (int)blockIdx.x);
    if constexpr (FUSE_RES && !DRY) { EpiRes E{(float*)(F.ws + WS_XW), (const float*)(F.ws + WS_MOD) + (size_t)l * 5 * MODW + 2 * D};
        pg8::gemm_phase<EpiRes, RowOrder, true, true>(F.lds + RING_OFF, g, S, E); }
    else { EpiF32 E{(float*)(F.ws + WS_T3), D};
        pg8::gemm_phase<EpiF32, RowOrder, true, true>(F.lds + RING_OFF, g, S, E); }
}
constexpr int PH_P0 = 0, PH_P0B = 1, PH_L0 = 2, PH_PER_LAYER = 11, PH_FINAL = PH_L0 + PH_PER_LAYER * DEPTH, NPH = PH_FINAL + 1;
enum { L_NORM1 = 0, L_INPROJ = 1, L_POST = 2, L_ATTN = 3, L_BR = 4, L_GATE = 5, L_OUT = 6, L_NORM2R = 7, L_COMPACT = 8, L_UP = 9, L_DOWN = 10 };
struct Args { const float* in[NIN]; float* out; unsigned char* ws; int ph_lo, ph_hi, li, pad; };

__global__ void __launch_bounds__(NWAVES * 64, 2) mk_fwd(Args args) {
    extern __shared__ __attribute__((aligned(16))) unsigned char lds[];
    Frame F;
    F.lds = (LAS unsigned char*)lds;
    F.MISC = (volatile LAS unsigned*)(F.lds + MISC_OFF);
    F.tid = threadIdx.x; F.lane = F.tid & 63; F.wave = __builtin_amdgcn_readfirstlane(F.tid >> 6);
    F.G = gridDim.x; { const int bx = blockIdx.x; F.vcu = (F.G % 8 == 0) ? (bx % 8) * (F.G / 8) + bx / 8 : bx; }
    F.ws = args.ws; F.out = args.out; F.ctl = (gu32*)(args.ws + WS_CTL);
    for (int u = F.tid; u < (LDS_BYTES - LDSCTL_OFF) / 4; u += NWAVES * 64) ((LAS unsigned*)(F.lds + LDSCTL_OFF))[u] = 0u;
    __syncthreads();
    if (F.tid < NIN) ((LAS cfptr*)(F.lds + LDSCTL_OFF + 256))[F.tid] = args.in[F.tid];
    __syncthreads();
    XcdBarrier bar = xcd_barrier_post((unsigned*)(F.ctl + CW_BAR) + args.li * XCD_BAR_WORDS, F.MISC + 8);
    const int lo = args.ph_lo, hi = args.ph_hi;
    const int n2nd = (M / 256) * (D / 256) - (int)gridDim.x;
    const int idle_wk = (n2nd > 0 && n2nd < (int)gridDim.x) ? ((int)blockIdx.x >= n2nd ? (int)blockIdx.x - n2nd : -1) : (int)blockIdx.x, idle_n = (n2nd > 0 && n2nd < (int)gridDim.x) ? (int)gridDim.x - n2nd : (int)gridDim.x;
    const int nrep2 = 2 + args.pad;
#define IN(k) (lo <= (k) && (k) < hi)
#if TPROBE >= 0
#define TSTAMP(k) do { if (blockIdx.x == TPROBE_BLK && F.tid == 0) ((volatile LAS unsigned long long*)(F.lds + LDSCTL_OFF + 800))[(k) + 1] = __builtin_amdgcn_s_memrealtime(); } while (0)
#else
#define TSTAMP(k) do { } while (0)
#endif
#if TPROBE >= 300
#define TSTAMPX(slot, l_) do { if (F.tid == 0 && (l_) == 1) { const unsigned long long tn_ = __builtin_amdgcn_s_memrealtime(); if (blockIdx.x == TPROBE_BLK) ((volatile LAS unsigned long long*)(F.lds + LDSCTL_OFF + 800))[slot] = tn_; atomicMax((unsigned*)F.ctl + 200000 + 512, ((unsigned)tn_ << 8) | (unsigned)blockIdx.x); } } while (0)
#else
#define TSTAMPX(slot, l_) do { } while (0)
#endif
#define SEAM(k) do { if (IN(k) && IN((k) + 1)) { xcd_barrier(bar); if (REPMASK & (1 << 12)) xcd_barrier(bar); } TSTAMP(k); } while (0)
    TSTAMP(-1);

    if (IN(PH_P0)) p0_work(F, 0, P0_SPLIT ? 1 : DEPTH, F.vcu, F.G, 3, true);
    SEAM(PH_P0);
    if (IN(PH_P0B)) p0b_reduce(F, 0, P0_SPLIT ? 1 : DEPTH, F.vcu, F.G);
    SEAM(PH_P0B);
#define LAYER_PROGRAM(l) do { constexpr int pb = PH_L0 + PH_PER_LAYER * (l); \
        if (IN(pb + L_NORM1)) { ph_norm1<false>(F, (l)); if (REPMASK & (1 << L_NORM1)) ph_norm1<true>(F, (l)); } \
        SEAM(pb + L_NORM1); \
        if (IN(pb + L_INPROJ)) { if constexpr (FAST_INPROJ) { fast_inproj(F, (l)); if (REPMASK & (1 << L_INPROJ)) fast_inproj(F, (l)); } } \
        SEAM(pb + L_INPROJ); \
        if (IN(pb + L_POST)) { if constexpr (!FUSE_POST) { ph_post(F, (l)); if (REPMASK & (1 << L_POST)) ph_post(F, (l)); } } \
        if constexpr (!FUSE_POST) SEAM(pb + L_POST); \
        if (IN(pb + L_ATTN)) { if constexpr (FAST_ATTN) { _Pragma("nounroll") for (int rep_ = 0; rep_ < ((REPMASK & (1 << L_ATTN)) ? nrep2 : 1); ++rep_) fast_attn(F, (l)); } } \
        SEAM(pb + L_ATTN); \
        if (IN(pb + L_BR)) { if constexpr (FAST_BR) { _Pragma("nounroll") for (int rep_ = 0; rep_ < ((REPMASK & (1 << L_BR)) ? nrep2 : 1); ++rep_) fast_br(F, (l)); \
            if (P0_SPLIT && (l) == 0 && idle_wk >= 0) p0_work(F, 1, DEPTH, idle_wk, idle_n, 1, false); } } \
        SEAM(pb + L_BR); \
        if (IN(pb + L_GATE)) { if constexpr (!FUSE_GATE) ph_gate(F, (l)); } \
        if constexpr (!FUSE_GATE) SEAM(pb + L_GATE); \
        if (IN(pb + L_OUT)) { if constexpr (FAST_OUT) { if (REPMASK & (1 << L_OUT)) fast_out<true>(F, (l)); fast_out<false>(F, (l)); TSTAMPX(27, (l)); \
            if (P0_SPLIT && (l) == 0 && idle_wk >= 0) p0_work(F, 1, DEPTH, idle_wk, idle_n, 2, false); } } \
        SEAM(pb + L_OUT); \
        if (IN(pb + L_NORM2R)) { if (REPMASK & (1 << L_NORM2R)) ph_norm2_router<!FUSE_RES, true>(F, (l)); ph_norm2_router<!FUSE_RES, false>(F, (l)); } \
        SEAM(pb + L_NORM2R); \
        if (IN(pb + L_COMPACT)) { ph_compact(F, (l)); if (P0_SPLIT && (l) == 0 && F.vcu >= NE) p0b_reduce(F, 1, DEPTH, F.vcu - NE, F.G - NE); } \
        SEAM(pb + L_COMPACT); \
        if (IN(pb + L_UP)) { if constexpr (FAST_UP) { fast_moe_up(F, (l)); } } \
        SEAM(pb + L_UP); \
        if (IN(pb + L_DOWN)) { if constexpr (FAST_DOWN) { fast_moe_down(F, (l)); } } \
        SEAM(pb + L_DOWN); } while (0)
    LAYER_PROGRAM(0);
    LAYER_PROGRAM(1);
#undef LAYER_PROGRAM
    if (IN(PH_FINAL)) { ph_final(F); if (REPMASK & (1 << 11)) ph_final(F); }
#if TPROBE >= 0
    if (blockIdx.x == TPROBE_BLK && F.tid == 0) { volatile LAS unsigned long long* ts = (volatile LAS unsigned long long*)(F.lds + LDSCTL_OFF + 800);
        const unsigned long long dt = (TPROBE == 302) ? (unsigned long long)(((const unsigned*)F.ctl)[200000 + 512] & 255u) * 100ull : (TPROBE == 303) ? (unsigned long long)((((const unsigned*)F.ctl)[200000 + 512] >> 8) - (((unsigned)ts[18]) & 0xffffffu)) & 0xffffffull : (TPROBE == 300) ? ts[27] - ts[18] : (TPROBE == 301) ? ts[20] - ts[27] : (TPROBE >= 200) ? (unsigned long long)(((const unsigned*)F.ctl)[200000 + 64 * (TPROBE - 200)] - (unsigned)ts[0]) : (TPROBE >= 100) ? ts[26] : ts[(TPROBE_HI < 0 ? 0 : TPROBE_HI) + 1] - ts[TPROBE >= 100 ? 0 : TPROBE], t0 = __builtin_amdgcn_s_memrealtime();
        while (__builtin_amdgcn_s_memrealtime() - t0 < 4ull * dt) __builtin_amdgcn_s_sleep(8); }
#endif
#if CNTPROBE
    xcd_barrier(bar);
    if (blockIdx.x == 0) {
        const unsigned* cnt = (const unsigned*)F.ctl + CW_CNT + (CNTPROBE_L) * 64; unsigned mx = 0, mn = 1u << 30, big = 0, big2 = 0;
        for (int e = 0; e < NE; ++e) { const unsigned c = cnt[e]; mx = c > mx ? c : mx; mn = c < mn ? c : mn; big += c > 384 ? 1 : 0; big2 += c > 512 ? 1 : 0; }
        const float val = CNTPROBE == 1 ? (float)mx : CNTPROBE == 2 ? (float)big : CNTPROBE == 3 ? (float)mn : (float)big2;
        const float c1 = sqrtf(val);
        for (size_t i = F.tid; i < (size_t)NB * SEQ * D; i += NWAVES * 64) F.out[i] = c1;
    }
#endif
#undef IN
#undef SEAM
}

static bool phase_is_naive(int ph) {
    if (ph < PH_L0 || ph == PH_FINAL) return false;
    const int k = (ph - PH_L0) % PH_PER_LAYER;
    switch (k) { case L_INPROJ: return !FAST_INPROJ; case L_ATTN: return !FAST_ATTN; case L_BR: return !FAST_BR; case L_OUT: return !FAST_OUT; case L_UP: return !FAST_UP; case L_DOWN: return !FAST_DOWN; default: return false; }
}
extern "C" void kernel_launch(void* const* d_in, const int* in_sizes, int n_in, void* d_out, int out_size, void* d_ws, size_t ws_size, hipStream_t stream) {
    static int grid = 0;
    if (grid == 0) {
        if (n_in != NIN || in_sizes[0] != NB * SEQ * D || out_size != NB * SEQ * D || ws_size < WS_END) { fprintf(stderr, "kernel_launch: shape/workspace mismatch (n_in %d, ws %zu)\n", n_in, ws_size); grid = -1; return; }
        int dev = 0, cus = 0, per_cu = 0;
        if (hipGetDevice(&dev) != hipSuccess || hipDeviceGetAttribute(&cus, hipDeviceAttributeMultiprocessorCount, dev) != hipSuccess) { grid = -1; return; }
        if (hipFuncSetAttribute((const void*)mk_fwd, hipFuncAttributeMaxDynamicSharedMemorySize, LDS_BYTES) != hipSuccess) { fprintf(stderr, "kernel_launch: hipFuncSetAttribute failed\n"); grid = -1; return; }
        if (hipOccupancyMaxActiveBlocksPerMultiprocessor(&per_cu, (const void*)mk_fwd, NWAVES * 64, LDS_BYTES) != hipSuccess || per_cu < 1) fprintf(stderr, "kernel_launch: occupancy query reports %d\n", per_cu);
        (void)hipGetLastError();
        grid = cus;
    }
    if (grid < 0) return;
    unsigned char* ws = (unsigned char*)d_ws;
    (void)hipMemsetAsync(ws + WS_CTL, 0, CTL_ZERO_BYTES, stream);
    Args a{};
    for (int i = 0; i < NIN; ++i) a.in[i] = (const float*)d_in[i];
    a.out = (float*)d_out; a.ws = ws;
    const float* const* in = (const float* const*)d_in;
    int li = 0, lo = -1;
    for (int ph = 0; ph < NPH; ++ph) {
        const bool nv = phase_is_naive(ph);
        if (!nv && lo < 0) lo = ph;
        if (nv || ph == NPH - 1) {
            if (lo >= 0) { a.ph_lo = lo; a.ph_hi = nv ? ph : ph + 1; a.li = li++; hipLaunchKernelGGL(mk_fwd, dim3(grid), dim3(NWAVES * 64), LDS_BYTES, stream, a); lo = -1; }
            if (nv) {
                const int l = (ph - PH_L0) / PH_PER_LAYER, k = (ph - PH_L0) % PH_PER_LAYER;
                const unsigned* cnt = (const unsigned*)ws + CW_CNT + l * 64;
                if (k == L_INPROJ) hipLaunchKernelGGL(naive_gemm<1>, dim3(INC / 64, M / 32), dim3(64, 4), 0, stream, (const bf16*)(ws + WS_HA), D, in[IN_WIN] + (size_t)l * D * INC, INC, (float*)(ws + WS_P), INC, D);
                else if (k == L_ATTN) { const int wq = (l < DEPTH - 1) ? 1 : 0; const long items = (long)NB * NH * (wq ? TT : SEQ);
                    hipLaunchKernelGGL(naive_attn, dim3((unsigned)((items + 3) / 4)), dim3(256), 0, stream, (const bf16*)(ws + WS_QA), (const bf16*)(ws + WS_KA), (const bf16*)(ws + WS_VA), (bf16*)(ws + WS_YAB), (const float*)nullptr, 0, wq);
                    hipLaunchKernelGGL(naive_attn, dim3((unsigned)((items + 3) / 4)), dim3(256), 0, stream, (const bf16*)(ws + WS_QB), (const bf16*)(ws + WS_KB), (const bf16*)(ws + WS_VB), (bf16*)(ws + WS_YAB) + QW, in[IN_SINK] + l * NH, 1, wq); }
                else if (k == L_BR) { hipLaunchKernelGGL(naive_gemm<0>, dim3(D / 64, M / 32), dim3(64, 4), 0, stream, (const bf16*)(ws + WS_YAB), D, in[IN_WBRA] + (size_t)l * QW * D, D, (float*)(ws + WS_T1), D, QW);
                    hipLaunchKernelGGL(naive_gemm<0>, dim3(D / 64, M / 32), dim3(64, 4), 0, stream, (const bf16*)(ws + WS_YAB) + QW, D, in[IN_WBRB] + (size_t)l * QW * D, D, (float*)(ws + WS_T2), D, QW); }
                else if (k == L_OUT) hipLaunchKernelGGL(naive_gemm<0>, dim3(D / 64, M / 32), dim3(64, 4), 0, stream, (const bf16*)(ws + WS_MB), D, in[IN_WOUT] + (size_t)l * D * D, D, (float*)(ws + WS_T3), D, D);
                else if (k == L_UP) hipLaunchKernelGGL(naive_moe_up, dim3(DE / 64, 2 * M / 4), dim3(64, 4), 0, stream, (const bf16*)(ws + WS_HA), in[IN_W1] + (size_t)l * NE * D * DE, in[IN_W3] + (size_t)l * NE * D * DE, cnt, (const unsigned*)(ws + WS_LIST) + (size_t)l * NE * M, (bf16*)(ws + WS_HB));
                else if (k == L_DOWN) hipLaunchKernelGGL(naive_moe_down, dim3(D / 64, 2 * M / 4), dim3(64, 4), 0, stream, (const bf16*)(ws + WS_HB), in[IN_W2] + (size_t)l * NE * DE * D, cnt, (bf16*)(ws + WS_YM));
            }
        }
    }
    const hipError_t le = hipPeekAtLastError();
    if (le != hipSuccess) fprintf(stderr, "kernel_launch: launch failed: %s\n", hipGetErrorName(le));
}
```

```cpp
#include <hip/hip_runtime.h>
#include <cstdio>
#include <cstdint>

constexpr int D = 2048, NB = 4, SEQ = 2048, CTX = 256, TT = CTX + SEQ, M = NB * TT, DEPTH = 2;
constexpr int HD = 128, NH = 8, NKV = 2, GRIDW = 64;
constexpr int QW = NH * HD, KW = NKV * HD;
constexpr int INC = 2 * QW + 4 * KW + 2 * D;
constexpr int OFF_QA = 0, OFF_KA = 1024, OFF_VA = 1280, OFF_QB = 1536, OFF_KB = 2560, OFF_VB = 2816, OFF_GA = 3072, OFF_GB = 5120;
constexpr int NE = 64, NG = 8, EPG = 8, DE = 512;
constexpr float EPS = 1e-6f;
constexpr float ATTN_SCALE = 0.08838834764831845f;
constexpr int MODW = 6 * D;
constexpr int NIN = 23;

__host__ __device__ __forceinline__ int perm_d2j(int d) { return 32 * (2 * (d >> 6) + ((d >> 4) & 1)) + 16 * ((d >> 5) & 1) + (d & 15); }
__host__ __device__ __forceinline__ int perm_j2d(int j) { const int wc = j >> 5, n = (j >> 4) & 1, t = j & 15; return 64 * (wc >> 1) + 32 * n + 16 * (wc & 1) + t; }
__host__ __device__ __forceinline__ bool inproj_roped(int c) { return (c < OFF_VA) || (c >= OFF_QB && c < OFF_VB); }
__host__ __device__ __forceinline__ int inproj_src_col(int c) { return inproj_roped(c) ? (c & ~127) + perm_j2d(c & 127) : c; }
__host__ __device__ __forceinline__ int inproj_dst_col(int n) { return inproj_roped(n) ? (n & ~127) + perm_d2j(n & 127) : n; }

constexpr size_t MiB = 1u << 20;
constexpr size_t WS_CTL = 0, CTL_ZERO_BYTES = 1 * MiB;
constexpr size_t WS_MOD = 1 * MiB;
constexpr size_t WS_ROPE = 1 * MiB + 512 * 1024;
constexpr size_t WS_TOK = 2 * MiB;
constexpr size_t WS_LIST = 3 * MiB;
constexpr size_t WS_WIN = 8 * MiB;
constexpr size_t WS_WBR = 64 * MiB;
constexpr size_t WS_WOUT = 80 * MiB;
constexpr size_t WS_XW = 96 * MiB;
constexpr size_t WS_HA = 168 * MiB;
constexpr size_t WS_QA = 204 * MiB, WS_KA = 222 * MiB, WS_VA = 227 * MiB, WS_QB = 232 * MiB, WS_KB = 250 * MiB, WS_VB = 255 * MiB;
constexpr size_t WS_GA = 260 * MiB, WS_GB = 296 * MiB;
constexpr size_t WS_YAB = 332 * MiB;
constexpr size_t WS_MB = 368 * MiB;
constexpr size_t WS_HB = 404 * MiB;
constexpr size_t WS_YM = 424 * MiB;
constexpr size_t WS_P = 496 * MiB;
constexpr size_t WS_MODP = 964 * MiB;
constexpr size_t WS_WR = 740 * MiB;
constexpr size_t WS_T1 = 748 * MiB, WS_T2 = 820 * MiB, WS_T3 = 892 * MiB;
constexpr size_t WS_END = 996 * MiB;
constexpr int CW_TMO = 0, CW_CODE = 1;
constexpr int CW_BAR = 4096;
constexpr int CW_CNT = 131072;
constexpr int MAX_LAUNCH = 32;

constexpr int RING_OFF = 0, RING_BYTES = 131072;
constexpr int XS_OFF = 131072, XS_BYTES = 16384;
constexpr int LDSCTL_OFF = 162816, MISC_OFF = LDSCTL_OFF;
constexpr int LDS_BYTES = 163840;
constexpr int NWAVES = 8;
constexpr bool FAST_INPROJ = true, FAST_ATTN = true, FAST_BR = true, FAST_OUT = true, FAST_UP = true, FAST_DOWN = true;
constexpr bool FUSE_POST = true, FUSE_GATE = true, FUSE_RES = true, GATE_MIDK = true, P0_SPLIT = true, REDEAL = true, X0_DIRECT = true;
#ifndef REPMASK
#define REPMASK 0
#endif
#ifndef CNTPROBE
#define CNTPROBE 0
#define CNTPROBE_L 0
#endif
#ifndef MOEVAR
#define MOEVAR 0
#endif
#ifndef TPROBE
#define TPROBE -1
#define TPROBE_HI -1
#endif
#ifndef TPROBE_BLK
#define TPROBE_BLK 0
#endif
namespace pg8 {
#define PG8_LAS __attribute__((address_space(3)))
typedef unsigned short bf16_t;
typedef short bf16x8 __attribute__((ext_vector_type(8)));
typedef float f32x4 __attribute__((ext_vector_type(4)));
typedef unsigned u32x4 __attribute__((ext_vector_type(4)));
constexpr int BM = 256, BK = 64, HALF = 128, HTB = HALF * BK * 2  , STAGE_BYTES = 8 * HTB, NXCD = 8, WGM = 8;

__host__ __device__ __forceinline__ int lds_byte(int r, int c) { const int st = (r >> 4) * 2 + (c >> 5), rr = r & 15, cc = c & 31, ob = rr * 64 + cc * 2; return st * 1024 + (ob ^ (((ob >> 9) & 1) << 5)); }
__host__ __device__ __forceinline__ void stage_rc(int b, int& R, int& C) { const int st = b / 1024, sb = b % 1024, swz = sb ^ (((sb >> 9) & 1) << 5); R = (st >> 1) * 16 + swz / 64; C = (st & 1) * 32 + (swz % 64) / 2; }
__host__ __device__ __forceinline__ int perm32(int rho) { const int n = rho >> 4, i = rho & 15; return 8 * (i >> 2) + 4 * n + (i & 3); }

struct Unit { int pm, pn; };
struct Gemm { const bf16_t* A; const bf16_t* Bt; int M, N, K, lda, ldb; };

struct StaticOrder {
    int nM, nN, nwg, G, c;
    __host__ __device__ void init(int M, int N, int G_, int c_) { nM = M / BM; nN = N / BM; nwg = nM * nN; G = G_; c = c_; }
    __host__ __device__ bool next(int i, Unit& u) const {
        const long L = (long)i * G + c; if (L >= nwg) return false;
        int wgid = (int)L; { const int q = nwg / NXCD, r = nwg % NXCD, xcd = wgid % NXCD, off = wgid / NXCD; wgid = (xcd < r ? xcd * (q + 1) : r * (q + 1) + (xcd - r) * q) + off; }
        const int nig = WGM * nN, gid = wgid / nig, fm = gid * WGM, gsz = (nM - fm) < WGM ? (nM - fm) : WGM;
        u.pm = fm + ((wgid % nig) % gsz); u.pn = (wgid % nig) / gsz; return true;
    }
    __device__ __forceinline__ void a_ready(const Unit&) const {}
    __device__ __forceinline__ void done(const Unit&) const {}
};

__device__ __forceinline__ unsigned cvt_pk_bf16(float lo, float hi) { unsigned r; asm volatile("v_cvt_pk_bf16_f32 %0, %1, %2" : "=v"(r) : "v"(lo), "v"(hi)); return r; }
typedef float f32x2 __attribute__((ext_vector_type(2)));
__device__ __forceinline__ f32x2 gelu_pk(f32x2 v) {
    const f32x2 av = __builtin_elementwise_abs(v), d = av * 0.2316418882f + 1.0f;
    f32x2 t; t.x = __builtin_amdgcn_rcpf(d.x); t.y = __builtin_amdgcn_rcpf(d.y);
    f32x2 q = t * 0.5307027145f + (-0.7265760135f); q = q * t + 0.7107068705f; q = q * t + (-0.142248368f); q = q * t + 0.127414796f; q = q * t;
    const f32x2 s = (v * v) * (-0.72134752044f);
    f32x2 e; e.x = __builtin_amdgcn_exp2f(s.x); e.y = __builtin_amdgcn_exp2f(s.y);
    const f32x2 m = v * (q * e), r = v - m;
    f32x2 o; o.x = v.x < 0.f ? m.x : r.x; o.y = v.y < 0.f ? m.y : r.y; return o;
}

template <int ACT  > struct EpiBf16 {
    static constexpr int MIDK = 0; static constexpr bool PERM = true, AFTER_DRAIN = false; static_assert(ACT == 0 || ACT == 1, "EpiBf16: ACT is 0 (none) or 1 (gelu_pk)");
    bf16_t* O; int ldc; const float* bias; int split_cols; size_t split_stride; float scale0;
    __device__ __forceinline__ void operator()(const f32x4 (&acc)[2][2][4][2], const Unit& u, int wr, int wc, int fr, int fq) const {
        const int row0 = u.pm * BM + wr * 64 + fr; int colt = u.pn * BM; bf16_t* base = O;
        float sc = 1.f; if (split_cols) { const int t = colt / split_cols; base += (size_t)t * split_stride; colt -= t * split_cols; if (t == 0) sc = scale0; }
        const int col0 = colt + wc * 32 + 8 * fq, bcol0 = u.pn * BM + wc * 32 + 8 * fq;
        f32x4 bv[2][2];
#pragma unroll
        for (int bj = 0; bj < 2; ++bj)
#pragma unroll
            for (int n = 0; n < 2; ++n) bv[bj][n] = bias ? *(const f32x4*)(bias + bcol0 + bj * HALF + 4 * n) : (f32x4){0.f, 0.f, 0.f, 0.f};
#pragma unroll
        for (int ai = 0; ai < 2; ++ai)
#pragma unroll
            for (int m = 0; m < 4; ++m) { bf16_t* rowp = base + (size_t)(row0 + ai * HALF + m * 16) * ldc + col0;
#pragma unroll
                for (int bj = 0; bj < 2; ++bj) { f32x4 v0 = acc[ai][bj][m][0] + bv[bj][0], v1 = acc[ai][bj][m][1] + bv[bj][1];
                    if (ACT == 1) { f32x2 a = gelu_pk((f32x2){v0[0], v0[1]}), b = gelu_pk((f32x2){v0[2], v0[3]}), c = gelu_pk((f32x2){v1[0], v1[1]}), d = gelu_pk((f32x2){v1[2], v1[3]});
                        v0 = (f32x4){a.x, a.y, b.x, b.y}; v1 = (f32x4){c.x, c.y, d.x, d.y}; }
                    v0 = v0 * sc; v1 = v1 * sc; u32x4 w; w.x = cvt_pk_bf16(v0[0], v0[1]); w.y = cvt_pk_bf16(v0[2], v0[3]); w.z = cvt_pk_bf16(v1[0], v1[1]); w.w = cvt_pk_bf16(v1[2], v1[3]);
                    *(u32x4*)(rowp + bj * HALF) = w; } }
    }
};

struct PanelStats {
    unsigned* xbuf;
    unsigned* cnt;
    unsigned* tmo;
    int ntn; float eps;
    unsigned code;
    __device__ __forceinline__ bool run(const f32x4 (&v)[2][2][4][2], const Unit& u, int wr, int wc, int fr, int fq, PG8_LAS unsigned char* lds, int wid, int lane) const {
        typedef float f32x2v __attribute__((ext_vector_type(2)));
        PG8_LAS f32x2v* P = (PG8_LAS f32x2v*)lds;
        PG8_LAS f32x2v* S = (PG8_LAS f32x2v*)(lds + 8192);
        PG8_LAS unsigned* flag = (PG8_LAS unsigned*)(lds + 8192 + 2048);
#pragma unroll
        for (int ai = 0; ai < 2; ++ai)
#pragma unroll
            for (int m = 0; m < 4; ++m) {
                float s = 0.f;
#pragma unroll
                for (int bj = 0; bj < 2; ++bj)
#pragma unroll
                    for (int n = 0; n < 2; ++n) { const f32x4 x = v[ai][bj][m][n]; s += (x[0] + x[1]) + (x[2] + x[3]); }
                s += __shfl_xor(s, 16); s += __shfl_xor(s, 32);
                const float mw = s * (1.0f / 64.0f); float q = 0.f;
#pragma unroll
                for (int bj = 0; bj < 2; ++bj)
#pragma unroll
                    for (int n = 0; n < 2; ++n) { const f32x4 d = v[ai][bj][m][n] - mw; q += (d[0] * d[0] + d[1] * d[1]) + (d[2] * d[2] + d[3] * d[3]); }
                q += __shfl_xor(q, 16); q += __shfl_xor(q, 32);
                if (fq == 0) P[(ai * HALF + wr * 64 + m * 16 + fr) * 4 + wc] = (f32x2v){mw, q};
            }
        asm volatile("s_waitcnt lgkmcnt(0)" ::: "memory"); __builtin_amdgcn_s_barrier(); asm volatile("" ::: "memory");
#if defined(BROKEN_EXCHANGE_NO_WAIT)
#warning BROKEN CONTROL BUILD: the row-statistics exchange does not wait; results are wrong by design
        if (blockIdx.x >= 64) { const long long t0_ = clock64(); while (clock64() - t0_ < 60000) __builtin_amdgcn_s_sleep(8); }
#endif
        const int row = wid * 32 + (lane & 31);
        if (lane < 32) {
            const f32x2v a = P[row * 4 + 0], b = P[row * 4 + 1], c = P[row * 4 + 2], d = P[row * 4 + 3];
            const float mt = (a.x + b.x + c.x + d.x) * 0.25f;
            const float da = a.x - mt, db = b.x - mt, dc = c.x - mt, dd = d.x - mt;
            const float m2 = (a.y + b.y) + (c.y + d.y) + 64.0f * ((da * da + db * db) + (dc * dc + dd * dd));
            unsigned long long* slot = (unsigned long long*)xbuf + ((size_t)(u.pm * BM + row) * 4 + u.pn);
            __hip_atomic_store(slot, ((unsigned long long)__float_as_uint(m2) << 32) | __float_as_uint(mt), __ATOMIC_RELAXED, __HIP_MEMORY_SCOPE_AGENT);
        }
        asm volatile("s_waitcnt vmcnt(0)" ::: "memory");
        if (lane == 0) __hip_atomic_fetch_add(cnt + 64 * u.pm, 1u, __ATOMIC_RELAXED, __HIP_MEMORY_SCOPE_AGENT);
        if (wid == 0) {
            bool dead = false; const unsigned long long t0 = __builtin_amdgcn_s_memrealtime(); const unsigned want = 8u * (unsigned)ntn;
            for (;;) {
#if defined(BROKEN_EXCHANGE_NO_WAIT)
                break;
#endif
                if ((unsigned)__builtin_amdgcn_readfirstlane(__hip_atomic_load(cnt + 64 * u.pm, __ATOMIC_RELAXED, __HIP_MEMORY_SCOPE_AGENT)) >= want) break;
                if (__builtin_amdgcn_s_memrealtime() - t0 > 2000000ull) {
                    if (lane == 0) { unsigned expect = 0u; __hip_atomic_compare_exchange_strong(tmo + 1, &expect, code | (unsigned)(u.pm & 0xff), __ATOMIC_RELAXED, __ATOMIC_RELAXED, __HIP_MEMORY_SCOPE_AGENT);
                                     __hip_atomic_store(tmo, 1u, __ATOMIC_RELAXED, __HIP_MEMORY_SCOPE_AGENT); }
                    dead = true; break; }
                __builtin_amdgcn_s_sleep(2);
            }
            __builtin_amdgcn_fence(__ATOMIC_ACQUIRE, "agent");
            if (lane == 0) flag[0] = dead ? 1u : 0u;
        }
        asm volatile("s_waitcnt vmcnt(0) lgkmcnt(0)" ::: "memory"); __builtin_amdgcn_s_barrier(); asm volatile("" ::: "memory");
        const bool bad = flag[0] != 0u;
        if (lane < 32) {
            const unsigned long long* slot = (const unsigned long long*)xbuf + (size_t)(u.pm * BM + row) * 4; float mt[4], m2[4]; float ms = 0.f;
#pragma unroll
            for (int t = 0; t < 4; ++t) { if (t < ntn) { const unsigned long long w = __hip_atomic_load(slot + t, __ATOMIC_RELAXED, __HIP_MEMORY_SCOPE_AGENT); mt[t] = __uint_as_float((unsigned)w); m2[t] = __uint_as_float((unsigned)(w >> 32)); } else { mt[t] = 0.f; m2[t] = 0.f; } ms += mt[t]; }
            const float mean = ms / (float)ntn; float q = 0.f;
#pragma unroll
            for (int t = 0; t < 4; ++t) if (t < ntn) { const float dm = mt[t] - mean; q += m2[t] + 256.0f * dm * dm; }
            S[row] = (f32x2v){mean, 1.0f / sqrtf(q / (256.0f * (float)ntn) + eps)};
        }
        asm volatile("s_waitcnt lgkmcnt(0)" ::: "memory"); __builtin_amdgcn_s_barrier(); asm volatile("" ::: "memory");
        return bad;
    }
};
struct EpiLnRes {
    static constexpr int MIDK = 0; static constexpr bool PERM = false, AFTER_DRAIN = true;
    const float* base; float* out; int ldc; const float* bias; PanelStats st; unsigned poison;
    __device__ __forceinline__ void fused(f32x4 (&acc)[2][2][4][2], const Unit& u, int wr, int wc, int fr, int fq, PG8_LAS unsigned char* lds, int wid, int lane) const {
        typedef float f32x2v __attribute__((ext_vector_type(2)));
        const PG8_LAS f32x2v* S = (const PG8_LAS f32x2v*)(lds + 8192);
        const int col0 = u.pn * BM + wc * 32 + 4 * fq;
#pragma unroll
        for (int bj = 0; bj < 2; ++bj)
#pragma unroll
            for (int n = 0; n < 2; ++n) { const f32x4 bv = bias ? *(const f32x4*)(bias + col0 + bj * HALF + n * 16) : (f32x4){0.f, 0.f, 0.f, 0.f};
#pragma unroll
                for (int ai = 0; ai < 2; ++ai)
#pragma unroll
                    for (int m = 0; m < 4; ++m) acc[ai][bj][m][n] += bv; }
        f32x4 pre[4][2][2];
#pragma unroll
        for (int m = 0; m < 4; ++m) { const size_t off = (size_t)(u.pm * BM + wr * 64 + m * 16 + fr) * ldc + col0;
#pragma unroll
            for (int bj = 0; bj < 2; ++bj)
#pragma unroll
                for (int n = 0; n < 2; ++n) pre[m][bj][n] = *(const f32x4*)(base + off + bj * HALF + n * 16); }
        const bool bad = st.run(acc, u, wr, wc, fr, fq, lds, wid, lane) || poison != 0u;
        const float qnan = __builtin_nanf("");
#pragma unroll
        for (int ai = 0; ai < 2; ++ai)
#pragma unroll
            for (int m = 0; m < 4; ++m) { const int r = ai * HALF + wr * 64 + m * 16 + fr; const f32x2v sr = S[r]; const size_t off = (size_t)(u.pm * BM + r) * ldc + col0;
#pragma unroll
                for (int bj = 0; bj < 2; ++bj)
#pragma unroll
                    for (int n = 0; n < 2; ++n) { const f32x4 bs = ai == 0 ? pre[m][bj][n] : *(const f32x4*)(base + off + bj * HALF + n * 16); f32x4 o = bs + (acc[ai][bj][m][n] - sr.x) * sr.y;
                        if (bad) o = (f32x4){qnan, qnan, qnan, qnan}; *(f32x4*)(out + off + bj * HALF + n * 16) = o; }
                if (m & 1) asm volatile("" ::: "memory"); }
    }
};
struct EpiLnResLn {
    static constexpr int MIDK = 0; static constexpr bool PERM = false, AFTER_DRAIN = true;
    const float* base; float* out; bf16_t* xn; int ldc; const float* bias; PanelStats st1, st2; unsigned poison;
    __device__ __forceinline__ void fused(f32x4 (&acc)[2][2][4][2], const Unit& u, int wr, int wc, int fr, int fq, PG8_LAS unsigned char* lds, int wid, int lane) const {
        typedef float f32x2v __attribute__((ext_vector_type(2))); typedef unsigned u32x2v __attribute__((ext_vector_type(2)));
        const PG8_LAS f32x2v* S = (const PG8_LAS f32x2v*)(lds + 8192);
        const int col0 = u.pn * BM + wc * 32 + 4 * fq;
#pragma unroll
        for (int bj = 0; bj < 2; ++bj)
#pragma unroll
            for (int n = 0; n < 2; ++n) { const f32x4 bv = bias ? *(const f32x4*)(bias + col0 + bj * HALF + n * 16) : (f32x4){0.f, 0.f, 0.f, 0.f};
#pragma unroll
                for (int ai = 0; ai < 2; ++ai)
#pragma unroll
                    for (int m = 0; m < 4; ++m) acc[ai][bj][m][n] += bv; }
        bool bad = st1.run(acc, u, wr, wc, fr, fq, lds, wid, lane) || poison != 0u;
        const float qnan = __builtin_nanf("");
#pragma unroll
        for (int ai = 0; ai < 2; ++ai)
#pragma unroll
            for (int m = 0; m < 4; ++m) { const int r = ai * HALF + wr * 64 + m * 16 + fr; const f32x2v sr = S[r]; const size_t off = (size_t)(u.pm * BM + r) * ldc + col0;
#pragma unroll
                for (int bj = 0; bj < 2; ++bj)
#pragma unroll
                    for (int n = 0; n < 2; ++n) { const f32x4 bs = *(const f32x4*)(base + off + bj * HALF + n * 16); acc[ai][bj][m][n] = bs + (acc[ai][bj][m][n] - sr.x) * sr.y; }
                asm volatile("" : "+v"(acc[ai][0][m][0]), "+v"(acc[ai][0][m][1]), "+v"(acc[ai][1][m][0]), "+v"(acc[ai][1][m][1]));
                if (m & 1) asm volatile("" ::: "memory"); }
        const bool bad1 = bad;
        bad = st2.run(acc, u, wr, wc, fr, fq, lds, wid, lane) || bad;
#pragma unroll
        for (int ai = 0; ai < 2; ++ai)
#pragma unroll
            for (int m = 0; m < 4; ++m) { const int r = ai * HALF + wr * 64 + m * 16 + fr; const f32x2v sr = S[r]; const size_t off = (size_t)(u.pm * BM + r) * ldc + col0;
#pragma unroll
                for (int bj = 0; bj < 2; ++bj)
#pragma unroll
                    for (int n = 0; n < 2; ++n) { const f32x4 x1 = acc[ai][bj][m][n]; *(f32x4*)(out + off + bj * HALF + n * 16) = bad1 ? (f32x4){qnan, qnan, qnan, qnan} : x1;
                        const f32x4 o = (x1 - sr.x) * sr.y; u32x2v w; w.x = cvt_pk_bf16(o[0], o[1]); w.y = cvt_pk_bf16(o[2], o[3]);
                        if (bad) { w.x = 0x7fc07fc0u; w.y = 0x7fc07fc0u; } *(u32x2v*)(xn + off + bj * HALF + n * 16) = w; }
                asm volatile("" ::: "memory"); }
    }
};

template <class Epi, class Sched, bool ALIGN_EPI = false, bool SP2 = false>
__device__ __forceinline__ void gemm_phase(PG8_LAS unsigned char* lds, const Gemm g, const Sched& S, const Epi& E) {
    const int tid = threadIdx.x, wid = __builtin_amdgcn_readfirstlane(tid >> 6), lane = tid & 63, wr = wid >> 2, wc = wid & 3, fr = lane & 15, fq = lane >> 4;
    const int K = g.K, nt = K / BK;
    unsigned voffA[2], voffB[2];
#pragma unroll
    for (int i = 0; i < 2; ++i) { int R, C; stage_rc(tid * 16 + i * 8192, R, C); const int Rb = Epi::PERM ? ((R & ~31) + perm32(R & 31)) : R;
        voffA[i] = (unsigned)(R * g.lda + C) * 2u; voffB[i] = (unsigned)(Rb * g.ldb + C) * 2u; }
    const size_t kstep = (size_t)(BK * 2);
    const size_t hstepA = (size_t)HALF * g.lda * 2, hstepB = (size_t)HALF * g.ldb * 2;
    const size_t tstepA = 2 * hstepA, tstepB = 2 * hstepB;
    const unsigned ldsw = (unsigned)wid * 1024u;
    const int aoff = lds_byte(wr * 64 + fr, fq * 8), boff = lds_byte(wc * 32 + fr, fq * 8);
#define PG8_SA(b, h) (((b) * 2 + (h)) * HTB)
#define PG8_SB(b, h) ((4 + (b) * 2 + (h)) * HTB)
#define PG8_STAGE(bufoff, gbase, voff) do { _Pragma("unroll") for (int _i = 0; _i < 2; ++_i) \
        __builtin_amdgcn_global_load_lds((const unsigned*)((const char*)(gbase) + (voff)[_i]), (PG8_LAS unsigned*)(lds + (bufoff) + ldsw + _i * 8192), 16, 0, 0); } while (0)
#define PG8_LDA(dst, b, h) do { _Pragma("unroll") for (int m = 0; m < 4; ++m) _Pragma("unroll") for (int k = 0; k < 2; ++k) dst[m][k] = *(const PG8_LAS bf16x8*)(lds + PG8_SA(b, h) + aoff + m * 2048 + k * 1024); } while (0)
#define PG8_LDB(dst, b, h) do { _Pragma("unroll") for (int n = 0; n < 2; ++n) _Pragma("unroll") for (int k = 0; k < 2; ++k) dst[n][k] = *(const PG8_LAS bf16x8*)(lds + PG8_SB(b, h) + boff + n * 2048 + k * 1024); } while (0)
#define PG8_MMA(ai, bj, At, Bt) do { __builtin_amdgcn_s_setprio(1); _Pragma("unroll") for (int m = 0; m < 4; ++m) _Pragma("unroll") for (int n = 0; n < 2; ++n) _Pragma("unroll") for (int k = 0; k < 2; ++k) \
        acc[ai][bj][m][n] = __builtin_amdgcn_mfma_f32_16x16x32_bf16(Bt[n][k], At[m][k], acc[ai][bj][m][n], 0, 0, 0); __builtin_amdgcn_s_setprio(0); } while (0)
#define PG8_WAIT_V(n) asm volatile("s_waitcnt vmcnt(" #n ")" ::: "memory")
#define PG8_WAIT_L(n) asm volatile("s_waitcnt lgkmcnt(" #n ")" ::: "memory")
#define PG8_BAR __builtin_amdgcn_s_barrier()
#define PG8_SCHED __builtin_amdgcn_sched_barrier(0)
    Unit cur, nxt; int ui = 0;
    if (!S.next(0, cur)) return;
    f32x4 acc[2][2][4][2];
#pragma unroll
    for (int a = 0; a < 2; ++a)
#pragma unroll
        for (int b = 0; b < 2; ++b)
#pragma unroll
            for (int m = 0; m < 4; ++m)
#pragma unroll
                for (int n = 0; n < 2; ++n) acc[a][b][m][n] = (f32x4){0.f, 0.f, 0.f, 0.f};
    bf16x8 At[4][2], B0[2][2], B1[2][2];
    const char* cA = (const char*)g.A + (size_t)cur.pm * tstepA; const char* cB = (const char*)g.Bt + (size_t)cur.pn * tstepB;
    S.a_ready(cur);
    if constexpr (SP2) {
        PG8_STAGE(PG8_SB(0, 0), cB, voffB); PG8_STAGE(PG8_SB(0, 1), cB + hstepB, voffB); PG8_STAGE(PG8_SA(0, 0), cA, voffA); PG8_STAGE(PG8_SA(0, 1), cA + hstepA, voffA);
        if (wr == 1) PG8_BAR;
        PG8_WAIT_V(2); PG8_BAR;
        PG8_STAGE(PG8_SB(1, 0), cB + kstep, voffB); PG8_STAGE(PG8_SA(1, 0), cA + kstep, voffA); PG8_STAGE(PG8_SB(1, 1), cB + hstepB + kstep, voffB);
        PG8_WAIT_V(6); PG8_BAR;
    } else {
        PG8_STAGE(PG8_SB(0, 0), cB, voffB); PG8_STAGE(PG8_SA(0, 0), cA, voffA); PG8_STAGE(PG8_SB(0, 1), cB + hstepB, voffB); PG8_STAGE(PG8_SA(0, 1), cA + hstepA, voffA);
        if (wr == 1) PG8_BAR;
        PG8_WAIT_V(4); PG8_BAR;
        PG8_STAGE(PG8_SB(1, 0), cB + kstep, voffB); PG8_STAGE(PG8_SA(1, 0), cA + kstep, voffA); PG8_STAGE(PG8_SB(1, 1), cB + hstepB + kstep, voffB);
        PG8_WAIT_V(6); PG8_BAR;
    }
    for (;;) {
        const bool has_next = S.next(ui + 1, nxt);
        const char* nA = has_next ? (const char*)g.A + (size_t)nxt.pm * tstepA : cA; const char* nB = has_next ? (const char*)g.Bt + (size_t)nxt.pn * tstepB : cB;
        for (int t = 0; t < nt; t += 2) {
            if constexpr (Epi::MIDK > 0) { if (t == Epi::MIDK) E.mid(acc, cur, wr, wc, fr, fq); }
            const bool last = (t == nt - 2);
            const char* a1 = cA + (size_t)(t + 1) * kstep;
            const char* a2 = last ? nA : cA + (size_t)(t + 2) * kstep; const char* b2 = last ? nB : cB + (size_t)(t + 2) * kstep;
            const char* a3 = a2 + kstep; const char* b3 = b2 + kstep;
            if (last && has_next) S.a_ready(nxt);
            if constexpr (SP2) {
            PG8_LDB(B0, 0, 0); PG8_LDB(B1, 0, 1); PG8_SCHED; PG8_LDA(At, 0, 0); PG8_STAGE(PG8_SA(1, 1), a1 + hstepA, voffA);
            PG8_WAIT_V(8); PG8_WAIT_L(0); PG8_BAR; PG8_MMA(0, 0, At, B0); PG8_MMA(0, 1, At, B1); PG8_BAR; PG8_SCHED;
            PG8_LDA(At, 0, 1); PG8_STAGE(PG8_SB(0, 0), b2, voffB); PG8_STAGE(PG8_SB(0, 1), b2 + hstepB, voffB); PG8_STAGE(PG8_SA(0, 0), a2, voffA);
            PG8_WAIT_V(8); PG8_WAIT_L(0); PG8_BAR; PG8_MMA(1, 0, At, B0); PG8_MMA(1, 1, At, B1); PG8_BAR; PG8_SCHED;
            PG8_LDB(B0, 1, 0); PG8_LDB(B1, 1, 1); PG8_SCHED; PG8_LDA(At, 1, 0); PG8_STAGE(PG8_SA(0, 1), a2 + hstepA, voffA);
            PG8_WAIT_V(8); PG8_WAIT_L(0); PG8_BAR; PG8_MMA(0, 0, At, B0); PG8_MMA(0, 1, At, B1); PG8_BAR; PG8_SCHED;
            PG8_LDA(At, 1, 1); PG8_STAGE(PG8_SB(1, 0), b3, voffB); PG8_STAGE(PG8_SB(1, 1), b3 + hstepB, voffB); PG8_STAGE(PG8_SA(1, 0), a3, voffA);
            PG8_WAIT_V(8); PG8_WAIT_L(0); PG8_BAR; PG8_MMA(1, 0, At, B0); PG8_MMA(1, 1, At, B1); PG8_BAR; PG8_SCHED;
            } else {
            PG8_LDB(B0, 0, 0); PG8_SCHED; PG8_LDA(At, 0, 0); PG8_STAGE(PG8_SA(1, 1), a1 + hstepA, voffA);
            PG8_WAIT_L(8); PG8_BAR; PG8_WAIT_L(0); PG8_MMA(0, 0, At, B0); PG8_BAR; PG8_SCHED;
            PG8_LDB(B1, 0, 1); PG8_STAGE(PG8_SB(0, 0), b2, voffB);
            PG8_BAR; PG8_WAIT_L(0); PG8_MMA(0, 1, At, B1); PG8_BAR;
            PG8_LDA(At, 0, 1); PG8_STAGE(PG8_SA(0, 0), a2, voffA);
            PG8_BAR; PG8_WAIT_L(0); PG8_MMA(1, 0, At, B0); PG8_BAR; PG8_SCHED;
            PG8_STAGE(PG8_SB(0, 1), b2 + hstepB, voffB);
            PG8_WAIT_V(6); PG8_BAR; PG8_MMA(1, 1, At, B1); PG8_BAR;
            PG8_LDB(B0, 1, 0); PG8_SCHED; PG8_LDA(At, 1, 0); PG8_STAGE(PG8_SA(0, 1), a2 + hstepA, voffA);
            PG8_WAIT_L(8); PG8_BAR; PG8_WAIT_L(0); PG8_MMA(0, 0, At, B0); PG8_BAR; PG8_SCHED;
            PG8_LDB(B1, 1, 1); PG8_STAGE(PG8_SB(1, 0), b3, voffB);
            PG8_BAR; PG8_WAIT_L(0); PG8_MMA(0, 1, At, B1); PG8_BAR;
            PG8_LDA(At, 1, 1); PG8_STAGE(PG8_SA(1, 0), a3, voffA);
            PG8_BAR; PG8_WAIT_L(0); PG8_MMA(1, 0, At, B0); PG8_BAR; PG8_SCHED;
            PG8_STAGE(PG8_SB(1, 1), b3 + hstepB, voffB);
            PG8_WAIT_V(6); PG8_BAR; PG8_MMA(1, 1, At, B1); PG8_BAR;
            }
        }
        if constexpr (ALIGN_EPI) { if (wr == 0) PG8_BAR; }
        if constexpr (!Epi::AFTER_DRAIN) { E(acc, cur, wr, wc, fr, fq); S.done(cur); }
        if (!has_next) break;
#pragma unroll
        for (int a = 0; a < 2; ++a)
#pragma unroll
            for (int b = 0; b < 2; ++b)
#pragma unroll
                for (int m = 0; m < 4; ++m)
#pragma unroll
                    for (int n = 0; n < 2; ++n) acc[a][b][m][n] = (f32x4){0.f, 0.f, 0.f, 0.f};
        cur = nxt; cA = nA; cB = nB; ++ui;
        if constexpr (ALIGN_EPI) { if (wr == 1) PG8_BAR; }
    }
    PG8_WAIT_V(0);
    if constexpr (!ALIGN_EPI) { if (wr == 0) PG8_BAR; }
    PG8_BAR;
    if constexpr (Epi::AFTER_DRAIN) { E.fused(acc, cur, wr, wc, fr, fq, lds, wid, lane); S.done(cur); }
#undef PG8_SA
#undef PG8_SB
#undef PG8_STAGE
#undef PG8_LDA
#undef PG8_LDB
#undef PG8_MMA
#undef PG8_WAIT_V
#undef PG8_WAIT_L
#undef PG8_BAR
#undef PG8_SCHED
}
}
#define GAS __attribute__((address_space(1)))
#define LAS __attribute__((address_space(3)))
typedef unsigned short bf16;
typedef unsigned v4u __attribute__((ext_vector_type(4)));
typedef float f32x4 __attribute__((ext_vector_type(4)));
typedef short bf16x8 __attribute__((ext_vector_type(8)));
typedef GAS unsigned gu32;
typedef GAS unsigned long long gu64;
#define RLX_AGENT __ATOMIC_RELAXED, __HIP_MEMORY_SCOPE_AGENT
#define LDS_WAIT() asm volatile("s_waitcnt lgkmcnt(0)" ::: "memory")
#define VM_WAIT() asm volatile("s_waitcnt vmcnt(0)" ::: "memory")
__device__ __forceinline__ unsigned long long rt() { return __builtin_amdgcn_s_memrealtime(); }
__device__ __forceinline__ unsigned f2bf(float f) { unsigned u = __builtin_bit_cast(unsigned, f); return (u + 0x7fffu + ((u >> 16) & 1u)) >> 16; }
__device__ __forceinline__ unsigned pk2(float lo, float hi) { return f2bf(lo) | (f2bf(hi) << 16); }

#define XB_TMO      128
#define XB_XCNT(j)  (256  + 64 * (j))
#define XB_XSUB(j)  (1280 + 64 * (j))
#define XB_XGEN(j)  (2304 + 64 * (j))
#define XB_TOP      3328
#define XB_TOPGEN   3392
#define XCD_BAR_WORDS 3456
#define XB_SPIN_CAP (1u << 18)

__device__ __forceinline__ unsigned xb_ld(unsigned* p)              { return __hip_atomic_load(p, __ATOMIC_RELAXED, __HIP_MEMORY_SCOPE_AGENT); }
__device__ __forceinline__ unsigned xb_add(unsigned* p, unsigned v) { return __hip_atomic_fetch_add(p, v, __ATOMIC_RELAXED, __HIP_MEMORY_SCOPE_AGENT); }
__device__ __forceinline__ unsigned xb_xcc_id() { return (unsigned)__builtin_amdgcn_s_getreg((3 << 11) | 20) & 0xFu; }
#define XB_SPIN(cond, bar) do { unsigned _sp = 0; while (cond) { __builtin_amdgcn_s_sleep(1); \
    if ((++_sp & 255u) == 0u) { if (xb_ld(&(bar)[XB_TMO])) break; if (_sp > XB_SPIN_CAP) { atomicAdd(&(bar)[XB_TMO], 1u); break; } } } } while (0)

struct XcdBarrier {
    unsigned* bar; unsigned x;
    volatile LAS unsigned* st;
};

__device__ __forceinline__ XcdBarrier xcd_barrier_post(unsigned* bar, volatile LAS unsigned* st) {
    XcdBarrier b; b.bar = bar; b.x = xb_xcc_id(); b.st = st;
    if (threadIdx.x == 0) (void)xb_add(&bar[XB_XCNT(b.x)], 1u);
    return b;
}
__device__ __forceinline__ void xcd_barrier_complete(unsigned* bar, unsigned x, unsigned& nloc, unsigned& nx) {
    const unsigned G = gridDim.x * gridDim.y * gridDim.z;
    unsigned sum, cnt, mine, sp = 0u;
    for (;;) {
        sum = 0u; cnt = 0u; mine = 0u;
#pragma unroll
        for (unsigned j = 0; j < 16; ++j) { const unsigned c = xb_ld(&bar[XB_XCNT(j)]); sum += c; cnt += (c > 0u) ? 1u : 0u; mine = (j == x) ? c : mine; }
        if (sum == G) break;
        __builtin_amdgcn_s_sleep(1);
        if ((++sp & 255u) == 0u) { if (xb_ld(&bar[XB_TMO])) break; if (sp > XB_SPIN_CAP) { atomicAdd(&bar[XB_TMO], 1u); break; } }
    }
    nloc = mine > 0u ? mine : 1u; nx = cnt > 0u ? cnt : 1u;
}

__device__ __forceinline__ void xcd_barrier(const XcdBarrier& b) {
    asm volatile("s_waitcnt vmcnt(0)" ::: "memory");
    __syncthreads();
    if (threadIdx.x == 0) {
        unsigned* bar = b.bar;
        __builtin_amdgcn_s_waitcnt(0);
        unsigned nloc = b.st[0], nx = b.st[1];
        if (nloc == 0u) { xcd_barrier_complete(bar, b.x, nloc, nx); b.st[0] = nloc; b.st[1] = nx; }
        const unsigned old = xb_add(&bar[XB_XSUB(b.x)], 1u);
        const unsigned gen = old / nloc;
        if (old + 1u == (gen + 1u) * nloc) {
            __builtin_amdgcn_fence(__ATOMIC_RELEASE, "agent");
            asm volatile("s_waitcnt vmcnt(0)" ::: "memory");
            const unsigned og = xb_add(&bar[XB_TOP], 1u);
            const unsigned tg = og / nx;
            if (og + 1u == (tg + 1u) * nx) xb_add(&bar[XB_TOPGEN], 1u);
            else XB_SPIN(xb_ld(&bar[XB_TOPGEN]) == tg, bar);
            __builtin_amdgcn_fence(__ATOMIC_ACQUIRE, "agent");
            xb_add(&bar[XB_XGEN(b.x)], 1u);
            asm volatile("s_waitcnt vmcnt(0)" ::: "memory");
        } else {
            XB_SPIN(xb_ld(&bar[XB_XGEN(b.x)]) == gen, bar);
            __builtin_amdgcn_fence(__ATOMIC_ACQUIRE, "agent");
            asm volatile("s_waitcnt vmcnt(0)" ::: "memory");
        }
    }
    __syncthreads();
}
typedef float f32x4v __attribute__((ext_vector_type(4)));
struct Frame {
    LAS unsigned char* lds;
    volatile LAS unsigned* MISC;
    gu32* ctl;
    int tid, lane, wave, G, vcu;
    float* out; unsigned char* ws;
};
typedef const float* cfptr;
#define INP(i) (((const LAS cfptr*)(F.lds + LDSCTL_OFF + 256))[i])
#define IN_X 0
#define IN_C 1
#define IN_CTX 2
#define IN_CCTX 3
#define IN_WMOD 4
#define IN_BMOD 5
#define IN_NMIX 6
#define IN_NFFN 7
#define IN_WIN 8
#define IN_QNA 9
#define IN_KNA 10
#define IN_SINK 11
#define IN_WBRA 12
#define IN_WBRB 13
#define IN_WOUT 14
#define IN_WRG 15
#define IN_BRG 16
#define IN_WRE 17
#define IN_BRE 18
#define IN_W1 19
#define IN_W3 20
#define IN_W2 21
#define IN_NFIN 22

__device__ __forceinline__ float wave_sum(float v) {
#pragma unroll
    for (int o = 1; o < 64; o <<= 1) v += __shfl_xor(v, o);
    return v;
}
__device__ __forceinline__ float wave_max(float v) {
#pragma unroll
    for (int o = 1; o < 64; o <<= 1) v = fmaxf(v, __shfl_xor(v, o));
    return v;
}
__device__ __forceinline__ float bf2f(bf16 h) { return __builtin_bit_cast(float, (unsigned)h << 16); }
__device__ __forceinline__ int mod_row(int m) { return (m % TT) < CTX ? 4 : m / TT; }

__device__ __forceinline__ void compute_base(const unsigned* cnt, LAS unsigned* base, int tid) {
    if (tid < 64) {
        const unsigned c = __hip_atomic_load(cnt + tid, RLX_AGENT); unsigned v = c;
#pragma unroll
        for (int o = 1; o < 64; o <<= 1) { const unsigned t = __shfl_up(v, o); if (tid >= o) v += t; }
        base[tid] = v - c; if (tid == 63) base[64] = v;
    }
    __syncthreads();
}

template <int MODE>
__device__ __forceinline__ void tr_item(const float* W, int ldw, bf16* WT, int ldt, int koff, LAS float* scr, int kb, int nb, int lane) {
    const int k0 = 64 * kb, n0 = 32 * nb;
    const int lr = lane >> 3, lc = (lane & 7) * 4;
    f32x4v v[8];
#pragma unroll
    for (int i = 0; i < 8; ++i) v[i] = __builtin_nontemporal_load((const f32x4v*)(W + (size_t)(k0 + 8 * i + lr) * ldw + n0 + lc));
#pragma unroll
    for (int i = 0; i < 8; ++i) { LAS float* d = scr + (8 * i + lr) * 33 + lc; d[0] = v[i].x; d[1] = v[i].y; d[2] = v[i].z; d[3] = v[i].w; }
    LDS_WAIT(); asm volatile("" ::: "memory");
    const int c = lane & 7;
#pragma unroll
    for (int j = 0; j < 4; ++j) { const int n = (lane >> 3) + 8 * j; const LAS float* s = scr + (8 * c) * 33 + n;
        v4u o; o.x = pk2(s[0 * 33], s[1 * 33]); o.y = pk2(s[2 * 33], s[3 * 33]); o.z = pk2(s[4 * 33], s[5 * 33]); o.w = pk2(s[6 * 33], s[7 * 33]);
        const int drow = (MODE == 1) ? inproj_dst_col(n0 + n) : (n0 + n);
        *(GAS v4u*)(WT + (size_t)drow * ldt + koff + k0 + 8 * c) = o; }
    LDS_WAIT(); asm volatile("" ::: "memory");
}

__device__ __forceinline__ void p0_work(Frame& F, int l_lo, int l_hi, int wk, int nwk, int parts, bool rope) {
    const int nl = l_hi - l_lo;
    if (parts & 1) {
        LAS float* sl = (LAS float*)(F.lds);
        { const float* cp = INP(IN_C); const float* cc = INP(IN_CCTX); float cv[20];
#pragma unroll
          for (int j = 0; j < 20; ++j) { const int i = F.tid + j * (NWAVES * 64); cv[j] = (i < 4 * D) ? cp[i] : cc[i - 4 * D]; }
#pragma unroll
          for (int j = 0; j < 20; ++j) sl[F.tid + j * (NWAVES * 64)] = cv[j] / (1.f + __expf(-cv[j])); }
        __syncthreads();
        float* MODP = (float*)(F.ws + WS_MODP);
        for (int u = wk; u < nl * 6 * 64; u += nwk) {
            const int l = l_lo + u / (6 * 64), cb = (u / 64) % 6, kslc = u % 64, col = cb * 2048 + 4 * F.tid;
            const float* W = INP(IN_WMOD) + (size_t)l * D * MODW + (size_t)(kslc * 32) * MODW + col;
            f32x4v acc[5];
#pragma unroll
            for (int r = 0; r < 5; ++r) acc[r] = (f32x4v){0.f, 0.f, 0.f, 0.f};
#pragma unroll 16
            for (int kk = 0; kk < 32; ++kk) { const int k = kslc * 32 + kk; const f32x4v w = __builtin_nontemporal_load((const f32x4v*)(W + (size_t)kk * MODW));
#pragma unroll
                for (int r = 0; r < 5; ++r) acc[r] += sl[r * D + k] * w; }
#pragma unroll
            for (int r = 0; r < 5; ++r) *(f32x4v*)(MODP + ((size_t)(l * 64 + kslc) * 5 + r) * MODW + col) = acc[r];
        }
        __syncthreads();
        if (rope && wk == 0) { float* RT = (float*)(F.ws + WS_ROPE);
            for (int i = F.tid; i < 64 * 32; i += NWAVES * 64) { const int pos = i >> 5, f = i & 31; const float freq = powf(10000.f, -(float)f / 32.f); const float ang = (float)pos * freq; RT[i] = cosf(ang); RT[2048 + i] = sinf(ang); } }
    }
    if (parts & (2 | 4 | 8)) {
        const bool do_late = (parts & (2 | 4)) != 0, do_win = (parts & (2 | 8)) != 0;
        if (do_late)
        { bf16* WRT = (bf16*)(F.ws + WS_WR);
          for (int it = wk * NWAVES * 64 + F.tid; it < nl * 80 * 256; it += nwk * NWAVES * 64) {
              const int l = l_lo + it / (80 * 256), c = (it / 256) % 80, k0 = (it % 256) * 8;
              float wv[8];
#pragma unroll
              for (int i = 0; i < 8; ++i) wv[i] = c < 64 ? INP(IN_WRE)[((size_t)l * D + k0 + i) * NE + c] : (c < 72 ? INP(IN_WRG)[((size_t)l * D + k0 + i) * NG + (c - 64)] : 0.f);
              unsigned hi[4], lo[4];
#pragma unroll
              for (int i = 0; i < 4; ++i) { const unsigned h0 = f2bf(wv[2 * i]), h1 = f2bf(wv[2 * i + 1]); hi[i] = h0 | (h1 << 16);
                  lo[i] = f2bf(wv[2 * i] - __builtin_bit_cast(float, h0 << 16)) | (f2bf(wv[2 * i + 1] - __builtin_bit_cast(float, h1 << 16)) << 16); }
              const int ko = k0 >> 3, sI = ko >> 2, fqI = ko & 3, cfI = c >> 4, frI = c & 15;
              *(v4u*)(WRT + ((((size_t)(l * 2 + 0) * 64 + sI) * 5 + cfI) * 64 + fqI * 16 + frI) * 8) = (v4u){hi[0], hi[1], hi[2], hi[3]};
              *(v4u*)(WRT + ((((size_t)(l * 2 + 1) * 64 + sI) * 5 + cfI) * 64 + fqI * 16 + frI) * 8) = (v4u){lo[0], lo[1], lo[2], lo[3]};
          } }
        __syncthreads();
        LAS float* scr = (LAS float*)(F.lds + F.wave * 16384);
        const int gw = wk * NWAVES + F.wave, NGW = nwk * NWAVES;
        constexpr int I_IN = 32 * 224, I_BR = 16 * 64, I_OUT = 32 * 64, I_L = I_IN + 2 * I_BR + I_OUT;
        const bool wdeal = (parts == (1 | 8)) && nl == 1 && nwk == 256;
        const int nit = wdeal ? (wk < 128 ? 2 : 5) : 0, it0 = wdeal ? (wk < 128 ? (wk * NWAVES + F.wave) * 2 : 2048 + ((wk - 128) * NWAVES + F.wave) * 5) : 0;
        for (int i = 0; i < nit; ++i) tr_item<1>(INP(IN_WIN) + (size_t)l_lo * D * INC, INC, (bf16*)(F.ws + WS_WIN) + (size_t)l_lo * INC * D, D, 0, scr, (it0 + i) / 224, (it0 + i) % 224, F.lane);
        for (int it = wdeal ? nl * I_L : gw; it < nl * I_L; it += NGW) {
            const int l = l_lo + it / I_L; int r = it % I_L;
            if (r < I_IN) { if (do_win) tr_item<1>(INP(IN_WIN) + (size_t)l * D * INC, INC, (bf16*)(F.ws + WS_WIN) + (size_t)l * INC * D, D, 0, scr, r / 224, r % 224, F.lane); continue; } r -= I_IN;
            if (!do_late) continue;
            if (r < I_BR) { tr_item<0>(INP(IN_WBRA) + (size_t)l * QW * D, D, (bf16*)(F.ws + WS_WBR) + (size_t)l * D * D, D, 0, scr, r / 64, r % 64, F.lane); continue; } r -= I_BR;
            if (r < I_BR) { tr_item<0>(INP(IN_WBRB) + (size_t)l * QW * D, D, (bf16*)(F.ws + WS_WBR) + (size_t)l * D * D, D, QW, scr, r / 64, r % 64, F.lane); continue; } r -= I_BR;
            tr_item<0>(INP(IN_WOUT) + (size_t)l * D * D, D, (bf16*)(F.ws + WS_WOUT) + (size_t)l * D * D, D, 0, scr, r / 64, r % 64, F.lane);
        }
        __syncthreads();
    }
}
__device__ __forceinline__ void p0b_reduce(Frame& F, int l_lo, int l_hi, int wk, int nwk) {
    const float* MODP = (const float*)(F.ws + WS_MODP); float* MOD = (float*)(F.ws + WS_MOD);
    for (int o = wk * NWAVES * 64 + F.tid; o < (l_hi - l_lo) * 5 * (MODW / 4); o += nwk * NWAVES * 64) {
        const int l = l_lo + o / (5 * (MODW / 4)), r = (o / (MODW / 4)) % 5, n = (o % (MODW / 4)) * 4;
        f32x4v a = *(const f32x4v*)(INP(IN_BMOD) + l * MODW + n);
#pragma unroll 16
        for (int k2 = 0; k2 < 64; ++k2) a += *(const f32x4v*)(MODP + ((size_t)(l * 64 + k2) * 5 + r) * MODW + n);
        *(f32x4v*)(MOD + (size_t)(l * 5 + r) * MODW + n) = a;
    }
}

__device__ __forceinline__ void moe_combine_add(Frame& F, int lp, int m, const LAS unsigned* base, f32x4v (&v)[8]) {
    const unsigned* TE = (const unsigned*)(F.ws + WS_TOK) + (size_t)lp * M * 2;
    const unsigned* TP = (const unsigned*)(F.ws + WS_TOK) + (size_t)(2 + lp) * M * 2;
    const float* TW = (const float*)(F.ws + WS_TOK) + (size_t)(4 + lp) * M * 2;
    const unsigned e0 = TE[m * 2], e1 = TE[m * 2 + 1];
    const unsigned s0 = base[e0] + TP[m * 2], s1 = base[e1] + TP[m * 2 + 1];
    const float w0 = TW[m * 2], w1 = TW[m * 2 + 1];
    const bf16* Y0 = (const bf16*)(F.ws + WS_YM) + (size_t)s0 * D; const bf16* Y1 = (const bf16*)(F.ws + WS_YM) + (size_t)s1 * D;
    const float* g2 = (const float*)(F.ws + WS_MOD) + (size_t)(lp * 5 + mod_row(m)) * MODW + 5 * D;
#pragma unroll
    for (int j = 0; j < 8; ++j) { const int col = 4 * (F.lane + 64 * j);
        const uint2 a = *(const uint2*)(Y0 + col), b = *(const uint2*)(Y1 + col); const f32x4v g = *(const f32x4v*)(g2 + col);
        f32x4v ya = {__builtin_bit_cast(float, a.x << 16), __builtin_bit_cast(float, a.x & 0xffff0000u), __builtin_bit_cast(float, a.y << 16), __builtin_bit_cast(float, a.y & 0xffff0000u)};
        f32x4v yb = {__builtin_bit_cast(float, b.x << 16), __builtin_bit_cast(float, b.x & 0xffff0000u), __builtin_bit_cast(float, b.y << 16), __builtin_bit_cast(float, b.y & 0xffff0000u)};
        v[j] += g * (w0 * ya + w1 * yb); }
}
__device__ __forceinline__ void store_bf16_row(bf16* dst, int lane, const f32x4v (&h)[8]) {
#pragma unroll
    for (int j = 0; j < 8; ++j) { uint2 o; o.x = pk2(h[j].x, h[j].y); o.y = pk2(h[j].z, h[j].w); *(uint2*)(dst + 4 * (lane + 64 * j)) = o; }
}
__device__ __forceinline__ void load_bf16_row(const bf16* src, int lane, f32x4v (&v)[8]) {
#pragma unroll
    for (int j = 0; j < 8; ++j) { const uint2 a = *(const uint2*)(src + 4 * (lane + 64 * j));
        v[j] = (f32x4v){__builtin_bit_cast(float, a.x << 16), __builtin_bit_cast(float, a.x & 0xffff0000u), __builtin_bit_cast(float, a.y << 16), __builtin_bit_cast(float, a.y & 0xffff0000u)}; }
}
__device__ __forceinline__ float row_sumsq(const f32x4v (&v)[8]) {
    float s = 0.f;
#pragma unroll
    for (int j = 0; j < 8; ++j) s += (v[j].x * v[j].x + v[j].y * v[j].y) + (v[j].z * v[j].z + v[j].w * v[j].w);
    return wave_sum(s);
}

template <bool DRY>
__device__ __forceinline__ void ph_norm1(Frame& F, int l) {
    LAS unsigned* base = (LAS unsigned*)(F.lds);
    if (l > 0) compute_base((const unsigned*)F.ctl + CW_CNT + (l - 1) * 64, base, F.tid);
    const int gw = F.vcu * NWAVES + F.wave, NGW = F.G * NWAVES;
    const bf16* XW = (const bf16*)(F.ws + WS_XW); bf16* HA = (bf16*)(F.ws + (DRY ? WS_T2 : WS_HA)); bf16* XWo = (bf16*)(F.ws + (DRY ? WS_T1 : WS_XW));
    const float* nw = INP(IN_NMIX) + l * D;
#define N1_LOAD(m_, v_) do { const int b_ = (m_) / TT, t_ = (m_) % TT; \
        if (l == 0) { const float* src_ = (t_ < CTX ? INP(IN_CTX) + ((size_t)b_ * CTX + t_) * D : INP(IN_X) + ((size_t)b_ * SEQ + (t_ - CTX)) * D); \
            _Pragma("unroll") for (int j = 0; j < 8; ++j) v_[j] = *(const f32x4v*)(src_ + 4 * (F.lane + 64 * j)); } \
        else load_bf16_row(XW + (size_t)(m_) * D, F.lane, v_); } while (0)
#define N1_FINISH(m_, v_) do { \
        if (l > 0) moe_combine_add(F, l - 1, (m_), base, v_); \
        if (!(X0_DIRECT && l == 0 && !DRY)) store_bf16_row(XWo + (size_t)(m_) * D, F.lane, v_); \
        const float rstd = 1.0f / sqrtf(row_sumsq(v_) * (1.0f / D) + EPS); \
        f32x4v h[8]; \
        _Pragma("unroll") for (int j = 0; j < 8; ++j) h[j] = (v_[j] * rstd * nwv[j]) * (1.0f + scv[j]) + shv[j]; \
        store_bf16_row(HA + (size_t)(m_) * D, F.lane, h); } while (0)
#define N1_MODLD(m_) do { const float* mod_ = (const float*)(F.ws + WS_MOD) + (size_t)(l * 5 + mod_row(m_)) * MODW; \
        _Pragma("unroll") for (int j = 0; j < 8; ++j) { const int col = 4 * (F.lane + 64 * j); shv[j] = *(const f32x4v*)(mod_ + col); scv[j] = *(const f32x4v*)(mod_ + D + col); } } while (0)
    f32x4v va[8], vb[8], nwv[8], shv[8], scv[8];
#pragma unroll
    for (int j = 0; j < 8; ++j) nwv[j] = *(const f32x4v*)(nw + 4 * (F.lane + 64 * j));
    int m = gw; if (m < M) N1_LOAD(m, va);
    while (m < M) {
        N1_MODLD(m); asm volatile("" ::: "memory");
        const int m1 = m + NGW; if (m1 < M) N1_LOAD(m1, vb);
        N1_FINISH(m, va);
        if (m1 >= M) break;
        N1_MODLD(m1); asm volatile("" ::: "memory");
        const int m2 = m1 + NGW; if (m2 < M) N1_LOAD(m2, va);
        N1_FINISH(m1, vb);
        m = m2;
    }
#undef N1_LOAD
#undef N1_FINISH
#undef N1_MODLD
}

__device__ __forceinline__ void post_head(const float* P, bf16* dst, const float* nw, bool rope, int rowpos, int colpos, const float* RT, int lane) {
    const int wc = lane >> 4, tt = lane & 15, j0 = 32 * wc + tt, j1 = j0 + 16, d1 = 64 * (wc >> 1) + 16 * (wc & 1) + tt, d2 = d1 + 32;
    float x1 = P[j0], x2 = P[j1];
    if (nw) { const float ss = wave_sum(x1 * x1 + x2 * x2); const float r = 1.0f / sqrtf(ss * (1.0f / HD) + EPS); x1 = x1 * r * nw[d1]; x2 = x2 * r * nw[d2]; }
    if (rope) { const int pos = (wc >> 1) ? colpos : rowpos, fi = 16 * (wc & 1) + tt; const float cs = RT[pos * 32 + fi], sn = RT[2048 + pos * 32 + fi];
        const float o1 = x1 * cs - x2 * sn, o2 = x1 * sn + x2 * cs; x1 = o1; x2 = o2; }
    dst[j0] = (bf16)f2bf(x1); dst[j1] = (bf16)f2bf(x2);
}
__device__ __forceinline__ void ph_post(Frame& F, int l) {
    const int gw = F.vcu * NWAVES + F.wave, NGW = F.G * NWAVES;
    const float* RT = (const float*)(F.ws + WS_ROPE);
    const float* qn = INP(IN_QNA) + l * HD; const float* kn = INP(IN_KNA) + l * HD;
    for (int m = gw; m < M; m += NGW) {
        const int t = m % TT; const bool rope = t >= CTX; const int s = t - CTX, rowpos = rope ? s / GRIDW : 0, colpos = rope ? s % GRIDW : 0;
        const float* P = (const float*)(F.ws + WS_P) + (size_t)m * INC;
        for (int h = 0; h < NH; ++h) post_head(P + OFF_QA + h * HD, (bf16*)(F.ws + WS_QA) + (size_t)m * QW + h * HD, qn, rope, rowpos, colpos, RT, F.lane);
        for (int h = 0; h < NKV; ++h) post_head(P + OFF_KA + h * HD, (bf16*)(F.ws + WS_KA) + (size_t)m * KW + h * HD, kn, rope, rowpos, colpos, RT, F.lane);
        for (int h = 0; h < NH; ++h) post_head(P + OFF_QB + h * HD, (bf16*)(F.ws + WS_QB) + (size_t)m * QW + h * HD, nullptr, rope, rowpos, colpos, RT, F.lane);
        for (int h = 0; h < NKV; ++h) post_head(P + OFF_KB + h * HD, (bf16*)(F.ws + WS_KB) + (size_t)m * KW + h * HD, nullptr, rope, rowpos, colpos, RT, F.lane);
        { const f32x4v a = *(const f32x4v*)(P + OFF_VA + 4 * F.lane), b = *(const f32x4v*)(P + OFF_VB + 4 * F.lane); uint2 o; o.x = pk2(a.x, a.y); o.y = pk2(a.z, a.w); *(uint2*)((bf16*)(F.ws + WS_VA) + (size_t)m * KW + 4 * F.lane) = o;
          o.x = pk2(b.x, b.y); o.y = pk2(b.z, b.w); *(uint2*)((bf16*)(F.ws + WS_VB) + (size_t)m * KW + 4 * F.lane) = o; }
#pragma unroll
        for (int j = 0; j < 8; ++j) { const int col = 4 * (F.lane + 64 * j);
            const f32x4v a = *(const f32x4v*)(P + OFF_GA + col), b = *(const f32x4v*)(P + OFF_GB + col);
            uint2 o; o.x = pk2(1.f / (1.f + __expf(-a.x)), 1.f / (1.f + __expf(-a.y))); o.y = pk2(1.f / (1.f + __expf(-a.z)), 1.f / (1.f + __expf(-a.w))); *(uint2*)((bf16*)(F.ws + WS_GA) + (size_t)m * D + col) = o;
            o.x = pk2(1.f / (1.f + __expf(-b.x)), 1.f / (1.f + __expf(-b.y))); o.y = pk2(1.f / (1.f + __expf(-b.z)), 1.f / (1.f + __expf(-b.w))); *(uint2*)((bf16*)(F.ws + WS_GB) + (size_t)m * D + col) = o; }
    }
}

__device__ __forceinline__ void ph_gate(Frame& F, int l) {
    const int gw = F.vcu * NWAVES + F.wave, NGW = F.G * NWAVES;
    for (int m = gw; m < M; m += NGW) {
        if (l == DEPTH - 1 && (m % TT) < CTX) continue;
        const bf16* GA = (const bf16*)(F.ws + WS_GA) + (size_t)m * D; const bf16* GB = (const bf16*)(F.ws + WS_GB) + (size_t)m * D;
        const float* T1 = (const float*)(F.ws + WS_T1) + (size_t)m * D; const float* T2 = (const float*)(F.ws + WS_T2) + (size_t)m * D;
        f32x4v h[8];
#pragma unroll
        for (int j = 0; j < 8; ++j) { const int col = 4 * (F.lane + 64 * j); const uint2 a = *(const uint2*)(GA + col), b = *(const uint2*)(GB + col);
            const f32x4v ga = {__builtin_bit_cast(float, a.x << 16), __builtin_bit_cast(float, a.x & 0xffff0000u), __builtin_bit_cast(float, a.y << 16), __builtin_bit_cast(float, a.y & 0xffff0000u)};
            const f32x4v gb = {__builtin_bit_cast(float, b.x << 16), __builtin_bit_cast(float, b.x & 0xffff0000u), __builtin_bit_cast(float, b.y << 16), __builtin_bit_cast(float, b.y & 0xffff0000u)};
            h[j] = ga * *(const f32x4v*)(T1 + col) + gb * *(const f32x4v*)(T2 + col); }
        store_bf16_row((bf16*)(F.ws + WS_MB) + (size_t)m * D, F.lane, h);
    }
}

template <bool ADD_T3, bool DRY>
__device__ __forceinline__ void ph_norm2_router(Frame& F, int l) {
    typedef short bf16x8r __attribute__((ext_vector_type(8)));
    constexpr int HP = 4112;
    LAS unsigned char* hhi = F.lds; LAS unsigned char* hlo = F.lds + 16 * HP;
    bf16* XW = (bf16*)(F.ws + WS_XW); bf16* H2 = (bf16*)(F.ws + (DRY ? WS_T2 : WS_HA));
    const float* nw = INP(IN_NFFN) + l * D;
    const bf16* WRH = (const bf16*)(F.ws + WS_WR) + (size_t)(l * 2) * 80 * D; const bf16* WRL = WRH + (size_t)80 * D;
    const int nrows = (l == DEPTH - 1) ? NB * SEQ : M, niter = nrows / 16;
    unsigned* TE = (unsigned*)(F.ws + WS_TOK) + (size_t)l * M * 2; float* TW = (float*)(F.ws + WS_TOK) + (size_t)(4 + l) * M * 2;
    const int w = F.wave, lane = F.lane, fr = lane & 15, fq = lane >> 4;
#if TPROBE >= 100
    unsigned long long tacc1 = 0, tacc3 = 0, tacc5 = 0, tprev = __builtin_amdgcn_s_memrealtime();
#define SUBT(acc_) do { if (blockIdx.x == 0 && F.tid == 0 && l == 0) { const unsigned long long tn_ = __builtin_amdgcn_s_memrealtime(); acc_ += tn_ - tprev; tprev = tn_; } } while (0)
#else
#define SUBT(acc_) do { } while (0)
#endif
    f32x4v vrow[2][8];
#define N2_LOADROWS(it_) do { _Pragma("unroll") for (int rr_ = 0; rr_ < 2; ++rr_) { const int q_ = (it_) * 16 + 2 * w + rr_; const int m_ = (l == DEPTH - 1) ? (q_ / SEQ) * TT + CTX + (q_ % SEQ) : q_; \
        load_bf16_row(XW + (size_t)m_ * D, lane, vrow[rr_]); } } while (0)
    if (F.vcu < niter) N2_LOADROWS(F.vcu);
    for (int it = F.vcu; it < niter; it += F.G) {
        __syncthreads();
        if (it != F.vcu) N2_LOADROWS(it);
#pragma unroll
        for (int rr = 0; rr < 2; ++rr) {
            const int lr = 2 * w + rr, q = it * 16 + lr; const int m = (l == DEPTH - 1) ? (q / SEQ) * TT + CTX + (q % SEQ) : q;
            f32x4v v[8];
#pragma unroll
            for (int j = 0; j < 8; ++j) v[j] = vrow[rr][j];
            const float* mod = (const float*)(F.ws + WS_MOD) + (size_t)(l * 5 + mod_row(m)) * MODW;
            if (ADD_T3) { const float* T3 = (const float*)(F.ws + WS_T3) + (size_t)m * D;
#pragma unroll
                for (int j = 0; j < 8; ++j) { const int col = 4 * (lane + 64 * j); v[j] += *(const f32x4v*)(mod + 2 * D + col) * *(const f32x4v*)(T3 + col); uint2 o_; o_.x = pk2(v[j].x, v[j].y); o_.y = pk2(v[j].z, v[j].w); *(uint2*)(XW + (size_t)m * D + col) = o_; } }
            const float rstd = 1.0f / sqrtf(row_sumsq(v) * (1.0f / D) + EPS);
            f32x4v h[8];
#pragma unroll
            for (int j = 0; j < 8; ++j) { const int col = 4 * (lane + 64 * j); const f32x4v ww = *(const f32x4v*)(nw + col), sh = *(const f32x4v*)(mod + 3 * D + col), sc = *(const f32x4v*)(mod + 4 * D + col);
                h[j] = (v[j] * rstd * ww) * (1.0f + sc) + sh;
                const unsigned a0 = f2bf(h[j].x), a1 = f2bf(h[j].y), a2 = f2bf(h[j].z), a3 = f2bf(h[j].w);
                typedef unsigned u32x2r __attribute__((ext_vector_type(2))); u32x2r hi2, lo2; hi2.x = a0 | (a1 << 16); hi2.y = a2 | (a3 << 16);
                lo2.x = f2bf(h[j].x - __builtin_bit_cast(float, a0 << 16)) | (f2bf(h[j].y - __builtin_bit_cast(float, a1 << 16)) << 16);
                lo2.y = f2bf(h[j].z - __builtin_bit_cast(float, a2 << 16)) | (f2bf(h[j].w - __builtin_bit_cast(float, a3 << 16)) << 16);
                *(LAS u32x2r*)(hhi + lr * HP + col * 2) = hi2; *(LAS u32x2r*)(hlo + lr * HP + col * 2) = lo2; }
            store_bf16_row(H2 + (size_t)m * D, lane, h);
        }
        __syncthreads(); SUBT(tacc1);
        {
            pg8::f32x4 acc[5];
#pragma unroll
            for (int cf = 0; cf < 5; ++cf) acc[cf] = (pg8::f32x4){0.f, 0.f, 0.f, 0.f};
            const __amdgpu_buffer_rsrc_t wrs = __builtin_amdgcn_make_buffer_rsrc((void*)WRH, 0, 2 * 80 * D * 2, 0x00020000);
            const unsigned wvo = (unsigned)lane * 16u;
            const LAS unsigned char* ah = hhi + fr * HP + (256 * w + 8 * fq) * 2; const LAS unsigned char* al = hlo + fr * HP + (256 * w + 8 * fq) * 2;
            bf16x8r Wh0[5], Wl0[5], Wh1[5], Wl1[5];
#define RT_LOADW(Wh, Wl, s_) do { _Pragma("unroll") for (int cf = 0; cf < 5; ++cf) { Wh[cf] = __builtin_bit_cast(bf16x8r, __builtin_amdgcn_raw_buffer_load_b128(wrs, wvo, ((8 * w + (s_)) * 5 + cf) * 1024, 0)); Wl[cf] = __builtin_bit_cast(bf16x8r, __builtin_amdgcn_raw_buffer_load_b128(wrs, wvo, ((64 + 8 * w + (s_)) * 5 + cf) * 1024, 0)); } } while (0)
#define RT_MMA(Wh, Wl, s_) do { const bf16x8r Hh = *(const LAS bf16x8r*)(ah + 64 * (s_)), Hl = *(const LAS bf16x8r*)(al + 64 * (s_)); \
            _Pragma("unroll") for (int cf = 0; cf < 5; ++cf) { acc[cf] = __builtin_amdgcn_mfma_f32_16x16x32_bf16(Wh[cf], Hh, acc[cf], 0, 0, 0); \
                acc[cf] = __builtin_amdgcn_mfma_f32_16x16x32_bf16(Wh[cf], Hl, acc[cf], 0, 0, 0); acc[cf] = __builtin_amdgcn_mfma_f32_16x16x32_bf16(Wl[cf], Hh, acc[cf], 0, 0, 0); } } while (0)
            RT_LOADW(Wh0, Wl0, 0);
#pragma unroll
            for (int s2 = 0; s2 < 8; s2 += 2) {
                RT_LOADW(Wh1, Wl1, s2 + 1); RT_MMA(Wh0, Wl0, s2);
                if (s2 + 2 < 8) RT_LOADW(Wh0, Wl0, s2 + 2);
                RT_MMA(Wh1, Wl1, s2 + 1);
            }
#undef RT_LOADW
#undef RT_MMA
            asm volatile("s_waitcnt lgkmcnt(0)" ::: "memory");
#pragma unroll
            for (int cf = 0; cf < 5; ++cf) *(LAS pg8::f32x4*)(hhi + fr * HP + 512 * w + (16 * cf + 4 * fq) * 4) = acc[cf];
        }
        __syncthreads(); SUBT(tacc3);
#pragma unroll 1
        for (int rr = 0; rr < 2; ++rr) {
            const int lr = 2 * w + rr, q = it * 16 + lr; const int m = (l == DEPTH - 1) ? (q / SEQ) * TT + CTX + (q % SEQ) : q;
            LAS float* elb = (LAS float*)(hlo + (2 * w + rr) * HP + 512 * w);
            float el = lane < 64 ? INP(IN_BRE)[l * NE + lane] : 0.f;
#pragma unroll
            for (int k2 = 0; k2 < 8; ++k2) el += *(const LAS float*)(hhi + lr * HP + 512 * k2 + lane * 4);
            elb[lane] = el;
            if (lane < 8) { float gl = INP(IN_BRG)[l * NG + lane];
#pragma unroll
                for (int k2 = 0; k2 < 8; ++k2) gl += *(const LAS float*)(hhi + lr * HP + 512 * k2 + (64 + lane) * 4);
                elb[64 + lane] = gl; }
            LDS_WAIT(); asm volatile("" ::: "memory");
            float gmax = elb[64]; int gi = 0;
#pragma unroll
            for (int i = 1; i < 8; ++i) { const float x = elb[64 + i]; if (x > gmax) { gmax = x; gi = i; } }
            float gs = 0.f;
#pragma unroll
            for (int i = 0; i < 8; ++i) gs += __expf(elb[64 + i] - gmax);
            const float pgv = 1.0f / gs;
            float v1 = elb[gi * 8]; int i1 = 0;
#pragma unroll
            for (int i = 1; i < 8; ++i) { const float x = elb[gi * 8 + i]; if (x > v1) { v1 = x; i1 = i; } }
            float v2 = -3.0e38f; int i2 = 0;
#pragma unroll
            for (int i = 0; i < 8; ++i) { const float x = elb[gi * 8 + i]; if (i != i1 && x > v2) { v2 = x; i2 = i; } }
            const float e2 = __expf(v2 - v1), s1 = 1.0f / (1.0f + e2), s2 = e2 * s1;
            if (lane == 0 && !DRY) {
                const unsigned ea = gi * 8 + i1, eb = gi * 8 + i2;
                TE[m * 2] = ea; TE[m * 2 + 1] = eb; TW[m * 2] = s1 * pgv; TW[m * 2 + 1] = s2 * pgv;
            }
        }
        SUBT(tacc5);
    }
#if TPROBE >= 100
    if (blockIdx.x == 0 && F.tid == 0 && l == 0) { volatile LAS unsigned long long* ts = (volatile LAS unsigned long long*)(F.lds + LDSCTL_OFF + 800); ts[26] = TPROBE == 100 ? tacc1 : TPROBE == 101 ? tacc3 : tacc5; }
#endif
#undef SUBT
}

__device__ __forceinline__ void ph_compact(Frame& F, int l) {
    LAS unsigned* wtot = (LAS unsigned*)(F.lds);
    const unsigned* TE = (const unsigned*)(F.ws + WS_TOK) + (size_t)l * M * 2; unsigned* TP = (unsigned*)(F.ws + WS_TOK) + (size_t)(2 + l) * M * 2;
    unsigned* LIST = (unsigned*)(F.ws + WS_LIST) + (size_t)l * NE * M; unsigned* cnt = (unsigned*)F.ctl + CW_CNT + l * 64;
    constexpr int TPT = M / (NWAVES * 64);
    for (int e = F.vcu; e < NE; e += F.G) {
        const int m0 = F.tid * TPT; unsigned c = 0;
        for (int i = 0; i < TPT; ++i) { const int m = m0 + i; const bool valid = (l < DEPTH - 1) || ((m % TT) >= CTX);
            const uint2 te = *(const uint2*)(TE + 2 * m); c += (valid && te.x == (unsigned)e) ? 1u : 0u; c += (valid && te.y == (unsigned)e) ? 1u : 0u; }
        unsigned v = c;
#pragma unroll
        for (int o = 1; o < 64; o <<= 1) { const unsigned t = __shfl_up(v, o); if (F.lane >= o) v += t; }
        if (F.lane == 63) wtot[F.wave] = v;
        __syncthreads();
        unsigned off = 0, tot = 0;
#pragma unroll
        for (int k2 = 0; k2 < NWAVES; ++k2) { const unsigned x = wtot[k2]; off += (k2 < F.wave) ? x : 0u; tot += x; }
        unsigned pos = off + v - c;
        for (int i = 0; i < TPT; ++i) { const int m = m0 + i; const bool valid = (l < DEPTH - 1) || ((m % TT) >= CTX);
            const uint2 te = *(const uint2*)(TE + 2 * m);
            if (valid && te.x == (unsigned)e) { LIST[(size_t)e * M + pos] = (unsigned)m; TP[2 * m] = pos; ++pos; }
            if (valid && te.y == (unsigned)e) { LIST[(size_t)e * M + pos] = (unsigned)m; TP[2 * m + 1] = pos; ++pos; } }
        if (F.tid == 0) cnt[e] = tot;
        __syncthreads();
    }
}

__device__ __forceinline__ void ph_final(Frame& F) {
    LAS unsigned* base = (LAS unsigned*)(F.lds);
    compute_base((const unsigned*)F.ctl + CW_CNT + (DEPTH - 1) * 64, base, F.tid);
    const int gw = F.vcu * NWAVES + F.wave, NGW = F.G * NWAVES;
    const bf16* XW = (const bf16*)(F.ws + WS_XW); const float* nw = INP(IN_NFIN);
    for (int q = gw; q < NB * SEQ; q += NGW) {
        const int m = (q / SEQ) * TT + CTX + (q % SEQ);
        f32x4v v[8];
        load_bf16_row(XW + (size_t)m * D, F.lane, v);
        moe_combine_add(F, DEPTH - 1, m, base, v);
        const float rstd = 1.0f / sqrtf(row_sumsq(v) * (1.0f / D) + EPS);
#pragma unroll
        for (int j = 0; j < 8; ++j) { const int col = 4 * (F.lane + 64 * j); *(f32x4v*)(F.out + (size_t)q * D + col) = v[j] * rstd * *(const f32x4v*)(nw + col); }
    }
}
template <int COLMAP>
__global__ void __launch_bounds__(256) naive_gemm(const bf16* A, int lda, const float* W, int ldw, float* Cc, int ldc, int K) {
    const int n = blockIdx.x * 64 + threadIdx.x, m0 = blockIdx.y * 32 + threadIdx.y * 8;
    const int sc = COLMAP ? inproj_src_col(n) : n;
    float acc[8];
#pragma unroll
    for (int i = 0; i < 8; ++i) acc[i] = 0.f;
    for (int k = 0; k < K; ++k) { const float w = W[(size_t)k * ldw + sc];
#pragma unroll
        for (int i = 0; i < 8; ++i) acc[i] += bf2f(A[(size_t)(m0 + i) * lda + k]) * w; }
#pragma unroll
    for (int i = 0; i < 8; ++i) Cc[(size_t)(m0 + i) * ldc + n] = acc[i];
}

__global__ void __launch_bounds__(256) naive_attn(const bf16* Q, const bf16* K, const bf16* V, bf16* Y, const float* sink, int mode, int with_ctx_q) {
    __shared__ float sc[4][TT]; __shared__ float qs[4][HD];
    const int wave = threadIdx.x >> 6, lane = threadIdx.x & 63;
    const int nq = with_ctx_q ? TT : SEQ; const long item = (long)blockIdx.x * 4 + wave; if (item >= (long)NB * NH * nq) return;
    const int tq = (int)(item % nq) + (with_ctx_q ? 0 : CTX), h = (int)((item / nq) % NH), b = (int)(item / ((long)nq * NH)), kvh = h / (NH / NKV);
    const size_t m = (size_t)b * TT + tq;
    qs[wave][lane] = bf2f(Q[m * QW + h * HD + lane]); qs[wave][lane + 64] = bf2f(Q[m * QW + h * HD + lane + 64]);
    __builtin_amdgcn_wave_barrier(); asm volatile("s_waitcnt lgkmcnt(0)" ::: "memory");
    const bool isctx = tq < CTX; const int nk = isctx ? CTX : TT;
    float mx = -3.0e38f;
    for (int kk = lane; kk < nk; kk += 64) {
        bool valid = true;
        if (mode == 1 && !isctx && kk >= CTX) { const int dq = (tq - CTX) - (kk - CTX); valid = dq <= 128 && dq >= -128; }
        float s = -3.0e38f;
        if (valid) { const bf16* kr = K + ((size_t)b * TT + kk) * KW + kvh * HD; float dsum = 0.f;
            for (int d = 0; d < HD; ++d) dsum += bf2f(kr[d]) * qs[wave][d];
            s = dsum * ATTN_SCALE; }
        sc[wave][kk] = s; mx = fmaxf(mx, s);
    }
    mx = wave_max(mx);
    float sk = 0.f; if (mode == 1) { sk = sink[h]; mx = fmaxf(mx, sk); }
    float sum = 0.f;
    for (int kk = lane; kk < nk; kk += 64) { const float s = sc[wave][kk]; const float p = s > -1.0e38f ? __expf(s - mx) : 0.f; sc[wave][kk] = p; sum += p; }
    sum = wave_sum(sum); if (mode == 1) sum += __expf(sk - mx);
    asm volatile("s_waitcnt lgkmcnt(0)" ::: "memory"); __builtin_amdgcn_wave_barrier();
    float o0 = 0.f, o1 = 0.f;
    for (int kk = 0; kk < nk; ++kk) { const float p = sc[wave][kk]; const bf16* vr = V + ((size_t)b * TT + kk) * KW + kvh * HD; o0 += p * bf2f(vr[lane]); o1 += p * bf2f(vr[lane + 64]); }
    const float inv = 1.0f / sum;
    Y[m * D + h * HD + lane] = (bf16)f2bf(o0 * inv); Y[m * D + h * HD + lane + 64] = (bf16)f2bf(o1 * inv);
}

__global__ void __launch_bounds__(256) naive_moe_up(const bf16* H2, const float* w1, const float* w3, const unsigned* cnt, const unsigned* LIST, bf16* HB) {
    __shared__ unsigned base[65];
    const int tid = threadIdx.y * 64 + threadIdx.x;
    if (tid == 0) { unsigned a = 0; for (int e = 0; e < NE; ++e) { base[e] = a; a += cnt[e]; } base[64] = a; }
    __syncthreads();
    const unsigned slot = blockIdx.y * 4 + threadIdx.y; if (slot >= base[64]) return;
    int e = 0; while (base[e + 1] <= slot) ++e;
    const unsigned tok = LIST[(size_t)e * M + (slot - base[e])];
    const int j = blockIdx.x * 64 + threadIdx.x;
    const float* W1 = w1 + (size_t)e * D * DE + j; const float* W3 = w3 + (size_t)e * D * DE + j; const bf16* x = H2 + (size_t)tok * D;
    float a = 0.f, b = 0.f;
    for (int k = 0; k < D; ++k) { const float xv = bf2f(x[k]); a += xv * W1[(size_t)k * DE]; b += xv * W3[(size_t)k * DE]; }
    HB[(size_t)slot * DE + j] = (bf16)f2bf(a / (1.f + __expf(-a)) * b);
}
__global__ void __launch_bounds__(256) naive_moe_down(const bf16* HB, const float* w2, const unsigned* cnt, bf16* YM) {
    __shared__ unsigned base[65];
    const int tid = threadIdx.y * 64 + threadIdx.x;
    if (tid == 0) { unsigned a = 0; for (int e = 0; e < NE; ++e) { base[e] = a; a += cnt[e]; } base[64] = a; }
    __syncthreads();
    const unsigned slot = blockIdx.y * 4 + threadIdx.y; if (slot >= base[64]) return;
    int e = 0; while (base[e + 1] <= slot) ++e;
    const int col = blockIdx.x * 64 + threadIdx.x;
    const float* W2 = w2 + (size_t)e * DE * D + col; const bf16* hrow = HB + (size_t)slot * DE;
    float a = 0.f;
    for (int k = 0; k < DE; ++k) a += bf2f(hrow[k]) * W2[(size_t)k * D];
    YM[(size_t)slot * D + col] = (bf16)f2bf(a);
}
namespace att {
constexpr int NW = 8, QBLK = 32, KVBLK = 64;
constexpr float THR = 8.f;
constexpr int LDQ = QW, LDK = KW, LDO = D;
constexpr size_t SHM_V = KVBLK * HD * 2, SHM_K = KVBLK * HD * 2, SHM_ATTN = 2 * SHM_V + 2 * SHM_K + NW * 64 * 4;
using bf16x8 = __attribute__((ext_vector_type(8))) short;
using s16x4  = __attribute__((ext_vector_type(4))) short;
using f32x16 = __attribute__((ext_vector_type(16))) float;
using u32x4  = __attribute__((ext_vector_type(4))) unsigned;
#define KSWZ(row, colB) ((row) * 256 + ((colB) ^ (((row) & 7) << 4)))
#define SBAR() __builtin_amdgcn_sched_barrier(0)
__device__ __forceinline__ int crow(int r, int hi) { return (r & 3) + 8 * (r >> 2) + 4 * hi; }
__device__ __forceinline__ unsigned cvtpk(float lo, float hi) { unsigned r; asm volatile("v_cvt_pk_bf16_f32 %0, %1, %2" : "=v"(r) : "v"(lo), "v"(hi)); return r; }
__device__ __forceinline__ void partialSM(f32x16& p0, f32x16& p1, float& m_reg, float& mn, float& alpha) {
  constexpr float C = ATTN_SCALE * 1.4426950408889634f;
  float pmax = p0[0]; for (int r = 1; r < 16; ++r) pmax = fmaxf(pmax, p0[r]); for (int r = 0; r < 16; ++r) pmax = fmaxf(pmax, p1[r]);
  { auto rr = __builtin_amdgcn_permlane32_swap(__float_as_uint(pmax), __float_as_uint(pmax), false, false);
    pmax = fmaxf(__uint_as_float(rr[0]), __uint_as_float(rr[1])); }
  if (__builtin_expect(__all(pmax - m_reg <= THR / ATTN_SCALE), 1)) { mn = m_reg; alpha = 1.f; }
  else { mn = fmaxf(m_reg, pmax); alpha = __builtin_amdgcn_exp2f((m_reg - mn) * C); m_reg = mn; }
  float mnC = -mn * C;
  for (int r = 0; r < 16; ++r) p0[r] = fmaf(p0[r], C, mnC); for (int r = 0; r < 16; ++r) p1[r] = fmaf(p1[r], C, mnC);
  for (int r = 0; r < 16; ++r) p0[r] = __builtin_amdgcn_exp2f(p0[r]);
}
__device__ __forceinline__ void finishSM(f32x16& p0, f32x16& p1, float alpha, float& l_reg, bf16x8& pa0, bf16x8& pa1, bf16x8& pa2, bf16x8& pa3) {
  for (int r = 0; r < 16; ++r) p1[r] = __builtin_amdgcn_exp2f(p1[r]);
  float ps = 0; for (int r = 0; r < 16; ++r) ps += p0[r]; for (int r = 0; r < 16; ++r) ps += p1[r];
  { auto rr = __builtin_amdgcn_permlane32_swap(__float_as_uint(ps), __float_as_uint(ps), false, false);
    ps = __uint_as_float(rr[0]) + __uint_as_float(rr[1]); }
  l_reg = l_reg * alpha + ps;
#define PK4(P, BASE, OUT) do { unsigned a0 = cvtpk(P[BASE + 0], P[BASE + 1]), a1 = cvtpk(P[BASE + 2], P[BASE + 3]);   \
    unsigned b0 = cvtpk(P[BASE + 4], P[BASE + 5]), b1 = cvtpk(P[BASE + 6], P[BASE + 7]);                              \
    auto r0 = __builtin_amdgcn_permlane32_swap(a0, b0, false, false); auto r1 = __builtin_amdgcn_permlane32_swap(a1, b1, false, false); \
    u32x4 w = {r0[0], r1[0], r0[1], r1[1]}; OUT = *reinterpret_cast<bf16x8*>(&w); } while (0)
  PK4(p0, 0, pa0); PK4(p0, 8, pa1); PK4(p1, 0, pa2); PK4(p1, 8, pa3);
#undef PK4
}
__device__ __forceinline__ void qkt(f32x16& p0, f32x16& p1, const bf16* Ks, const bf16x8* qr, int r32, int hi) {
  p0 = f32x16{}; p1 = f32x16{};
  for (int d0 = 0; d0 < 8; ++d0) { int cb = (d0 * 16 + hi * 8) * 2;
    bf16x8 b0 = *reinterpret_cast<const bf16x8*>((const char*)Ks + KSWZ(r32, cb));
    bf16x8 b1 = *reinterpret_cast<const bf16x8*>((const char*)Ks + KSWZ(32 + r32, cb));
    p0 = __builtin_amdgcn_mfma_f32_32x32x16_bf16(b0, qr[d0], p0, 0, 0, 0);
    p1 = __builtin_amdgcn_mfma_f32_32x32x16_bf16(b1, qr[d0], p1, 0, 0, 0); }
}
__device__ __forceinline__ void wmask(f32x16& p0, f32x16& p1, int kb, int qpos, int hi) {
  const float NEG = -1.0e30f; const int d0 = kb + 4 * hi - qpos;
#pragma unroll
  for (int r = 0; r < 16; ++r) { const int dd = d0 + (r & 3) + 8 * (r >> 2); if (dd > 128 || dd < -128) p0[r] = NEG; if (dd + 32 > 128 || dd + 32 < -128) p1[r] = NEG; }
}
__device__ __forceinline__ int v_st(int k, int c) { const int kk = (k & ~0xC) | ((k & 4) << 1) | ((k & 8) >> 1); return ((kk >> 3) * 4 + (c >> 5)) * 512 + ((kk & 7) * 32 + (c & 31)) * 2; }
__device__ __forceinline__ int v_rd_base(int lane) { return ((lane & 3) << 3) | (((lane >> 2) & 3) << 6) | (((lane >> 4) & 1) << 5) | (((lane >> 5) & 1) << 8); }
constexpr int v_rd_off(int d0, int ks, int half) { return d0 * 512 + ks * 4096 + half * 2048; }
template <int OFF> __device__ __forceinline__ s16x4 tr_read(int vb) {
  s16x4 r; asm volatile("ds_read_b64_tr_b16 %0, %1 offset:%2" : "=&v"(r) : "v"(vb), "i"(OFF) : "memory"); return r;
}
template <int D0> __device__ __forceinline__ void pv_one(f32x16& od, int vb, bf16x8 pa0, bf16x8 pa1, bf16x8 pa2, bf16x8 pa3) {
  const s16x4 l0 = tr_read<v_rd_off(D0, 0, 0)>(vb), h0 = tr_read<v_rd_off(D0, 0, 1)>(vb), l1 = tr_read<v_rd_off(D0, 1, 0)>(vb), h1 = tr_read<v_rd_off(D0, 1, 1)>(vb);
  const s16x4 l2 = tr_read<v_rd_off(D0, 2, 0)>(vb), h2 = tr_read<v_rd_off(D0, 2, 1)>(vb), l3 = tr_read<v_rd_off(D0, 3, 0)>(vb), h3 = tr_read<v_rd_off(D0, 3, 1)>(vb);
  asm volatile("s_waitcnt lgkmcnt(0)" ::: "memory"); SBAR();
#define PK(L, H) (bf16x8){L[0], L[1], L[2], L[3], H[0], H[1], H[2], H[3]}
  od = __builtin_amdgcn_mfma_f32_32x32x16_bf16(pa0, PK(l0, h0), od, 0, 0, 0);
  od = __builtin_amdgcn_mfma_f32_32x32x16_bf16(pa1, PK(l1, h1), od, 0, 0, 0);
  od = __builtin_amdgcn_mfma_f32_32x32x16_bf16(pa2, PK(l2, h2), od, 0, 0, 0);
  od = __builtin_amdgcn_mfma_f32_32x32x16_bf16(pa3, PK(l3, h3), od, 0, 0, 0);
#undef PK
}
__device__ __forceinline__ void pv_d0(f32x16* o, int vb, bf16x8 pa0, bf16x8 pa1, bf16x8 pa2, bf16x8 pa3) {
  pv_one<0>(o[0], vb, pa0, pa1, pa2, pa3); pv_one<1>(o[1], vb, pa0, pa1, pa2, pa3); pv_one<2>(o[2], vb, pa0, pa1, pa2, pa3); pv_one<3>(o[3], vb, pa0, pa1, pa2, pa3);
}
__device__ __forceinline__ void attn_unit(const bool MASKED, const bf16* __restrict__ Qb, const bf16* __restrict__ Kh, const bf16* __restrict__ Vh, bf16* __restrict__ Ob,
                                          int NT, int klo, int q0, float m0, float l0, char* lds) {
  const int tid = threadIdx.x, wid = tid >> 6, lane = tid & 63, r32 = lane & 31, hi = lane >> 5;
  bf16* V_lds = (bf16*)lds; bf16* K_lds = (bf16*)(lds + 2 * SHM_V);
  float* ws = (float*)(lds + 2 * SHM_V + 2 * SHM_K) + wid * 64; float* li_l = ws; float* al_l = ws + 32;
  float m_reg = m0, l_reg = l0; f32x16 o[4] = {}; bf16x8 qr[8];
  const bf16* Qw = Qb + (long)(wid * QBLK + r32) * LDQ + hi * 8;
#pragma unroll
  for (int d0 = 0; d0 < 8; ++d0) qr[d0] = *reinterpret_cast<const bf16x8*>(Qw + d0 * 16);
  const int sr = tid >> 4, sc = (tid & 15) * 8, vst0 = v_st(sr, sc), vst1 = v_st(32 + sr, sc);
  const int vb0 = (int)(uintptr_t)V_lds + v_rd_base(lane);
  const int qpos = q0 + wid * QBLK + r32;
  struct { bf16x8 vs0, vs1, ks0, ks1; } sr_[2];
#define KROW(j) ((!MASKED || (j) < 4) ? 64 * (j) : CTX + klo + 64 * ((j) - 4))
#define SLOAD(i, j) do { const int k0_ = KROW(j); sr_[i].vs0 = *reinterpret_cast<const bf16x8*>(&Vh[(long)(k0_ + sr) * LDK + sc]); sr_[i].vs1 = *reinterpret_cast<const bf16x8*>(&Vh[(long)(k0_ + 32 + sr) * LDK + sc]); \
    sr_[i].ks0 = *reinterpret_cast<const bf16x8*>(&Kh[(long)(k0_ + sr) * LDK + sc]); sr_[i].ks1 = *reinterpret_cast<const bf16x8*>(&Kh[(long)(k0_ + 32 + sr) * LDK + sc]); } while (0)
#define SWRITE(b, i) do { *(bf16x8*)((char*)V_lds + (b) * SHM_V + vst0) = sr_[i].vs0;          \
    *(bf16x8*)((char*)V_lds + (b) * SHM_V + vst1) = sr_[i].vs1; int kc = sc * 2;               \
    *(bf16x8*)((char*)K_lds + (b) * SHM_K + KSWZ(sr, kc)) = sr_[i].ks0;                       \
    *(bf16x8*)((char*)K_lds + (b) * SHM_K + KSWZ(32 + sr, kc)) = sr_[i].ks1; } while (0)
#define SWAIT() asm volatile("s_waitcnt vmcnt(4)" ::: "memory")
#define RESC(a) do { if (__any((a) < 1.f)) { if (hi == 0) al_l[r32] = (a); asm volatile("s_waitcnt lgkmcnt(0)" ::: "memory"); \
    for (int d = 0; d < 4; ++d) for (int r = 0; r < 16; ++r) o[d][r] *= al_l[crow(r, hi)]; } } while (0)
#define WMASK(P0, P1, j) do { if (MASKED && (j) >= 4) wmask(P0, P1, klo + 64 * ((j) - 4), qpos, hi); } while (0)
  f32x16 pA0, pA1, pB0, pB1; float mnA, mnB, alA, alB; bf16x8 pa0, pa1, pa2, pa3;
  constexpr int SE = 0, SO = 1;
  __syncthreads();
  SLOAD(SE, 0); asm volatile("s_waitcnt vmcnt(0)" ::: "memory"); SWRITE(0, SE); __syncthreads();
  qkt(pA0, pA1, K_lds, qr, r32, hi); WMASK(pA0, pA1, 0); partialSM(pA0, pA1, m_reg, mnA, alA);
  SLOAD(SO, 1); if (2 < NT) SLOAD(SE, 2);
  SWAIT(); SWRITE(1, SO); __syncthreads();
  for (int j = 1; j + 1 < NT; j += 2) {
    SBAR(); qkt(pB0, pB1, (bf16*)((char*)K_lds + SHM_K), qr, r32, hi); WMASK(pB0, pB1, j);
    finishSM(pA0, pA1, alA, l_reg, pa0, pa1, pa2, pa3); SBAR();
    SLOAD(SO, j + 2); SBAR();
    pv_d0(o, vb0, pa0, pa1, pa2, pa3); partialSM(pB0, pB1, m_reg, mnB, alB);
    __syncthreads(); SWAIT(); SWRITE(0, SE);
    RESC(alB); __syncthreads();
    SBAR(); qkt(pA0, pA1, K_lds, qr, r32, hi); WMASK(pA0, pA1, j + 1);
    finishSM(pB0, pB1, alB, l_reg, pa0, pa1, pa2, pa3); SBAR();
    if (j + 3 < NT) SLOAD(SE, j + 3); SBAR();
    pv_d0(o, vb0 + (int)SHM_V, pa0, pa1, pa2, pa3); partialSM(pA0, pA1, m_reg, mnA, alA);
    __syncthreads(); SWAIT(); SWRITE(1, SO);
    RESC(alA); __syncthreads();
  }
  SBAR(); qkt(pB0, pB1, (bf16*)((char*)K_lds + SHM_K), qr, r32, hi); WMASK(pB0, pB1, NT - 1);
  finishSM(pA0, pA1, alA, l_reg, pa0, pa1, pa2, pa3); SBAR();
  pv_d0(o, vb0, pa0, pa1, pa2, pa3); partialSM(pB0, pB1, m_reg, mnB, alB);
  __syncthreads(); RESC(alB);
  finishSM(pB0, pB1, alB, l_reg, pa0, pa1, pa2, pa3); SBAR();
  pv_d0(o, vb0 + (int)SHM_V, pa0, pa1, pa2, pa3);
  if (hi == 0) li_l[r32] = l_reg; asm volatile("s_waitcnt lgkmcnt(0)" ::: "memory");
  float rli[16];
#pragma unroll
  for (int r = 0; r < 16; ++r) rli[r] = __builtin_amdgcn_rcpf(li_l[crow(r, hi)]);
  bf16* Ow = Ob + (long)(wid * QBLK) * LDO;
#pragma unroll
  for (int r = 0; r < 16; ++r) { int orow = crow(r, hi);
    for (int d0 = 0; d0 < 4; ++d0) Ow[(long)orow * LDO + d0 * 32 + r32] = (bf16)f2bf(o[d0][r] * rli[r]); }
#undef KROW
#undef SLOAD
#undef SWRITE
#undef SWAIT
#undef RESC
#undef WMASK
}
#undef KSWZ
#undef SBAR
}

__device__ __forceinline__ void fast_attn(Frame& F, int l) {
    char* lds = (char*)F.lds;
    const int nsub = (l < DEPTH - 1) ? 3 : 2;
    for (int u = (int)blockIdx.x; u < 256; u += F.G) {
        const int x = u & 7, y = u >> 3, b = x >> 1, kvh = x & 1, g = y >> 3, qb = y & 7, h = kvh * 4 + g;
        for (int s = 0; s < nsub; ++s) {
            if (s == 2 && qb != 0 && qb != 7) break;
            const bool mixB = (s == 1) || (s == 2 && qb == 7), ctxq = (s == 2);
            const size_t brow = (size_t)b * TT, qrow = ctxq ? brow : brow + CTX + 256 * qb;
            const bf16* Qp = (const bf16*)(F.ws + (mixB ? WS_QB : WS_QA)) + qrow * QW + h * HD;
            const bf16* Kp = (const bf16*)(F.ws + (mixB ? WS_KB : WS_KA)) + brow * KW + kvh * HD;
            const bf16* Vp = (const bf16*)(F.ws + (mixB ? WS_VB : WS_VA)) + brow * KW + kvh * HD;
            bf16* Op = (bf16*)(F.ws + WS_YAB) + qrow * D + (mixB ? QW : 0) + h * HD;
            const int q0 = 256 * qb, klo = q0 - 128 < 0 ? 0 : q0 - 128, khi = q0 + 384 > SEQ ? SEQ : q0 + 384;
            const int NT = ctxq ? CTX / 64 : (s == 0 ? TT / 64 : 4 + (khi - klo) / 64);
            const float m0 = mixB ? INP(IN_SINK)[l * NH + h] * (1.0f / ATTN_SCALE) : -1.0e30f, l0 = mixB ? 1.f : 0.f;
            att::attn_unit(s == 1, Qp, Kp, Vp, Op, NT, klo, q0, m0, l0, lds);
        }
    }
}
namespace moe {
typedef unsigned u32x4 __attribute__((ext_vector_type(4)));
using pg8::bf16x8; using pg8::f32x4;
#ifndef MOE_CAPT
#define MOE_CAPT 576
#endif
constexpr int CAPT = MOE_CAPT;
constexpr int B_STAGE = 16896, B_PART = 8448, CAP = 576;
constexpr int NMF = CAP / 32, GS = 3, NGRP = NMF / GS;
static_assert(2 * (CAP / 16) * 1024 + 4 * B_STAGE <= LDSCTL_OFF && NGRP == 6, "MoE LDS map / group nest");
__device__ __forceinline__ void wait_vm1(int n) {
    switch (n) { case 0: asm volatile("s_waitcnt vmcnt(0)" ::: "memory"); break; case 1: asm volatile("s_waitcnt vmcnt(1)" ::: "memory"); break; case 2: asm volatile("s_waitcnt vmcnt(2)" ::: "memory"); break;
                 case 3: asm volatile("s_waitcnt vmcnt(3)" ::: "memory"); break; case 4: asm volatile("s_waitcnt vmcnt(4)" ::: "memory"); break; case 5: asm volatile("s_waitcnt vmcnt(5)" ::: "memory"); break;
                 case 6: asm volatile("s_waitcnt vmcnt(6)" ::: "memory"); break; default: asm volatile("s_waitcnt vmcnt(7)" ::: "memory"); break; }
}
__device__ __forceinline__ void wait_vm8(int n) {
    switch (n) { case 0: asm volatile("s_waitcnt vmcnt(0)" ::: "memory"); break; case 1: asm volatile("s_waitcnt vmcnt(8)" ::: "memory"); break; case 2: asm volatile("s_waitcnt vmcnt(16)" ::: "memory"); break;
                 case 3: asm volatile("s_waitcnt vmcnt(24)" ::: "memory"); break; case 4: asm volatile("s_waitcnt vmcnt(32)" ::: "memory"); break; case 5: asm volatile("s_waitcnt vmcnt(40)" ::: "memory"); break; default: asm volatile("s_waitcnt vmcnt(48)" ::: "memory"); break; }
}
__device__ __forceinline__ unsigned cvt_pk(float lo, float hi) { unsigned r; asm volatile("v_cvt_pk_bf16_f32 %0, %1, %2" : "=v"(r) : "v"(lo), "v"(hi)); return r; }
__device__ __forceinline__ int swz(int ob) { return ob ^ (((ob >> 9) & 1) << 5); }

template <int MODE>
__device__ __forceinline__ void moe_phase(Frame& F, int l) {
    LAS unsigned char* lds = F.lds;
    LAS unsigned* base = (LAS unsigned*)(F.lds + LDSCTL_OFF + 512);
    const unsigned* cnt = (const unsigned*)F.ctl + CW_CNT + l * 64;
    compute_base(cnt, base, F.tid);
    LAS unsigned char* order = (LAS unsigned char*)(F.lds + LDSCTL_OFF + 512 + 272);
    if (F.tid < NE) { const unsigned c = base[F.tid + 1] - base[F.tid]; int rank = 0;
        for (int e2 = 0; e2 < NE; ++e2) { const unsigned c2 = base[e2 + 1] - base[e2]; rank += (c2 > c || (c2 == c && e2 < F.tid)) ? 1 : 0; }
        order[rank] = (unsigned char)F.tid; }
    __syncthreads();
    constexpr int NCS = MODE == 0 ? 8 : 16, K = MODE == 0 ? D : DE, NT = K / 32, LDW = MODE == 0 ? DE : D, BKS = MODE == 0 ? 256 : 512;
    const int wid = F.wave, lane = F.lane, wr = wid >> 2, wc = wid & 3, fr = lane & 15, fq = lane >> 4;
    const int afo = swz(fr * 64 + fq * 16);
    const int sb = swz(lane * 16), drow = sb >> 6, dk = (sb & 63) >> 1;
    int bro[2];
#pragma unroll
    for (int j = 0; j < 2; ++j) bro[j] = ((MODE == 0) ? j * B_PART + ((8 * fq) * 64 + 16 * wc + fr) * 4 : ((8 * fq) * 128 + 32 * wc + 16 * j + fr) * 4) + fq * 64;
    const int bw = wid - 6;
    const unsigned bvo = (MODE == 0) ? (unsigned)((lane >> 4) * LDW + (lane & 15) * 4) * 4u : (unsigned)((lane >> 5) * LDW + (lane & 31) * 4) * 4u;
    const unsigned* LISTl = (const unsigned*)(F.ws + WS_LIST) + (size_t)l * NE * M;
    const __amdgpu_buffer_rsrc_t ars = __builtin_amdgcn_make_buffer_rsrc((void*)(F.ws + (MODE == 0 ? WS_HA : WS_HB)), 0, 0x7ffffff0, 0x00020000);
    constexpr int UREP = (REPMASK & (MODE == 0 ? (1 << 8) : (1 << 9))) ? 2 : 1;
    for (int u2 = F.vcu; u2 < UREP * NE * NCS; u2 += F.G) {
        const int u = u2 % (NE * NCS); const int cs = u % NCS; const bool rep = (UREP > 1) && (u2 >= NE * NCS);
        const int uq = u / NCS; int rnk;
        if (F.G * NCS >= NE * NCS / 2 && NE * NCS / F.G == 2) { const int slot = uq % (NE / 2), i = uq / (NE / 2); rnk = i == 0 ? slot : NE - 1 - slot; }
        else if (NE * NCS / F.G == 4 && NE % 4 == 0) { const int slot = uq % (NE / 4), i = uq / (NE / 4); rnk = i == 0 ? slot : i == 1 ? NE / 2 - 1 - slot : i == 2 ? NE / 2 + slot : NE - 1 - slot; }
        else rnk = uq;
        const int e = (int)order[rnk];
        const int n_e = (int)(base[e + 1] - base[e]), base_e = (int)base[e];
        const float* wbase;
        if (MODE == 0) wbase = ((bw == 1) ? INP(IN_W3) : INP(IN_W1)) + ((size_t)(l * NE + e) * D) * DE + 64 * cs;
        else           wbase = INP(IN_W2) + ((size_t)(l * NE + e) * DE) * D + 128 * cs + (size_t)(bw == 1 ? 16 : 0) * D;
        unsigned wlo_v = (unsigned)(unsigned long long)wbase, whi_v = (unsigned)((unsigned long long)wbase >> 32);
        asm volatile("" : "+v"(wlo_v), "+v"(whi_v));
        for (int r0 = 0; r0 < n_e; r0 += CAPT) {
            const int nrows = (n_e - r0) < CAPT ? (n_e - r0) : CAPT, nsub = (nrows + 15) >> 4;
            const int asz = nsub * 1024; const int na = 2;
            const int boff = na * asz; int nstg = (LDSCTL_OFF - boff) / B_STAGE; nstg = nstg > 8 ? 8 : nstg;
            int naw = 0;
#pragma unroll
            for (int j = 0; j < 7; ++j) naw += (wid + 6 * j < nsub) ? 1 : 0;
            unsigned aof[7];
#pragma unroll
            for (int j = 0; j < 7; ++j) { const int sx = wid + 6 * j; int r = 16 * sx + drow; if (r >= nrows) r = 0;
                if (MODE == 0) aof[j] = LISTl[(size_t)e * M + r0 + r] * (unsigned)(D * 2) + (unsigned)dk * 2u;
                else           aof[j] = (unsigned)(base_e + r0 + r) * (unsigned)(DE * 2) + (unsigned)dk * 2u; }
            f32x4 acc[NMF][2];
#pragma unroll
            for (int m = 0; m < NMF; ++m)
#pragma unroll
                for (int n = 0; n < 2; ++n) acc[m][n] = (f32x4){0.f, 0.f, 0.f, 0.f};
#define MOE_DMA_A(t, b) do { _Pragma("unroll") for (int j_ = 0; j_ < 7; ++j_) { const int s_ = wid + 6 * j_; if (s_ < nsub) \
        __builtin_amdgcn_raw_ptr_buffer_load_lds(ars, (LAS void*)(lds + (b) * asz + s_ * 1024), 16, aof[j_], (t) * 64, 0, 0); } } while (0)
#define MOE_DMA_B(t) do { unsigned lo_, hi_; asm volatile("v_readfirstlane_b32 %0, %2\n\tv_readfirstlane_b32 %1, %3" : "=s"(lo_), "=s"(hi_) : "v"(wlo_v), "v"(whi_v)); \
        const __amdgpu_buffer_rsrc_t wrs_ = __builtin_amdgcn_make_buffer_rsrc((void*)(((unsigned long long)hi_ << 32) | lo_), 0, 0x7ffffff0, 0x00020000); \
        LAS unsigned char* bst_ = lds + boff + ((t) % nstg) * B_STAGE + (MODE == 0 ? bw * B_PART : bw * 8192 + bw * 128); \
        _Pragma("unroll") for (int i_ = 0; i_ < 8; ++i_) __builtin_amdgcn_raw_ptr_buffer_load_lds(wrs_, (LAS void*)(bst_ + i_ * 1024 + (MODE == 0 ? (i_ >> 1) : (i_ >> 2)) * 64), 16, bvo, ((t) * 32 + (MODE == 0 ? 4 : 2) * i_) * (LDW * 4), 0, 2); } while (0)
#define MOE_DMA_BS(t, slot) do { unsigned lo_, hi_; asm volatile("v_readfirstlane_b32 %0, %2\n\tv_readfirstlane_b32 %1, %3" : "=s"(lo_), "=s"(hi_) : "v"(wlo_v), "v"(whi_v)); \
        const __amdgpu_buffer_rsrc_t wrs_ = __builtin_amdgcn_make_buffer_rsrc((void*)(((unsigned long long)hi_ << 32) | lo_), 0, 0x7ffffff0, 0x00020000); \
        LAS unsigned char* bst_ = lds + boff + (slot) * B_STAGE + (MODE == 0 ? bw * B_PART : bw * 8192 + bw * 128); \
        _Pragma("unroll") for (int i_ = 0; i_ < 8; ++i_) __builtin_amdgcn_raw_ptr_buffer_load_lds(wrs_, (LAS void*)(bst_ + i_ * 1024 + (MODE == 0 ? (i_ >> 1) : (i_ >> 2)) * 64), 16, bvo, ((t) * 32 + (MODE == 0 ? 4 : 2) * i_) * (LDW * 4), 0, 2); } while (0)
#define MOE_LDA(dst, g_) do { _Pragma("unroll") for (int q_ = 0; q_ < GS; ++q_) dst[q_] = *(const LAS bf16x8*)(Ab + (2 * (GS * (g_) + q_) + wr) * 1024 + afo); } while (0)
#define MOE_MMA(src, g_) do { _Pragma("unroll") for (int q_ = 0; q_ < GS; ++q_) _Pragma("unroll") for (int j_ = 0; j_ < 2; ++j_) \
        acc[GS * (g_) + q_][j_] = __builtin_amdgcn_mfma_f32_16x16x32_bf16(Bf[j_], src[q_], acc[GS * (g_) + q_][j_], 0, 0, 0); } while (0)
            asm volatile("s_waitcnt lgkmcnt(0)" ::: "memory"); __builtin_amdgcn_s_barrier(); asm volatile("" ::: "memory");
            if (wid < 6) { MOE_DMA_A(0, 0); if (na == 3 && NT > 1) MOE_DMA_A(1, 1); }
            else { for (int p = 0; p < nstg - 1 && p < NT; ++p) MOE_DMA_B(p); }
            const int ngrp = (nsub - wr + 2 * GS - 1) / (2 * GS);
            int abuf = 0, bslot = 0;
#define MOE_BUILDB(dst, Bb_) do { float w0[8], w1[8]; \
        _Pragma("unroll") for (int i = 0; i < 8; ++i) w0[i] = *(const LAS float*)((Bb_) + bro[0] + i * BKS); \
        _Pragma("unroll") for (int i = 0; i < 8; ++i) w1[i] = *(const LAS float*)((Bb_) + bro[1] + i * BKS); \
        u32x4 p; p.x = cvt_pk(w0[0], w0[1]); p.y = cvt_pk(w0[2], w0[3]); p.z = cvt_pk(w0[4], w0[5]); p.w = cvt_pk(w0[6], w0[7]); dst[0] = __builtin_bit_cast(bf16x8, p); \
        p.x = cvt_pk(w1[0], w1[1]); p.y = cvt_pk(w1[2], w1[3]); p.z = cvt_pk(w1[4], w1[5]); p.w = cvt_pk(w1[6], w1[7]); dst[1] = __builtin_bit_cast(bf16x8, p); } while (0)
            bf16x8 Bf[2];
            {
                if (wid >= 6) { const int ahead = (nstg - 1 < NT ? nstg - 1 : NT) - 1; wait_vm8(ahead); }
                asm volatile("s_waitcnt lgkmcnt(0)" ::: "memory"); __builtin_amdgcn_s_barrier(); asm volatile("" ::: "memory");
                MOE_BUILDB(Bf, lds + boff);
            }
            for (int t = 0; t < NT; ++t) {
                if (wid < 6) { if (na == 3 && t + 1 < NT) wait_vm1(naw); else asm volatile("s_waitcnt vmcnt(0)" ::: "memory"); }
                else { const int rem = NT - 2 - t; const int cap = nstg - 3; wait_vm8(rem < 0 ? 0 : (rem < cap ? rem : cap)); }
                asm volatile("s_waitcnt lgkmcnt(0)" ::: "memory"); __builtin_amdgcn_s_barrier(); asm volatile("" ::: "memory");
                if (wid < 6) { if (t + na - 1 < NT) { int nb = abuf + na - 1; nb = nb >= na ? nb - na : nb; MOE_DMA_A(t + na - 1, nb); } }
                else { if (t + nstg - 1 < NT) { int ns = bslot + nstg - 1; ns = ns >= nstg ? ns - nstg : ns; MOE_DMA_BS(t + nstg - 1, ns); } }
                const LAS unsigned char* Ab = lds + abuf * asz;
                abuf = (abuf + 1 == na) ? 0 : abuf + 1; bslot = (bslot + 1 == nstg) ? 0 : bslot + 1;
                const LAS unsigned char* Bn = lds + boff + bslot * B_STAGE;
                bf16x8 At0[GS], At1[GS], Bn2[2];
                MOE_LDA(At0, 0);
                if (ngrp > 1) MOE_LDA(At1, 1);
                MOE_MMA(At0, 0);
                if (t + 1 < NT) MOE_BUILDB(Bn2, Bn);
                if (ngrp > 1) { if (ngrp > 2) MOE_LDA(At0, 2); MOE_MMA(At1, 1);
                    if (ngrp > 2) { if (ngrp > 3) MOE_LDA(At1, 3); MOE_MMA(At0, 2);
                        if (ngrp > 3) { if (ngrp > 4) MOE_LDA(At0, 4); MOE_MMA(At1, 3);
                            if (ngrp > 4) { if (ngrp > 5) MOE_LDA(At1, 5); MOE_MMA(At0, 4);
                                if (ngrp > 5) MOE_MMA(At1, 5); } } } }
                if (t + 1 < NT) { Bf[0] = Bn2[0]; Bf[1] = Bn2[1]; }
            }
#undef MOE_BUILDB
#pragma unroll
            for (int m = 0; m < NMF; ++m) { const int row = 16 * (2 * m + wr) + fr;
                if (row < nrows && !rep) {
                    if (MODE == 0) { const f32x4 x = acc[m][0], y = acc[m][1]; uint2 o;
                        o.x = cvt_pk(x[0] / (1.f + __expf(-x[0])) * y[0], x[1] / (1.f + __expf(-x[1])) * y[1]); o.y = cvt_pk(x[2] / (1.f + __expf(-x[2])) * y[2], x[3] / (1.f + __expf(-x[3])) * y[3]);
                        *(uint2*)((bf16*)(F.ws + WS_HB) + (size_t)(base_e + r0 + row) * DE + 64 * cs + 16 * wc + 4 * fq) = o;
                    } else {
#pragma unroll
                        for (int n = 0; n < 2; ++n) { const f32x4 x = acc[m][n]; uint2 o; o.x = cvt_pk(x[0], x[1]); o.y = cvt_pk(x[2], x[3]);
                            *(uint2*)((bf16*)(F.ws + WS_YM) + (size_t)(base_e + r0 + row) * D + 128 * cs + 32 * wc + 16 * n + 4 * fq) = o; }
                    }
                } }
        }
    }
    asm volatile("s_waitcnt vmcnt(0) lgkmcnt(0)" ::: "memory"); __syncthreads();
#undef MOE_DMA_A
#undef MOE_DMA_B
#undef MOE_DMA_BS
#undef MOE_LDA
#undef MOE_MMA
}
}
__device__ __forceinline__ void fast_moe_up(Frame& F, int l) { moe::moe_phase<0>(F, l); }
__device__ __forceinline__ void fast_moe_down(Frame& F, int l) { moe::moe_phase<1>(F, l); }
struct RowOrder {
    pg8::StaticOrder so; bool latent_only;
    __device__ void init(bool lat, int N, int G, int c) { latent_only = lat; so.init(lat ? NB * SEQ : M, N, G, c); }
    __device__ bool next(int i, pg8::Unit& u) const { if (!so.next(i, u)) return false; if (latent_only) u.pm = (u.pm >> 3) * 9 + 1 + (u.pm & 7); return true; }
    __device__ __forceinline__ void a_ready(const pg8::Unit&) const {}
    __device__ __forceinline__ void done(const pg8::Unit&) const {}
};
struct OneUnit {
    bool has; pg8::Unit u0;
    __device__ bool next(int i, pg8::Unit& u) const { if (i != 0 || !has) return false; u = u0; return true; }
    __device__ __forceinline__ void a_ready(const pg8::Unit&) const {}
    __device__ __forceinline__ void done(const pg8::Unit&) const {}
};
struct EpiF32 {
    static constexpr int MIDK = 0; static constexpr bool PERM = false, AFTER_DRAIN = false;
    float* O; int ldc;
    __device__ __forceinline__ void operator()(const pg8::f32x4 (&acc)[2][2][4][2], const pg8::Unit& u, int wr, int wc, int fr, int fq) const {
        const int row0 = u.pm * 256 + wr * 64 + fr, col0 = u.pn * 256 + wc * 32 + 4 * fq;
#pragma unroll
        for (int ai = 0; ai < 2; ++ai)
#pragma unroll
            for (int m = 0; m < 4; ++m) { float* rowp = O + (size_t)(row0 + ai * 128 + m * 16) * ldc + col0;
#pragma unroll
                for (int bj = 0; bj < 2; ++bj)
#pragma unroll
                    for (int n = 0; n < 2; ++n) *(pg8::f32x4*)(rowp + bj * 128 + n * 16) = acc[ai][bj][m][n]; }
    }
};
template <int PASS>
struct EpiGate {
    static constexpr int MIDK = 0; static constexpr bool PERM = false, AFTER_DRAIN = false;
    const bf16* G; bf16* O;
    __device__ __forceinline__ void operator()(const pg8::f32x4 (&acc)[2][2][4][2], const pg8::Unit& u, int wr, int wc, int fr, int fq) const {
        asm volatile("" : "+v"(fr), "+v"(fq));
        const int row0 = u.pm * 256 + wr * 64 + fr, col0 = u.pn * 256 + wc * 32 + 4 * fq;
#pragma unroll
        for (int ai = 0; ai < 2; ++ai) {
            uint2 gv[4][2][2], tv[4][2][2];
#pragma unroll
            for (int m = 0; m < 4; ++m) { const size_t off = (size_t)(row0 + ai * 128 + m * 16) * D + col0;
#pragma unroll
                for (int bj = 0; bj < 2; ++bj)
#pragma unroll
                    for (int n = 0; n < 2; ++n) { gv[m][bj][n] = *(const uint2*)(G + off + bj * 128 + n * 16); if (PASS == 2) tv[m][bj][n] = *(const uint2*)(O + off + bj * 128 + n * 16); } }
#pragma unroll
            for (int m = 0; m < 4; ++m) { const size_t off = (size_t)(row0 + ai * 128 + m * 16) * D + col0;
#pragma unroll
                for (int bj = 0; bj < 2; ++bj)
#pragma unroll
                    for (int n = 0; n < 2; ++n) { const uint2 g2 = gv[m][bj][n];
                        pg8::f32x4 g = {__builtin_bit_cast(float, g2.x << 16), __builtin_bit_cast(float, g2.x & 0xffff0000u), __builtin_bit_cast(float, g2.y << 16), __builtin_bit_cast(float, g2.y & 0xffff0000u)};
                        pg8::f32x4 v = g * acc[ai][bj][m][n];
                        if (PASS == 2) { const uint2 t2 = tv[m][bj][n];
                            v += (pg8::f32x4){__builtin_bit_cast(float, t2.x << 16), __builtin_bit_cast(float, t2.x & 0xffff0000u), __builtin_bit_cast(float, t2.y << 16), __builtin_bit_cast(float, t2.y & 0xffff0000u)}; }
                        uint2 o; o.x = pg8::cvt_pk_bf16(v[0], v[1]); o.y = pg8::cvt_pk_bf16(v[2], v[3]); *(uint2*)(O + off + bj * 128 + n * 16) = o; } }
            asm volatile("" ::: "memory");
        }
    }
};
struct EpiGateK {
    static constexpr int MIDK = 16; static constexpr bool PERM = false, AFTER_DRAIN = false;
    const bf16* GA; const bf16* GB; bf16* O;
    __device__ __forceinline__ void mid(pg8::f32x4 (&acc)[2][2][4][2], const pg8::Unit& u, int wr, int wc, int fr, int fq) const {
        asm volatile("" : "+v"(fr), "+v"(fq));
        const int row0 = u.pm * 256 + wr * 64 + fr, col0 = u.pn * 256 + wc * 32 + 4 * fq;
#pragma unroll
        for (int ai = 0; ai < 2; ++ai) {
            uint2 av[4][2][2], bv[4][2][2];
#pragma unroll
            for (int m = 0; m < 4; ++m) { const size_t off = (size_t)(row0 + ai * 128 + m * 16) * D + col0;
#pragma unroll
                for (int bj = 0; bj < 2; ++bj)
#pragma unroll
                    for (int n = 0; n < 2; ++n) { av[m][bj][n] = *(const uint2*)(GA + off + bj * 128 + n * 16); bv[m][bj][n] = *(const uint2*)(GB + off + bj * 128 + n * 16); } }
#pragma unroll
            for (int m = 0; m < 4; ++m)
#pragma unroll
                for (int bj = 0; bj < 2; ++bj)
#pragma unroll
                    for (int n = 0; n < 2; ++n) { const uint2 a2 = av[m][bj][n], b2 = bv[m][bj][n];
                        const pg8::f32x4 ga = {__builtin_bit_cast(float, a2.x << 16), __builtin_bit_cast(float, a2.x & 0xffff0000u), __builtin_bit_cast(float, a2.y << 16), __builtin_bit_cast(float, a2.y & 0xffff0000u)};
                        const pg8::f32x4 gb = {__builtin_bit_cast(float, b2.x << 16), __builtin_bit_cast(float, b2.x & 0xffff0000u), __builtin_bit_cast(float, b2.y << 16), __builtin_bit_cast(float, b2.y & 0xffff0000u)};
#pragma unroll
                        for (int e = 0; e < 4; ++e) acc[ai][bj][m][n][e] *= ga[e] * __builtin_amdgcn_rcpf(fmaxf(gb[e], 1.0e-30f)); }
        }
    }
    __device__ __forceinline__ void operator()(const pg8::f32x4 (&acc)[2][2][4][2], const pg8::Unit& u, int wr, int wc, int fr, int fq) const {
        asm volatile("" : "+v"(fr), "+v"(fq));
        const int row0 = u.pm * 256 + wr * 64 + fr, col0 = u.pn * 256 + wc * 32 + 4 * fq;
#pragma unroll
        for (int ai = 0; ai < 2; ++ai) {
            uint2 bv[4][2][2];
#pragma unroll
            for (int m = 0; m < 4; ++m) { const size_t off = (size_t)(row0 + ai * 128 + m * 16) * D + col0;
#pragma unroll
                for (int bj = 0; bj < 2; ++bj)
#pragma unroll
                    for (int n = 0; n < 2; ++n) bv[m][bj][n] = *(const uint2*)(GB + off + bj * 128 + n * 16); }
#pragma unroll
            for (int m = 0; m < 4; ++m) { const size_t off = (size_t)(row0 + ai * 128 + m * 16) * D + col0;
#pragma unroll
                for (int bj = 0; bj < 2; ++bj)
#pragma unroll
                    for (int n = 0; n < 2; ++n) { const uint2 b2 = bv[m][bj][n];
                        const pg8::f32x4 gb = {__builtin_bit_cast(float, b2.x << 16), __builtin_bit_cast(float, b2.x & 0xffff0000u), __builtin_bit_cast(float, b2.y << 16), __builtin_bit_cast(float, b2.y & 0xffff0000u)};
                        const pg8::f32x4 v = gb * acc[ai][bj][m][n];
                        uint2 o; o.x = pg8::cvt_pk_bf16(v[0], v[1]); o.y = pg8::cvt_pk_bf16(v[2], v[3]); *(uint2*)(O + off + bj * 128 + n * 16) = o; } }
        }
    }
};
struct EpiRes {
    static constexpr int MIDK = 0; static constexpr bool PERM = false, AFTER_DRAIN = false;
    bf16* X; const float* g1l;
    const float* xin; const float* cin;
    __device__ __forceinline__ void operator()(const pg8::f32x4 (&acc)[2][2][4][2], const pg8::Unit& u, int wr, int wc, int fr, int fq) const {
        asm volatile("" : "+v"(fr), "+v"(fq));
        const int row0 = u.pm * 256 + wr * 64 + fr, col0 = u.pn * 256 + wc * 32 + 4 * fq;
        const float* g1 = g1l + (size_t)((u.pm % 9 == 0) ? 4 : u.pm / 9) * MODW + col0;
        pg8::f32x4 gv[2][2];
#pragma unroll
        for (int bj = 0; bj < 2; ++bj)
#pragma unroll
            for (int n = 0; n < 2; ++n) gv[bj][n] = *(const pg8::f32x4*)(g1 + bj * 128 + n * 16);
#pragma unroll
        for (int ai = 0; ai < 2; ++ai) {
            pg8::f32x4 xv[4][2][2];
#pragma unroll
            for (int m = 0; m < 4; ++m) { const int rt = wr * 64 + fr + ai * 128 + m * 16;
                if (xin) { const int b = u.pm / 9, tb = u.pm % 9; const float* rowp = (tb == 0 ? cin + ((size_t)b * CTX + rt) * D : xin + ((size_t)b * SEQ + (tb - 1) * 256 + rt) * D) + col0;
#pragma unroll
                    for (int bj = 0; bj < 2; ++bj)
#pragma unroll
                        for (int n = 0; n < 2; ++n) xv[m][bj][n] = *(const pg8::f32x4*)(rowp + bj * 128 + n * 16); }
                else { const bf16* rowp = X + (size_t)(u.pm * 256 + rt) * D + col0;
#pragma unroll
                    for (int bj = 0; bj < 2; ++bj)
#pragma unroll
                        for (int n = 0; n < 2; ++n) { const uint2 a = *(const uint2*)(rowp + bj * 128 + n * 16);
                            xv[m][bj][n] = (pg8::f32x4){__builtin_bit_cast(float, a.x << 16), __builtin_bit_cast(float, a.x & 0xffff0000u), __builtin_bit_cast(float, a.y << 16), __builtin_bit_cast(float, a.y & 0xffff0000u)}; } } }
#pragma unroll
            for (int m = 0; m < 4; ++m) { bf16* rowp = X + (size_t)(row0 + ai * 128 + m * 16) * D + col0;
#pragma unroll
                for (int bj = 0; bj < 2; ++bj)
#pragma unroll
                    for (int n = 0; n < 2; ++n) { const pg8::f32x4 r = xv[m][bj][n] + gv[bj][n] * acc[ai][bj][m][n]; uint2 o; o.x = pk2(r[0], r[1]); o.y = pk2(r[2], r[3]); *(uint2*)(rowp + bj * 128 + n * 16) = o; } }
            asm volatile("" ::: "memory");
        }
    }
};
struct EpiInproj {
    static constexpr int MIDK = 0; static constexpr bool PERM = false, AFTER_DRAIN = false;
    unsigned char* ws; const float* qn; const float* kn; LAS float* xs;
    __device__ __forceinline__ void operator()(const pg8::f32x4 (&acc)[2][2][4][2], const pg8::Unit& u, int wr, int wc, int fr, int fq) const {
        asm volatile("" : "+v"(fr), "+v"(fq));
        const int pn = u.pn; bf16* dst; int ldo, kind; const float* nw = nullptr;
        if (pn < 4) { dst = (bf16*)(ws + WS_QA) + pn * 256; ldo = QW; kind = 0; nw = qn; }
        else if (pn == 4) { dst = (bf16*)(ws + WS_KA); ldo = KW; kind = 0; nw = kn; }
        else if (pn == 5) { dst = (bf16*)(ws + WS_VA); ldo = KW; kind = 2; }
        else if (pn < 10) { dst = (bf16*)(ws + WS_QB) + (pn - 6) * 256; ldo = QW; kind = 1; }
        else if (pn == 10) { dst = (bf16*)(ws + WS_KB); ldo = KW; kind = 1; }
        else if (pn == 11) { dst = (bf16*)(ws + WS_VB); ldo = KW; kind = 2; }
        else if (pn < 20) { dst = (bf16*)(ws + WS_GA) + (pn - 12) * 256; ldo = D; kind = 3; }
        else { dst = (bf16*)(ws + WS_GB) + (pn - 20) * 256; ldo = D; kind = 3; }
        const int rt0 = wr * 64 + fr;
        const int cw = 32 * wc + 4 * fq;
        const int tb = u.pm % 9; const bool rope = (kind < 2) && (tb != 0);
        if (kind == 0) {
#pragma unroll
            for (int ai = 0; ai < 2; ++ai)
#pragma unroll
                for (int m = 0; m < 4; ++m)
#pragma unroll
                    for (int bj = 0; bj < 2; ++bj) { const pg8::f32x4 a = acc[ai][bj][m][0], b = acc[ai][bj][m][1];
                        float ss = (a[0] * a[0] + a[1] * a[1]) + (a[2] * a[2] + a[3] * a[3]) + (b[0] * b[0] + b[1] * b[1]) + (b[2] * b[2] + b[3] * b[3]);
                        ss += __shfl_xor(ss, 16); ss += __shfl_xor(ss, 32);
                        if (fq == 0) xs[(bj * 256 + rt0 + 128 * ai + 16 * m) * 4 + wc] = ss; }
            asm volatile("s_waitcnt lgkmcnt(0)" ::: "memory"); __builtin_amdgcn_s_barrier(); asm volatile("" ::: "memory");
        }
        pg8::f32x4 w1 = {1.f, 1.f, 1.f, 1.f}, w2 = w1;
        if (kind == 0) { const int d1 = 64 * (wc >> 1) + 16 * (wc & 1) + 4 * fq; w1 = *(const pg8::f32x4*)(nw + d1); w2 = *(const pg8::f32x4*)(nw + d1 + 32); }
        const float* RT = (const float*)(ws + WS_ROPE) + 16 * (wc & 1) + 4 * fq;
#pragma unroll
        for (int ai = 0; ai < 2; ++ai)
#pragma unroll
            for (int m = 0; m < 4; ++m) {
                const int rt = rt0 + 128 * ai + 16 * m;
                pg8::f32x4 cs = {1.f, 1.f, 1.f, 1.f}, sn = {0.f, 0.f, 0.f, 0.f};
                if (rope) { const int s = (tb - 1) * 256 + rt; const int pos = (wc >> 1) ? (s & 63) : (s >> 6); cs = *(const pg8::f32x4*)(RT + pos * 32); sn = *(const pg8::f32x4*)(RT + 2048 + pos * 32); }
                bf16* rowp = dst + (size_t)(u.pm * 256 + rt) * ldo + cw;
#pragma unroll
                for (int bj = 0; bj < 2; ++bj) {
                    pg8::f32x4 x1 = acc[ai][bj][m][0], x2 = acc[ai][bj][m][1];
                    if (kind == 0) { const pg8::f32x4 p = *(const LAS pg8::f32x4*)(xs + (bj * 256 + rt) * 4); const float r = 1.0f / sqrtf(((p[0] + p[1]) + (p[2] + p[3])) * (1.0f / HD) + EPS); x1 = x1 * r * w1; x2 = x2 * r * w2; }
                    if (kind < 2) { const pg8::f32x4 o1 = x1 * cs - x2 * sn, o2 = x1 * sn + x2 * cs; x1 = o1; x2 = o2; }
                    if (kind == 3) {
#pragma unroll
                        for (int e = 0; e < 4; ++e) { x1[e] = 1.f / (1.f + __expf(-x1[e])); x2[e] = 1.f / (1.f + __expf(-x2[e])); } }
                    uint2 o; o.x = pg8::cvt_pk_bf16(x1[0], x1[1]); o.y = pg8::cvt_pk_bf16(x1[2], x1[3]); *(uint2*)(rowp + bj * 128) = o;
                    o.x = pg8::cvt_pk_bf16(x2[0], x2[1]); o.y = pg8::cvt_pk_bf16(x2[2], x2[3]); *(uint2*)(rowp + bj * 128 + 16) = o;
                }
                asm volatile("" ::: "memory");
            }
    }
};
__device__ __forceinline__ void fast_inproj(Frame& F, int l) {
    pg8::Gemm g{(const bf16*)(F.ws + WS_HA), (const bf16*)(F.ws + WS_WIN) + (size_t)l * INC * D, M, INC, D, D, D};
    RowOrder S; S.init(false, INC, F.G, (int)blockIdx.x);
    if constexpr (FUSE_POST) { EpiInproj E{F.ws, INP(IN_QNA) + l * HD, INP(IN_KNA) + l * HD, (LAS float*)(F.lds + XS_OFF)};
        pg8::gemm_phase<EpiInproj, RowOrder, true, true>(F.lds + RING_OFF, g, S, E); }
    else { EpiF32 E{(float*)(F.ws + WS_P), INC};
        pg8::gemm_phase<EpiF32, RowOrder, true, true>(F.lds + RING_OFF, g, S, E); }
}
__device__ __forceinline__ void fast_br(Frame& F, int l) {
    const bool lat = (l == DEPTH - 1);
    if constexpr (FUSE_GATE && GATE_MIDK) {
        pg8::Gemm g{(const bf16*)(F.ws + WS_YAB), (const bf16*)(F.ws + WS_WBR) + (size_t)l * D * D, M, D, D, D, D};
        RowOrder S; S.init(lat, D, F.G, (int)blockIdx.x); EpiGateK E{(const bf16*)(F.ws + WS_GA), (const bf16*)(F.ws + WS_GB), (bf16*)(F.ws + WS_MB)};
        pg8::gemm_phase<EpiGateK, RowOrder, true, true>(F.lds + RING_OFF, g, S, E);
    } else if constexpr (FUSE_GATE) {
        { pg8::Gemm g{(const bf16*)(F.ws + WS_YAB), (const bf16*)(F.ws + WS_WBR) + (size_t)l * D * D, M, D, QW, D, D};
          RowOrder S; S.init(lat, D, F.G, (int)blockIdx.x); EpiGate<1> E{(const bf16*)(F.ws + WS_GA), (bf16*)(F.ws + WS_MB)};
          pg8::gemm_phase<EpiGate<1>, RowOrder, true, true>(F.lds + RING_OFF, g, S, E); }
        { pg8::Gemm g{(const bf16*)(F.ws + WS_YAB) + QW, (const bf16*)(F.ws + WS_WBR) + (size_t)l * D * D + QW, M, D, QW, D, D};
          RowOrder S; S.init(lat, D, F.G, (int)blockIdx.x); EpiGate<2> E{(const bf16*)(F.ws + WS_GB), (bf16*)(F.ws + WS_MB)};
          pg8::gemm_phase<EpiGate<2>, RowOrder, true, true>(F.lds + RING_OFF, g, S, E); }
    } else {
        { pg8::Gemm g{(const bf16*)(F.ws + WS_YAB), (const bf16*)(F.ws + WS_WBR) + (size_t)l * D * D, M, D, QW, D, D};
          RowOrder S; S.init(lat, D, F.G, (int)blockIdx.x); EpiF32 E{(float*)(F.ws + WS_T1), D};
          pg8::gemm_phase<EpiF32, RowOrder, true, true>(F.lds + RING_OFF, g, S, E); }
        { pg8::Gemm g{(const bf16*)(F.ws + WS_YAB) + QW, (const bf16*)(F.ws + WS_WBR) + (size_t)l * D * D + QW, M, D, QW, D, D};
          RowOrder S; S.init(lat, D, F.G, (int)blockIdx.x); EpiF32 E{(float*)(F.ws + WS_T2), D};
          pg8::gemm_phase<EpiF32, RowOrder, true, true>(F.lds + RING_OFF, g, S, E); }
    }
}
template <bool DRY>
__device__ __forceinline__ void fast_out(Frame& F, int l) {
    const bool lat = (l == DEPTH - 1);
    pg8::Gemm g{(const bf16*)(F.ws + WS_MB), (const bf16*)(F.ws + WS_WOUT) + (size_t)l * D * D, M, D, D, D, D};
    RowOrder S; S.init(lat, D, F.G, (int)blockIdx.x);
    if constexpr (FUSE_RES && !DRY) { EpiRes E{(bf16*)(F.ws + WS_XW), (const float*)(F.ws + WS_MOD) + (size_t)l * 5 * MODW + 2 * D, (X0_DIRECT && l == 0) ? INP(IN_X) : nullptr, (X0_DIRECT && l == 0) ? INP(IN_CTX) : nullptr};
        pg8::gemm_phase<EpiRes, RowOrder, true, true>(F.lds + RING_OFF, g, S, E); }
    else { EpiF32 E{(float*)(F.ws + WS_T3), D};
        pg8::gemm_phase<EpiF32, RowOrder, true, true>(F.lds + RING_OFF, g, S, E); }
}

__device__ __forceinline__ void merge_one(Frame& F, int l, bool has, int idx) {
    pg8::Gemm g{(const bf16*)(F.ws + WS_YAB), (const bf16*)(F.ws + WS_WBR) + (size_t)l * D * D, M, D, D, D, D};
    OneUnit S{has, pg8::Unit{idx >> 3, idx & 7}}; EpiGateK E{(const bf16*)(F.ws + WS_GA), (const bf16*)(F.ws + WS_GB), (bf16*)(F.ws + WS_MB)};
    pg8::gemm_phase<EpiGateK, OneUnit, true, true>(F.lds + RING_OFF, g, S, E);
}
__device__ __forceinline__ void out_one(Frame& F, int l, bool has, int idx) {
    pg8::Gemm g{(const bf16*)(F.ws + WS_MB), (const bf16*)(F.ws + WS_WOUT) + (size_t)l * D * D, M, D, D, D, D};
    OneUnit S{has, pg8::Unit{idx >> 3, idx & 7}}; EpiRes E{(bf16*)(F.ws + WS_XW), (const float*)(F.ws + WS_MOD) + (size_t)l * 5 * MODW + 2 * D, (X0_DIRECT && l == 0) ? INP(IN_X) : nullptr, (X0_DIRECT && l == 0) ? INP(IN_CTX) : nullptr};
    pg8::gemm_phase<EpiRes, OneUnit, true, true>(F.lds + RING_OFF, g, S, E);
}
constexpr int PH_P0 = 0, PH_P0B = 1, PH_L0 = 2, PH_PER_LAYER = 11, PH_FINAL = PH_L0 + PH_PER_LAYER * DEPTH, NPH = PH_FINAL + 1;
enum { L_NORM1 = 0, L_INPROJ = 1, L_POST = 2, L_ATTN = 3, L_BR = 4, L_GATE = 5, L_OUT = 6, L_NORM2R = 7, L_COMPACT = 8, L_UP = 9, L_DOWN = 10 };
struct Args { const float* in[NIN]; float* out; unsigned char* ws; int ph_lo, ph_hi, li, pad; };

__global__ void __launch_bounds__(NWAVES * 64, 2) mk_fwd(Args args) {
    extern __shared__ __attribute__((aligned(16))) unsigned char lds[];
    Frame F;
    F.lds = (LAS unsigned char*)lds;
    F.MISC = (volatile LAS unsigned*)(F.lds + MISC_OFF);
    F.tid = threadIdx.x; F.lane = F.tid & 63; F.wave = __builtin_amdgcn_readfirstlane(F.tid >> 6);
    F.G = gridDim.x; { const int bx = blockIdx.x; F.vcu = (F.G % 8 == 0) ? (bx % 8) * (F.G / 8) + bx / 8 : bx; }
    F.ws = args.ws; F.out = args.out; F.ctl = (gu32*)(args.ws + WS_CTL);
    for (int u = F.tid; u < (LDS_BYTES - LDSCTL_OFF) / 4; u += NWAVES * 64) ((LAS unsigned*)(F.lds + LDSCTL_OFF))[u] = 0u;
    __syncthreads();
    if (F.tid < NIN) ((LAS cfptr*)(F.lds + LDSCTL_OFF + 256))[F.tid] = args.in[F.tid];
    __syncthreads();
    XcdBarrier bar = xcd_barrier_post((unsigned*)(F.ctl + CW_BAR) + args.li * XCD_BAR_WORDS, F.MISC + 8);
    const int lo = args.ph_lo, hi = args.ph_hi;
    const int n2nd = (M / 256) * (D / 256) - (int)gridDim.x;
    const int idle_wk = (n2nd > 0 && n2nd < (int)gridDim.x) ? ((int)blockIdx.x >= n2nd ? (int)blockIdx.x - n2nd : -1) : (int)blockIdx.x, idle_n = (n2nd > 0 && n2nd < (int)gridDim.x) ? (int)gridDim.x - n2nd : (int)gridDim.x;
    const int nrep2 = 2 + args.pad;
#define IN(k) (lo <= (k) && (k) < hi)
    const bool redeal_ok = (gridDim.x == 256) && IN(PH_L0 + L_BR) && IN(PH_L0 + L_OUT);
#if TPROBE >= 0
#define TSOFF(s) (((s) < 6) ? 448 + 8 * (s) : 800 + 8 * (s))
#define TSTAMP(k) do { if (blockIdx.x == TPROBE_BLK && F.tid == 0) *(volatile LAS unsigned long long*)(F.lds + LDSCTL_OFF + TSOFF((k) + 1)) = __builtin_amdgcn_s_memrealtime(); } while (0)
#else
#define TSTAMP(k) do { } while (0)
#endif
#if TPROBE >= 300
#define TSTAMPX(slot, l_) do { if (F.tid == 0 && (l_) == 1) { const unsigned long long tn_ = __builtin_amdgcn_s_memrealtime(); if (blockIdx.x == TPROBE_BLK) ((volatile LAS unsigned long long*)(F.lds + LDSCTL_OFF + 800))[slot] = tn_; atomicMax((unsigned*)F.ctl + 200000 + 512, ((unsigned)tn_ << 8) | (unsigned)blockIdx.x); } } while (0)
#else
#define TSTAMPX(slot, l_) do { } while (0)
#endif
#define SEAM(k) do { if (IN(k) && IN((k) + 1)) { xcd_barrier(bar); if (REPMASK & (1 << 12)) xcd_barrier(bar); } TSTAMP(k); } while (0)
    TSTAMP(-1);

    const bool attn_slot = P0_SPLIT && redeal_ok && IN(PH_P0) && IN(PH_L0 + L_ATTN);
    if (IN(PH_P0)) p0_work(F, 0, P0_SPLIT ? 1 : DEPTH, F.vcu, F.G, attn_slot ? (1 | 8) : 3, true);
    SEAM(PH_P0);
    if (IN(PH_P0B)) p0b_reduce(F, 0, P0_SPLIT ? 1 : DEPTH, F.vcu, F.G);
    SEAM(PH_P0B);
#define LAYER_PROGRAM(l) do { constexpr int pb = PH_L0 + PH_PER_LAYER * (l); \
        if (IN(pb + L_NORM1)) { ph_norm1<false>(F, (l)); if (REPMASK & (1 << L_NORM1)) ph_norm1<true>(F, (l)); } \
        SEAM(pb + L_NORM1); \
        if (IN(pb + L_INPROJ)) { if constexpr (FAST_INPROJ) { fast_inproj(F, (l)); if (REPMASK & (1 << L_INPROJ)) fast_inproj(F, (l)); } } \
        SEAM(pb + L_INPROJ); \
        if (IN(pb + L_POST)) { if constexpr (!FUSE_POST) { ph_post(F, (l)); if (REPMASK & (1 << L_POST)) ph_post(F, (l)); } } \
        if constexpr (!FUSE_POST) SEAM(pb + L_POST); \
        if (IN(pb + L_ATTN)) { if constexpr (FAST_ATTN) { _Pragma("nounroll") for (int rep_ = 0; rep_ < ((REPMASK & (1 << L_ATTN)) ? nrep2 : 1); ++rep_) fast_attn(F, (l)); \
            if ((l) == 0 && attn_slot) { const int bx_ = (int)blockIdx.x, y_ = bx_ >> 3, qb_ = y_ & 7; if (qb_ != 0 && qb_ != 7) p0_work(F, 0, 1, (((y_ >> 3) * 6 + (qb_ - 1)) << 3) + (bx_ & 7), 192, 4, false); } } } \
        SEAM(pb + L_ATTN); \
        if (IN(pb + L_BR)) { if constexpr (FAST_BR) { \
            if (REDEAL && (l) == 0 && redeal_ok) { merge_one(F, 0, true, F.vcu); xcd_barrier(bar); \
                if (F.vcu < 32) merge_one(F, 0, true, 256 + F.vcu); else out_one(F, 0, true, F.vcu - 32); } \
            else { _Pragma("nounroll") for (int rep_ = 0; rep_ < ((REPMASK & (1 << L_BR)) ? nrep2 : 1); ++rep_) fast_br(F, (l)); \
                if (P0_SPLIT && (l) == 0 && idle_wk >= 0) p0_work(F, 1, DEPTH, idle_wk, idle_n, 1, false); } } } \
        SEAM(pb + L_BR); \
        if (IN(pb + L_GATE)) { if constexpr (!FUSE_GATE) ph_gate(F, (l)); } \
        if constexpr (!FUSE_GATE) SEAM(pb + L_GATE); \
        if (IN(pb + L_OUT)) { if constexpr (FAST_OUT) { \
            if (REDEAL && (l) == 0 && redeal_ok) { if (F.vcu < 64) out_one(F, 0, true, 224 + F.vcu); else if (P0_SPLIT) p0_work(F, 1, DEPTH, F.vcu - 64, F.G - 64, 3, false); } \
            else { if (REPMASK & (1 << L_OUT)) fast_out<true>(F, (l)); fast_out<false>(F, (l)); TSTAMPX(27, (l)); \
                if (P0_SPLIT && (l) == 0 && idle_wk >= 0) p0_work(F, 1, DEPTH, idle_wk, idle_n, 2, false); } } } \
        SEAM(pb + L_OUT); \
        if (IN(pb + L_NORM2R)) { if (REPMASK & (1 << L_NORM2R)) ph_norm2_router<!FUSE_RES, true>(F, (l)); ph_norm2_router<!FUSE_RES, false>(F, (l)); } \
        SEAM(pb + L_NORM2R); \
        if (IN(pb + L_COMPACT)) { ph_compact(F, (l)); if (P0_SPLIT && (l) == 0 && F.vcu >= NE) p0b_reduce(F, 1, DEPTH, F.vcu - NE, F.G - NE); } \
        SEAM(pb + L_COMPACT); \
        if (IN(pb + L_UP)) { if constexpr (FAST_UP) { fast_moe_up(F, (l)); } } \
        SEAM(pb + L_UP); \
        if (IN(pb + L_DOWN)) { if constexpr (FAST_DOWN) { fast_moe_down(F, (l)); } } \
        SEAM(pb + L_DOWN); } while (0)
    LAYER_PROGRAM(0);
    LAYER_PROGRAM(1);
#undef LAYER_PROGRAM
    if (IN(PH_FINAL)) { ph_final(F); if (REPMASK & (1 << 11)) ph_final(F); }
#if TPROBE >= 0
    if (blockIdx.x == TPROBE_BLK && F.tid == 0) { volatile LAS unsigned long long* ts = (volatile LAS unsigned long long*)(F.lds + LDSCTL_OFF + 800);
        const unsigned long long dt = (TPROBE == 302) ? (unsigned long long)(((const unsigned*)F.ctl)[200000 + 512] & 255u) * 100ull : (TPROBE == 303) ? (unsigned long long)((((const unsigned*)F.ctl)[200000 + 512] >> 8) - (((unsigned)ts[18]) & 0xffffffu)) & 0xffffffull : (TPROBE == 300) ? ts[27] - ts[18] : (TPROBE == 301) ? ts[20] - ts[27] : (TPROBE >= 200) ? (unsigned long long)(((const unsigned*)F.ctl)[200000 + 64 * (TPROBE - 200)] - (unsigned)ts[0]) : (TPROBE >= 100) ? ts[26] : *(volatile LAS unsigned long long*)(F.lds + LDSCTL_OFF + TSOFF((TPROBE_HI < 0 ? 0 : TPROBE_HI) + 1)) - *(volatile LAS unsigned long long*)(F.lds + LDSCTL_OFF + TSOFF(TPROBE >= 100 ? 0 : TPROBE)), t0 = __builtin_amdgcn_s_memrealtime();
        while (__builtin_amdgcn_s_memrealtime() - t0 < 4ull * dt) __builtin_amdgcn_s_sleep(8); }
#endif
#if CNTPROBE
    xcd_barrier(bar);
    if (blockIdx.x == 0) {
        const unsigned* cnt = (const unsigned*)F.ctl + CW_CNT + (CNTPROBE_L) * 64; unsigned mx = 0, mn = 1u << 30, big = 0, big2 = 0;
        for (int e = 0; e < NE; ++e) { const unsigned c = cnt[e]; mx = c > mx ? c : mx; mn = c < mn ? c : mn; big += c > 384 ? 1 : 0; big2 += c > 512 ? 1 : 0; }
        const float val = CNTPROBE == 1 ? (float)mx : CNTPROBE == 2 ? (float)big : CNTPROBE == 3 ? (float)mn : (float)big2;
        const float c1 = sqrtf(val);
        for (size_t i = F.tid; i < (size_t)NB * SEQ * D; i += NWAVES * 64) F.out[i] = c1;
    }
#endif
#undef IN
#undef SEAM
}

static bool phase_is_naive(int ph) {
    if (ph < PH_L0 || ph == PH_FINAL) return false;
    const int k = (ph - PH_L0) % PH_PER_LAYER;
    switch (k) { case L_INPROJ: return !FAST_INPROJ; case L_ATTN: return !FAST_ATTN; case L_BR: return !FAST_BR; case L_OUT: return !FAST_OUT; case L_UP: return !FAST_UP; case L_DOWN: return !FAST_DOWN; default: return false; }
}
extern "C" void kernel_launch(void* const* d_in, const int* in_sizes, int n_in, void* d_out, int out_size, void* d_ws, size_t ws_size, hipStream_t stream) {
    static int grid = 0;
    if (grid == 0) {
        if (n_in != NIN || in_sizes[0] != NB * SEQ * D || out_size != NB * SEQ * D || ws_size < WS_END) { fprintf(stderr, "kernel_launch: shape/workspace mismatch (n_in %d, ws %zu)\n", n_in, ws_size); grid = -1; return; }
        int dev = 0, cus = 0, per_cu = 0;
        if (hipGetDevice(&dev) != hipSuccess || hipDeviceGetAttribute(&cus, hipDeviceAttributeMultiprocessorCount, dev) != hipSuccess) { grid = -1; return; }
        if (hipFuncSetAttribute((const void*)mk_fwd, hipFuncAttributeMaxDynamicSharedMemorySize, LDS_BYTES) != hipSuccess) { fprintf(stderr, "kernel_launch: hipFuncSetAttribute failed\n"); grid = -1; return; }
        if (hipOccupancyMaxActiveBlocksPerMultiprocessor(&per_cu, (const void*)mk_fwd, NWAVES * 64, LDS_BYTES) != hipSuccess || per_cu < 1) fprintf(stderr, "kernel_launch: occupancy query reports %d\n", per_cu);
        (void)hipGetLastError();
        grid = cus;
    }
    if (grid < 0) return;
    unsigned char* ws = (unsigned char*)d_ws;
    (void)hipMemsetAsync(ws + WS_CTL, 0, CTL_ZERO_BYTES, stream);
    Args a{};
    for (int i = 0; i < NIN; ++i) a.in[i] = (const float*)d_in[i];
    a.out = (float*)d_out; a.ws = ws;
    const float* const* in = (const float* const*)d_in;
    int li = 0, lo = -1;
    for (int ph = 0; ph < NPH; ++ph) {
        const bool nv = phase_is_naive(ph);
        if (!nv && lo < 0) lo = ph;
        if (nv || ph == NPH - 1) {
            if (lo >= 0) { a.ph_lo = lo; a.ph_hi = nv ? ph : ph + 1; a.li = li++; hipLaunchKernelGGL(mk_fwd, dim3(grid), dim3(NWAVES * 64), LDS_BYTES, stream, a); lo = -1; }
            if (nv) {
                const int l = (ph - PH_L0) / PH_PER_LAYER, k = (ph - PH_L0) % PH_PER_LAYER;
                const unsigned* cnt = (const unsigned*)ws + CW_CNT + l * 64;
                if (k == L_INPROJ) hipLaunchKernelGGL(naive_gemm<1>, dim3(INC / 64, M / 32), dim3(64, 4), 0, stream, (const bf16*)(ws + WS_HA), D, in[IN_WIN] + (size_t)l * D * INC, INC, (float*)(ws + WS_P), INC, D);
                else if (k == L_ATTN) { const int wq = (l < DEPTH - 1) ? 1 : 0; const long items = (long)NB * NH * (wq ? TT : SEQ);
                    hipLaunchKernelGGL(naive_attn, dim3((unsigned)((items + 3) / 4)), dim3(256), 0, stream, (const bf16*)(ws + WS_QA), (const bf16*)(ws + WS_KA), (const bf16*)(ws + WS_VA), (bf16*)(ws + WS_YAB), (const float*)nullptr, 0, wq);
                    hipLaunchKernelGGL(naive_attn, dim3((unsigned)((items + 3) / 4)), dim3(256), 0, stream, (const bf16*)(ws + WS_QB), (const bf16*)(ws + WS_KB), (const bf16*)(ws + WS_VB), (bf16*)(ws + WS_YAB) + QW, in[IN_SINK] + l * NH, 1, wq); }
                else if (k == L_BR) { hipLaunchKernelGGL(naive_gemm<0>, dim3(D / 64, M / 32), dim3(64, 4), 0, stream, (const bf16*)(ws + WS_YAB), D, in[IN_WBRA] + (size_t)l * QW * D, D, (float*)(ws + WS_T1), D, QW);
                    hipLaunchKernelGGL(naive_gemm<0>, dim3(D / 64, M / 32), dim3(64, 4), 0, stream, (const bf16*)(ws + WS_YAB) + QW, D, in[IN_WBRB] + (size_t)l * QW * D, D, (float*)(ws + WS_T2), D, QW); }
                else if (k == L_OUT) hipLaunchKernelGGL(naive_gemm<0>, dim3(D / 64, M / 32), dim3(64, 4), 0, stream, (const bf16*)(ws + WS_MB), D, in[IN_WOUT] + (size_t)l * D * D, D, (float*)(ws + WS_T3), D, D);
                else if (k == L_UP) hipLaunchKernelGGL(naive_moe_up, dim3(DE / 64, 2 * M / 4), dim3(64, 4), 0, stream, (const bf16*)(ws + WS_HA), in[IN_W1] + (size_t)l * NE * D * DE, in[IN_W3] + (size_t)l * NE * D * DE, cnt, (const unsigned*)(ws + WS_LIST) + (size_t)l * NE * M, (bf16*)(ws + WS_HB));
                else if (k == L_DOWN) hipLaunchKernelGGL(naive_moe_down, dim3(D / 64, 2 * M / 4), dim3(64, 4), 0, stream, (const bf16*)(ws + WS_HB), in[IN_W2] + (size_t)l * NE * DE * D, cnt, (bf16*)(ws + WS_YM));
            }
        }
    }
    const hipError_t le = hipPeekAtLastError();
    if (le != hipSuccess) fprintf(stderr, "kernel_launch: launch failed: %s\n", hipGetErrorName(le));
}
```
